# Optimizing an MI355X kernel written in HIP

```python
import math
import jax, jax.numpy as jnp
from jax import lax
import numpy as np

D_MODEL = 1024
BATCH = 8
SEQ = 2048
DEPTH = 2

S5_WIDTH = D_MODEL // 2
S5_GROUP = 16
S5_GROUPS = S5_WIDTH // S5_GROUP
S5_STATE = 64
S5_DT_MIN = 0.001
S5_DT_MAX = 0.1
S5_DIRS = 2
HY_WIDTH = D_MODEL
HY_ORDER = 2
HY_SHORT = 3
HY_BANDS = 16
HY_EMB = 1 + 2 * HY_BANDS
HY_FFN = 64
HY_DIRS = 2
HY_FILTERS = HY_ORDER * HY_DIRS * HY_WIDTH
HY_DECAY_TARGET = 1e-2
HY_FAST_PCT = 0.3
HY_SLOW_PCT = 1.5
HY_SHIFT = 0.05
HY_EPS = 1e-6
N_BRANCH = 2
RMS_EPS = 1e-6
IN_COLS = 2 * S5_WIDTH + (HY_ORDER + 1) * HY_WIDTH + HY_WIDTH + N_BRANCH * D_MODEL
SPLITS = [S5_WIDTH, 2 * S5_WIDTH, 2 * S5_WIDTH + (HY_ORDER + 1) * HY_WIDTH,
          2 * S5_WIDTH + (HY_ORDER + 2) * HY_WIDTH]

kernel_name = "hybrid_s5_hyena_gated_encoder"


def rmsnorm(x, w):
    xf = x.astype(jnp.float32)
    y = xf * lax.rsqrt(jnp.mean(xf * xf, axis=-1, keepdims=True) + RMS_EPS)
    return (y * w.astype(jnp.float32)).astype(x.dtype)


def _cmul(ar, ai, br, bi):
    return ar * br - ai * bi, ar * bi + ai * br


def _s5_combine(e1, e2):
    a1r, a1i, b1r, b1i = e1
    a2r, a2i, b2r, b2i = e2
    ar, ai = _cmul(a1r, a1i, a2r, a2i)
    tr, ti = _cmul(a2r, a2i, b1r, b1i)
    return ar, ai, tr + b2r, ti + b2i


def s5_direction(u, lam_re, lam_im, log_step, b_re, b_im, c_re, c_im, reverse):
    dt = jnp.exp(log_step)[:, None]
    mag = jnp.exp(lam_re * dt)
    ang = lam_im * dt
    lbar_re, lbar_im = mag * jnp.cos(ang), mag * jnp.sin(ang)
    nr, ni = lbar_re - 1.0, lbar_im
    den = lam_re * lam_re + lam_im * lam_im
    kr = (nr * lam_re + ni * lam_im) / den
    ki = (ni * lam_re - nr * lam_im) / den
    bb_re, bb_im = _cmul(kr[..., None], ki[..., None], b_re, b_im)
    bu_re = jnp.einsum('blgh,gph->blgp', u, bb_re)
    bu_im = jnp.einsum('blgh,gph->blgp', u, bb_im)
    L = u.shape[1]
    a_re = jnp.broadcast_to(lbar_re, (1, L) + lbar_re.shape)
    a_im = jnp.broadcast_to(lbar_im, (1, L) + lbar_im.shape)
    _, _, s_re, s_im = lax.associative_scan(_s5_combine, (a_re, a_im, bu_re, bu_im),
                                            reverse=reverse, axis=1)
    return (jnp.einsum('ghp,blgp->blgh', c_re, s_re)
            - jnp.einsum('ghp,blgp->blgh', c_im, s_im))


def s5_mixer(u, gate, lam_re, lam_im, log_step, b_re, b_im, c_re, c_im, d, w_glu, b_glu):
    bsz, L, _ = u.shape
    f32 = jnp.float32
    uf = u.astype(f32).reshape(bsz, L, S5_GROUPS, S5_GROUP)
    y = uf * d.astype(f32).reshape(S5_GROUPS, S5_GROUP)
    for direction, rev in enumerate((False, True)):
        y = y + s5_direction(uf, lam_re[direction].astype(f32), lam_im[direction].astype(f32),
                             log_step[direction].astype(f32), b_re[direction].astype(f32),
                             b_im[direction].astype(f32), c_re[direction].astype(f32),
                             c_im[direction].astype(f32), rev)
    y = y.reshape(bsz, L, S5_WIDTH).astype(u.dtype)
    y = jax.nn.gelu(y)
    y = y * jax.nn.sigmoid(y @ w_glu + b_glu)
    return y * jax.nn.silu(gate)


def hyena_filters(L, w1, b1, freq, w2, b2, w3, decay):
    f32 = jnp.float32
    t = jnp.linspace(0.0, 1.0, L, dtype=f32)[:, None]
    pos = jnp.arange(L, dtype=f32)[:, None]
    bands = jnp.linspace(1e-4, HY_BANDS - 1, HY_BANDS, dtype=f32)[None, :]
    ang = bands * pos * (2.0 * math.pi / L)
    feats = jnp.concatenate([t, jnp.cos(ang), -jnp.sin(ang)], axis=-1)
    fr = freq.astype(f32)
    h = jnp.sin(fr * (feats @ w1.astype(f32) + b1.astype(f32)))
    h = jnp.sin(fr * (h @ w2.astype(f32) + b2.astype(f32)))
    h = h @ w3.astype(f32)
    h = h * (jnp.exp(-t * jnp.abs(decay.astype(f32))) + HY_SHIFT)
    h = h.reshape(L, HY_ORDER, HY_DIRS, HY_WIDTH)
    h_fwd, h_bwd = h[:, :, 0], h[:, :, 1]
    k = jnp.concatenate([h_fwd, jnp.zeros_like(h_fwd[:1]), jnp.flip(h_bwd[1:], axis=0)], axis=0)
    k = k * lax.rsqrt(jnp.sum(k * k, axis=0, keepdims=True) + HY_EPS)
    return jnp.fft.rfft(k, axis=0)


def hyena_mixer(proj, gate, conv_w, conv_b, w1, b1, freq, w2, b2, w3, decay, d):
    f32 = jnp.float32
    bsz, L, _ = proj.shape
    pad = HY_SHORT // 2
    pp = jnp.pad(proj, ((0, 0), (pad, pad), (0, 0)))
    sc = conv_b
    for j in range(HY_SHORT):
        sc = sc + pp[:, j:j + L] * conv_w[j]
    v, x1, x2 = jnp.split(sc, HY_ORDER + 1, axis=-1)
    kf = hyena_filters(L, w1, b1, freq, w2, b2, w3, decay)
    z = v.astype(f32)
    for o, g in enumerate((x1, x2)):
        zf = jnp.fft.rfft(z, n=2 * L, axis=1)
        conv = jnp.fft.irfft(zf * kf[:, o][None], n=2 * L, axis=1)[:, :L]
        z = g.astype(f32) * (conv + d[o].astype(f32) * z)
    return z.astype(proj.dtype) * jax.nn.silu(gate)


def setup_inputs(seed: int = 0) -> dict:
    key = jax.random.key(seed)
    ks = jax.random.split(key, 32)
    f32 = jnp.float32
    nrm = lambda k, shape, s: jax.random.normal(k, shape, f32) * s
    x = nrm(ks[0], (BATCH, SEQ, D_MODEL), 1.0)
    norm_w = 1.0 + nrm(ks[1], (DEPTH, D_MODEL), 0.02)
    w_in = nrm(ks[2], (DEPTH, D_MODEL, IN_COLS), D_MODEL ** -0.5)
    n_idx = jnp.arange(S5_STATE, dtype=f32)
    s5_lam_re = -0.5 + nrm(ks[3], (DEPTH, S5_DIRS, S5_GROUPS, S5_STATE), 0.01)
    s5_lam_im = math.pi * n_idx + nrm(ks[4], (DEPTH, S5_DIRS, S5_GROUPS, S5_STATE), 0.01)
    s5_log_step = (math.log(S5_DT_MIN) + jax.random.uniform(ks[5], (DEPTH, S5_DIRS, S5_GROUPS), f32)
                   * (math.log(S5_DT_MAX) - math.log(S5_DT_MIN)))
    s5_b_re = nrm(ks[6], (DEPTH, S5_DIRS, S5_GROUPS, S5_STATE, S5_GROUP), (2 * S5_GROUP) ** -0.5)
    s5_b_im = nrm(ks[7], (DEPTH, S5_DIRS, S5_GROUPS, S5_STATE, S5_GROUP), (2 * S5_GROUP) ** -0.5)
    s5_c_re = nrm(ks[8], (DEPTH, S5_DIRS, S5_GROUPS, S5_GROUP, S5_STATE), S5_STATE ** -0.5)
    s5_c_im = nrm(ks[9], (DEPTH, S5_DIRS, S5_GROUPS, S5_GROUP, S5_STATE), S5_STATE ** -0.5)
    s5_d = nrm(ks[10], (DEPTH, S5_WIDTH), 1.0)
    s5_w_glu = nrm(ks[11], (DEPTH, S5_WIDTH, S5_WIDTH), S5_WIDTH ** -0.5)
    s5_b_glu = nrm(ks[12], (DEPTH, S5_WIDTH), 0.01)
    hy_conv_w = nrm(ks[13], (DEPTH, HY_SHORT, (HY_ORDER + 1) * HY_WIDTH), HY_SHORT ** -0.5)
    hy_conv_b = nrm(ks[14], (DEPTH, (HY_ORDER + 1) * HY_WIDTH), 0.01)
    hy_w1 = nrm(ks[15], (DEPTH, HY_EMB, HY_FFN), HY_EMB ** -0.5)
    hy_b1 = nrm(ks[16], (DEPTH, HY_FFN), 0.1)
    hy_freq = 1.0 + nrm(ks[17], (DEPTH, HY_FFN), 0.02)
    hy_w2 = nrm(ks[18], (DEPTH, HY_FFN, HY_FFN), HY_FFN ** -0.5)
    hy_b2 = nrm(ks[19], (DEPTH, HY_FFN), 0.1)
    hy_w3 = nrm(ks[20], (DEPTH, HY_FFN, HY_FILTERS), HY_FFN ** -0.5)
    min_decay = math.log(HY_DECAY_TARGET) / HY_SLOW_PCT
    max_decay = math.log(HY_DECAY_TARGET) / HY_FAST_PCT
    base_decay = jnp.tile(jnp.linspace(min_decay, max_decay, HY_WIDTH, dtype=f32), HY_ORDER * HY_DIRS)
    hy_decay = base_decay[None, :] + nrm(ks[21], (DEPTH, HY_FILTERS), 0.01)
    hy_d = nrm(ks[22], (DEPTH, HY_ORDER, HY_WIDTH), 0.5)
    w_branch_s5 = nrm(ks[23], (DEPTH, S5_WIDTH, D_MODEL), S5_WIDTH ** -0.5)
    w_branch_hy = nrm(ks[24], (DEPTH, HY_WIDTH, D_MODEL), HY_WIDTH ** -0.5)
    w_out = nrm(ks[25], (DEPTH, D_MODEL, D_MODEL), D_MODEL ** -0.5)
    final_norm_w = 1.0 + nrm(ks[26], (D_MODEL,), 0.02)
    return {"x": x, "norm_w": norm_w, "w_in": w_in,
            "s5_lam_re": s5_lam_re, "s5_lam_im": s5_lam_im, "s5_log_step": s5_log_step,
            "s5_b_re": s5_b_re, "s5_b_im": s5_b_im, "s5_c_re": s5_c_re, "s5_c_im": s5_c_im,
            "s5_d": s5_d, "s5_w_glu": s5_w_glu, "s5_b_glu": s5_b_glu,
            "hy_conv_w": hy_conv_w, "hy_conv_b": hy_conv_b, "hy_w1": hy_w1, "hy_b1": hy_b1,
            "hy_freq": hy_freq, "hy_w2": hy_w2, "hy_b2": hy_b2, "hy_w3": hy_w3,
            "hy_decay": hy_decay, "hy_d": hy_d,
            "w_branch_s5": w_branch_s5, "w_branch_hy": w_branch_hy, "w_out": w_out,
            "final_norm_w": final_norm_w}


def reference(x, norm_w, w_in, s5_lam_re, s5_lam_im, s5_log_step, s5_b_re, s5_b_im, s5_c_re, s5_c_im,
              s5_d, s5_w_glu, s5_b_glu, hy_conv_w, hy_conv_b, hy_w1, hy_b1, hy_freq, hy_w2, hy_b2,
              hy_w3, hy_decay, hy_d, w_branch_s5, w_branch_hy, w_out, final_norm_w):
    h = x
    for l in range(DEPTH):
        xn = rmsnorm(h, norm_w[l])
        proj = xn @ w_in[l]
        u_s5, g_s5, p_hy, g_hy, m_logits = jnp.split(proj, SPLITS, axis=-1)
        y_s5 = s5_mixer(u_s5, g_s5, s5_lam_re[l], s5_lam_im[l], s5_log_step[l], s5_b_re[l], s5_b_im[l],
                        s5_c_re[l], s5_c_im[l], s5_d[l], s5_w_glu[l], s5_b_glu[l]) @ w_branch_s5[l]
        y_hy = hyena_mixer(p_hy, g_hy, hy_conv_w[l], hy_conv_b[l], hy_w1[l], hy_b1[l], hy_freq[l],
                           hy_w2[l], hy_b2[l], hy_w3[l], hy_decay[l], hy_d[l]) @ w_branch_hy[l]
        m = jax.nn.sigmoid(m_logits)
        merged = m[..., :D_MODEL] * y_s5 + m[..., D_MODEL:] * y_hy
        h = h + merged @ w_out[l]
    return rmsnorm(h, final_norm_w)
```

```cpp
#include <hip/hip_runtime.h>
#include <math.h>

namespace nv {
constexpr int D = 1024, BATCH = 8, SEQ = 2048, DEPTH = 2, M = BATCH * SEQ;
constexpr int S5W = 512, S5H = 16, S5G = 32, S5P = 64;
constexpr int HYW = 1024, HYF = 4096, HYE = 33, HYN = 64;
constexpr int INC = 7168;

__global__ void k_rmsnorm(const float* __restrict__ h, const float* __restrict__ w, float* __restrict__ out) {
    const int row = blockIdx.x; const float* x = h + (size_t)row * D; __shared__ float red[256];
    float s = 0.f; for (int i = threadIdx.x; i < D; i += 256) s += x[i] * x[i];
    red[threadIdx.x] = s; __syncthreads();
    for (int o = 128; o > 0; o >>= 1) { if (threadIdx.x < o) red[threadIdx.x] += red[threadIdx.x + o]; __syncthreads(); }
    const float r = rsqrtf(red[0] / D + 1e-6f);
    for (int i = threadIdx.x; i < D; i += 256) out[(size_t)row * D + i] = x[i] * r * w[i];
}
__global__ void k_gemm(const float* __restrict__ A, int lda, const float* __restrict__ B, int ldb, float* C, int ldc, const float* base, int ldbase, int Mm, int Nn, int Kk) {
    __shared__ float As[16][65], Bs[16][65];
    const int tx = threadIdx.x & 15, ty = threadIdx.x >> 4, r0 = blockIdx.y * 64, c0 = blockIdx.x * 64;
    float acc[4][4] = {};
    for (int k0 = 0; k0 < Kk; k0 += 16) {
        for (int i = threadIdx.x; i < 64 * 16; i += 256) { const int r = i >> 4, k = i & 15; As[k][r] = A[(size_t)(r0 + r) * lda + k0 + k]; }
        for (int i = threadIdx.x; i < 64 * 16; i += 256) { const int k = i >> 6, c = i & 63; Bs[k][c] = B[(size_t)(k0 + k) * ldb + c0 + c]; }
        __syncthreads();
#pragma unroll
        for (int k = 0; k < 16; ++k) { float a[4], b[4];
#pragma unroll
            for (int i = 0; i < 4; ++i) { a[i] = As[k][ty * 4 + i]; b[i] = Bs[k][tx * 4 + i]; }
#pragma unroll
            for (int i = 0; i < 4; ++i)
#pragma unroll
                for (int j = 0; j < 4; ++j) acc[i][j] += a[i] * b[j]; }
        __syncthreads();
    }
    for (int i = 0; i < 4; ++i) for (int j = 0; j < 4; ++j) { const int r = r0 + ty * 4 + i, c = c0 + tx * 4 + j;
        C[(size_t)r * ldc + c] = acc[i][j] + (base ? base[(size_t)r * ldbase + c] : 0.f); }
}
__global__ void k_s5_prep(const float* lam_re, const float* lam_im, const float* log_step, const float* b_re, const float* b_im, float* lbar, float* bb) {
    const int i = blockIdx.x * blockDim.x + threadIdx.x; if (i >= 2 * S5G * S5P) return;
    const int dg = i / S5P; const float dt = expf(log_step[dg]);
    const float lr = lam_re[i], li = lam_im[i]; const float mag = expf(lr * dt), ang = li * dt;
    const float br = mag * cosf(ang), bi = mag * sinf(ang); lbar[2 * i] = br; lbar[2 * i + 1] = bi;
    const float nr = br - 1.f, ni = bi, den = lr * lr + li * li; const float kr = (nr * lr + ni * li) / den, ki = (ni * lr - nr * li) / den;
    for (int h = 0; h < S5H; ++h) { const float xr = b_re[(size_t)i * S5H + h], xi = b_im[(size_t)i * S5H + h];
        bb[((size_t)i * S5H + h) * 2] = kr * xr - ki * xi; bb[((size_t)i * S5H + h) * 2 + 1] = kr * xi + ki * xr; }
}
__global__ void k_s5_scan(const float* __restrict__ u, int ldu, const float* __restrict__ lbar, const float* __restrict__ bb, const float* __restrict__ c_re, const float* __restrict__ c_im, float* __restrict__ yf, float* __restrict__ yb) {
    const int g = blockIdx.x, dir = blockIdx.y, p = threadIdx.x; const int i = (dir * S5G + g) * S5P + p;
    __shared__ float ss[2][S5P]; __shared__ float us[S5H];
    const float ar = lbar[2 * i], ai = lbar[2 * i + 1]; float br[S5H], bi[S5H];
    for (int h = 0; h < S5H; ++h) { br[h] = bb[((size_t)i * S5H + h) * 2]; bi[h] = bb[((size_t)i * S5H + h) * 2 + 1]; }
    const int hh = p & 15, q = p >> 4; float cr[16], ci[16];
    for (int j = 0; j < 16; ++j) { cr[j] = c_re[((size_t)(dir * S5G + g) * S5H + hh) * S5P + 16 * q + j]; ci[j] = c_im[((size_t)(dir * S5G + g) * S5H + hh) * S5P + 16 * q + j]; }
    float sr = 0.f, si = 0.f; float* y = dir ? yb : yf;
    for (int it = 0; it < SEQ; ++it) { const int t = dir ? SEQ - 1 - it : it;
        if (p < S5H) us[p] = u[(size_t)t * ldu + g * S5H + p];
        __syncthreads();
        float xr = 0.f, xi = 0.f;
#pragma unroll
        for (int h = 0; h < S5H; ++h) { xr += br[h] * us[h]; xi += bi[h] * us[h]; }
        const float nr = ar * sr - ai * si + xr, ni = ar * si + ai * sr + xi; sr = nr; si = ni;
        ss[0][p] = sr; ss[1][p] = si; __syncthreads();
        float o = 0.f;
#pragma unroll
        for (int j = 0; j < 16; ++j) o += cr[j] * ss[0][16 * q + j] - ci[j] * ss[1][16 * q + j];
        o += __shfl_xor(o, 16); o += __shfl_xor(o, 32);
        if (q == 0) y[(size_t)t * S5W + g * S5H + hh] = o;
        __syncthreads();
    }
}
__device__ __forceinline__ float gelu_tanh(float x) { return 0.5f * x * (1.f + tanhf(0.7978845608028654f * (x + 0.044715f * x * x * x))); }
__device__ __forceinline__ float sigm(float x) { return 1.f / (1.f + expf(-x)); }
__global__ void k_s5_post1(const float* u, int ldu, const float* d, const float* yf, const float* yb, float* Y) {
    const int i = blockIdx.x * 256 + threadIdx.x; if (i >= SEQ * S5W) return; const int t = i / S5W, c = i % S5W;
    Y[i] = gelu_tanh(u[(size_t)t * ldu + c] * d[c] + yf[i] + yb[i]);
}
__global__ void k_s5_post2(float* Y, const float* T, const float* bglu, const float* gate, int ldg) {
    const int i = blockIdx.x * 256 + threadIdx.x; if (i >= SEQ * S5W) return; const int t = i / S5W, c = i % S5W;
    const float g = gate[(size_t)t * ldg + c]; Y[i] = Y[i] * sigm(T[i] + bglu[c]) * (g * sigm(g));
}
__global__ void k_hy_mlp(const float* w1, const float* b1, const float* fr, const float* w2, const float* b2, float* h2) {
    const int t = blockIdx.x, j = threadIdx.x; __shared__ float f[HYE], h1[HYN];
    if (j == 0) f[0] = (float)t / (float)(SEQ - 1);
    if (j < 16) { const float band = 1e-4f + (float)j * ((15.f - 1e-4f) / 15.f); const float ang = band * (float)t * (float)(2.0 * M_PI / SEQ); f[1 + j] = cosf(ang); f[17 + j] = -sinf(ang); }
    __syncthreads();
    float a = b1[j]; for (int i = 0; i < HYE; ++i) a += f[i] * w1[i * HYN + j];
    h1[j] = sinf(fr[j] * a); __syncthreads();
    float c = b2[j]; for (int i = 0; i < HYN; ++i) c += h1[i] * w2[i * HYN + j];
    h2[t * HYN + j] = sinf(fr[j] * c);
}
__global__ void k_hy_filter(const float* h2, const float* w3, const float* decay, float* K) {
    const size_t i = (size_t)blockIdx.x * 256 + threadIdx.x; if (i >= (size_t)2 * 2 * SEQ * HYW) return;
    const int c = i % HYW; const int idx = (i / HYW) % (2 * SEQ); const int o = i / ((size_t)HYW * 2 * SEQ);
    int t, dir; if (idx < SEQ) { t = idx; dir = 0; } else if (idx == SEQ) { K[i] = 0.f; return; } else { t = 2 * SEQ - idx; dir = 1; }
    const int f = o * 2 * HYW + dir * HYW + c; float a = 0.f;
    for (int j = 0; j < HYN; ++j) a += h2[t * HYN + j] * w3[(size_t)j * HYF + f];
    const float tn = (float)t / (float)(SEQ - 1);
    K[i] = a * (expf(-tn * fabsf(decay[f])) + 0.05f);
}
__global__ void k_hy_norm(float* K) {
    const int i = blockIdx.x * 256 + threadIdx.x; if (i >= 2 * HYW) return; const int c = i % HYW, o = i / HYW;
    float* k = K + (size_t)o * 2 * SEQ * HYW + c; float s = 0.f;
    for (int idx = 0; idx < 2 * SEQ; ++idx) { const float v = k[(size_t)idx * HYW]; s += v * v; }
    const float r = rsqrtf(s + 1e-6f);
    for (int idx = 0; idx < 2 * SEQ; ++idx) k[(size_t)idx * HYW] *= r;
}
__global__ void k_shortconv(const float* p, int ldp, const float* cw, const float* cb, float* sc) {
    const int i = blockIdx.x * 256 + threadIdx.x; if (i >= SEQ * 3 * HYW) return; const int t = i / (3 * HYW), j = i % (3 * HYW);
    float a = cb[j] + cw[1 * 3 * HYW + j] * p[(size_t)t * ldp + j];
    if (t > 0) a += cw[j] * p[(size_t)(t - 1) * ldp + j];
    if (t < SEQ - 1) a += cw[2 * 3 * HYW + j] * p[(size_t)(t + 1) * ldp + j];
    sc[i] = a;
}
__global__ void k_hyconv(const float* __restrict__ z, int ldz, const float* __restrict__ K, const float* __restrict__ g, int ldg, const float* __restrict__ d, float* __restrict__ zout) {
    const int c = blockIdx.x * 64 + (threadIdx.x & 63); const int t0 = (blockIdx.y * 4 + (threadIdx.x >> 6)) * 4;
    float a0 = 0.f, a1 = 0.f, a2 = 0.f, a3 = 0.f;
    for (int s = 0; s < SEQ; ++s) { const float zz = z[(size_t)s * ldz + c]; const int l = (t0 - s) & (2 * SEQ - 1);
        a0 += K[(size_t)l * HYW + c] * zz; a1 += K[(size_t)((l + 1) & (2 * SEQ - 1)) * HYW + c] * zz; a2 += K[(size_t)((l + 2) & (2 * SEQ - 1)) * HYW + c] * zz; a3 += K[(size_t)((l + 3) & (2 * SEQ - 1)) * HYW + c] * zz; }
    const float dd = d[c]; float a[4] = {a0, a1, a2, a3};
    for (int i = 0; i < 4; ++i) { const int t = t0 + i; zout[(size_t)t * HYW + c] = g[(size_t)t * ldg + c] * (a[i] + dd * z[(size_t)t * ldz + c]); }
}
__global__ void k_hy_post(float* z, const float* gate, int ldg) {
    const int i = blockIdx.x * 256 + threadIdx.x; if (i >= SEQ * HYW) return; const int t = i / HYW, c = i % HYW;
    const float g = gate[(size_t)t * ldg + c]; z[i] = z[i] * (g * sigm(g));
}
__global__ void k_merge(const float* ml, int ldm, const float* ys5, const float* yhy, float* mg) {
    const int i = blockIdx.x * 256 + threadIdx.x; if (i >= SEQ * D) return; const int t = i / D, c = i % D;
    mg[i] = sigm(ml[(size_t)t * ldm + c]) * ys5[i] + sigm(ml[(size_t)t * ldm + D + c]) * yhy[i];
}
}

extern "C" void kernel_launch(void* const* d_in, const int* in_sizes, int n_in, void* d_out, int out_size, void* d_ws, size_t ws_size, hipStream_t stream) {
    using namespace nv;
    const float* x = (const float*)d_in[0]; const float* norm_w = (const float*)d_in[1]; const float* w_in = (const float*)d_in[2];
    const float* lam_re = (const float*)d_in[3]; const float* lam_im = (const float*)d_in[4]; const float* log_step = (const float*)d_in[5];
    const float* b_re = (const float*)d_in[6]; const float* b_im = (const float*)d_in[7]; const float* c_re = (const float*)d_in[8]; const float* c_im = (const float*)d_in[9];
    const float* s5_d = (const float*)d_in[10]; const float* w_glu = (const float*)d_in[11]; const float* b_glu = (const float*)d_in[12];
    const float* conv_w = (const float*)d_in[13]; const float* conv_b = (const float*)d_in[14]; const float* hw1 = (const float*)d_in[15]; const float* hb1 = (const float*)d_in[16];
    const float* hfreq = (const float*)d_in[17]; const float* hw2 = (const float*)d_in[18]; const float* hb2 = (const float*)d_in[19]; const float* hw3 = (const float*)d_in[20];
    const float* hdecay = (const float*)d_in[21]; const float* hd = (const float*)d_in[22]; const float* wbs5 = (const float*)d_in[23]; const float* wbhy = (const float*)d_in[24];
    const float* w_out = (const float*)d_in[25]; const float* fnw = (const float*)d_in[26];
    float* out = (float*)d_out; float* ws = (float*)d_ws; size_t off = 0;
    auto take = [&](size_t n) { float* p = ws + off; off += (n + 63) & ~(size_t)63; return p; };
    float* xn = take((size_t)SEQ * D); float* proj = take((size_t)SEQ * INC); float* yf = take((size_t)SEQ * S5W); float* yb = take((size_t)SEQ * S5W);
    float* Y = take((size_t)SEQ * S5W); float* T = take((size_t)SEQ * S5W); float* ys5 = take((size_t)SEQ * D); float* yhy = take((size_t)SEQ * D);
    float* sc = take((size_t)SEQ * 3 * HYW); float* z1 = take((size_t)SEQ * HYW); float* z2 = take((size_t)SEQ * HYW); float* mg = take((size_t)SEQ * D);
    float* K = take((size_t)2 * 2 * SEQ * HYW); float* h2 = take((size_t)SEQ * HYN); float* lbar = take(2 * 2 * S5G * S5P); float* bb = take((size_t)2 * S5G * S5P * S5H * 2);
    float* hcur = out;
    for (int l = 0; l < DEPTH; ++l) {
        k_s5_prep<<<(2 * S5G * S5P + 255) / 256, 256, 0, stream>>>(lam_re + (size_t)l * 2 * S5G * S5P, lam_im + (size_t)l * 2 * S5G * S5P, log_step + l * 2 * S5G,
            b_re + (size_t)l * 2 * S5G * S5P * S5H, b_im + (size_t)l * 2 * S5G * S5P * S5H, lbar, bb);
        k_hy_mlp<<<SEQ, 64, 0, stream>>>(hw1 + (size_t)l * HYE * HYN, hb1 + l * HYN, hfreq + l * HYN, hw2 + (size_t)l * HYN * HYN, hb2 + l * HYN, h2);
        k_hy_filter<<<(unsigned)(((size_t)2 * 2 * SEQ * HYW + 255) / 256), 256, 0, stream>>>(h2, hw3 + (size_t)l * HYN * HYF, hdecay + (size_t)l * HYF, K);
        k_hy_norm<<<(2 * HYW + 255) / 256, 256, 0, stream>>>(K);
        for (int b = 0; b < BATCH; ++b) {
            const float* hin = (l == 0 ? x : hcur) + (size_t)b * SEQ * D; float* hout = hcur + (size_t)b * SEQ * D;
            k_rmsnorm<<<SEQ, 256, 0, stream>>>(hin, norm_w + l * D, xn);
            k_gemm<<<dim3(INC / 64, SEQ / 64), 256, 0, stream>>>(xn, D, w_in + (size_t)l * D * INC, INC, proj, INC, nullptr, 0, SEQ, INC, D);
            k_s5_scan<<<dim3(S5G, 2), 64, 0, stream>>>(proj, INC, lbar, bb, c_re + (size_t)l * 2 * S5G * S5H * S5P, c_im + (size_t)l * 2 * S5G * S5H * S5P, yf, yb);
            k_s5_post1<<<SEQ * S5W / 256, 256, 0, stream>>>(proj, INC, s5_d + l * S5W, yf, yb, Y);
            k_gemm<<<dim3(S5W / 64, SEQ / 64), 256, 0, stream>>>(Y, S5W, w_glu + (size_t)l * S5W * S5W, S5W, T, S5W, nullptr, 0, SEQ, S5W, S5W);
            k_s5_post2<<<SEQ * S5W / 256, 256, 0, stream>>>(Y, T, b_glu + l * S5W, proj + S5W, INC);
            k_gemm<<<dim3(D / 64, SEQ / 64), 256, 0, stream>>>(Y, S5W, wbs5 + (size_t)l * S5W * D, D, ys5, D, nullptr, 0, SEQ, D, S5W);
            k_shortconv<<<SEQ * 3 * HYW / 256, 256, 0, stream>>>(proj + 2 * S5W, INC, conv_w + (size_t)l * 3 * 3 * HYW, conv_b + (size_t)l * 3 * HYW, sc);
            k_hyconv<<<dim3(HYW / 64, SEQ / 16), 256, 0, stream>>>(sc, 3 * HYW, K, sc + HYW, 3 * HYW, hd + (size_t)l * 2 * HYW, z1);
            k_hyconv<<<dim3(HYW / 64, SEQ / 16), 256, 0, stream>>>(z1, HYW, K + (size_t)2 * SEQ * HYW, sc + 2 * HYW, 3 * HYW, hd + (size_t)l * 2 * HYW + HYW, z2);
            k_hy_post<<<SEQ * HYW / 256, 256, 0, stream>>>(z2, proj + 2 * S5W + 3 * HYW, INC);
            k_gemm<<<dim3(D / 64, SEQ / 64), 256, 0, stream>>>(z2, HYW, wbhy + (size_t)l * HYW * D, D, yhy, D, nullptr, 0, SEQ, D, HYW);
            k_merge<<<SEQ * D / 256, 256, 0, stream>>>(proj + 2 * S5W + 4 * HYW, INC, ys5, yhy, mg);
            k_gemm<<<dim3(D / 64, SEQ / 64), 256, 0, stream>>>(mg, D, w_out + (size_t)l * D * D, D, hout, D, hin, D, SEQ, D, D);
        }
    }
    k_rmsnorm<<<M, 256, 0, stream>>>(hcur, fnw, out);
}
```

```cpp
#include <hip/hip_runtime.h>
#include <cstdio>
#include <cstdint>
#include <cmath>
namespace pg8 {
#define PG8_LAS __attribute__((address_space(3)))
typedef unsigned short bf16_t;
typedef short bf16x8 __attribute__((ext_vector_type(8)));
typedef float f32x4 __attribute__((ext_vector_type(4)));
typedef unsigned u32x4 __attribute__((ext_vector_type(4)));
constexpr int BM = 256, BK = 64, HALF = 128, HTB = HALF * BK * 2  , STAGE_BYTES = 8 * HTB, NXCD = 8, WGM = 8;

__host__ __device__ __forceinline__ int lds_byte(int r, int c) { const int st = (r >> 4) * 2 + (c >> 5), rr = r & 15, cc = c & 31, ob = rr * 64 + cc * 2; return st * 1024 + (ob ^ (((ob >> 9) & 1) << 5)); }
__host__ __device__ __forceinline__ void stage_rc(int b, int& R, int& C) { const int st = b / 1024, sb = b % 1024, swz = sb ^ (((sb >> 9) & 1) << 5); R = (st >> 1) * 16 + swz / 64; C = (st & 1) * 32 + (swz % 64) / 2; }
__host__ __device__ __forceinline__ int perm32(int rho) { const int n = rho >> 4, i = rho & 15; return 8 * (i >> 2) + 4 * n + (i & 3); }

struct Unit { int pm, pn; };
struct Gemm { const bf16_t* A; const bf16_t* Bt; int M, N, K, lda, ldb; };

struct StaticOrder {
    int nM, nN, nwg, G, c;
    __host__ __device__ void init(int M, int N, int G_, int c_) { nM = M / BM; nN = N / BM; nwg = nM * nN; G = G_; c = c_; }
    __host__ __device__ bool next(int i, Unit& u) const {
        const long L = (long)i * G + c; if (L >= nwg) return false;
        int wgid = (int)L; { const int q = nwg / NXCD, r = nwg % NXCD, xcd = wgid % NXCD, off = wgid / NXCD; wgid = (xcd < r ? xcd * (q + 1) : r * (q + 1) + (xcd - r) * q) + off; }
        const int nig = WGM * nN, gid = wgid / nig, fm = gid * WGM, gsz = (nM - fm) < WGM ? (nM - fm) : WGM;
        u.pm = fm + ((wgid % nig) % gsz); u.pn = (wgid % nig) / gsz; return true;
    }
    __device__ __forceinline__ void a_ready(const Unit&) const {}
    __device__ __forceinline__ void done(const Unit&) const {}
};

typedef unsigned u32x2 __attribute__((ext_vector_type(2)));

typedef __bf16 bf16x2_t __attribute__((ext_vector_type(2)));
typedef float f32x2_t __attribute__((ext_vector_type(2)));
__device__ __forceinline__ unsigned cvt_pk_bf16(float lo, float hi) { const f32x2_t v = {lo, hi}; const bf16x2_t b = __builtin_convertvector(v, bf16x2_t); return __builtin_bit_cast(unsigned, b); }
__device__ __forceinline__ float bf_lo(unsigned w) { return __uint_as_float(w << 16); }
__device__ __forceinline__ float bf_hi(unsigned w) { return __uint_as_float(w & 0xffff0000u); }
__device__ __forceinline__ float fast_sigmoid(float x) { return __builtin_amdgcn_rcpf(1.0f + __builtin_amdgcn_exp2f(-1.4426950408889634f * x)); }
constexpr float RMS_EPS = 1e-6f;
__device__ __forceinline__ float rs_of(const float* ssq, int tok) {
    const f32x4* p = (const f32x4*)(ssq + (size_t)tok * 16); const f32x4 a = p[0], b = p[1], c = p[2], d = p[3];
    const float s = ((a[0] + a[1]) + (a[2] + a[3])) + ((b[0] + b[1]) + (b[2] + b[3])) + ((c[0] + c[1]) + (c[2] + c[3])) + ((d[0] + d[1]) + (d[2] + d[3]));
    return 1.0f / sqrtf(s * (1.0f / 1024.0f) + RMS_EPS);
}
struct EpiHT {
    static constexpr bool PERM = true, AFTER_DRAIN = false;
    bf16_t* O; int ldc; const float* ssq;
    __device__ __forceinline__ void operator()(const f32x4 (&acc)[2][2][4][2], const Unit& u, int wr, int wc, int fr, int fq) const {
        const int lane = (fq << 4) | fr;
        const int ctile = u.pn * BM + wc * 32 + 8 * fq;
        const float mine = rs_of(ssq, ctile + 128 * (fr >> 3) + (fr & 7));
        const int row0 = u.pm * BM + wr * 64 + fr;
#pragma unroll
        for (int bj = 0; bj < 2; ++bj) { float rsv[8];
#pragma unroll
            for (int i = 0; i < 8; ++i) rsv[i] = __shfl(mine, (lane & 48) | (8 * bj + i));
#pragma unroll
            for (int ai = 0; ai < 2; ++ai)
#pragma unroll
                for (int m = 0; m < 4; ++m) { bf16_t* rowp = O + (size_t)(row0 + ai * HALF + m * 16) * ldc + ctile + bj * HALF;
                    const f32x4 v0 = acc[ai][bj][m][0], v1 = acc[ai][bj][m][1]; u32x4 w;
                    w.x = cvt_pk_bf16(v0[0] * rsv[0], v0[1] * rsv[1]); w.y = cvt_pk_bf16(v0[2] * rsv[2], v0[3] * rsv[3]);
                    w.z = cvt_pk_bf16(v1[0] * rsv[4], v1[1] * rsv[5]); w.w = cvt_pk_bf16(v1[2] * rsv[6], v1[3] * rsv[7]);
                    *(u32x4*)rowp = w; }
            asm volatile("" ::: "memory"); }
    }
};
template <int SIG> struct EpiRow {
    static constexpr bool PERM = true, AFTER_DRAIN = false;
    bf16_t* O; int ldc; const float* ssq;
    __device__ __forceinline__ void operator()(const f32x4 (&acc)[2][2][4][2], const Unit& u, int wr, int wc, int fr, int fq) const {
        const int lane = (fq << 4) | fr;
        const int row0 = u.pm * BM + wr * 64 + fr;
        float mine[2];
#pragma unroll
        for (int i = 0; i < 2; ++i) { const int q = 2 * fq + i; mine[i] = rs_of(ssq, row0 + (q >> 2) * HALF + (q & 3) * 16); }
        const int col0 = u.pn * BM + wc * 32 + 8 * fq;
#pragma unroll
        for (int ai = 0; ai < 2; ++ai)
#pragma unroll
            for (int m = 0; m < 4; ++m) { const int q = ai * 4 + m; const float rs = __shfl(mine[q & 1], ((q >> 1) << 4) | (lane & 15));
                bf16_t* rowp = O + (size_t)(row0 + ai * HALF + m * 16) * ldc + col0;
#pragma unroll
                for (int bj = 0; bj < 2; ++bj) { f32x4 v0 = acc[ai][bj][m][0] * rs, v1 = acc[ai][bj][m][1] * rs;
                    if (SIG) {
#pragma unroll
                        for (int e = 0; e < 4; ++e) { v0[e] = fast_sigmoid(v0[e]); v1[e] = fast_sigmoid(v1[e]); } }
                    u32x4 w; w.x = cvt_pk_bf16(v0[0], v0[1]); w.y = cvt_pk_bf16(v0[2], v0[3]); w.z = cvt_pk_bf16(v1[0], v1[1]); w.w = cvt_pk_bf16(v1[2], v1[3]);
                    *(u32x4*)(rowp + bj * HALF) = w; }
                asm volatile("" ::: "memory"); }
    }
};
struct EpiGLU {
    static constexpr bool PERM = true, AFTER_DRAIN = false;
    bf16_t* O; int ldc; const bf16_t* YG; int ldy; const float* bglu;
    __device__ __forceinline__ void operator()(const f32x4 (&acc)[2][2][4][2], const Unit& u, int wr, int wc, int fr, int fq) const {
        const int row0 = u.pm * BM + wr * 64 + fr, col0 = u.pn * BM + wc * 32 + 8 * fq;
        f32x4 bv[2][2];
#pragma unroll
        for (int bj = 0; bj < 2; ++bj)
#pragma unroll
            for (int n = 0; n < 2; ++n) bv[bj][n] = *(const f32x4*)(bglu + col0 + bj * HALF + 4 * n);
#pragma unroll
        for (int ai = 0; ai < 2; ++ai)
#pragma unroll
            for (int m = 0; m < 4; ++m) { const size_t r = (size_t)(row0 + ai * HALF + m * 16);
#pragma unroll
                for (int bj = 0; bj < 2; ++bj) { const int c = col0 + bj * HALF;
                    const u32x4 yv = *(const u32x4*)(YG + r * ldy + c), gv = *(const u32x4*)(YG + r * ldy + 512 + c);
                    const f32x4 a0 = acc[ai][bj][m][0] + bv[bj][0], a1 = acc[ai][bj][m][1] + bv[bj][1];
                    float o[8]; const unsigned yw[4] = {yv.x, yv.y, yv.z, yv.w}, gw[4] = {gv.x, gv.y, gv.z, gv.w};
#pragma unroll
                    for (int e = 0; e < 8; ++e) { const float a = e < 4 ? a0[e & 3] : a1[e & 3]; const float y = (e & 1) ? bf_hi(yw[e >> 1]) : bf_lo(yw[e >> 1]);
                        const float g = (e & 1) ? bf_hi(gw[e >> 1]) : bf_lo(gw[e >> 1]); o[e] = y * fast_sigmoid(a) * (g * fast_sigmoid(g)); }
                    u32x4 w; w.x = cvt_pk_bf16(o[0], o[1]); w.y = cvt_pk_bf16(o[2], o[3]); w.z = cvt_pk_bf16(o[4], o[5]); w.w = cvt_pk_bf16(o[6], o[7]);
                    *(u32x4*)(O + r * ldc + c) = w; asm volatile("" ::: "memory"); } }
    }
};
template <int ADD> struct EpiMerge {
    static constexpr bool PERM = true, AFTER_DRAIN = false;
    bf16_t* O; int ldc; const bf16_t* G; int ldg; int goff;
    __device__ __forceinline__ void operator()(const f32x4 (&acc)[2][2][4][2], const Unit& u, int wr, int wc, int fr, int fq) const {
        const int row0 = u.pm * BM + wr * 64 + fr, col0 = u.pn * BM + wc * 32 + 8 * fq;
#pragma unroll
        for (int ai = 0; ai < 2; ++ai)
#pragma unroll
            for (int m = 0; m < 4; ++m) { const size_t r = (size_t)(row0 + ai * HALF + m * 16);
#pragma unroll
                for (int bj = 0; bj < 2; ++bj) { const int c = col0 + bj * HALF;
                    const u32x4 gv = *(const u32x4*)(G + r * ldg + goff + c); u32x4 tv = {0u, 0u, 0u, 0u}; if (ADD) tv = *(const u32x4*)(O + r * ldc + c);
                    const f32x4 a0 = acc[ai][bj][m][0], a1 = acc[ai][bj][m][1];
                    float o[8]; const unsigned gw[4] = {gv.x, gv.y, gv.z, gv.w}, tw[4] = {tv.x, tv.y, tv.z, tv.w};
#pragma unroll
                    for (int e = 0; e < 8; ++e) { const float a = e < 4 ? a0[e & 3] : a1[e & 3]; const float g = (e & 1) ? bf_hi(gw[e >> 1]) : bf_lo(gw[e >> 1]);
                        const float t = (e & 1) ? bf_hi(tw[e >> 1]) : bf_lo(tw[e >> 1]); o[e] = (ADD ? t : 0.f) + g * a; }
                    u32x4 w; w.x = cvt_pk_bf16(o[0], o[1]); w.y = cvt_pk_bf16(o[2], o[3]); w.z = cvt_pk_bf16(o[4], o[5]); w.w = cvt_pk_bf16(o[6], o[7]);
                    *(u32x4*)(O + r * ldc + c) = w; asm volatile("" ::: "memory"); } }
    }
};
struct EpiOut {
    static constexpr bool PERM = false, AFTER_DRAIN = false;
    const float* base; float* H; bf16_t* XN; float* ssq;
    __device__ __forceinline__ void operator()(const f32x4 (&acc)[2][2][4][2], const Unit& u, int wr, int wc, int fr, int fq) const {
        const int row0 = u.pm * BM + wr * 64 + fr, col0 = u.pn * BM + wc * 32 + 4 * fq;
#pragma unroll
        for (int ai = 0; ai < 2; ++ai)
#pragma unroll
            for (int m = 0; m < 4; ++m) { const size_t r = (size_t)(row0 + ai * HALF + m * 16); float s = 0.f;
#pragma unroll
                for (int bj = 0; bj < 2; ++bj)
#pragma unroll
                    for (int n = 0; n < 2; ++n) { const size_t off = r * 1024 + col0 + bj * HALF + n * 16;
                        const f32x4 h = *(const f32x4*)(base + off) + acc[ai][bj][m][n]; *(f32x4*)(H + off) = h;
                        s += (h[0] * h[0] + h[1] * h[1]) + (h[2] * h[2] + h[3] * h[3]);
                        u32x2 w; w.x = cvt_pk_bf16(h[0], h[1]); w.y = cvt_pk_bf16(h[2], h[3]); *(u32x2*)(XN + off) = w; }
                s += __shfl_xor(s, 16); s += __shfl_xor(s, 32);
                if (fq == 0) ssq[r * 16 + u.pn * 4 + wc] = s; }
    }
};
template <class Epi, class Sched, bool ALIGN_EPI, bool SP2, int KK, int LDA, int LDB>
__device__ __forceinline__ void gemm_phase(PG8_LAS unsigned char* lds, const Gemm g, const Sched& S, const Epi& E) {
    int tid_ = threadIdx.x; asm volatile("" : "+v"(tid_));
    const int tid = tid_, wid = __builtin_amdgcn_readfirstlane(tid >> 6), lane = tid & 63, wr = wid >> 2, wc = wid & 3, fr = lane & 15, fq = lane >> 4;
    constexpr int K = KK, nt = K / BK;
    unsigned voffA[2], voffB[2];
#pragma unroll
    for (int i = 0; i < 2; ++i) { int R, C; stage_rc(tid * 16 + i * 8192, R, C); const int Rb = Epi::PERM ? ((R & ~31) + perm32(R & 31)) : R;
        voffA[i] = (unsigned)(R * LDA + C) * 2u; voffB[i] = (unsigned)(Rb * LDB + C) * 2u; }
    constexpr size_t kstep = (size_t)(BK * 2);
    constexpr size_t hstepA = (size_t)HALF * LDA * 2, hstepB = (size_t)HALF * LDB * 2;
    constexpr size_t tstepA = 2 * hstepA, tstepB = 2 * hstepB;
    const unsigned ldsw = (unsigned)wid * 1024u;
    const int aoff = lds_byte(wr * 64 + fr, fq * 8), boff = lds_byte(wc * 32 + fr, fq * 8);
#define PG8_SA(b, h) (((b) * 2 + (h)) * HTB)
#define PG8_SB(b, h) ((4 + (b) * 2 + (h)) * HTB)
#define PG8_STAGE(bufoff, gbase, voff) do { _Pragma("unroll") for (int _i = 0; _i < 2; ++_i) \
        __builtin_amdgcn_global_load_lds((const unsigned*)((const char*)(gbase) + (voff)[_i]), (PG8_LAS unsigned*)(lds + (bufoff) + ldsw + _i * 8192), 16, 0, 0); } while (0)
#define PG8_LDA(dst, b, h) do { _Pragma("unroll") for (int m = 0; m < 4; ++m) _Pragma("unroll") for (int k = 0; k < 2; ++k) dst[m][k] = *(const PG8_LAS bf16x8*)(lds + PG8_SA(b, h) + aoff + m * 2048 + k * 1024); } while (0)
#define PG8_LDB(dst, b, h) do { _Pragma("unroll") for (int n = 0; n < 2; ++n) _Pragma("unroll") for (int k = 0; k < 2; ++k) dst[n][k] = *(const PG8_LAS bf16x8*)(lds + PG8_SB(b, h) + boff + n * 2048 + k * 1024); } while (0)
#define PG8_MMA(ai, bj, At, Bt) do { __builtin_amdgcn_s_setprio(1); _Pragma("unroll") for (int m = 0; m < 4; ++m) _Pragma("unroll") for (int n = 0; n < 2; ++n) _Pragma("unroll") for (int k = 0; k < 2; ++k) \
        acc[ai][bj][m][n] = __builtin_amdgcn_mfma_f32_16x16x32_bf16(Bt[n][k], At[m][k], acc[ai][bj][m][n], 0, 0, 0); __builtin_amdgcn_s_setprio(0); } while (0)
#define PG8_WAIT_V(n) asm volatile("s_waitcnt vmcnt(" #n ")" ::: "memory")
#define PG8_WAIT_L(n) asm volatile("s_waitcnt lgkmcnt(" #n ")" ::: "memory")
#define PG8_BAR __builtin_amdgcn_s_barrier()
#define PG8_SCHED __builtin_amdgcn_sched_barrier(0)
    Unit cur, nxt; int ui = 0;
    if (!S.next(0, cur)) return;
    f32x4 acc[2][2][4][2];
#pragma unroll
    for (int a = 0; a < 2; ++a)
#pragma unroll
        for (int b = 0; b < 2; ++b)
#pragma unroll
            for (int m = 0; m < 4; ++m)
#pragma unroll
                for (int n = 0; n < 2; ++n) acc[a][b][m][n] = (f32x4){0.f, 0.f, 0.f, 0.f};
    bf16x8 At[4][2], B0[2][2], B1[2][2];
    const char* cA = (const char*)g.A + (size_t)cur.pm * tstepA; const char* cB = (const char*)g.Bt + (size_t)cur.pn * tstepB;
    S.a_ready(cur);
    if constexpr (SP2) {
        PG8_STAGE(PG8_SB(0, 0), cB, voffB); PG8_STAGE(PG8_SB(0, 1), cB + hstepB, voffB); PG8_STAGE(PG8_SA(0, 0), cA, voffA); PG8_STAGE(PG8_SA(0, 1), cA + hstepA, voffA);
        if (wr == 1) PG8_BAR;
        PG8_WAIT_V(2); PG8_BAR;
        PG8_STAGE(PG8_SB(1, 0), cB + kstep, voffB); PG8_STAGE(PG8_SA(1, 0), cA + kstep, voffA); PG8_STAGE(PG8_SB(1, 1), cB + hstepB + kstep, voffB);
        PG8_WAIT_V(6); PG8_BAR;
    } else {
        PG8_STAGE(PG8_SB(0, 0), cB, voffB); PG8_STAGE(PG8_SA(0, 0), cA, voffA); PG8_STAGE(PG8_SB(0, 1), cB + hstepB, voffB); PG8_STAGE(PG8_SA(0, 1), cA + hstepA, voffA);
        if (wr == 1) PG8_BAR;
        PG8_WAIT_V(4); PG8_BAR;
        PG8_STAGE(PG8_SB(1, 0), cB + kstep, voffB); PG8_STAGE(PG8_SA(1, 0), cA + kstep, voffA); PG8_STAGE(PG8_SB(1, 1), cB + hstepB + kstep, voffB);
        PG8_WAIT_V(6); PG8_BAR;
    }
    for (;;) {
        const bool has_next = S.next(ui + 1, nxt);
        const char* nA = has_next ? (const char*)g.A + (size_t)nxt.pm * tstepA : cA; const char* nB = has_next ? (const char*)g.Bt + (size_t)nxt.pn * tstepB : cB;
        for (int t = 0; t < nt; t += 2) {
            const bool last = (t == nt - 2);
            const char* a1 = cA + (size_t)(t + 1) * kstep;
            const char* a2 = last ? nA : cA + (size_t)(t + 2) * kstep; const char* b2 = last ? nB : cB + (size_t)(t + 2) * kstep;
            const char* a3 = a2 + kstep; const char* b3 = b2 + kstep;
            if (last && has_next) S.a_ready(nxt);
            if constexpr (SP2) {
            PG8_LDB(B0, 0, 0); PG8_LDB(B1, 0, 1); PG8_SCHED; PG8_LDA(At, 0, 0); PG8_STAGE(PG8_SA(1, 1), a1 + hstepA, voffA);
            PG8_WAIT_V(8); PG8_WAIT_L(0); PG8_BAR; PG8_MMA(0, 0, At, B0); PG8_MMA(0, 1, At, B1); PG8_BAR; PG8_SCHED;
            PG8_LDA(At, 0, 1); PG8_STAGE(PG8_SB(0, 0), b2, voffB); PG8_STAGE(PG8_SB(0, 1), b2 + hstepB, voffB); PG8_STAGE(PG8_SA(0, 0), a2, voffA);
            PG8_WAIT_V(8); PG8_WAIT_L(0); PG8_BAR; PG8_MMA(1, 0, At, B0); PG8_MMA(1, 1, At, B1); PG8_BAR; PG8_SCHED;
            PG8_LDB(B0, 1, 0); PG8_LDB(B1, 1, 1); PG8_SCHED; PG8_LDA(At, 1, 0); PG8_STAGE(PG8_SA(0, 1), a2 + hstepA, voffA);
            PG8_WAIT_V(8); PG8_WAIT_L(0); PG8_BAR; PG8_MMA(0, 0, At, B0); PG8_MMA(0, 1, At, B1); PG8_BAR; PG8_SCHED;
            PG8_LDA(At, 1, 1); PG8_STAGE(PG8_SB(1, 0), b3, voffB); PG8_STAGE(PG8_SB(1, 1), b3 + hstepB, voffB); PG8_STAGE(PG8_SA(1, 0), a3, voffA);
            PG8_WAIT_V(8); PG8_WAIT_L(0); PG8_BAR; PG8_MMA(1, 0, At, B0); PG8_MMA(1, 1, At, B1); PG8_BAR; PG8_SCHED;
            } else {
            PG8_LDB(B0, 0, 0); PG8_SCHED; PG8_LDA(At, 0, 0); PG8_STAGE(PG8_SA(1, 1), a1 + hstepA, voffA);
            PG8_WAIT_L(8); PG8_BAR; PG8_WAIT_L(0); PG8_MMA(0, 0, At, B0); PG8_BAR; PG8_SCHED;
            PG8_LDB(B1, 0, 1); PG8_STAGE(PG8_SB(0, 0), b2, voffB);
            PG8_BAR; PG8_WAIT_L(0); PG8_MMA(0, 1, At, B1); PG8_BAR;
            PG8_LDA(At, 0, 1); PG8_STAGE(PG8_SA(0, 0), a2, voffA);
            PG8_BAR; PG8_WAIT_L(0); PG8_MMA(1, 0, At, B0); PG8_BAR; PG8_SCHED;
            PG8_STAGE(PG8_SB(0, 1), b2 + hstepB, voffB);
            PG8_WAIT_V(6); PG8_BAR; PG8_MMA(1, 1, At, B1); PG8_BAR;
            PG8_LDB(B0, 1, 0); PG8_SCHED; PG8_LDA(At, 1, 0); PG8_STAGE(PG8_SA(0, 1), a2 + hstepA, voffA);
            PG8_WAIT_L(8); PG8_BAR; PG8_WAIT_L(0); PG8_MMA(0, 0, At, B0); PG8_BAR; PG8_SCHED;
            PG8_LDB(B1, 1, 1); PG8_STAGE(PG8_SB(1, 0), b3, voffB);
            PG8_BAR; PG8_WAIT_L(0); PG8_MMA(0, 1, At, B1); PG8_BAR;
            PG8_LDA(At, 1, 1); PG8_STAGE(PG8_SA(1, 0), a3, voffA);
            PG8_BAR; PG8_WAIT_L(0); PG8_MMA(1, 0, At, B0); PG8_BAR; PG8_SCHED;
            PG8_STAGE(PG8_SB(1, 1), b3 + hstepB, voffB);
            PG8_WAIT_V(6); PG8_BAR; PG8_MMA(1, 1, At, B1); PG8_BAR;
            }
        }
        if constexpr (ALIGN_EPI) { if (wr == 0) PG8_BAR; }
        if constexpr (!Epi::AFTER_DRAIN) { E(acc, cur, wr, wc, fr, fq); S.done(cur); }
        if (!has_next) break;
#pragma unroll
        for (int a = 0; a < 2; ++a)
#pragma unroll
            for (int b = 0; b < 2; ++b)
#pragma unroll
                for (int m = 0; m < 4; ++m)
#pragma unroll
                    for (int n = 0; n < 2; ++n) acc[a][b][m][n] = (f32x4){0.f, 0.f, 0.f, 0.f};
        cur = nxt; cA = nA; cB = nB; ++ui;
        if constexpr (ALIGN_EPI) { if (wr == 1) PG8_BAR; }
    }
    PG8_WAIT_V(0);
    if constexpr (!ALIGN_EPI) { if (wr == 0) PG8_BAR; }
    PG8_BAR;
    if constexpr (Epi::AFTER_DRAIN) { E.fused(acc, cur, wr, wc, fr, fq, lds, wid, lane); S.done(cur); }
#undef PG8_SA
#undef PG8_SB
#undef PG8_STAGE
#undef PG8_LDA
#undef PG8_LDB
#undef PG8_MMA
#undef PG8_WAIT_V
#undef PG8_WAIT_L
#undef PG8_BAR
#undef PG8_SCHED
}
}

constexpr int NWAVES = 8, NTHREADS = 512;
#ifndef MK_PER_PHASE
#define MK_PER_PHASE 0
#endif
constexpr int D = 1024, BATCH = 8, SEQ = 2048, M = BATCH * SEQ, DEPTH = 2;
constexpr int S5W = 512, S5H = 16, S5G = 32, S5P = 64;
constexpr int HYW = 1024, HYF = 4096, HYE = 33, HYN = 64;
constexpr int INC = 7168;
constexpr int NPHASE = 12;

constexpr size_t MiB = 1u << 20;
constexpr size_t WS_CTL = 0, CTL_ZERO_BYTES = 64 * 1024;
constexpr size_t WS_H2 = 1 * MiB;
constexpr size_t WS_LBAR = 2 * MiB;
constexpr size_t WS_BBT = 2 * MiB + 64 * 1024;
constexpr size_t WS_CT = WS_BBT + 512 * 1024;
constexpr size_t WS_W = 4 * MiB;
constexpr size_t W_IN = 0, W_GLU = 14 * MiB, W_BS5 = W_GLU + 512 * 1024, W_BHY = W_BS5 + 1 * MiB, W_OUT = W_BHY + 2 * MiB, W_LAYER = W_OUT + 2 * MiB;
constexpr size_t WS_SSQ = 43 * MiB;
constexpr size_t WS_X = 44 * MiB;
constexpr size_t WS_R1 = 76 * MiB, WS_R2 = 108 * MiB, WS_R3 = 140 * MiB, WS_R4 = 172 * MiB, WS_R5 = 204 * MiB, WS_R6 = 236 * MiB, WS_END = 252 * MiB;
static_assert(WS_W + 2 * W_LAYER <= WS_SSQ, "weights");
constexpr int LDS_BYTES = 163840 - 256;
constexpr int LDSCTL_OFF = LDS_BYTES - 256;

#define GAS __attribute__((address_space(1)))
#define LAS __attribute__((address_space(3)))
typedef unsigned short bf16;
typedef unsigned v4u __attribute__((ext_vector_type(4)));
typedef unsigned v2u __attribute__((ext_vector_type(2)));
typedef float f32x4 __attribute__((ext_vector_type(4)));
typedef float f32x2 __attribute__((ext_vector_type(2)));
typedef short bf16x8 __attribute__((ext_vector_type(8)));
typedef GAS unsigned gu32;
#define RLX_AGENT __ATOMIC_RELAXED, __HIP_MEMORY_SCOPE_AGENT
#define LDS_WAIT() asm volatile("s_waitcnt lgkmcnt(0)" ::: "memory")
#define VM_WAIT() asm volatile("s_waitcnt vmcnt(0)" ::: "memory")
__device__ __forceinline__ unsigned f2bf(float f) { unsigned u = __builtin_bit_cast(unsigned, f); return (u + 0x7fffu + ((u >> 16) & 1u)) >> 16; }
__device__ __forceinline__ unsigned pk2(float lo, float hi) { return f2bf(lo) | (f2bf(hi) << 16); }
__device__ __forceinline__ float bf2f(unsigned short h) { return __uint_as_float((unsigned)h << 16); }
using pg8::bf_lo; using pg8::bf_hi; using pg8::fast_sigmoid;

#define XB_TMO      128
#define XB_XCNT(j)  (256  + 64 * (j))
#define XB_XSUB(j)  (1280 + 64 * (j))
#define XB_XGEN(j)  (2304 + 64 * (j))
#define XB_TOP      3328
#define XB_TOPGEN   3392
#define XCD_BAR_WORDS 3456
#define XB_SPIN_CAP (1u << 18)
__device__ __forceinline__ unsigned xb_ld(unsigned* p)              { return __hip_atomic_load(p, __ATOMIC_RELAXED, __HIP_MEMORY_SCOPE_AGENT); }
__device__ __forceinline__ unsigned xb_add(unsigned* p, unsigned v) { return __hip_atomic_fetch_add(p, v, __ATOMIC_RELAXED, __HIP_MEMORY_SCOPE_AGENT); }
__device__ __forceinline__ unsigned xb_xcc_id() { return (unsigned)__builtin_amdgcn_s_getreg((3 << 11) | 20) & 0xFu; }
#define XB_SPIN(cond, bar) do { unsigned _sp = 0; while (cond) { __builtin_amdgcn_s_sleep(1); \
    if ((++_sp & 255u) == 0u) { if (xb_ld(&(bar)[XB_TMO])) break; if (_sp > XB_SPIN_CAP) { atomicAdd(&(bar)[XB_TMO], 1u); break; } } } } while (0)
struct XcdBarrier { unsigned* bar; unsigned x; volatile LAS unsigned* st; };
__device__ __forceinline__ XcdBarrier xcd_barrier_post(unsigned* bar, volatile LAS unsigned* st) {
    XcdBarrier b; b.bar = bar; b.x = xb_xcc_id(); b.st = st;
    if (threadIdx.x == 0) (void)xb_add(&bar[XB_XCNT(b.x)], 1u);
    return b;
}
__device__ __forceinline__ void xcd_barrier_complete(unsigned* bar, unsigned x, unsigned& nloc, unsigned& nx) {
    const unsigned G = gridDim.x * gridDim.y * gridDim.z;
    unsigned sum, cnt, mine, sp = 0u;
    for (;;) {
        sum = 0u; cnt = 0u; mine = 0u;
#pragma unroll
        for (unsigned j = 0; j < 16; ++j) { const unsigned c = xb_ld(&bar[XB_XCNT(j)]); sum += c; cnt += (c > 0u) ? 1u : 0u; mine = (j == x) ? c : mine; }
        if (sum == G) break;
        __builtin_amdgcn_s_sleep(1);
        if ((++sp & 255u) == 0u) { if (xb_ld(&bar[XB_TMO])) break; if (sp > XB_SPIN_CAP) { atomicAdd(&bar[XB_TMO], 1u); break; } }
    }
    nloc = mine > 0u ? mine : 1u; nx = cnt > 0u ? cnt : 1u;
}
__device__ __forceinline__ void xcd_barrier(const XcdBarrier& b) {
    asm volatile("s_waitcnt vmcnt(0)" ::: "memory");
    __syncthreads();
    if (threadIdx.x == 0) {
        unsigned* bar = b.bar;
        __builtin_amdgcn_s_waitcnt(0);
        unsigned nloc = b.st[0], nx = b.st[1];
        if (nloc == 0u) { xcd_barrier_complete(bar, b.x, nloc, nx); b.st[0] = nloc; b.st[1] = nx; }
        const unsigned old = xb_add(&bar[XB_XSUB(b.x)], 1u);
        const unsigned gen = old / nloc;
        if (old + 1u == (gen + 1u) * nloc) {
            __builtin_amdgcn_fence(__ATOMIC_RELEASE, "agent");
            asm volatile("s_waitcnt vmcnt(0)" ::: "memory");
            const unsigned og = xb_add(&bar[XB_TOP], 1u);
            const unsigned tg = og / nx;
            if (og + 1u == (tg + 1u) * nx) xb_add(&bar[XB_TOPGEN], 1u);
            else XB_SPIN(xb_ld(&bar[XB_TOPGEN]) == tg, bar);
            __builtin_amdgcn_fence(__ATOMIC_ACQUIRE, "agent");
            xb_add(&bar[XB_XGEN(b.x)], 1u);
            asm volatile("s_waitcnt vmcnt(0)" ::: "memory");
        } else {
            XB_SPIN(xb_ld(&bar[XB_XGEN(b.x)]) == gen, bar);
            __builtin_amdgcn_fence(__ATOMIC_ACQUIRE, "agent");
            asm volatile("s_waitcnt vmcnt(0)" ::: "memory");
        }
    }
    __syncthreads();
}

struct Frame {
    LAS unsigned char* lds;
    int tid, lane, wave, G, bx;
    const float* in[27]; float* out; unsigned char* ws;
};
__device__ __forceinline__ float wave_sum(float v) {
#pragma unroll
    for (int o = 1; o < 64; o <<= 1) v += __shfl_xor(v, o);
    return v;
}

__device__ __forceinline__ void p0_transpose_item(const float* W, int K, int N, bf16* WT, int k0, int n0, int drow, const float* kscale, LAS float* scr, int lane) {
#pragma unroll 8
    for (int i = 0; i < 32; ++i) { const int kk = 2 * i + (lane >> 5); float v = W[(size_t)(k0 + kk) * N + n0 + (lane & 31)]; if (kscale) v *= kscale[k0 + kk]; scr[kk * 33 + (lane & 31)] = v; }
    LDS_WAIT(); asm volatile("" ::: "memory");
    const int c = lane & 7;
#pragma unroll
    for (int j = 0; j < 4; ++j) { const int n = (lane >> 3) + 8 * j; const LAS float* s = scr + (8 * c) * 33 + n;
        v4u o; o.x = pk2(s[0 * 33], s[1 * 33]); o.y = pk2(s[2 * 33], s[3 * 33]); o.z = pk2(s[4 * 33], s[5 * 33]); o.w = pk2(s[6 * 33], s[7 * 33]);
        *(GAS v4u*)(WT + (size_t)(drow + n) * K + k0 + 8 * c) = o; }
    LDS_WAIT(); asm volatile("" ::: "memory");
}
__device__ __forceinline__ void p0_prologue(Frame& F) {
    LAS float* scr = (LAS float*)(F.lds + F.wave * 16384);
    const int gw = F.bx * NWAVES + F.wave, NGW = F.G * NWAVES, lane = F.lane;
    constexpr int I_IN = (D / 64) * (INC / 32), I_GLU = (S5W / 64) * (S5W / 32), I_BS5 = (S5W / 64) * (D / 32), I_BHY = (HYW / 64) * (D / 32), I_OUT = (D / 64) * (D / 32);
    constexpr int I_LAYER = I_IN + I_GLU + I_BS5 + I_BHY + I_OUT;
    for (int it = gw; it < DEPTH * I_LAYER; it += NGW) {
        const int l = it / I_LAYER; int r = it % I_LAYER; bf16* wl = (bf16*)(F.ws + WS_W + (size_t)l * W_LAYER);
        if (r < I_IN) { const int nblk = INC / 32, kb = r / nblk, nb = r % nblk, n0 = nb * 32;
            const int drow = (n0 >= 1024 && n0 < 5120) ? n0 - 1024 : (n0 < 1024 ? n0 + 4096 : n0);
            p0_transpose_item(F.in[2] + (size_t)l * D * INC, D, INC, wl + W_IN / 2, kb * 64, n0, drow, F.in[1] + l * D, scr, lane); continue; } r -= I_IN;
        if (r < I_GLU) { const int nblk = S5W / 32; p0_transpose_item(F.in[11] + (size_t)l * S5W * S5W, S5W, S5W, wl + W_GLU / 2, (r / nblk) * 64, (r % nblk) * 32, (r % nblk) * 32, nullptr, scr, lane); continue; } r -= I_GLU;
        if (r < I_BS5) { const int nblk = D / 32; p0_transpose_item(F.in[23] + (size_t)l * S5W * D, S5W, D, wl + W_BS5 / 2, (r / nblk) * 64, (r % nblk) * 32, (r % nblk) * 32, nullptr, scr, lane); continue; } r -= I_BS5;
        if (r < I_BHY) { const int nblk = D / 32; p0_transpose_item(F.in[24] + (size_t)l * HYW * D, HYW, D, wl + W_BHY / 2, (r / nblk) * 64, (r % nblk) * 32, (r % nblk) * 32, nullptr, scr, lane); continue; } r -= I_BHY;
        { const int nblk = D / 32; p0_transpose_item(F.in[25] + (size_t)l * D * D, D, D, wl + W_OUT / 2, (r / nblk) * 64, (r % nblk) * 32, (r % nblk) * 32, nullptr, scr, lane); }
    }
    { bf16* X = (bf16*)(F.ws + WS_X); float* ssq = (float*)(F.ws + WS_SSQ);
      for (int m = gw; m < M; m += NGW) { const GAS f32x4* xr = (const GAS f32x4*)(F.in[0] + (size_t)m * D) + lane; f32x4 v[4]; float s = 0.f;
#pragma unroll
        for (int j = 0; j < 4; ++j) { v[j] = xr[64 * j]; s += (v[j].x * v[j].x + v[j].y * v[j].y) + (v[j].z * v[j].z + v[j].w * v[j].w); }
        s = wave_sum(s);
        GAS unsigned long long* o8 = (GAS unsigned long long*)(X + (size_t)m * D) + lane;
#pragma unroll
        for (int j = 0; j < 4; ++j) o8[64 * j] = (unsigned long long)pk2(v[j].x, v[j].y) | ((unsigned long long)pk2(v[j].z, v[j].w) << 32);
        if (lane < 16) ssq[(size_t)m * 16 + lane] = lane == 0 ? s : 0.f; } }
    { float* H2 = (float*)(F.ws + WS_H2);
      for (int it = gw; it < DEPTH * SEQ; it += NGW) { const int l = it / SEQ, t = it % SEQ, j = lane;
        const float* w1 = F.in[15] + (size_t)l * HYE * HYN; const float* b1 = F.in[16] + l * HYN; const float* fr = F.in[17] + l * HYN; const float* w2 = F.in[18] + (size_t)l * HYN * HYN; const float* b2 = F.in[19] + l * HYN;
        float f = 0.f;
        if (j == 0) f = (float)t / (float)(SEQ - 1);
        else if (j < 33) { const int bi = (j - 1) & 15; const float band = 1e-4f + (float)bi * ((15.f - 1e-4f) / 15.f); const float ang = band * (float)t * (float)(2.0 * 3.14159265358979323846 / SEQ); f = j < 17 ? cosf(ang) : -sinf(ang); }
        float a = b1[j];
        for (int i = 0; i < HYE; ++i) a += __shfl(f, i) * w1[i * HYN + j];
        const float h1 = sinf(fr[j] * a);
        float c = b2[j];
        for (int i = 0; i < HYN; ++i) c += __shfl(h1, i) * w2[i * HYN + j];
        H2[(size_t)it * HYN + j] = sinf(fr[j] * c); } }
    { float* LB = (float*)(F.ws + WS_LBAR); bf16* BBT = (bf16*)(F.ws + WS_BBT); bf16* CT = (bf16*)(F.ws + WS_CT);
      for (int q = gw; q < DEPTH * 2 * S5G; q += NGW) { const int p = lane; const int i = q * S5P + p;
        const float dt = expf(F.in[5][q]); const float lr = F.in[3][i], li = F.in[4][i]; const float mag = expf(lr * dt), ang = li * dt;
        const float br = mag * cosf(ang), bi = mag * sinf(ang); LB[2 * i] = br; LB[2 * i + 1] = bi;
        const float nr = br - 1.f, ni = bi, den = lr * lr + li * li; const float kr = (nr * lr + ni * li) / den, ki = (ni * lr - nr * li) / den;
        const float* bre = F.in[6] + (size_t)i * S5H; const float* bim = F.in[7] + (size_t)i * S5H;
        bf16* rowr = BBT + ((size_t)q * 128 + 2 * p) * 16; bf16* rowi = rowr + 16;
        for (int h = 0; h < S5H; ++h) { const float xr = bre[h], xi = bim[h]; rowr[h] = (bf16)f2bf(kr * xr - ki * xi); rowi[h] = (bf16)f2bf(kr * xi + ki * xr); }
        const float* cre = F.in[8] + (size_t)q * S5H * S5P; const float* cim = F.in[9] + (size_t)q * S5H * S5P;
        for (int h = 0; h < S5H; ++h) { *(unsigned*)(CT + ((size_t)q * 16 + h) * 128 + 2 * p) = pk2(cre[h * S5P + p], -cim[h * S5P + p]); } } }
}

constexpr int S5_YB = 0, S5_CH = 65536, S5_CHB = 8448, S5_SEND = S5_CH + 8 * S5_CHB;
__device__ __forceinline__ float gelu_tanh_fast(float x) {
    const float z = 0.7978845608028654f * (x + 0.044715f * x * x * x);
    const float e = __builtin_amdgcn_exp2f(2.0f * 1.4426950408889634f * z);
    const float th = 1.0f - 2.0f * __builtin_amdgcn_rcpf(e + 1.0f);
    return 0.5f * x * (1.0f + th);
}
template <int DIR, bool EMIT>
__device__ __forceinline__ void s5_pass(Frame& F, const bf16* Ub  , int tlo  , float ar, float ai, float& sr, float& si,
                                        const bf16x8 (&bbf)[8], const bf16x8 (&ctf)[4], const bf16x8& ddf, LAS unsigned char* ch, LAS unsigned char* yb, bf16* YGb) {
    const int lane = F.lane, fr = lane & 15, fq = lane >> 4;
    bf16x8 uf, ufn;
    auto load_u = [&](int tc0) -> bf16x8 { bf16x8 z = {0, 0, 0, 0, 0, 0, 0, 0}; if (fq < 2) z = *(const bf16x8*)(Ub + (size_t)(tc0 + fr) * 1024 + 8 * fq); return z; };
    uf = load_u(DIR ? tlo + 240 : tlo);
#pragma unroll 1
    for (int ci = 0; ci < 16; ++ci) {
        const int tc0 = DIR ? tlo + 16 * (15 - ci) : tlo + 16 * ci;
        if (ci < 15) ufn = load_u(DIR ? tc0 - 16 : tc0 + 16);
        LAS float* bu = (LAS float*)ch;
#pragma unroll
        for (int j = 0; j < 8; ++j) { f32x4 a = {0.f, 0.f, 0.f, 0.f}; a = __builtin_amdgcn_mfma_f32_16x16x32_bf16(bbf[j], uf, a, 0, 0, 0);
            *(LAS f32x4*)(bu + fr * 132 + 16 * j + 4 * fq) = a; }
        LDS_WAIT();
        f32x2 x[16];
#pragma unroll
        for (int tt = 0; tt < 16; ++tt) x[tt] = *(const LAS f32x2*)(bu + tt * 132 + 2 * lane);
        LDS_WAIT();
        unsigned spk[16];
#pragma unroll
        for (int i = 0; i < 16; ++i) { const int tt = DIR ? 15 - i : i;
            const float nr = ar * sr - ai * si + x[tt].x, ni = ar * si + ai * sr + x[tt].y; sr = nr; si = ni;
            if (EMIT) spk[tt] = pg8::cvt_pk_bf16(nr, ni); }
        if (EMIT) {
            LAS unsigned* sb = (LAS unsigned*)ch;
#pragma unroll
            for (int tt = 0; tt < 16; ++tt) sb[tt * 68 + lane] = spk[tt];
            LDS_WAIT();
            f32x4 y = {0.f, 0.f, 0.f, 0.f};
#pragma unroll
            for (int ks = 0; ks < 4; ++ks) { const bf16x8 sf = *(const LAS bf16x8*)(ch + fr * 272 + ks * 64 + fq * 16); y = __builtin_amdgcn_mfma_f32_16x16x32_bf16(ctf[ks], sf, y, 0, 0, 0); }
            LDS_WAIT();
            LAS v2u* ybp = (LAS v2u*)(yb + (size_t)(tc0 + fr) * 32 + 8 * fq);
            if (DIR == 0) { v2u w; w.x = pg8::cvt_pk_bf16(y[0], y[1]); w.y = pg8::cvt_pk_bf16(y[2], y[3]); *ybp = w; }
            else { y = __builtin_amdgcn_mfma_f32_16x16x32_bf16(ddf, uf, y, 0, 0, 0);
                const v2u f = *ybp; const float o0 = gelu_tanh_fast(y[0] + bf_lo(f.x)), o1 = gelu_tanh_fast(y[1] + bf_hi(f.x)), o2 = gelu_tanh_fast(y[2] + bf_lo(f.y)), o3 = gelu_tanh_fast(y[3] + bf_hi(f.y));
                v2u w; w.x = pg8::cvt_pk_bf16(o0, o1); w.y = pg8::cvt_pk_bf16(o2, o3);
                *(v2u*)(YGb + (size_t)(tc0 + fr) * 1024 + 4 * fq) = w; }
        }
        uf = ufn;
    }
}
__device__ __forceinline__ void s5_item(Frame& F, int l, int b, int g) {
    const int lane = F.lane, fr = lane & 15, fq = lane >> 4, seg = F.wave;
    bf16* U = (bf16*)(F.ws + WS_R5) + (size_t)b * SEQ * 1024 + g * 16;
    LAS unsigned char* ch = F.lds + S5_CH + seg * S5_CHB; LAS unsigned char* yb = F.lds + S5_YB;
    LAS f32x2* send = (LAS f32x2*)(F.lds + S5_SEND);
#pragma unroll 1
    for (int dir = 0; dir < 2; ++dir) {
        const int q = (l * 2 + dir) * S5G + g;
        const float ar = ((const float*)(F.ws + WS_LBAR))[(size_t)(q * S5P + lane) * 2], ai = ((const float*)(F.ws + WS_LBAR))[(size_t)(q * S5P + lane) * 2 + 1];
        bf16x8 bbf[8], ctf[4], ddf; const bf16x8 zero8 = {0, 0, 0, 0, 0, 0, 0, 0};
        const bf16* BBT = (const bf16*)(F.ws + WS_BBT) + (size_t)q * 128 * 16; const bf16* CT = (const bf16*)(F.ws + WS_CT) + (size_t)q * 16 * 128;
#pragma unroll
        for (int j = 0; j < 8; ++j) bbf[j] = fq < 2 ? *(const bf16x8*)(BBT + (16 * j + fr) * 16 + 8 * fq) : zero8;
#pragma unroll
        for (int ks = 0; ks < 4; ++ks) ctf[ks] = *(const bf16x8*)(CT + fr * 128 + 32 * ks + 8 * fq);
        { const short dv = (short)f2bf(F.in[10][l * S5W + g * 16 + fr]); ddf = zero8;
#pragma unroll
          for (int jj = 0; jj < 8; ++jj) if (8 * fq + jj == fr) ddf[jj] = dv; }
        const int tlo = dir ? SEQ - 256 * (seg + 1) : 256 * seg;
        float sr = 0.f, si = 0.f;
        if (dir == 0) s5_pass<0, false>(F, U, tlo, ar, ai, sr, si, bbf, ctf, ddf, ch, yb, U); else s5_pass<1, false>(F, U, tlo, ar, ai, sr, si, bbf, ctf, ddf, ch, yb, U);
        send[seg * 64 + lane] = (f32x2){sr, si};
        LDS_WAIT(); __syncthreads();
        float pr = ar, pi = ai;
#pragma unroll
        for (int k = 0; k < 8; ++k) { const float nr = pr * pr - pi * pi, ni = 2.f * pr * pi; pr = nr; pi = ni; }
        sr = 0.f; si = 0.f;
        for (int k = 0; k < seg; ++k) { const f32x2 e = send[k * 64 + lane]; const float nr = pr * sr - pi * si + e.x, ni = pr * si + pi * sr + e.y; sr = nr; si = ni; }
        if (dir == 0) s5_pass<0, true>(F, U, tlo, ar, ai, sr, si, bbf, ctf, ddf, ch, yb, U); else s5_pass<1, true>(F, U, tlo, ar, ai, sr, si, bbf, ctf, ddf, ch, yb, U);
        LDS_WAIT(); __syncthreads();
    }
}

constexpr int HY_XB = 0, HY_XBSEQ = 16 * 272 * 8, HY_KF = 2 * HY_XBSEQ, HY_RAW = HY_KF + 65536, HY_RAWROW = 2064, HY_W3C = HY_RAW + 4 * HY_RAWROW * 2, HY_RED = HY_W3C + 1024;
static_assert(HY_RED + 256 <= LDSCTL_OFF, "hyena LDS map");

#define CMUL(ar, ai, br, bi, cr, ci) do { const float _r = (ar) * (br) - (ai) * (bi); const float _i = (ar) * (bi) + (ai) * (br); (cr) = _r; (ci) = _i; } while (0)
template <bool INV> __device__ __forceinline__ void r4(float& x0r, float& x0i, float& x1r, float& x1i, float& x2r, float& x2i, float& x3r, float& x3i) {
    const float t0r = x0r + x2r, t0i = x0i + x2i, t1r = x0r - x2r, t1i = x0i - x2i, t2r = x1r + x3r, t2i = x1i + x3i, t3r = x1r - x3r, t3i = x1i - x3i;
    x0r = t0r + t2r; x0i = t0i + t2i; x2r = t0r - t2r; x2i = t0i - t2i;
    if (!INV) { x1r = t1r + t3i; x1i = t1i - t3r; x3r = t1r - t3i; x3i = t1i + t3r; }
    else      { x1r = t1r - t3i; x1i = t1i + t3r; x3r = t1r + t3i; x3i = t1i - t3r; }
}
template <bool INV> __device__ __forceinline__ void dft16(float (&re)[16], float (&im)[16]) {
#pragma unroll
    for (int n0 = 0; n0 < 4; ++n0) r4<INV>(re[n0], im[n0], re[n0 + 4], im[n0 + 4], re[n0 + 8], im[n0 + 8], re[n0 + 12], im[n0 + 12]);
    __builtin_amdgcn_sched_barrier(0);
    constexpr float C1 = 0.9238795325112867f, S1 = 0.3826834323650898f, R = 0.7071067811865476f;
    constexpr float sg = INV ? 1.f : -1.f;
#define TW(slot, wr, wi) CMUL(re[slot], im[slot], (wr), sg * (wi), re[slot], im[slot])
    TW(1 + 4 * 1, C1, S1);  TW(2 + 4 * 1, R, R);    TW(3 + 4 * 1, S1, C1);
    TW(1 + 4 * 2, R, R);    TW(2 + 4 * 2, 0.f, 1.f); TW(3 + 4 * 2, -R, R);
    TW(1 + 4 * 3, S1, C1);  TW(2 + 4 * 3, -R, R);   TW(3 + 4 * 3, -C1, -S1);
#undef TW
    __builtin_amdgcn_sched_barrier(0);
#pragma unroll
    for (int k1 = 0; k1 < 4; ++k1) r4<INV>(re[4 * k1], im[4 * k1], re[4 * k1 + 1], im[4 * k1 + 1], re[4 * k1 + 2], im[4 * k1 + 2], re[4 * k1 + 3], im[4 * k1 + 3]);
    __builtin_amdgcn_sched_barrier(0);
#pragma unroll
    for (int a = 0; a < 4; ++a)
#pragma unroll
        for (int b = a + 1; b < 4; ++b) { float t = re[4 * a + b]; re[4 * a + b] = re[4 * b + a]; re[4 * b + a] = t; t = im[4 * a + b]; im[4 * a + b] = im[4 * b + a]; im[4 * b + a] = t; }
}
__device__ __forceinline__ void twiddle_pow(float (&re)[16], float (&im)[16], float wr, float wi) {
    __builtin_amdgcn_sched_barrier(0);
    float pr[9], pi[9]; pr[1] = wr; pi[1] = wi;
#define AP(s, xr, xi) CMUL(re[s], im[s], (xr), (xi), re[s], im[s])
    AP(1, pr[1], pi[1]);
    CMUL(pr[1], pi[1], pr[1], pi[1], pr[2], pi[2]); AP(2, pr[2], pi[2]);
    CMUL(pr[2], pi[2], pr[1], pi[1], pr[3], pi[3]); AP(3, pr[3], pi[3]);
    CMUL(pr[2], pi[2], pr[2], pi[2], pr[4], pi[4]); AP(4, pr[4], pi[4]);
    CMUL(pr[4], pi[4], pr[1], pi[1], pr[5], pi[5]); AP(5, pr[5], pi[5]);
    CMUL(pr[4], pi[4], pr[2], pi[2], pr[6], pi[6]); AP(6, pr[6], pi[6]);
    CMUL(pr[4], pi[4], pr[3], pi[3], pr[7], pi[7]); AP(7, pr[7], pi[7]);
    CMUL(pr[4], pi[4], pr[4], pi[4], pr[8], pi[8]); AP(8, pr[8], pi[8]);
#pragma unroll
    for (int s = 9; s < 16; ++s) { float qr, qi; CMUL(pr[8], pi[8], pr[s - 8], pi[s - 8], qr, qi); AP(s, qr, qi); }
#undef AP
    __builtin_amdgcn_sched_barrier(0);
}
__device__ __forceinline__ void w4096(int e, float sign, float& wr, float& wi) { float rev = (float)(e & 4095) * (1.0f / 4096.0f); asm volatile("" : "+v"(rev));   wr = __builtin_amdgcn_cosf(rev); wi = sign * __builtin_amdgcn_sinf(rev); }

__device__ __forceinline__ void xchg(LAS f32x2* xb, float (&re)[16], float (&im)[16], int wbase, int wstride, int rbase, int rstride) {
    __builtin_amdgcn_sched_barrier(0);
#pragma unroll
    for (int s = 0; s < 16; ++s) xb[wbase + s * wstride] = (f32x2){re[s], im[s]};
    LDS_WAIT(); __syncthreads();
#pragma unroll
    for (int s = 0; s < 16; ++s) { const f32x2 v = xb[rbase + s * rstride]; re[s] = v.x; im[s] = v.y; }
    LDS_WAIT(); __syncthreads();
}
__device__ __forceinline__ void fft_fwd(LAS f32x2* xb, float (&re)[16], float (&im)[16], int j) {
    const int hi = j >> 4, lo = j & 15; float wr, wi;
    dft16<false>(re, im);
    w4096(j, -1.f, wr, wi); twiddle_pow(re, im, wr, wi);
    xchg(xb, re, im, 17 * hi + lo, 272, 272 * hi + lo, 17);
    dft16<false>(re, im);
    w4096(16 * lo, -1.f, wr, wi); twiddle_pow(re, im, wr, wi);
    xchg(xb, re, im, 272 * hi + lo, 17, 272 * hi + 17 * lo, 1);
    dft16<false>(re, im);
}
__device__ __forceinline__ void fft_inv(LAS f32x2* xb, float (&re)[16], float (&im)[16], int j) {
    const int hi = j >> 4, lo = j & 15; float wr, wi;
    dft16<true>(re, im);
    w4096(16 * lo, 1.f, wr, wi); twiddle_pow(re, im, wr, wi);
    xchg(xb, re, im, 272 * hi + 17 * lo, 1, 272 * hi + lo, 17);
    dft16<true>(re, im);
    { float ur, ui; w4096(lo * hi, 1.f, ur, ui);
      w4096(16 * hi, 1.f, wr, wi); twiddle_pow(re, im, wr, wi);
#pragma unroll
      for (int s = 0; s < 16; ++s) CMUL(re[s], im[s], ur, ui, re[s], im[s]); }
    xchg(xb, re, im, 272 * hi + lo, 17, 17 * hi + lo, 272);
    dft16<true>(re, im);
}
__device__ __forceinline__ void hy_stage(Frame& F, const bf16* src  ) {
    LAS unsigned char* raw = F.lds + HY_RAW;
#pragma unroll
    for (int i = 0; i < 2; ++i) { const int q = F.tid + 512 * i, bb = q >> 8, t0 = (q & 255) * 8;
        const v4u v = *(const GAS v4u*)(src + (size_t)bb * SEQ + t0);
        *(LAS v4u*)(raw + bb * (HY_RAWROW * 2) + 16 + 2 * t0) = v; }
    if (F.tid < 8) { const int bb = F.tid >> 1; LAS unsigned short* row = (LAS unsigned short*)(raw + bb * (HY_RAWROW * 2)); row[(F.tid & 1) ? 8 + SEQ : 7] = 0; }
}
__device__ __forceinline__ float raw_at(LAS unsigned char* raw, int bb, int t) { return bf2f(*(const LAS unsigned short*)(raw + bb * (HY_RAWROW * 2) + 16 + 2 * t)); }

__device__ __forceinline__ void hy_item(Frame& F, int l, int c) {
    const int tid = F.tid, sq = tid >> 8, j = tid & 255;
    LAS f32x2* xb = (LAS f32x2*)(F.lds + HY_XB + sq * HY_XBSEQ);
    LAS f32x2* kf = (LAS f32x2*)(F.lds + HY_KF);
    LAS float* hfb = (LAS float*)(F.lds + HY_KF);
    LAS float* w3c = (LAS float*)(F.lds + HY_W3C); LAS float* red = (LAS float*)(F.lds + HY_RED);
    LAS unsigned char* raw = F.lds + HY_RAW;
    const bf16* PV = (const bf16*)(F.ws + WS_R1) + (size_t)c * M; const bf16* PX1 = (const bf16*)(F.ws + WS_R2) + (size_t)c * M; const bf16* PX2 = (const bf16*)(F.ws + WS_R3) + (size_t)c * M;
    const bf16* GH = (const bf16*)(F.ws + WS_R4) + (size_t)c * M; bf16* OUT = (bf16*)(F.ws + WS_R1) + (size_t)c * M;
#ifndef HYDBG_NOFILT
    { const float* w3 = F.in[20] + (size_t)l * HYN * HYF; const float* dec = F.in[21] + (size_t)l * HYF; const float* H2 = (const float*)(F.ws + WS_H2) + (size_t)l * SEQ * HYN;
      if (tid < 256) { const int jj = tid >> 2, f4 = tid & 3; w3c[jj * 4 + f4] = w3[(size_t)jj * HYF + (f4 >> 1) * 2 * HYW + (f4 & 1) * HYW + c]; }
      LDS_WAIT(); __syncthreads();
      float dk[4];
#pragma unroll
      for (int f4 = 0; f4 < 4; ++f4) dk[f4] = fabsf(dec[(f4 >> 1) * 2 * HYW + (f4 & 1) * HYW + c]);
      float ss0 = 0.f, ss1 = 0.f;
#pragma unroll 1
      for (int i = 0; i < 4; ++i) { const int t = tid + 512 * i; const f32x4* hp = (const f32x4*)(H2 + (size_t)t * HYN); f32x4 a = {0.f, 0.f, 0.f, 0.f};
#pragma unroll 2
          for (int q4 = 0; q4 < 16; ++q4) { const f32x4 hv = hp[q4];
#pragma unroll
              for (int e = 0; e < 4; ++e) { const f32x4 wv = *(const LAS f32x4*)(w3c + (4 * q4 + e) * 4); a += hv[e] * wv; } }
          const float tn = (float)t / (float)(SEQ - 1);
#pragma unroll
          for (int f4 = 0; f4 < 4; ++f4) { const float v = a[f4] * (__expf(-tn * dk[f4]) + 0.05f); hfb[f4 * SEQ + t] = v; const float sqv = ((f4 & 1) && t == 0) ? 0.f : v * v; if (f4 < 2) ss0 += sqv; else ss1 += sqv; } }
      ss0 = wave_sum(ss0); ss1 = wave_sum(ss1);
      if (F.lane == 0) { red[F.wave * 2] = ss0; red[F.wave * 2 + 1] = ss1; }
      LDS_WAIT(); __syncthreads(); }
#endif
    float nrm0 = 0.f, nrm1 = 0.f;
#pragma unroll
    for (int w = 0; w < 8; ++w) { nrm0 += red[2 * w]; nrm1 += red[2 * w + 1]; }
    nrm0 = 1.0f / sqrtf(nrm0 + 1e-6f); nrm1 = 1.0f / sqrtf(nrm1 + 1e-6f);
    float re[16], im[16];
#ifndef HYDBG_NOFFFT
#pragma unroll
    for (int m = 0; m < 16; ++m) { const int idx = 256 * m + j; float a, b;
        if (idx < SEQ) { a = hfb[idx]; b = hfb[2 * SEQ + idx]; } else if (idx == SEQ) { a = 0.f; b = 0.f; } else { a = hfb[SEQ + (2 * SEQ - idx)]; b = hfb[3 * SEQ + (2 * SEQ - idx)]; }
        re[m] = a * nrm0; im[m] = b * nrm1; }
    LDS_WAIT(); __syncthreads();
    fft_fwd(xb, re, im, j);
    { LAS f32x2* zb = (LAS f32x2*)(F.lds + HY_XB);
      if (sq == 0) {
#pragma unroll
          for (int k0 = 0; k0 < 16; ++k0) zb[k0 * 256 + j] = (f32x2){re[k0], im[k0]}; }
      LDS_WAIT(); __syncthreads();
      const int kb = (j >> 4) + 16 * (j & 15);
#pragma unroll
      for (int i = 0; i < 8; ++i) { const int k0 = 8 * sq + i; const int k = kb + 256 * k0, kc = (4096 - k) & 4095; const int jc = 16 * (kc & 15) + ((kc >> 4) & 15), k0c = kc >> 8;
          const f32x2 z = zb[k0 * 256 + j], zc = zb[k0c * 256 + jc]; const float sc = 0.5f / 4096.0f;
          kf[k0 * 256 + j] = (f32x2){(z.x + zc.x) * sc, (z.y - zc.y) * sc};
          kf[4096 + k0 * 256 + j] = (f32x2){(z.y + zc.y) * sc, -(z.x - zc.x) * sc}; }
      LDS_WAIT(); __syncthreads(); }
#endif
#ifndef HYDBG_NOMAIN
    const float* cw = F.in[13] + (size_t)l * 3 * 3 * HYW; const float* cb = F.in[14] + (size_t)l * 3 * HYW; const float* hd = F.in[22] + (size_t)l * 2 * HYW;
#pragma unroll 1
    for (int r = 0; r < 2; ++r) {
        float zr[8], zi[8];
        hy_stage(F, PV + (size_t)(4 * r) * SEQ); LDS_WAIT(); __syncthreads();
        { const float vw0 = cw[c], vw1 = cw[3 * HYW + c], vw2 = cw[6 * HYW + c], vb = cb[c];
#pragma unroll
          for (int m = 0; m < 8; ++m) { const int t = 256 * m + j;
              zr[m] = vb + vw0 * raw_at(raw, 2 * sq, t - 1) + vw1 * raw_at(raw, 2 * sq, t) + vw2 * raw_at(raw, 2 * sq, t + 1);
              zi[m] = vb + vw0 * raw_at(raw, 2 * sq + 1, t - 1) + vw1 * raw_at(raw, 2 * sq + 1, t) + vw2 * raw_at(raw, 2 * sq + 1, t + 1); } }
#pragma unroll 1
        for (int o = 0; o < 2; ++o) {
            const bf16* PX = o == 0 ? PX1 : PX2; const int xo = (o + 1) * HYW + c;
#pragma unroll
            for (int m = 0; m < 8; ++m) { re[m] = zr[m]; im[m] = zi[m]; re[m + 8] = 0.f; im[m + 8] = 0.f; }
            fft_fwd(xb, re, im, j);
#pragma unroll
            for (int k0 = 0; k0 < 16; ++k0) { const f32x2 kv = kf[o * 4096 + k0 * 256 + j]; CMUL(re[k0], im[k0], kv.x, kv.y, re[k0], im[k0]); }
            fft_inv(xb, re, im, j);
            hy_stage(F, PX + (size_t)(4 * r) * SEQ); LDS_WAIT(); __syncthreads();
            const float gw0 = cw[xo], gw1 = cw[3 * HYW + xo], gw2 = cw[6 * HYW + xo], gb = cb[xo], dco = hd[o * HYW + c];
#pragma unroll
            for (int m = 0; m < 8; ++m) { const int t = 256 * m + j;
                const float g0 = gb + gw0 * raw_at(raw, 2 * sq, t - 1) + gw1 * raw_at(raw, 2 * sq, t) + gw2 * raw_at(raw, 2 * sq, t + 1);
                const float g1 = gb + gw0 * raw_at(raw, 2 * sq + 1, t - 1) + gw1 * raw_at(raw, 2 * sq + 1, t) + gw2 * raw_at(raw, 2 * sq + 1, t + 1);
                zr[m] = g0 * (re[m] + dco * zr[m]); zi[m] = g1 * (im[m] + dco * zi[m]); }
            LDS_WAIT(); __syncthreads();
        }
        hy_stage(F, GH + (size_t)(4 * r) * SEQ); LDS_WAIT(); __syncthreads();
#pragma unroll
        for (int m = 0; m < 8; ++m) { const int t = 256 * m + j; const float g0 = raw_at(raw, 2 * sq, t), g1 = raw_at(raw, 2 * sq + 1, t);
            OUT[(size_t)(4 * r + 2 * sq) * SEQ + t] = (bf16)f2bf(zr[m] * g0 * fast_sigmoid(g0));
            OUT[(size_t)(4 * r + 2 * sq + 1) * SEQ + t] = (bf16)f2bf(zi[m] * g1 * fast_sigmoid(g1)); }
        LDS_WAIT(); __syncthreads();
    }
#endif
}

__device__ __forceinline__ void transpose_pass(Frame& F) {
    const bf16* src = (const bf16*)(F.ws + WS_R1); bf16* dst = (bf16*)(F.ws + WS_R2);
    LAS unsigned char* tile = F.lds + F.wave * 9216; const int lane = F.lane;
    const int gw = F.bx * NWAVES + F.wave, NGW = F.G * NWAVES;
    constexpr int NTC = HYW / 64, NTT = M / 64;
    for (int it = gw; it < NTC * NTT; it += NGW) { const int c0 = (it % NTC) * 64, t0 = (it / NTC) * 64;
#pragma unroll
        for (int i = 0; i < 8; ++i) { const int q = lane + 64 * i, cr = q >> 3, ch = q & 7;
            const v4u v = *(const GAS v4u*)(src + (size_t)(c0 + cr) * M + t0 + 8 * ch); *(LAS v4u*)(tile + cr * 144 + 16 * ch) = v; }
        LDS_WAIT(); asm volatile("" ::: "memory");
#pragma unroll
        for (int i = 0; i < 8; ++i) { const int q = lane + 64 * i, tr = q >> 3, ch = q & 7;
            unsigned short e[8];
#pragma unroll
            for (int k = 0; k < 8; ++k) e[k] = *(const LAS unsigned short*)(tile + (8 * ch + k) * 144 + 2 * tr);
            v4u o; o.x = e[0] | ((unsigned)e[1] << 16); o.y = e[2] | ((unsigned)e[3] << 16); o.z = e[4] | ((unsigned)e[5] << 16); o.w = e[6] | ((unsigned)e[7] << 16);
            *(GAS v4u*)(dst + (size_t)(t0 + tr) * HYW + c0 + 8 * ch) = o; }
        LDS_WAIT(); asm volatile("" ::: "memory");
    }
}
__device__ __forceinline__ void final_norm(Frame& F) {
    const int gw = F.bx * NWAVES + F.wave, NGW = F.G * NWAVES, lane = F.lane; const GAS f32x4* wv = (const GAS f32x4*)F.in[26] + lane;
    f32x4 w[4];
#pragma unroll
    for (int j = 0; j < 4; ++j) w[j] = wv[64 * j];
    for (int m = gw; m < M; m += NGW) { GAS f32x4* xr = (GAS f32x4*)(F.out + (size_t)m * D) + lane; f32x4 v[4]; float s = 0.f;
#pragma unroll
        for (int j = 0; j < 4; ++j) { v[j] = xr[64 * j]; s += (v[j].x * v[j].x + v[j].y * v[j].y) + (v[j].z * v[j].z + v[j].w * v[j].w); }
        const float rs = 1.0f / sqrtf(wave_sum(s) * (1.0f / D) + 1e-6f);
#pragma unroll
        for (int j = 0; j < 4; ++j) xr[64 * j] = v[j] * rs * w[j]; }
}

struct Args { const float* in[27]; float* out; unsigned char* ws; int ph_lo, ph_hi; };
__global__ void __launch_bounds__(NTHREADS, 2) mk_fwd(Args args) {
    extern __shared__ __attribute__((aligned(16))) unsigned char lds[];
    Frame F; F.lds = (LAS unsigned char*)lds; F.tid = threadIdx.x; F.lane = F.tid & 63; F.wave = __builtin_amdgcn_readfirstlane(F.tid >> 6); F.G = gridDim.x; F.bx = blockIdx.x;
#pragma unroll
    for (int i = 0; i < 27; ++i) F.in[i] = args.in[i];
    F.out = args.out; F.ws = args.ws;
    volatile LAS unsigned* MISC = (volatile LAS unsigned*)(F.lds + LDSCTL_OFF);
    if (F.tid < 64) MISC[F.tid] = 0u;
    __syncthreads();
    XcdBarrier bar; bar.bar = (unsigned*)(F.ws + WS_CTL) + 1024; bar.x = 0; bar.st = nullptr;
    if (!MK_PER_PHASE) bar = xcd_barrier_post((unsigned*)(F.ws + WS_CTL) + 1024, MISC + 8);
    const int lo = args.ph_lo, hi = args.ph_hi;
#define IN(k) (lo <= (k) && (k) < hi)
#define SEAM(k) do { if (IN(k) && IN((k) + 1)) xcd_barrier(bar); } while (0)
    LAS unsigned char* ring = F.lds;
#ifndef MK_ONLY
#define MK_ONLY -1
#endif
#define ON(k) (MK_ONLY < 0 || MK_ONLY == (k))
    if (ON(0) && IN(0)) { p0_prologue(F); }
    SEAM(0);
#pragma unroll 1
    for (int l = 0; l < DEPTH; ++l) {
        const int pb = 1 + 5 * l;
        unsigned char* wsl = F.ws; asm volatile("" : "+s"(wsl));
#define WSL(off) (wsl + (off))
#define OPQ(p) asm volatile("" : "+s"(p))
#define FRAME_P(Fp) Frame Fp = F; { int t_ = F.tid; asm volatile("" : "+v"(t_)); Fp.tid = t_; Fp.lane = t_ & 63; Fp.wave = __builtin_amdgcn_readfirstlane(t_ >> 6); Fp.ws = wsl; }
        bf16* wl = (bf16*)WSL(WS_W + (size_t)l * W_LAYER);
        bf16* X = (bf16*)WSL(WS_X); float* ssq = (float*)WSL(WS_SSQ);
        bf16 *R1 = (bf16*)WSL(WS_R1), *R2 = (bf16*)WSL(WS_R2), *R3 = (bf16*)WSL(WS_R3), *R5 = (bf16*)WSL(WS_R5), *R6 = (bf16*)WSL(WS_R6);
        if (ON(1) && IN(pb)) {
            { pg8::Gemm g{wl + W_IN / 2, X, 4096, M, D, D, D}; pg8::StaticOrder S; S.init(4096, M, F.G, F.bx); pg8::EpiHT E{R1, M, ssq};
              pg8::gemm_phase<pg8::EpiHT, pg8::StaticOrder, true, true, 1024, 1024, 1024>(ring, g, S, E); }
            OPQ(X); OPQ(wl);
            { pg8::Gemm g{X, wl + W_IN / 2 + (size_t)4096 * D, M, 1024, D, D, D}; pg8::StaticOrder S; S.init(M, 1024, F.G, F.bx); pg8::EpiRow<0> E{R5, 1024, ssq};
              pg8::gemm_phase<pg8::EpiRow<0>, pg8::StaticOrder, true, true, 1024, 1024, 1024>(ring, g, S, E); }
        }
        SEAM(pb);
        if (IN(pb + 1)) {
            if (ON(2)) { FRAME_P(Fp); for (int it = F.bx; it < BATCH * S5G; it += F.G) s5_item(Fp, l, it / S5G, it % S5G); }
            if (ON(3)) { FRAME_P(Fp); for (int c = F.bx; c < HYW; c += F.G) hy_item(Fp, l, c); }
        }
        SEAM(pb + 1);
        if (ON(4) && IN(pb + 2)) {
            { pg8::Gemm g{X, wl + W_IN / 2 + (size_t)5120 * D, M, 2048, D, D, D}; pg8::StaticOrder S; S.init(M, 2048, F.G, F.bx); pg8::EpiRow<1> E{R3, 2048, ssq};
              pg8::gemm_phase<pg8::EpiRow<1>, pg8::StaticOrder, true, true, 1024, 1024, 1024>(ring, g, S, E); }
            OPQ(R5); OPQ(wl);
            { pg8::Gemm g{R5, wl + W_GLU / 2, M, S5W, S5W, 1024, S5W}; pg8::StaticOrder S; S.init(M, S5W, F.G, F.bx); pg8::EpiGLU E{R6, S5W, R5, 1024, F.in[12] + l * S5W};
              pg8::gemm_phase<pg8::EpiGLU, pg8::StaticOrder, true, true, 512, 1024, 512>(ring, g, S, E); }
            __syncthreads();
            { FRAME_P(Fp); transpose_pass(Fp); }
        }
        SEAM(pb + 2);
        if (ON(5) && IN(pb + 3)) {
            { pg8::Gemm g{R6, wl + W_BS5 / 2, M, D, S5W, S5W, S5W}; pg8::StaticOrder S; S.init(M, D, F.G, F.bx); pg8::EpiMerge<0> E{R1, D, R3, 2048, 0};
              pg8::gemm_phase<pg8::EpiMerge<0>, pg8::StaticOrder, true, true, 512, 512, 512>(ring, g, S, E); }
            VM_WAIT(); __syncthreads();
            OPQ(R2); OPQ(wl);
            { pg8::Gemm g{R2, wl + W_BHY / 2, M, D, HYW, HYW, HYW}; pg8::StaticOrder S; S.init(M, D, F.G, F.bx); pg8::EpiMerge<1> E{R1, D, R3, 2048, 1024};
              pg8::gemm_phase<pg8::EpiMerge<1>, pg8::StaticOrder, true, true, 1024, 1024, 1024>(ring, g, S, E); }
        }
        SEAM(pb + 3);
        if (ON(6) && IN(pb + 4)) {
            pg8::Gemm g{R1, wl + W_OUT / 2, M, D, D, D, D}; pg8::StaticOrder S; S.init(M, D, F.G, F.bx); pg8::EpiOut E{l == 0 ? F.in[0] : F.out, F.out, X, ssq};
            pg8::gemm_phase<pg8::EpiOut, pg8::StaticOrder, true, true, 1024, 1024, 1024>(ring, g, S, E);
        }
        SEAM(pb + 4);
    }
    if (ON(7) && IN(11)) final_norm(F);
#undef IN
#undef SEAM
}

#if defined(MK_DEBUG_HASH)
extern "C" void kernel_launch_dbg(void* const* d_in, void* d_out, void* d_ws, hipStream_t stream, int grid);
#endif
extern "C" void kernel_launch(void* const* d_in, const int* in_sizes, int n_in, void* d_out, int out_size, void* d_ws, size_t ws_size, hipStream_t stream) {
    static int grid = 0;
    if (grid == 0) {
        if (n_in != 27 || out_size != M * D || ws_size < WS_END) { fprintf(stderr, "kernel_launch: unexpected shapes (n_in %d out %d ws %zu)\n", n_in, out_size, ws_size); grid = -1; return; }
        int dev = 0, cus = 0, per_cu = 0;
        if (hipGetDevice(&dev) != hipSuccess || hipDeviceGetAttribute(&cus, hipDeviceAttributeMultiprocessorCount, dev) != hipSuccess) { grid = -1; return; }
        if (hipFuncSetAttribute((const void*)mk_fwd, hipFuncAttributeMaxDynamicSharedMemorySize, LDS_BYTES) != hipSuccess) { fprintf(stderr, "kernel_launch: hipFuncSetAttribute failed\n"); grid = -1; return; }
        if (hipOccupancyMaxActiveBlocksPerMultiprocessor(&per_cu, (const void*)mk_fwd, NTHREADS, LDS_BYTES) != hipSuccess || per_cu < 1) fprintf(stderr, "kernel_launch: occupancy query says %d\n", per_cu);
        (void)hipGetLastError();
        grid = cus;
    }
    if (grid < 0) return;
    (void)hipMemsetAsync((char*)d_ws + WS_CTL, 0, CTL_ZERO_BYTES, stream);
    Args a{};
    for (int i = 0; i < 27; ++i) a.in[i] = (const float*)d_in[i];
    a.out = (float*)d_out; a.ws = (unsigned char*)d_ws;
#if defined(MK_DEBUG_HASH)
    kernel_launch_dbg(d_in, d_out, d_ws, stream, grid);
#elif MK_PER_PHASE
    for (int p = 0; p < NPHASE; ++p) { a.ph_lo = p; a.ph_hi = p + 1; hipLaunchKernelGGL(mk_fwd, dim3(grid), dim3(NTHREADS), LDS_BYTES, stream, a); }
#else
    a.ph_lo = 0; a.ph_hi = NPHASE; hipLaunchKernelGGL(mk_fwd, dim3(grid), dim3(NTHREADS), LDS_BYTES, stream, a);
#endif
}

#if defined(MK_DEBUG_HASH)
__global__ void dbg_hash(const unsigned* p, size_t nwords, unsigned long long* out) {
    unsigned long long s = 0; for (size_t i = (size_t)blockIdx.x * blockDim.x + threadIdx.x; i < nwords; i += (size_t)gridDim.x * blockDim.x) s += p[i];
    atomicAdd(out, s);
}
__global__ void dbg_report(const unsigned long long* h, float* out, size_t n) {
    int first = -1; for (int p = 0; p < NPHASE && first < 0; ++p) for (int r = 0; r < 4; ++r) if (h[p * 4 + r] != h[NPHASE * 4 + p * 4 + r]) { first = p; break; }
    const float c = first < 0 ? 0.f : sqrtf((float)(first + 1));
    for (size_t i = (size_t)blockIdx.x * blockDim.x + threadIdx.x; i < n; i += (size_t)gridDim.x * blockDim.x) out[i] = c;
}
extern "C" void kernel_launch_dbg(void* const* d_in, void* d_out, void* d_ws, hipStream_t stream, int grid) {
    Args a{}; for (int i = 0; i < 27; ++i) a.in[i] = (const float*)d_in[i];
    a.out = (float*)d_out; a.ws = (unsigned char*)d_ws;
    unsigned long long* H = (unsigned long long*)((char*)d_ws + 253 * MiB);
    (void)hipMemsetAsync(H, 0, 2 * NPHASE * 4 * 8, stream);
    struct Reg { size_t off, len; bool out; };
    auto regs_of = [&](int p, Reg (&r)[4]) { for (int i = 0; i < 4; ++i) r[i] = Reg{0, 0, false};
        if (p == 0) { r[0] = Reg{1 * MiB, 1 * MiB, false}; r[1] = Reg{2 * MiB, 1 * MiB + 64 * 1024, false}; r[2] = Reg{4 * MiB, 39 * MiB, false}; r[3] = Reg{43 * MiB, 33 * MiB, false}; return; }
        if (p == 11) { r[0] = Reg{0, (size_t)M * D * 4, true}; return; }
        const int q = (p - 1) % 5;
        if (q == 0) { r[0] = Reg{WS_R1, 128 * MiB, false}; r[1] = Reg{WS_R5, 32 * MiB, false}; }
        if (q == 1) { r[0] = Reg{WS_R1, 32 * MiB, false}; r[1] = Reg{WS_R5, 32 * MiB, false}; }
        if (q == 2) { r[0] = Reg{WS_R3, 64 * MiB, false}; r[1] = Reg{WS_R6, 16 * MiB, false}; r[2] = Reg{WS_R2, 32 * MiB, false}; }
        if (q == 3) { r[0] = Reg{WS_R1, 32 * MiB, false}; }
        if (q == 4) { r[0] = Reg{0, (size_t)M * D * 4, true}; r[1] = Reg{WS_X, 32 * MiB, false}; r[2] = Reg{WS_SSQ, 1 * MiB, false}; } };
    for (int run = 0; run < 2; ++run) {
        if (run == 0) (void)hipMemsetAsync((char*)d_ws + 1 * MiB, 0xAA, 251 * MiB, stream);
        (void)hipMemsetAsync((char*)d_ws + WS_CTL, 0, CTL_ZERO_BYTES, stream);
        for (int p = 0; p < NPHASE; ++p) { a.ph_lo = p; a.ph_hi = p + 1; hipLaunchKernelGGL(mk_fwd, dim3(grid), dim3(NTHREADS), LDS_BYTES, stream, a);
            Reg r[4]; regs_of(p, r);
            for (int i = 0; i < 4; ++i) if (r[i].len) hipLaunchKernelGGL(dbg_hash, dim3(1024), dim3(256), 0, stream, (const unsigned*)((r[i].out ? (char*)d_out : (char*)d_ws) + r[i].off), r[i].len / 4, H + (run * NPHASE + p) * 4 + i); }
    }
    hipLaunchKernelGGL(dbg_report, dim3(1024), dim3(256), 0, stream, H, (float*)d_out, (size_t)M * D);
}
#endif
```

```cpp
#include <hip/hip_runtime.h>
#include <cstdio>
#include <cstdint>
#include <cmath>
#include <utility>
namespace pg8 {
#define PG8_LAS __attribute__((address_space(3)))
typedef unsigned short bf16_t;
typedef short bf16x8 __attribute__((ext_vector_type(8)));
typedef float f32x4 __attribute__((ext_vector_type(4)));
typedef unsigned u32x4 __attribute__((ext_vector_type(4)));
constexpr int BM = 256, BK = 64, HALF = 128, HTB = HALF * BK * 2  , STAGE_BYTES = 8 * HTB, NXCD = 8, WGM = 8;

__host__ __device__ __forceinline__ int lds_byte(int r, int c) { const int st = (r >> 4) * 2 + (c >> 5), rr = r & 15, cc = c & 31, ob = rr * 64 + cc * 2; return st * 1024 + (ob ^ (((ob >> 9) & 1) << 5)); }
__host__ __device__ __forceinline__ void stage_rc(int b, int& R, int& C) { const int st = b / 1024, sb = b % 1024, swz = sb ^ (((sb >> 9) & 1) << 5); R = (st >> 1) * 16 + swz / 64; C = (st & 1) * 32 + (swz % 64) / 2; }
__host__ __device__ __forceinline__ int perm32(int rho) { const int n = rho >> 4, i = rho & 15; return 8 * (i >> 2) + 4 * n + (i & 3); }

struct Unit { int pm, pn; };
struct Gemm { const bf16_t* A; const bf16_t* Bt; int M, N, K, lda, ldb; };

struct StaticOrder {
    int nM, nN, nwg, G, c;
    __host__ __device__ void init(int M, int N, int G_, int c_) { nM = M / BM; nN = N / BM; nwg = nM * nN; G = G_; c = c_; }
    __host__ __device__ bool next(int i, Unit& u) const {
        const long L = (long)i * G + c; if (L >= nwg) return false;
        int wgid = (int)L; { const int q = nwg / NXCD, r = nwg % NXCD, xcd = wgid % NXCD, off = wgid / NXCD; wgid = (xcd < r ? xcd * (q + 1) : r * (q + 1) + (xcd - r) * q) + off; }
        const int nig = WGM * nN, gid = wgid / nig, fm = gid * WGM, gsz = (nM - fm) < WGM ? (nM - fm) : WGM;
        u.pm = fm + ((wgid % nig) % gsz); u.pn = (wgid % nig) / gsz; return true;
    }
    __device__ __forceinline__ void a_ready(const Unit&) const {}
    __device__ __forceinline__ void done(const Unit&) const {}
};

typedef unsigned u32x2 __attribute__((ext_vector_type(2)));

typedef __bf16 bf16x2_t __attribute__((ext_vector_type(2)));
typedef float f32x2_t __attribute__((ext_vector_type(2)));
__device__ __forceinline__ unsigned cvt_pk_bf16(float lo, float hi) { const f32x2_t v = {lo, hi}; const bf16x2_t b = __builtin_convertvector(v, bf16x2_t); return __builtin_bit_cast(unsigned, b); }
__device__ __forceinline__ float bf_lo(unsigned w) { return __uint_as_float(w << 16); }
__device__ __forceinline__ float bf_hi(unsigned w) { return __uint_as_float(w & 0xffff0000u); }
__device__ __forceinline__ float fast_sigmoid(float x) { return __builtin_amdgcn_rcpf(1.0f + __builtin_amdgcn_exp2f(-1.4426950408889634f * x)); }
constexpr float RMS_EPS = 1e-6f;
__device__ __forceinline__ float rs_of(const float* ssq, int tok) {
    const f32x4* p = (const f32x4*)(ssq + (size_t)tok * 16); const f32x4 a = p[0], b = p[1], c = p[2], d = p[3];
    const float s = ((a[0] + a[1]) + (a[2] + a[3])) + ((b[0] + b[1]) + (b[2] + b[3])) + ((c[0] + c[1]) + (c[2] + c[3])) + ((d[0] + d[1]) + (d[2] + d[3]));
    return 1.0f / sqrtf(s * (1.0f / 1024.0f) + RMS_EPS);
}
struct EpiHT {
    static constexpr bool PERM = true, AFTER_DRAIN = false;
    bf16_t* O; int ldc; const float* ssq;
    __device__ __forceinline__ void operator()(const f32x4 (&acc)[2][2][4][2], const Unit& u, int wr, int wc, int fr, int fq) const {
        const int lane = (fq << 4) | fr;
        const int ctile = u.pn * BM + wc * 32 + 8 * fq;
        const float mine = rs_of(ssq, ctile + 128 * (fr >> 3) + (fr & 7));
        const int row0 = u.pm * BM + wr * 64 + fr;
#pragma unroll
        for (int bj = 0; bj < 2; ++bj) { float rsv[8];
#pragma unroll
            for (int i = 0; i < 8; ++i) rsv[i] = __shfl(mine, (lane & 48) | (8 * bj + i));
#pragma unroll
            for (int ai = 0; ai < 2; ++ai)
#pragma unroll
                for (int m = 0; m < 4; ++m) { bf16_t* rowp = O + (size_t)(row0 + ai * HALF + m * 16) * ldc + ctile + bj * HALF;
                    const f32x4 v0 = acc[ai][bj][m][0], v1 = acc[ai][bj][m][1]; u32x4 w;
                    w.x = cvt_pk_bf16(v0[0] * rsv[0], v0[1] * rsv[1]); w.y = cvt_pk_bf16(v0[2] * rsv[2], v0[3] * rsv[3]);
                    w.z = cvt_pk_bf16(v1[0] * rsv[4], v1[1] * rsv[5]); w.w = cvt_pk_bf16(v1[2] * rsv[6], v1[3] * rsv[7]);
                    *(u32x4*)rowp = w; }
            asm volatile("" ::: "memory"); }
    }
};
template <int SIG> struct EpiRow {
    static constexpr bool PERM = true, AFTER_DRAIN = false;
    bf16_t* O; int ldc; const float* ssq;
    __device__ __forceinline__ void operator()(const f32x4 (&acc)[2][2][4][2], const Unit& u, int wr, int wc, int fr, int fq) const {
        const int lane = (fq << 4) | fr;
        const int row0 = u.pm * BM + wr * 64 + fr;
        float mine[2];
#pragma unroll
        for (int i = 0; i < 2; ++i) { const int q = 2 * fq + i; mine[i] = rs_of(ssq, row0 + (q >> 2) * HALF + (q & 3) * 16); }
        const int col0 = u.pn * BM + wc * 32 + 8 * fq;
#pragma unroll
        for (int ai = 0; ai < 2; ++ai)
#pragma unroll
            for (int m = 0; m < 4; ++m) { const int q = ai * 4 + m; const float rs = __shfl(mine[q & 1], ((q >> 1) << 4) | (lane & 15));
                bf16_t* rowp = O + (size_t)(row0 + ai * HALF + m * 16) * ldc + col0;
#pragma unroll
                for (int bj = 0; bj < 2; ++bj) { f32x4 v0 = acc[ai][bj][m][0] * rs, v1 = acc[ai][bj][m][1] * rs;
                    if (SIG) {
#pragma unroll
                        for (int e = 0; e < 4; ++e) { v0[e] = fast_sigmoid(v0[e]); v1[e] = fast_sigmoid(v1[e]); } }
                    u32x4 w; w.x = cvt_pk_bf16(v0[0], v0[1]); w.y = cvt_pk_bf16(v0[2], v0[3]); w.z = cvt_pk_bf16(v1[0], v1[1]); w.w = cvt_pk_bf16(v1[2], v1[3]);
                    *(u32x4*)(rowp + bj * HALF) = w; }
                asm volatile("" ::: "memory"); }
    }
};
struct EpiGLU {
    static constexpr bool PERM = true, AFTER_DRAIN = false;
    bf16_t* O; int ldc; const bf16_t* YG; int ldy; const float* bglu;
    __device__ __forceinline__ void operator()(const f32x4 (&acc)[2][2][4][2], const Unit& u, int wr, int wc, int fr, int fq) const {
        const int row0 = u.pm * BM + wr * 64 + fr, col0 = u.pn * BM + wc * 32 + 8 * fq;
        f32x4 bv[2][2];
#pragma unroll
        for (int bj = 0; bj < 2; ++bj)
#pragma unroll
            for (int n = 0; n < 2; ++n) bv[bj][n] = *(const f32x4*)(bglu + col0 + bj * HALF + 4 * n);
#pragma unroll
        for (int ai = 0; ai < 2; ++ai)
#pragma unroll
            for (int m = 0; m < 4; ++m) { const size_t r = (size_t)(row0 + ai * HALF + m * 16);
#pragma unroll
                for (int bj = 0; bj < 2; ++bj) { const int c = col0 + bj * HALF;
                    const u32x4 yv = *(const u32x4*)(YG + r * ldy + c), gv = *(const u32x4*)(YG + r * ldy + 512 + c);
                    const f32x4 a0 = acc[ai][bj][m][0] + bv[bj][0], a1 = acc[ai][bj][m][1] + bv[bj][1];
                    float o[8]; const unsigned yw[4] = {yv.x, yv.y, yv.z, yv.w}, gw[4] = {gv.x, gv.y, gv.z, gv.w};
#pragma unroll
                    for (int e = 0; e < 8; ++e) { const float a = e < 4 ? a0[e & 3] : a1[e & 3]; const float y = (e & 1) ? bf_hi(yw[e >> 1]) : bf_lo(yw[e >> 1]);
                        const float g = (e & 1) ? bf_hi(gw[e >> 1]) : bf_lo(gw[e >> 1]); o[e] = y * fast_sigmoid(a) * (g * fast_sigmoid(g)); }
                    u32x4 w; w.x = cvt_pk_bf16(o[0], o[1]); w.y = cvt_pk_bf16(o[2], o[3]); w.z = cvt_pk_bf16(o[4], o[5]); w.w = cvt_pk_bf16(o[6], o[7]);
                    *(u32x4*)(O + r * ldc + c) = w; asm volatile("" ::: "memory"); } }
    }
};
template <int ADD> struct EpiMerge {
    static constexpr bool PERM = true, AFTER_DRAIN = false;
    bf16_t* O; int ldc; const bf16_t* G; int ldg; int goff;
    __device__ __forceinline__ void operator()(const f32x4 (&acc)[2][2][4][2], const Unit& u, int wr, int wc, int fr, int fq) const {
        const int row0 = u.pm * BM + wr * 64 + fr, col0 = u.pn * BM + wc * 32 + 8 * fq;
#pragma unroll
        for (int ai = 0; ai < 2; ++ai)
#pragma unroll
            for (int m = 0; m < 4; ++m) { const size_t r = (size_t)(row0 + ai * HALF + m * 16);
#pragma unroll
                for (int bj = 0; bj < 2; ++bj) { const int c = col0 + bj * HALF;
                    const u32x4 gv = *(const u32x4*)(G + r * ldg + goff + c); u32x4 tv = {0u, 0u, 0u, 0u}; if (ADD) tv = *(const u32x4*)(O + r * ldc + c);
                    const f32x4 a0 = acc[ai][bj][m][0], a1 = acc[ai][bj][m][1];
                    float o[8]; const unsigned gw[4] = {gv.x, gv.y, gv.z, gv.w}, tw[4] = {tv.x, tv.y, tv.z, tv.w};
#pragma unroll
                    for (int e = 0; e < 8; ++e) { const float a = e < 4 ? a0[e & 3] : a1[e & 3]; const float g = (e & 1) ? bf_hi(gw[e >> 1]) : bf_lo(gw[e >> 1]);
                        const float t = (e & 1) ? bf_hi(tw[e >> 1]) : bf_lo(tw[e >> 1]); o[e] = (ADD ? t : 0.f) + g * a; }
                    u32x4 w; w.x = cvt_pk_bf16(o[0], o[1]); w.y = cvt_pk_bf16(o[2], o[3]); w.z = cvt_pk_bf16(o[4], o[5]); w.w = cvt_pk_bf16(o[6], o[7]);
                    *(u32x4*)(O + r * ldc + c) = w; asm volatile("" ::: "memory"); } }
    }
};
struct EpiOut {
    static constexpr bool PERM = false, AFTER_DRAIN = false;
    const float* base; float* H; bf16_t* XN; float* ssq;
    __device__ __forceinline__ void operator()(const f32x4 (&acc)[2][2][4][2], const Unit& u, int wr, int wc, int fr, int fq) const {
        const int row0 = u.pm * BM + wr * 64 + fr, col0 = u.pn * BM + wc * 32 + 4 * fq;
#pragma unroll
        for (int ai = 0; ai < 2; ++ai)
#pragma unroll
            for (int m = 0; m < 4; ++m) { const size_t r = (size_t)(row0 + ai * HALF + m * 16); float s = 0.f;
#pragma unroll
                for (int bj = 0; bj < 2; ++bj)
#pragma unroll
                    for (int n = 0; n < 2; ++n) { const size_t off = r * 1024 + col0 + bj * HALF + n * 16;
                        const f32x4 h = *(const f32x4*)(base + off) + acc[ai][bj][m][n]; *(f32x4*)(H + off) = h;
                        s += (h[0] * h[0] + h[1] * h[1]) + (h[2] * h[2] + h[3] * h[3]);
                        u32x2 w; w.x = cvt_pk_bf16(h[0], h[1]); w.y = cvt_pk_bf16(h[2], h[3]); *(u32x2*)(XN + off) = w; }
                s += __shfl_xor(s, 16); s += __shfl_xor(s, 32);
                if (fq == 0) ssq[r * 16 + u.pn * 4 + wc] = s; }
    }
};
template <class Epi, class Sched, bool ALIGN_EPI, bool SP2, int KK, int LDA, int LDB>
__device__ __forceinline__ void gemm_phase(PG8_LAS unsigned char* lds, const Gemm g, const Sched& S, const Epi& E) {
    int tid_ = threadIdx.x; asm volatile("" : "+v"(tid_));
    const int tid = tid_, wid = __builtin_amdgcn_readfirstlane(tid >> 6), lane = tid & 63, wr = wid >> 2, wc = wid & 3, fr = lane & 15, fq = lane >> 4;
    constexpr int K = KK, nt = K / BK;
    unsigned voffA[2], voffB[2];
#pragma unroll
    for (int i = 0; i < 2; ++i) { int R, C; stage_rc(tid * 16 + i * 8192, R, C); const int Rb = Epi::PERM ? ((R & ~31) + perm32(R & 31)) : R;
        voffA[i] = (unsigned)(R * LDA + C) * 2u; voffB[i] = (unsigned)(Rb * LDB + C) * 2u; }
    constexpr size_t kstep = (size_t)(BK * 2);
    constexpr size_t hstepA = (size_t)HALF * LDA * 2, hstepB = (size_t)HALF * LDB * 2;
    constexpr size_t tstepA = 2 * hstepA, tstepB = 2 * hstepB;
    const unsigned ldsw = (unsigned)wid * 1024u;
    const int aoff = lds_byte(wr * 64 + fr, fq * 8), boff = lds_byte(wc * 32 + fr, fq * 8);
#define PG8_SA(b, h) (((b) * 2 + (h)) * HTB)
#define PG8_SB(b, h) ((4 + (b) * 2 + (h)) * HTB)
#define PG8_STAGE(bufoff, gbase, voff) do { _Pragma("unroll") for (int _i = 0; _i < 2; ++_i) \
        __builtin_amdgcn_global_load_lds((const unsigned*)((const char*)(gbase) + (voff)[_i]), (PG8_LAS unsigned*)(lds + (bufoff) + ldsw + _i * 8192), 16, 0, 0); } while (0)
#define PG8_LDA(dst, b, h) do { _Pragma("unroll") for (int m = 0; m < 4; ++m) _Pragma("unroll") for (int k = 0; k < 2; ++k) dst[m][k] = *(const PG8_LAS bf16x8*)(lds + PG8_SA(b, h) + aoff + m * 2048 + k * 1024); } while (0)
#define PG8_LDB(dst, b, h) do { _Pragma("unroll") for (int n = 0; n < 2; ++n) _Pragma("unroll") for (int k = 0; k < 2; ++k) dst[n][k] = *(const PG8_LAS bf16x8*)(lds + PG8_SB(b, h) + boff + n * 2048 + k * 1024); } while (0)
#define PG8_MMA(ai, bj, At, Bt) do { __builtin_amdgcn_s_setprio(1); _Pragma("unroll") for (int m = 0; m < 4; ++m) _Pragma("unroll") for (int n = 0; n < 2; ++n) _Pragma("unroll") for (int k = 0; k < 2; ++k) \
        acc[ai][bj][m][n] = __builtin_amdgcn_mfma_f32_16x16x32_bf16(Bt[n][k], At[m][k], acc[ai][bj][m][n], 0, 0, 0); __builtin_amdgcn_s_setprio(0); } while (0)
#define PG8_WAIT_V(n) asm volatile("s_waitcnt vmcnt(" #n ")" ::: "memory")
#define PG8_WAIT_L(n) asm volatile("s_waitcnt lgkmcnt(" #n ")" ::: "memory")
#define PG8_BAR __builtin_amdgcn_s_barrier()
#define PG8_SCHED __builtin_amdgcn_sched_barrier(0)
    Unit cur, nxt; int ui = 0;
    if (!S.next(0, cur)) return;
    f32x4 acc[2][2][4][2];
#pragma unroll
    for (int a = 0; a < 2; ++a)
#pragma unroll
        for (int b = 0; b < 2; ++b)
#pragma unroll
            for (int m = 0; m < 4; ++m)
#pragma unroll
                for (int n = 0; n < 2; ++n) acc[a][b][m][n] = (f32x4){0.f, 0.f, 0.f, 0.f};
    bf16x8 At[4][2], B0[2][2], B1[2][2];
    const char* cA = (const char*)g.A + (size_t)cur.pm * tstepA; const char* cB = (const char*)g.Bt + (size_t)cur.pn * tstepB;
    S.a_ready(cur);
    if constexpr (SP2) {
        PG8_STAGE(PG8_SB(0, 0), cB, voffB); PG8_STAGE(PG8_SB(0, 1), cB + hstepB, voffB); PG8_STAGE(PG8_SA(0, 0), cA, voffA); PG8_STAGE(PG8_SA(0, 1), cA + hstepA, voffA);
        if (wr == 1) PG8_BAR;
        PG8_WAIT_V(2); PG8_BAR;
        PG8_STAGE(PG8_SB(1, 0), cB + kstep, voffB); PG8_STAGE(PG8_SA(1, 0), cA + kstep, voffA); PG8_STAGE(PG8_SB(1, 1), cB + hstepB + kstep, voffB);
        PG8_WAIT_V(6); PG8_BAR;
    } else {
        PG8_STAGE(PG8_SB(0, 0), cB, voffB); PG8_STAGE(PG8_SA(0, 0), cA, voffA); PG8_STAGE(PG8_SB(0, 1), cB + hstepB, voffB); PG8_STAGE(PG8_SA(0, 1), cA + hstepA, voffA);
        if (wr == 1) PG8_BAR;
        PG8_WAIT_V(4); PG8_BAR;
        PG8_STAGE(PG8_SB(1, 0), cB + kstep, voffB); PG8_STAGE(PG8_SA(1, 0), cA + kstep, voffA); PG8_STAGE(PG8_SB(1, 1), cB + hstepB + kstep, voffB);
        PG8_WAIT_V(6); PG8_BAR;
    }
    for (;;) {
        const bool has_next = S.next(ui + 1, nxt);
        const char* nA = has_next ? (const char*)g.A + (size_t)nxt.pm * tstepA : cA; const char* nB = has_next ? (const char*)g.Bt + (size_t)nxt.pn * tstepB : cB;
        for (int t = 0; t < nt; t += 2) {
            const bool last = (t == nt - 2);
            const char* a1 = cA + (size_t)(t + 1) * kstep;
            const char* a2 = last ? nA : cA + (size_t)(t + 2) * kstep; const char* b2 = last ? nB : cB + (size_t)(t + 2) * kstep;
            const char* a3 = a2 + kstep; const char* b3 = b2 + kstep;
            if (last && has_next) S.a_ready(nxt);
            if constexpr (SP2) {
            PG8_LDB(B0, 0, 0); PG8_LDB(B1, 0, 1); PG8_SCHED; PG8_LDA(At, 0, 0); PG8_STAGE(PG8_SA(1, 1), a1 + hstepA, voffA);
            PG8_WAIT_V(8); PG8_WAIT_L(0); PG8_BAR; PG8_MMA(0, 0, At, B0); PG8_MMA(0, 1, At, B1); PG8_BAR; PG8_SCHED;
            PG8_LDA(At, 0, 1); PG8_STAGE(PG8_SB(0, 0), b2, voffB); PG8_STAGE(PG8_SB(0, 1), b2 + hstepB, voffB); PG8_STAGE(PG8_SA(0, 0), a2, voffA);
            PG8_WAIT_V(8); PG8_WAIT_L(0); PG8_BAR; PG8_MMA(1, 0, At, B0); PG8_MMA(1, 1, At, B1); PG8_BAR; PG8_SCHED;
            PG8_LDB(B0, 1, 0); PG8_LDB(B1, 1, 1); PG8_SCHED; PG8_LDA(At, 1, 0); PG8_STAGE(PG8_SA(0, 1), a2 + hstepA, voffA);
            PG8_WAIT_V(8); PG8_WAIT_L(0); PG8_BAR; PG8_MMA(0, 0, At, B0); PG8_MMA(0, 1, At, B1); PG8_BAR; PG8_SCHED;
            PG8_LDA(At, 1, 1); PG8_STAGE(PG8_SB(1, 0), b3, voffB); PG8_STAGE(PG8_SB(1, 1), b3 + hstepB, voffB); PG8_STAGE(PG8_SA(1, 0), a3, voffA);
            PG8_WAIT_V(8); PG8_WAIT_L(0); PG8_BAR; PG8_MMA(1, 0, At, B0); PG8_MMA(1, 1, At, B1); PG8_BAR; PG8_SCHED;
            } else {
            PG8_LDB(B0, 0, 0); PG8_SCHED; PG8_LDA(At, 0, 0); PG8_STAGE(PG8_SA(1, 1), a1 + hstepA, voffA);
            PG8_WAIT_L(8); PG8_BAR; PG8_WAIT_L(0); PG8_MMA(0, 0, At, B0); PG8_BAR; PG8_SCHED;
            PG8_LDB(B1, 0, 1); PG8_STAGE(PG8_SB(0, 0), b2, voffB);
            PG8_BAR; PG8_WAIT_L(0); PG8_MMA(0, 1, At, B1); PG8_BAR;
            PG8_LDA(At, 0, 1); PG8_STAGE(PG8_SA(0, 0), a2, voffA);
            PG8_BAR; PG8_WAIT_L(0); PG8_MMA(1, 0, At, B0); PG8_BAR; PG8_SCHED;
            PG8_STAGE(PG8_SB(0, 1), b2 + hstepB, voffB);
            PG8_WAIT_V(6); PG8_BAR; PG8_MMA(1, 1, At, B1); PG8_BAR;
            PG8_LDB(B0, 1, 0); PG8_SCHED; PG8_LDA(At, 1, 0); PG8_STAGE(PG8_SA(0, 1), a2 + hstepA, voffA);
            PG8_WAIT_L(8); PG8_BAR; PG8_WAIT_L(0); PG8_MMA(0, 0, At, B0); PG8_BAR; PG8_SCHED;
            PG8_LDB(B1, 1, 1); PG8_STAGE(PG8_SB(1, 0), b3, voffB);
            PG8_BAR; PG8_WAIT_L(0); PG8_MMA(0, 1, At, B1); PG8_BAR;
            PG8_LDA(At, 1, 1); PG8_STAGE(PG8_SA(1, 0), a3, voffA);
            PG8_BAR; PG8_WAIT_L(0); PG8_MMA(1, 0, At, B0); PG8_BAR; PG8_SCHED;
            PG8_STAGE(PG8_SB(1, 1), b3 + hstepB, voffB);
            PG8_WAIT_V(6); PG8_BAR; PG8_MMA(1, 1, At, B1); PG8_BAR;
            }
        }
        if constexpr (ALIGN_EPI) { if (wr == 0) PG8_BAR; }
        if constexpr (!Epi::AFTER_DRAIN) { E(acc, cur, wr, wc, fr, fq); S.done(cur); }
        if (!has_next) break;
#pragma unroll
        for (int a = 0; a < 2; ++a)
#pragma unroll
            for (int b = 0; b < 2; ++b)
#pragma unroll
                for (int m = 0; m < 4; ++m)
#pragma unroll
                    for (int n = 0; n < 2; ++n) acc[a][b][m][n] = (f32x4){0.f, 0.f, 0.f, 0.f};
        cur = nxt; cA = nA; cB = nB; ++ui;
        if constexpr (ALIGN_EPI) { if (wr == 1) PG8_BAR; }
    }
    PG8_WAIT_V(0);
    if constexpr (!ALIGN_EPI) { if (wr == 0) PG8_BAR; }
    PG8_BAR;
    if constexpr (Epi::AFTER_DRAIN) { E.fused(acc, cur, wr, wc, fr, fq, lds, wid, lane); S.done(cur); }
#undef PG8_SA
#undef PG8_SB
#undef PG8_STAGE
#undef PG8_LDA
#undef PG8_LDB
#undef PG8_MMA
#undef PG8_WAIT_V
#undef PG8_WAIT_L
#undef PG8_BAR
#undef PG8_SCHED
}
}

constexpr int NWAVES = 8, NTHREADS = 512;
#ifndef MK_PER_PHASE
#define MK_PER_PHASE 0
#endif
constexpr int D = 1024, BATCH = 8, SEQ = 2048, M = BATCH * SEQ, DEPTH = 2;
constexpr int S5W = 512, S5H = 16, S5G = 32, S5P = 64;
constexpr int HYW = 1024, HYF = 4096, HYE = 33, HYN = 64;
constexpr int INC = 7168;
constexpr int NPHASE = 12;

constexpr size_t MiB = 1u << 20;
constexpr size_t WS_CTL = 0, CTL_ZERO_BYTES = 64 * 1024;
constexpr size_t WS_H2 = 1 * MiB;
constexpr size_t WS_LBAR = 2 * MiB;
constexpr size_t WS_BBT = 2 * MiB + 64 * 1024;
constexpr size_t WS_CT = WS_BBT + 512 * 1024;
constexpr size_t WS_W = 4 * MiB;
constexpr size_t W_IN = 0, W_GLU = 14 * MiB, W_BS5 = W_GLU + 512 * 1024, W_BHY = W_BS5 + 1 * MiB, W_OUT = W_BHY + 2 * MiB, W_LAYER = W_OUT + 2 * MiB;
constexpr size_t WS_SSQ = 43 * MiB;
constexpr size_t WS_X = 44 * MiB;
constexpr size_t WS_R1 = 76 * MiB, WS_R2 = 108 * MiB, WS_R3 = 140 * MiB, WS_R4 = 172 * MiB, WS_R5 = 204 * MiB, WS_R6 = 236 * MiB, WS_END = 252 * MiB;
static_assert(WS_W + 2 * W_LAYER <= WS_SSQ, "weights");
constexpr int LDS_BYTES = 163840 - 256;
constexpr int LDSCTL_OFF = LDS_BYTES - 512;

#define GAS __attribute__((address_space(1)))
#define LAS __attribute__((address_space(3)))
typedef unsigned short bf16;
typedef unsigned v4u __attribute__((ext_vector_type(4)));
typedef unsigned v2u __attribute__((ext_vector_type(2)));
typedef float f32x4 __attribute__((ext_vector_type(4)));
typedef float f32x2 __attribute__((ext_vector_type(2)));
typedef short bf16x8 __attribute__((ext_vector_type(8)));
typedef GAS unsigned gu32;
#define RLX_AGENT __ATOMIC_RELAXED, __HIP_MEMORY_SCOPE_AGENT
#define LDS_WAIT() asm volatile("s_waitcnt lgkmcnt(0)" ::: "memory")
#define VM_WAIT() asm volatile("s_waitcnt vmcnt(0)" ::: "memory")
__device__ __forceinline__ unsigned f2bf(float f) { unsigned u = __builtin_bit_cast(unsigned, f); return (u + 0x7fffu + ((u >> 16) & 1u)) >> 16; }
__device__ __forceinline__ unsigned pk2(float lo, float hi) { return f2bf(lo) | (f2bf(hi) << 16); }
__device__ __forceinline__ float bf2f(unsigned short h) { return __uint_as_float((unsigned)h << 16); }
using pg8::bf_lo; using pg8::bf_hi; using pg8::fast_sigmoid;

#define XB_TMO      128
#define XB_XCNT(j)  (256  + 64 * (j))
#define XB_XSUB(j)  (1280 + 64 * (j))
#define XB_XGEN(j)  (2304 + 64 * (j))
#define XB_TOP      3328
#define XB_TOPGEN   3392
#define XCD_BAR_WORDS 3456
#define XB_SPIN_CAP (1u << 18)
__device__ __forceinline__ unsigned xb_ld(unsigned* p)              { return __hip_atomic_load(p, __ATOMIC_RELAXED, __HIP_MEMORY_SCOPE_AGENT); }
__device__ __forceinline__ unsigned xb_add(unsigned* p, unsigned v) { return __hip_atomic_fetch_add(p, v, __ATOMIC_RELAXED, __HIP_MEMORY_SCOPE_AGENT); }
__device__ __forceinline__ unsigned xb_xcc_id() { return (unsigned)__builtin_amdgcn_s_getreg((3 << 11) | 20) & 0xFu; }
#define XB_SPIN(cond, bar) do { unsigned _sp = 0; while (cond) { __builtin_amdgcn_s_sleep(1); \
    if ((++_sp & 255u) == 0u) { if (xb_ld(&(bar)[XB_TMO])) break; if (_sp > XB_SPIN_CAP) { atomicAdd(&(bar)[XB_TMO], 1u); break; } } } } while (0)
struct XcdBarrier { unsigned* bar; unsigned x; volatile LAS unsigned* st; };
__device__ __forceinline__ XcdBarrier xcd_barrier_post(unsigned* bar, volatile LAS unsigned* st) {
    XcdBarrier b; b.bar = bar; b.x = xb_xcc_id(); b.st = st;
    if (threadIdx.x == 0) (void)xb_add(&bar[XB_XCNT(b.x)], 1u);
    return b;
}
__device__ __forceinline__ void xcd_barrier_complete(unsigned* bar, unsigned x, unsigned& nloc, unsigned& nx) {
    const unsigned G = gridDim.x * gridDim.y * gridDim.z;
    unsigned sum, cnt, mine, sp = 0u;
    for (;;) {
        sum = 0u; cnt = 0u; mine = 0u;
#pragma unroll
        for (unsigned j = 0; j < 16; ++j) { const unsigned c = xb_ld(&bar[XB_XCNT(j)]); sum += c; cnt += (c > 0u) ? 1u : 0u; mine = (j == x) ? c : mine; }
        if (sum == G) break;
        __builtin_amdgcn_s_sleep(1);
        if ((++sp & 255u) == 0u) { if (xb_ld(&bar[XB_TMO])) break; if (sp > XB_SPIN_CAP) { atomicAdd(&bar[XB_TMO], 1u); break; } }
    }
    nloc = mine > 0u ? mine : 1u; nx = cnt > 0u ? cnt : 1u;
}
__device__ __forceinline__ void xcd_barrier(const XcdBarrier& b) {
    asm volatile("s_waitcnt vmcnt(0)" ::: "memory");
    __syncthreads();
    if (threadIdx.x == 0) {
        unsigned* bar = b.bar;
        __builtin_amdgcn_s_waitcnt(0);
        unsigned nloc = b.st[0], nx = b.st[1];
        if (nloc == 0u) { xcd_barrier_complete(bar, b.x, nloc, nx); b.st[0] = nloc; b.st[1] = nx; }
        const unsigned old = xb_add(&bar[XB_XSUB(b.x)], 1u);
        const unsigned gen = old / nloc;
        if (old + 1u == (gen + 1u) * nloc) {
            __builtin_amdgcn_fence(__ATOMIC_RELEASE, "agent");
            asm volatile("s_waitcnt vmcnt(0)" ::: "memory");
            const unsigned og = xb_add(&bar[XB_TOP], 1u);
            const unsigned tg = og / nx;
            if (og + 1u == (tg + 1u) * nx) xb_add(&bar[XB_TOPGEN], 1u);
            else XB_SPIN(xb_ld(&bar[XB_TOPGEN]) == tg, bar);
            __builtin_amdgcn_fence(__ATOMIC_ACQUIRE, "agent");
            xb_add(&bar[XB_XGEN(b.x)], 1u);
            asm volatile("s_waitcnt vmcnt(0)" ::: "memory");
        } else {
            XB_SPIN(xb_ld(&bar[XB_XGEN(b.x)]) == gen, bar);
            __builtin_amdgcn_fence(__ATOMIC_ACQUIRE, "agent");
            asm volatile("s_waitcnt vmcnt(0)" ::: "memory");
        }
    }
    __syncthreads();
}

struct Frame {
    LAS unsigned char* lds;
    int tid, lane, wave, G, bx;
    float* out; unsigned char* ws;
    __device__ __forceinline__ const float* inp(int i) const {
        const LAS unsigned* t = (const LAS unsigned*)(lds + LDSCTL_OFF + 256) + 2 * i;
        const unsigned lo = __builtin_amdgcn_readfirstlane(t[0]), hi = __builtin_amdgcn_readfirstlane(t[1]);
        return (const float*)(((unsigned long long)hi << 32) | lo);
    }
};
__device__ __forceinline__ float wave_sum(float v) {
#pragma unroll
    for (int o = 1; o < 64; o <<= 1) v += __shfl_xor(v, o);
    return v;
}

__device__ __forceinline__ void p0_transpose_item(const float* W, int K, int N, bf16* WT, int k0, int n0, int drow, const float* kscale, LAS float* scr, int lane) {
#pragma unroll 8
    for (int i = 0; i < 32; ++i) { const int kk = 2 * i + (lane >> 5); float v = W[(size_t)(k0 + kk) * N + n0 + (lane & 31)]; if (kscale) v *= kscale[k0 + kk]; scr[kk * 33 + (lane & 31)] = v; }
    LDS_WAIT(); asm volatile("" ::: "memory");
    const int c = lane & 7;
#pragma unroll
    for (int j = 0; j < 4; ++j) { const int n = (lane >> 3) + 8 * j; const LAS float* s = scr + (8 * c) * 33 + n;
        v4u o; o.x = pk2(s[0 * 33], s[1 * 33]); o.y = pk2(s[2 * 33], s[3 * 33]); o.z = pk2(s[4 * 33], s[5 * 33]); o.w = pk2(s[6 * 33], s[7 * 33]);
        *(GAS v4u*)(WT + (size_t)(drow + n) * K + k0 + 8 * c) = o; }
    LDS_WAIT(); asm volatile("" ::: "memory");
}
__device__ __forceinline__ void p0_prologue(Frame& F) {
    LAS float* scr = (LAS float*)(F.lds + F.wave * 16384);
    const int gw = F.bx * NWAVES + F.wave, NGW = F.G * NWAVES, lane = F.lane;
    constexpr int I_IN = (D / 64) * (INC / 32), I_GLU = (S5W / 64) * (S5W / 32), I_BS5 = (S5W / 64) * (D / 32), I_BHY = (HYW / 64) * (D / 32), I_OUT = (D / 64) * (D / 32);
    constexpr int I_LAYER = I_IN + I_GLU + I_BS5 + I_BHY + I_OUT;
    for (int it = gw; it < DEPTH * I_LAYER; it += NGW) {
        const int l = it / I_LAYER; int r = it % I_LAYER; bf16* wl = (bf16*)(F.ws + WS_W + (size_t)l * W_LAYER);
        if (r < I_IN) { const int nblk = INC / 32, kb = r / nblk, nb = r % nblk, n0 = nb * 32;
            const int drow = (n0 >= 1024 && n0 < 5120) ? n0 - 1024 : (n0 < 1024 ? n0 + 4096 : n0);
            p0_transpose_item(F.inp(2) + (size_t)l * D * INC, D, INC, wl + W_IN / 2, kb * 64, n0, drow, F.inp(1) + l * D, scr, lane); continue; } r -= I_IN;
        if (r < I_GLU) { const int nblk = S5W / 32; p0_transpose_item(F.inp(11) + (size_t)l * S5W * S5W, S5W, S5W, wl + W_GLU / 2, (r / nblk) * 64, (r % nblk) * 32, (r % nblk) * 32, nullptr, scr, lane); continue; } r -= I_GLU;
        if (r < I_BS5) { const int nblk = D / 32; p0_transpose_item(F.inp(23) + (size_t)l * S5W * D, S5W, D, wl + W_BS5 / 2, (r / nblk) * 64, (r % nblk) * 32, (r % nblk) * 32, nullptr, scr, lane); continue; } r -= I_BS5;
        if (r < I_BHY) { const int nblk = D / 32; p0_transpose_item(F.inp(24) + (size_t)l * HYW * D, HYW, D, wl + W_BHY / 2, (r / nblk) * 64, (r % nblk) * 32, (r % nblk) * 32, nullptr, scr, lane); continue; } r -= I_BHY;
        { const int nblk = D / 32; p0_transpose_item(F.inp(25) + (size_t)l * D * D, D, D, wl + W_OUT / 2, (r / nblk) * 64, (r % nblk) * 32, (r % nblk) * 32, nullptr, scr, lane); }
    }
    { bf16* X = (bf16*)(F.ws + WS_X); float* ssq = (float*)(F.ws + WS_SSQ);
      for (int m = gw; m < M; m += NGW) { const GAS f32x4* xr = (const GAS f32x4*)(F.inp(0) + (size_t)m * D) + lane; f32x4 v[4]; float s = 0.f;
#pragma unroll
        for (int j = 0; j < 4; ++j) { v[j] = xr[64 * j]; s += (v[j].x * v[j].x + v[j].y * v[j].y) + (v[j].z * v[j].z + v[j].w * v[j].w); }
        s = wave_sum(s);
        GAS unsigned long long* o8 = (GAS unsigned long long*)(X + (size_t)m * D) + lane;
#pragma unroll
        for (int j = 0; j < 4; ++j) o8[64 * j] = (unsigned long long)pk2(v[j].x, v[j].y) | ((unsigned long long)pk2(v[j].z, v[j].w) << 32);
        if (lane < 16) ssq[(size_t)m * 16 + lane] = lane == 0 ? s : 0.f; } }
    {
      for (int it = gw; it < DEPTH * SEQ; it += NGW) { const int l = it / SEQ, t = it % SEQ, j = lane;
        const float* w1 = F.inp(15) + (size_t)l * HYE * HYN; const float* b1 = F.inp(16) + l * HYN; const float* fr = F.inp(17) + l * HYN; const float* w2 = F.inp(18) + (size_t)l * HYN * HYN; const float* b2 = F.inp(19) + l * HYN;
        float f = 0.f;
        if (j == 0) f = (float)t / (float)(SEQ - 1);
        else if (j < 33) { const int bi = (j - 1) & 15; const float band = 1e-4f + (float)bi * ((15.f - 1e-4f) / 15.f); const float ang = band * (float)t * (float)(2.0 * 3.14159265358979323846 / SEQ); f = j < 17 ? cosf(ang) : -sinf(ang); }
        float a = b1[j];
        for (int i = 0; i < HYE; ++i) a += __shfl(f, i) * w1[i * HYN + j];
        const float h1 = sinf(fr[j] * a);
        float c = b2[j];
        for (int i = 0; i < HYN; ++i) c += __shfl(h1, i) * w2[i * HYN + j];
        const float hv = sinf(fr[j] * c); const unsigned hh = f2bf(hv);
        bf16* H2H = (bf16*)(F.ws + WS_H2 + (size_t)l * 512 * 1024);
        H2H[(size_t)t * HYN + j] = (bf16)hh; H2H[(size_t)SEQ * HYN + (size_t)t * HYN + j] = (bf16)f2bf(hv - __uint_as_float(hh << 16)); } }
    { float* LB = (float*)(F.ws + WS_LBAR); bf16* BBT = (bf16*)(F.ws + WS_BBT); bf16* CT = (bf16*)(F.ws + WS_CT);
      for (int q = gw; q < DEPTH * 2 * S5G; q += NGW) { const int p = lane; const int i = q * S5P + p;
        const float dt = expf(F.inp(5)[q]); const float lr = F.inp(3)[i], li = F.inp(4)[i]; const float mag = expf(lr * dt), ang = li * dt;
        const float br = mag * cosf(ang), bi = mag * sinf(ang); LB[2 * i] = br; LB[2 * i + 1] = bi;
        const float nr = br - 1.f, ni = bi, den = lr * lr + li * li; const float kr = (nr * lr + ni * li) / den, ki = (ni * lr - nr * li) / den;
        const float* bre = F.inp(6) + (size_t)i * S5H; const float* bim = F.inp(7) + (size_t)i * S5H;
        bf16* rowr = BBT + ((size_t)q * 128 + 2 * p) * 16; bf16* rowi = rowr + 16;
        for (int h = 0; h < S5H; ++h) { const float xr = bre[h], xi = bim[h]; rowr[h] = (bf16)f2bf(kr * xr - ki * xi); rowi[h] = (bf16)f2bf(kr * xi + ki * xr); }
        const float* cre = F.inp(8) + (size_t)q * S5H * S5P; const float* cim = F.inp(9) + (size_t)q * S5H * S5P;
        for (int h = 0; h < S5H; ++h) { *(unsigned*)(CT + ((size_t)q * 16 + h) * 128 + 2 * p) = pk2(cre[h * S5P + p], -cim[h * S5P + p]); } } }
}

constexpr int S5_YB = 0, S5_CH = 65536, S5_CHB = 8448, S5_SEND = S5_CH + 8 * S5_CHB;
__device__ __forceinline__ float gelu_tanh_fast(float x) {
    const float z = 0.7978845608028654f * (x + 0.044715f * x * x * x);
    const float e = __builtin_amdgcn_exp2f(2.0f * 1.4426950408889634f * z);
    const float th = 1.0f - 2.0f * __builtin_amdgcn_rcpf(e + 1.0f);
    return 0.5f * x * (1.0f + th);
}
template <int DIR, bool EMIT>
__device__ __forceinline__ void s5_pass(Frame& F, const bf16* Ub  , int tlo  , float ar, float ai, float& sr, float& si,
                                        const bf16x8 (&bbf)[8], const bf16x8 (&ctf)[4], const bf16x8& ddf, LAS unsigned char* ch, LAS unsigned char* yb, bf16* YGb) {
    const int lane = F.lane, fr = lane & 15, fq = lane >> 4;
    bf16x8 uf, ufn;
    auto load_u = [&](int tc0) -> bf16x8 { bf16x8 z = {0, 0, 0, 0, 0, 0, 0, 0}; if (fq < 2) z = *(const bf16x8*)(Ub + (size_t)(tc0 + fr) * 1024 + 8 * fq); return z; };
    uf = load_u(DIR ? tlo + 240 : tlo);
#pragma unroll 1
    for (int ci = 0; ci < 16; ++ci) {
        const int tc0 = DIR ? tlo + 16 * (15 - ci) : tlo + 16 * ci;
        if (ci < 15) ufn = load_u(DIR ? tc0 - 16 : tc0 + 16);
        LAS float* bu = (LAS float*)ch;
#pragma unroll
        for (int j = 0; j < 8; ++j) { f32x4 a = {0.f, 0.f, 0.f, 0.f}; a = __builtin_amdgcn_mfma_f32_16x16x32_bf16(bbf[j], uf, a, 0, 0, 0);
            *(LAS f32x4*)(bu + fr * 132 + 16 * j + 4 * fq) = a; }
        LDS_WAIT();
        f32x2 x[16];
#pragma unroll
        for (int tt = 0; tt < 16; ++tt) x[tt] = *(const LAS f32x2*)(bu + tt * 132 + 2 * lane);
        LDS_WAIT();
        unsigned spk[16];
#pragma unroll
        for (int i = 0; i < 16; ++i) { const int tt = DIR ? 15 - i : i;
            const float nr = ar * sr - ai * si + x[tt].x, ni = ar * si + ai * sr + x[tt].y; sr = nr; si = ni;
            if (EMIT) spk[tt] = pg8::cvt_pk_bf16(nr, ni); }
        if (EMIT) {
            LAS unsigned* sb = (LAS unsigned*)ch;
#pragma unroll
            for (int tt = 0; tt < 16; ++tt) sb[tt * 68 + lane] = spk[tt];
            LDS_WAIT();
            f32x4 y = {0.f, 0.f, 0.f, 0.f};
#pragma unroll
            for (int ks = 0; ks < 4; ++ks) { const bf16x8 sf = *(const LAS bf16x8*)(ch + fr * 272 + ks * 64 + fq * 16); y = __builtin_amdgcn_mfma_f32_16x16x32_bf16(ctf[ks], sf, y, 0, 0, 0); }
            LDS_WAIT();
            LAS v2u* ybp = (LAS v2u*)(yb + (size_t)(tc0 + fr) * 32 + 8 * fq);
            if (DIR == 0) { v2u w; w.x = pg8::cvt_pk_bf16(y[0], y[1]); w.y = pg8::cvt_pk_bf16(y[2], y[3]); *ybp = w; }
            else { y = __builtin_amdgcn_mfma_f32_16x16x32_bf16(ddf, uf, y, 0, 0, 0);
                const v2u f = *ybp; const float o0 = gelu_tanh_fast(y[0] + bf_lo(f.x)), o1 = gelu_tanh_fast(y[1] + bf_hi(f.x)), o2 = gelu_tanh_fast(y[2] + bf_lo(f.y)), o3 = gelu_tanh_fast(y[3] + bf_hi(f.y));
                v2u w; w.x = pg8::cvt_pk_bf16(o0, o1); w.y = pg8::cvt_pk_bf16(o2, o3);
                *(v2u*)(YGb + (size_t)(tc0 + fr) * 1024 + 4 * fq) = w; }
        }
        uf = ufn;
    }
}
__device__ __forceinline__ void s5_item(Frame& F, int l, int b, int g, bool dry = false) {
    const int lane = F.lane, fr = lane & 15, fq = lane >> 4, seg = F.wave;
    bf16* U = (bf16*)(F.ws + WS_R5) + (size_t)b * SEQ * 1024 + g * 16;
    LAS unsigned char* ch = F.lds + S5_CH + seg * S5_CHB; LAS unsigned char* yb = F.lds + S5_YB;
    LAS f32x2* send = (LAS f32x2*)(F.lds + S5_SEND);
#pragma unroll 1
    for (int dir = 0; dir < 2; ++dir) {
        const int q = (l * 2 + dir) * S5G + g;
        const float ar = ((const float*)(F.ws + WS_LBAR))[(size_t)(q * S5P + lane) * 2], ai = ((const float*)(F.ws + WS_LBAR))[(size_t)(q * S5P + lane) * 2 + 1];
        bf16x8 bbf[8], ctf[4], ddf; const bf16x8 zero8 = {0, 0, 0, 0, 0, 0, 0, 0};
        const bf16* BBT = (const bf16*)(F.ws + WS_BBT) + (size_t)q * 128 * 16; const bf16* CT = (const bf16*)(F.ws + WS_CT) + (size_t)q * 16 * 128;
#pragma unroll
        for (int j = 0; j < 8; ++j) bbf[j] = fq < 2 ? *(const bf16x8*)(BBT + (16 * j + fr) * 16 + 8 * fq) : zero8;
#pragma unroll
        for (int ks = 0; ks < 4; ++ks) ctf[ks] = *(const bf16x8*)(CT + fr * 128 + 32 * ks + 8 * fq);
        { const short dv = (short)f2bf(F.inp(10)[l * S5W + g * 16 + fr]); ddf = zero8;
#pragma unroll
          for (int jj = 0; jj < 8; ++jj) if (8 * fq + jj == fr) ddf[jj] = dv; }
        const int tlo = dir ? SEQ - 256 * (seg + 1) : 256 * seg;
        float sr = 0.f, si = 0.f;
        if (dir == 0) s5_pass<0, false>(F, U, tlo, ar, ai, sr, si, bbf, ctf, ddf, ch, yb, U); else s5_pass<1, false>(F, U, tlo, ar, ai, sr, si, bbf, ctf, ddf, ch, yb, U);
        send[seg * 64 + lane] = (f32x2){sr, si};
        LDS_WAIT(); __syncthreads();
        float pr = ar, pi = ai;
#pragma unroll
        for (int k = 0; k < 8; ++k) { const float nr = pr * pr - pi * pi, ni = 2.f * pr * pi; pr = nr; pi = ni; }
        sr = 0.f; si = 0.f;
        for (int k = 0; k < seg; ++k) { const f32x2 e = send[k * 64 + lane]; const float nr = pr * sr - pi * si + e.x, ni = pr * si + pi * sr + e.y; sr = nr; si = ni; }
        bf16* YGo = dry ? (bf16*)(F.ws + WS_R6) + (size_t)(b & 1) * SEQ * 1024 + g * 16 : U;
        if (dir == 0) s5_pass<0, true>(F, U, tlo, ar, ai, sr, si, bbf, ctf, ddf, ch, yb, YGo); else s5_pass<1, true>(F, U, tlo, ar, ai, sr, si, bbf, ctf, ddf, ch, yb, YGo);
        LDS_WAIT(); __syncthreads();
    }
}

constexpr int HY_WX = 0, HY_WXB = 8704, HY_KF = 8 * HY_WXB, HY_KFO = 33 * 64 * 8, HY_KFCH = 2 * HY_KFO, HY_RED = HY_KF + 2 * HY_KFCH, HY_RAWROW = 4128;
static_assert(HY_RED + 256 <= LDSCTL_OFF && 4 * 2048 * 4 <= HY_KFCH && 2 * HY_RAWROW <= HY_WXB, "hyena LDS map");
#define C64_LIST 1.000000000e+00f, 9.951847267e-01f, 9.807852804e-01f, 9.569403357e-01f, 9.238795325e-01f, 8.819212643e-01f, 8.314696123e-01f, 7.730104534e-01f, 7.071067812e-01f, 6.343932842e-01f, 5.555702330e-01f, 4.713967368e-01f, 3.826834324e-01f, 2.902846773e-01f, 1.950903220e-01f, 9.801714033e-02f, 0.0f, -9.801714033e-02f, -1.950903220e-01f, -2.902846773e-01f, -3.826834324e-01f, -4.713967368e-01f, -5.555702330e-01f, -6.343932842e-01f, -7.071067812e-01f, -7.730104534e-01f, -8.314696123e-01f, -8.819212643e-01f, -9.238795325e-01f, -9.569403357e-01f, -9.807852804e-01f, -9.951847267e-01f, -1.000000000e+00f, -9.951847267e-01f, -9.807852804e-01f, -9.569403357e-01f, -9.238795325e-01f, -8.819212643e-01f, -8.314696123e-01f, -7.730104534e-01f, -7.071067812e-01f, -6.343932842e-01f, -5.555702330e-01f, -4.713967368e-01f, -3.826834324e-01f, -2.902846773e-01f, -1.950903220e-01f, -9.801714033e-02f, 0.0f, 9.801714033e-02f, 1.950903220e-01f, 2.902846773e-01f, 3.826834324e-01f, 4.713967368e-01f, 5.555702330e-01f, 6.343932842e-01f, 7.071067812e-01f, 7.730104534e-01f, 8.314696123e-01f, 8.819212643e-01f, 9.238795325e-01f, 9.569403357e-01f, 9.807852804e-01f, 9.951847267e-01f
__host__ __device__ constexpr int rev6(int s) { return ((s >> 4) & 3) | (s & 12) | ((s & 3) << 4); }

template <bool INV> __device__ __forceinline__ void r4(float& x0r, float& x0i, float& x1r, float& x1i, float& x2r, float& x2i, float& x3r, float& x3i) {
    const float t0r = x0r + x2r, t0i = x0i + x2i, t1r = x0r - x2r, t1i = x0i - x2i, t2r = x1r + x3r, t2i = x1i + x3i, t3r = x1r - x3r, t3i = x1i - x3i;
    x0r = t0r + t2r; x0i = t0i + t2i; x2r = t0r - t2r; x2i = t0i - t2i;
    if (!INV) { x1r = t1r + t3i; x1i = t1i - t3r; x3r = t1r - t3i; x3i = t1i + t3r; }
    else      { x1r = t1r - t3i; x1i = t1i + t3r; x3r = t1r + t3i; x3i = t1i - t3r; }
}
constexpr float C64T[64] = { C64_LIST };
template <int... Is, class Fn> __device__ __forceinline__ void static_for_impl(std::integer_sequence<int, Is...>, Fn&& f) { (f(std::integral_constant<int, Is>{}), ...); }
template <int N, class Fn> __device__ __forceinline__ void static_for(Fn&& f) { static_for_impl(std::make_integer_sequence<int, N>{}, f); }
template <bool INV, int E> __device__ __forceinline__ void twc(float& xr, float& xi) {
    constexpr int e = E & 63;
    if constexpr (e == 0) { return; }
    else if constexpr (e == 16) { const float tr = xr, ti = xi; if (!INV) { xr = ti; xi = -tr; } else { xr = -ti; xi = tr; } }
    else if constexpr (e == 32) { xr = -xr; xi = -xi; }
    else if constexpr (e == 48) { const float tr = xr, ti = xi; if (!INV) { xr = -ti; xi = tr; } else { xr = ti; xi = -tr; } }
    else {
        constexpr float c = C64T[e], sn = C64T[(e + 48) & 63], wi = INV ? sn : -sn;
        constexpr unsigned cb = __builtin_bit_cast(unsigned, c), wb = __builtin_bit_cast(unsigned, wi), nwb = wb ^ 0x80000000u;
        const float tr = xr, ti = xi; float a, b;
        asm("v_mul_f32 %0, %1, %2" : "=v"(a) : "i"(cb), "v"(tr));
        asm("v_fmac_f32 %0, %1, %2" : "+v"(a) : "i"(nwb), "v"(ti));
        asm("v_mul_f32 %0, %1, %2" : "=v"(b) : "i"(wb), "v"(tr));
        asm("v_fmac_f32 %0, %1, %2" : "+v"(b) : "i"(cb), "v"(ti));
        xr = a; xi = b;
    }
}
#define SFOR(N, I, ...) static_for<N>([&](auto I##_) __attribute__((always_inline)) { constexpr int I = decltype(I##_)::value; __VA_ARGS__ })
template <bool INV> __device__ __forceinline__ void dft64(float (&re)[64], float (&im)[64]) {
    if constexpr (!INV) {
        SFOR(16, bc, r4<false>(re[bc], im[bc], re[bc + 16], im[bc + 16], re[bc + 32], im[bc + 32], re[bc + 48], im[bc + 48]););
        SFOR(48, i, constexpr int p = 1 + i / 16; constexpr int bc = i % 16; twc<false, bc * p>(re[16 * p + bc], im[16 * p + bc]););
        __builtin_amdgcn_sched_barrier(0);
        SFOR(16, i, constexpr int s = 16 * (i / 4) + (i % 4); r4<false>(re[s], im[s], re[s + 4], im[s + 4], re[s + 8], im[s + 8], re[s + 12], im[s + 12]););
        SFOR(64, i, constexpr int q = (i >> 2) & 3; constexpr int c = i & 3; twc<false, 4 * c * q>(re[i], im[i]););
        __builtin_amdgcn_sched_barrier(0);
        SFOR(16, pq, constexpr int s = 4 * pq; r4<false>(re[s], im[s], re[s + 1], im[s + 1], re[s + 2], im[s + 2], re[s + 3], im[s + 3]););
    } else {
        SFOR(16, pq, constexpr int s = 4 * pq; r4<true>(re[s], im[s], re[s + 1], im[s + 1], re[s + 2], im[s + 2], re[s + 3], im[s + 3]););
        SFOR(64, i, constexpr int q = (i >> 2) & 3; constexpr int c = i & 3; twc<true, 4 * c * q>(re[i], im[i]););
        __builtin_amdgcn_sched_barrier(0);
        SFOR(16, i, constexpr int s = 16 * (i / 4) + (i % 4); r4<true>(re[s], im[s], re[s + 4], im[s + 4], re[s + 8], im[s + 8], re[s + 12], im[s + 12]););
        SFOR(48, i, constexpr int p = 1 + i / 16; constexpr int bc = i % 16; twc<true, bc * p>(re[16 * p + bc], im[16 * p + bc]););
        __builtin_amdgcn_sched_barrier(0);
        SFOR(16, bc, r4<true>(re[bc], im[bc], re[bc + 16], im[bc + 16], re[bc + 32], im[bc + 32], re[bc + 48], im[bc + 48]););
    }
    __builtin_amdgcn_sched_barrier(0);
}
__device__ __forceinline__ void wtrans(float (&v)[64], LAS float* wx, int lane) {
#pragma unroll
    for (int i = 0; i < 32; ++i) { const auto r = __builtin_amdgcn_permlane32_swap(__float_as_uint(v[i]), __float_as_uint(v[32 + i]), false, false); v[i] = __uint_as_float(r[0]); v[32 + i] = __uint_as_float(r[1]); }
    __builtin_amdgcn_sched_barrier(0);
    const int rd = (lane & 31) * 68 + (lane >> 5) * 32;
#pragma unroll
    for (int step = 0; step < 2; ++step) {
        asm volatile("" ::: "memory");
#pragma unroll
        for (int i = 0; i < 32; ++i) wx[i * 68 + lane] = v[32 * step + i];
        asm volatile("" ::: "memory");
#pragma unroll
        for (int i4 = 0; i4 < 8; ++i4) { const f32x4 q = *(const LAS f32x4*)(wx + rd + 4 * i4);
#pragma unroll
            for (int e = 0; e < 4; ++e) v[32 * step + 4 * i4 + e] = q[e]; }
        asm volatile("" ::: "memory");
    }
}
__device__ __forceinline__ void wfft_fwd(float (&re)[64], float (&im)[64], LAS float* wx, int lane) {
    dft64<false>(re, im);
    { float f = (float)lane * (1.0f / 4096.0f); asm volatile("" : "+v"(f));
#pragma unroll
      for (int s = 1; s < 64; ++s) { const float a = (float)rev6(s) * f; const float c = __builtin_amdgcn_cosf(a), sn = __builtin_amdgcn_sinf(a);
          const float tr = re[s] * c + im[s] * sn, ti = im[s] * c - re[s] * sn; re[s] = tr; im[s] = ti; if ((s & 7) == 7) __builtin_amdgcn_sched_barrier(0); } }
    __builtin_amdgcn_sched_barrier(0);
    wtrans(re, wx, lane); wtrans(im, wx, lane);
    __builtin_amdgcn_sched_barrier(0);
    dft64<false>(re, im);
}
__device__ __forceinline__ void wfft_inv(float (&re)[64], float (&im)[64], LAS float* wx, int lane) {
    dft64<true>(re, im);
    { float f = (float)rev6(lane) * (1.0f / 4096.0f); asm volatile("" : "+v"(f));
#pragma unroll
      for (int s = 1; s < 64; ++s) { const float a = (float)s * f; const float c = __builtin_amdgcn_cosf(a), sn = __builtin_amdgcn_sinf(a);
          const float tr = re[s] * c - im[s] * sn, ti = im[s] * c + re[s] * sn; re[s] = tr; im[s] = ti; if ((s & 7) == 7) __builtin_amdgcn_sched_barrier(0); } }
    __builtin_amdgcn_sched_barrier(0);
    wtrans(re, wx, lane); wtrans(im, wx, lane);
    __builtin_amdgcn_sched_barrier(0);
    dft64<true>(re, im);
}
__device__ __forceinline__ void hy_stage2(const bf16* row0, LAS unsigned char* wxb, int lane) {
    asm volatile("" ::: "memory");
#pragma unroll
    for (int i = 0; i < 4; ++i) { const int q = lane + 64 * i;
        const v4u a = *(const GAS v4u*)(row0 + 8 * q), b = *(const GAS v4u*)(row0 + SEQ + 8 * q);
        *(LAS v4u*)(wxb + 16 + 16 * q) = a; *(LAS v4u*)(wxb + HY_RAWROW + 16 + 16 * q) = b; }
    if (lane < 4) { LAS unsigned short* row = (LAS unsigned short*)(wxb + (lane >> 1) * HY_RAWROW); row[(lane & 1) ? 8 + SEQ : 7] = 0; }
    asm volatile("" ::: "memory");
}
__device__ __forceinline__ float raw2(LAS unsigned char* wxb, int r, int t) { return bf2f(*(const LAS unsigned short*)(wxb + r * HY_RAWROW + 16 + 2 * t)); }
__device__ __forceinline__ unsigned hilo_pack(float x0, float x1, unsigned& lo) {
    const unsigned h0 = f2bf(x0), h1 = f2bf(x1); lo = f2bf(x0 - __uint_as_float(h0 << 16)) | (f2bf(x1 - __uint_as_float(h1 << 16)) << 16); return h0 | (h1 << 16);
}
__device__ __forceinline__ void hy_filter_gen(Frame& F, int l, int c, int wq, LAS float* stg, LAS float* red) {
    int lane_ = F.lane; asm volatile("" : "+v"(lane_)); const int lane = lane_; const int fr = lane & 15, fq = lane >> 4;
    const float* w3 = F.inp(20) + (size_t)l * HYN * HYF; const float* dec = F.inp(21) + (size_t)l * HYF;
    const bf16* H2H = (const bf16*)(F.ws + WS_H2 + (size_t)l * 512 * 1024); const bf16* H2L = H2H + SEQ * HYN;
    bf16x8 ah[2], al[2];
#pragma unroll
    for (int ks = 0; ks < 2; ++ks) { float wv[8];
#pragma unroll
        for (int jj = 0; jj < 8; ++jj) wv[jj] = fr < 4 ? w3[(size_t)(32 * ks + 8 * fq + jj) * HYF + (fr >> 1) * 2 * HYW + (fr & 1) * HYW + c] : 0.f;
        unsigned l0, l1, l2, l3; v4u h, lw; h.x = hilo_pack(wv[0], wv[1], l0); h.y = hilo_pack(wv[2], wv[3], l1); h.z = hilo_pack(wv[4], wv[5], l2); h.w = hilo_pack(wv[6], wv[7], l3); lw.x = l0; lw.y = l1; lw.z = l2; lw.w = l3;
        ah[ks] = __builtin_bit_cast(bf16x8, h); al[ks] = __builtin_bit_cast(bf16x8, lw); }
    float dk[4];
#pragma unroll
    for (int r = 0; r < 4; ++r) dk[r] = fabsf(dec[(r >> 1) * 2 * HYW + (r & 1) * HYW + c]);
    float ss0 = 0.f, ss1 = 0.f;
#pragma unroll 2
    for (int tile = 0; tile < 32; ++tile) { const int t0 = 512 * wq + 16 * tile; f32x4 acc = {0.f, 0.f, 0.f, 0.f};
#pragma unroll
        for (int ks = 0; ks < 2; ++ks) { const bf16x8 bh = *(const bf16x8*)(H2H + (size_t)(t0 + fr) * HYN + 32 * ks + 8 * fq), bl = *(const bf16x8*)(H2L + (size_t)(t0 + fr) * HYN + 32 * ks + 8 * fq);
            acc = __builtin_amdgcn_mfma_f32_16x16x32_bf16(ah[ks], bh, acc, 0, 0, 0); acc = __builtin_amdgcn_mfma_f32_16x16x32_bf16(ah[ks], bl, acc, 0, 0, 0); acc = __builtin_amdgcn_mfma_f32_16x16x32_bf16(al[ks], bh, acc, 0, 0, 0); }
        if (fq == 0) { const int t = t0 + fr; const float tn = (float)t * (1.0f / (float)(SEQ - 1));
#pragma unroll
            for (int r = 0; r < 4; ++r) { const float v = acc[r] * (__expf(-tn * dk[r]) + 0.05f); stg[r * SEQ + t] = v; const float sq = ((r & 1) && t == 0) ? 0.f : v * v; if (r < 2) ss0 += sq; else ss1 += sq; } }
    }
    ss0 = wave_sum(ss0); ss1 = wave_sum(ss1);
    if (lane == 0) { red[0] = ss0; red[1] = ss1; }
}
__device__ __forceinline__ void hy_filter_fft(Frame& F, int l, int c, LAS unsigned char* kfch, const LAS float* red4, LAS float* wx) {
    int lane_ = F.lane; asm volatile("" : "+v"(lane_)); const int lane = lane_; const LAS float* stg = (const LAS float*)kfch;
    float re[64], im[64];
#pragma unroll
    for (int n1 = 0; n1 < 32; ++n1) { re[n1] = stg[64 * n1 + lane]; im[n1] = stg[2 * SEQ + 64 * n1 + lane]; }
#pragma unroll
    for (int n1 = 32; n1 < 64; ++n1) { const int t = 64 * (64 - n1) - lane; float a = stg[SEQ + t], b = stg[3 * SEQ + t]; if (n1 == 32 && lane == 0) { a = 0.f; b = 0.f; } re[n1] = a; im[n1] = b; }
    float s0 = 0.f, s1 = 0.f;
#pragma unroll
    for (int w = 0; w < 4; ++w) { s0 += red4[2 * w]; s1 += red4[2 * w + 1]; }
    const float sc = 1.0f / 4096.0f; const float n0 = 0.5f * sc / sqrtf(s0 + 1e-6f), n1s = 0.5f * sc / sqrtf(s1 + 1e-6f);
    const float d0 = F.inp(22)[(size_t)l * 2 * HYW + c] * sc, d1 = F.inp(22)[(size_t)l * 2 * HYW + HYW + c] * sc;
    asm volatile("s_waitcnt lgkmcnt(0)" ::: "memory");
    wfft_fwd(re, im, wx, lane);
    const int k1 = rev6(lane), lc = rev6((64 - k1) & 63);
    LAS f32x2* kf0 = (LAS f32x2*)kfch + k1; LAS f32x2* kf1 = (LAS f32x2*)(kfch + HY_KFO) + k1;
#pragma unroll
    for (int k0 = 0; k0 <= 32; ++k0) { const int s = rev6(k0), sm = rev6(63 - k0), sz = rev6((64 - k0) & 63);
        float pr = __shfl(re[sm], lc), pi = __shfl(im[sm], lc); if (lane == 0) { pr = re[sz]; pi = im[sz]; }
        const float zr = re[s], zi = im[s];
        kf0[k0 * 64] = (f32x2){(zr + pr) * n0 + d0, (zi - pi) * n0};
        kf1[k0 * 64] = (f32x2){(zi + pi) * n1s + d1, -(zr - pr) * n1s}; if ((k0 & 3) == 3) __builtin_amdgcn_sched_barrier(0); }
}
__device__ __forceinline__ void hy_wave_main(Frame& F, int l, int c, int ws, LAS unsigned char* wxb, LAS unsigned char* kfch) {
    int lane_ = F.lane; asm volatile("" : "+v"(lane_)); const int lane = lane_; LAS float* wx = (LAS float*)wxb;
    const size_t rowoff = (size_t)c * M + (size_t)(2 * ws) * SEQ;
    const bf16* PV = (const bf16*)(F.ws + WS_R1) + rowoff; const bf16* PX1 = (const bf16*)(F.ws + WS_R2) + rowoff; const bf16* PX2 = (const bf16*)(F.ws + WS_R3) + rowoff;
    const bf16* GH = (const bf16*)(F.ws + WS_R4) + rowoff; bf16* OUT = (bf16*)(F.ws + WS_R1) + rowoff;
    const float* cw = F.inp(13) + (size_t)l * 3 * 3 * HYW; const float* cb = F.inp(14) + (size_t)l * 3 * HYW;
    float re[64], im[64];
    hy_stage2(PV, wxb, lane);
    { const float w0 = cw[c], w1 = cw[3 * HYW + c], w2 = cw[6 * HYW + c], b = cb[c];
#pragma unroll
      for (int n1 = 0; n1 < 32; ++n1) { const int t = 64 * n1 + lane;
          re[n1] = b + w0 * raw2(wxb, 0, t - 1) + w1 * raw2(wxb, 0, t) + w2 * raw2(wxb, 0, t + 1);
          im[n1] = b + w0 * raw2(wxb, 1, t - 1) + w1 * raw2(wxb, 1, t) + w2 * raw2(wxb, 1, t + 1); if ((n1 & 3) == 3) __builtin_amdgcn_sched_barrier(0); } }
#pragma unroll 1
    for (int o = 0; o < 2; ++o) {
        int lane_o = F.lane; asm volatile("" : "+v"(lane_o));
        const int lane = lane_o; const int k1 = rev6(lane);
#pragma unroll
        for (int n1 = 32; n1 < 64; ++n1) { re[n1] = 0.f; im[n1] = 0.f; }
        asm volatile("s_waitcnt lgkmcnt(0)" ::: "memory");
        wfft_fwd(re, im, wx, lane);
        { const LAS unsigned char* bd = kfch + o * HY_KFO + k1 * 8; const LAS unsigned char* bm = kfch + o * HY_KFO + ((k1 ? 0 : 64) + ((64 - k1) & 63)) * 8;
#pragma unroll
          for (int s = 0; s < 64; ++s) { const int k0 = rev6(s);
              if (k0 < 32) { const f32x2 kv = *(const LAS f32x2*)(bd + k0 * 512); const float tr = re[s] * kv.x - im[s] * kv.y, ti = re[s] * kv.y + im[s] * kv.x; re[s] = tr; im[s] = ti; }
              else { const f32x2 kv = *(const LAS f32x2*)(bm + (63 - k0) * 512); const float tr = re[s] * kv.x + im[s] * kv.y, ti = im[s] * kv.x - re[s] * kv.y; re[s] = tr; im[s] = ti; }
              if ((s & 7) == 7) __builtin_amdgcn_sched_barrier(0); } }
        __builtin_amdgcn_sched_barrier(0);
        wfft_inv(re, im, wx, lane);
        hy_stage2(o == 0 ? PX1 : PX2, wxb, lane);
        { const int xo = (o + 1) * HYW + c; const float w0 = cw[xo], w1 = cw[3 * HYW + xo], w2 = cw[6 * HYW + xo], b = cb[xo];
#pragma unroll
          for (int n1 = 0; n1 < 32; ++n1) { const int t = 64 * n1 + lane;
              const float g0 = b + w0 * raw2(wxb, 0, t - 1) + w1 * raw2(wxb, 0, t) + w2 * raw2(wxb, 0, t + 1);
              const float g1 = b + w0 * raw2(wxb, 1, t - 1) + w1 * raw2(wxb, 1, t) + w2 * raw2(wxb, 1, t + 1);
              re[n1] *= g0; im[n1] *= g1; if ((n1 & 3) == 3) __builtin_amdgcn_sched_barrier(0); } }
    }
    int lane_g = F.lane; asm volatile("" : "+v"(lane_g));
    hy_stage2(GH, wxb, lane_g);
#pragma unroll
    for (int n1 = 0; n1 < 32; ++n1) { const int t = 64 * n1 + lane_g; const float g0 = raw2(wxb, 0, t), g1 = raw2(wxb, 1, t);
        OUT[t] = (bf16)f2bf(re[n1] * g0 * fast_sigmoid(g0)); OUT[SEQ + t] = (bf16)f2bf(im[n1] * g1 * fast_sigmoid(g1)); if ((n1 & 3) == 3) __builtin_amdgcn_sched_barrier(0); }
    asm volatile("s_waitcnt lgkmcnt(0)" ::: "memory");
}
__device__ __forceinline__ void hy_pair(Frame& F, int l, int cA, int cB) {
    const int grp = F.wave >> 2, ws = F.wave & 3, c = grp ? cB : cA;
    LAS unsigned char* wxb = F.lds + HY_WX + F.wave * HY_WXB;
    LAS unsigned char* kfch = F.lds + HY_KF + grp * HY_KFCH;
    LAS float* red = (LAS float*)(F.lds + HY_RED);
    hy_filter_gen(F, l, c, ws, (LAS float*)kfch, red + 2 * F.wave);
    LDS_WAIT(); __syncthreads();
    if (ws == 0) hy_filter_fft(F, l, c, kfch, red + 8 * grp, (LAS float*)wxb);
    LDS_WAIT(); __syncthreads();
    hy_wave_main(F, l, c, ws, wxb, kfch);
    LDS_WAIT(); __syncthreads();
}

__device__ __forceinline__ void transpose_pass(Frame& F) {
    const bf16* src = (const bf16*)(F.ws + WS_R1); bf16* dst = (bf16*)(F.ws + WS_R2);
    LAS unsigned char* tile = F.lds + F.wave * 9216; const int lane = F.lane;
    const int gw = F.bx * NWAVES + F.wave, NGW = F.G * NWAVES;
    constexpr int NTC = HYW / 64, NTT = M / 64;
    for (int it = gw; it < NTC * NTT; it += NGW) { const int c0 = (it % NTC) * 64, t0 = (it / NTC) * 64;
#pragma unroll
        for (int i = 0; i < 8; ++i) { const int q = lane + 64 * i, cr = q >> 3, ch = q & 7;
            const v4u v = *(const GAS v4u*)(src + (size_t)(c0 + cr) * M + t0 + 8 * ch); *(LAS v4u*)(tile + cr * 144 + 16 * ch) = v; }
        LDS_WAIT(); asm volatile("" ::: "memory");
#pragma unroll
        for (int i = 0; i < 8; ++i) { const int q = lane + 64 * i, tr = q >> 3, ch = q & 7;
            unsigned short e[8];
#pragma unroll
            for (int k = 0; k < 8; ++k) e[k] = *(const LAS unsigned short*)(tile + (8 * ch + k) * 144 + 2 * tr);
            v4u o; o.x = e[0] | ((unsigned)e[1] << 16); o.y = e[2] | ((unsigned)e[3] << 16); o.z = e[4] | ((unsigned)e[5] << 16); o.w = e[6] | ((unsigned)e[7] << 16);
            *(GAS v4u*)(dst + (size_t)(t0 + tr) * HYW + c0 + 8 * ch) = o; }
        LDS_WAIT(); asm volatile("" ::: "memory");
    }
}
__device__ __forceinline__ void final_norm(Frame& F) {
    const int gw = F.bx * NWAVES + F.wave, NGW = F.G * NWAVES, lane = F.lane; const GAS f32x4* wv = (const GAS f32x4*)F.inp(26) + lane;
    f32x4 w[4];
#pragma unroll
    for (int j = 0; j < 4; ++j) w[j] = wv[64 * j];
    for (int m = gw; m < M; m += NGW) { GAS f32x4* xr = (GAS f32x4*)(F.out + (size_t)m * D) + lane; f32x4 v[4]; float s = 0.f;
#pragma unroll
        for (int j = 0; j < 4; ++j) { v[j] = xr[64 * j]; s += (v[j].x * v[j].x + v[j].y * v[j].y) + (v[j].z * v[j].z + v[j].w * v[j].w); }
        const float rs = 1.0f / sqrtf(wave_sum(s) * (1.0f / D) + 1e-6f);
#pragma unroll
        for (int j = 0; j < 4; ++j) xr[64 * j] = v[j] * rs * w[j]; }
}

struct Args { const float* in[27]; float* out; unsigned char* ws; int ph_lo, ph_hi; };
__global__ void __launch_bounds__(NTHREADS, 2) mk_fwd(Args args) {
    extern __shared__ __attribute__((aligned(16))) unsigned char lds[];
    Frame F; F.lds = (LAS unsigned char*)lds; F.tid = threadIdx.x; F.lane = F.tid & 63; F.wave = __builtin_amdgcn_readfirstlane(F.tid >> 6); F.G = gridDim.x; F.bx = blockIdx.x;
    F.out = args.out; F.ws = args.ws;
    volatile LAS unsigned* MISC = (volatile LAS unsigned*)(F.lds + LDSCTL_OFF);
    if (F.tid < 64) MISC[F.tid] = 0u;
    if (F.tid == 64) { LAS unsigned long long* tab = (LAS unsigned long long*)(F.lds + LDSCTL_OFF + 256);
#pragma unroll
        for (int i = 0; i < 27; ++i) tab[i] = (unsigned long long)args.in[i]; }
    __syncthreads();
    XcdBarrier bar; bar.bar = (unsigned*)(F.ws + WS_CTL) + 1024; bar.x = 0; bar.st = nullptr;
    if (!MK_PER_PHASE) bar = xcd_barrier_post((unsigned*)(F.ws + WS_CTL) + 1024, MISC + 8);
    const int lo = args.ph_lo, hi = args.ph_hi;
#define IN(k) (lo <= (k) && (k) < hi)
#if defined(MK_TIMING)
    unsigned long long* TS = (unsigned long long*)(F.ws + WS_CTL + 32768);
#define STAMP(k) do { if (blockIdx.x == 0 && F.tid == 0) __hip_atomic_store(&TS[k], (unsigned long long)__builtin_amdgcn_s_memrealtime(), __ATOMIC_RELAXED, __HIP_MEMORY_SCOPE_AGENT); } while (0)
#else
#define STAMP(k) do { } while (0)
#endif
#define SEAM(k) do { if (IN(k) && IN((k) + 1)) xcd_barrier(bar); STAMP((k) + 1); } while (0)
    LAS unsigned char* ring = F.lds;
    STAMP(0);
#ifndef MK_ONLY
#define MK_ONLY -1
#endif
#define ON(k) (MK_ONLY < 0 || MK_ONLY == (k))
    if (ON(0) && IN(0)) { p0_prologue(F); }
    SEAM(0);
#pragma unroll 1
    for (int l = 0; l < DEPTH; ++l) {
        const int pb = 1 + 5 * l;
        unsigned char* wsl = F.ws; asm volatile("" : "+s"(wsl));
#define WSL(off) (wsl + (off))
#define OPQ(p) asm volatile("" : "+s"(p))
#define FRAME_P(Fp) Frame Fp = F; { int t_ = F.tid; asm volatile("" : "+v"(t_)); Fp.tid = t_; Fp.lane = t_ & 63; Fp.wave = __builtin_amdgcn_readfirstlane(t_ >> 6); Fp.ws = wsl; }
        bf16* wl = (bf16*)WSL(WS_W + (size_t)l * W_LAYER);
        bf16* X = (bf16*)WSL(WS_X); float* ssq = (float*)WSL(WS_SSQ);
        bf16 *R1 = (bf16*)WSL(WS_R1), *R2 = (bf16*)WSL(WS_R2), *R3 = (bf16*)WSL(WS_R3), *R5 = (bf16*)WSL(WS_R5), *R6 = (bf16*)WSL(WS_R6);
#ifndef MK_REP1
#define MK_REP1 1
#define MK_REP12 1
#define MK_REP3 1
#define MK_REP4 1
#endif
#pragma unroll 1
        for (int rep12 = 0; rep12 < MK_REP12; ++rep12) {
#pragma unroll 1
        for (int rep1 = 0; rep1 < MK_REP1; ++rep1)
        if (ON(1) && IN(pb)) {
            { pg8::Gemm g{wl + W_IN / 2, X, 4096, M, D, D, D}; pg8::StaticOrder S; S.init(4096, M, F.G, F.bx); pg8::EpiHT E{R1, M, ssq};
              pg8::gemm_phase<pg8::EpiHT, pg8::StaticOrder, true, true, 1024, 1024, 1024>(ring, g, S, E); }
            OPQ(X); OPQ(wl);
            { pg8::Gemm g{X, wl + W_IN / 2 + (size_t)4096 * D, M, 1024, D, D, D}; pg8::StaticOrder S; S.init(M, 1024, F.G, F.bx); pg8::EpiRow<0> E{R5, 1024, ssq};
              pg8::gemm_phase<pg8::EpiRow<0>, pg8::StaticOrder, true, true, 1024, 1024, 1024>(ring, g, S, E); }
        }
        SEAM(pb);
        if (IN(pb + 1)) {
#if defined(MK_S5DRY)
            if (ON(2)) { FRAME_P(Fq); for (int it = F.bx; it < BATCH * S5G; it += F.G) s5_item(Fq, l, it / S5G, it % S5G, true); }
#endif
            if (ON(2)) { FRAME_P(Fp); for (int it = F.bx; it < BATCH * S5G; it += F.G) s5_item(Fp, l, it / S5G, it % S5G); }
            if (ON(3)) { FRAME_P(Fp); for (int c = F.bx; c + F.G < HYW; c += 2 * F.G) hy_pair(Fp, l, c, c + F.G); }
        }
        if (rep12 + 1 < MK_REP12) xcd_barrier(bar);
        }
        SEAM(pb + 1);
#pragma unroll 1
        for (int rep3 = 0; rep3 < MK_REP3; ++rep3)
        if (ON(4) && IN(pb + 2)) {
            { pg8::Gemm g{X, wl + W_IN / 2 + (size_t)5120 * D, M, 2048, D, D, D}; pg8::StaticOrder S; S.init(M, 2048, F.G, F.bx); pg8::EpiRow<1> E{R3, 2048, ssq};
              pg8::gemm_phase<pg8::EpiRow<1>, pg8::StaticOrder, true, true, 1024, 1024, 1024>(ring, g, S, E); }
            OPQ(R5); OPQ(wl);
            { pg8::Gemm g{R5, wl + W_GLU / 2, M, S5W, S5W, 1024, S5W}; pg8::StaticOrder S; S.init(M, S5W, F.G, F.bx); pg8::EpiGLU E{R6, S5W, R5, 1024, F.inp(12) + l * S5W};
              pg8::gemm_phase<pg8::EpiGLU, pg8::StaticOrder, true, true, 512, 1024, 512>(ring, g, S, E); }
            __syncthreads();
            { FRAME_P(Fp); transpose_pass(Fp); }
        }
        SEAM(pb + 2);
#pragma unroll 1
        for (int rep4 = 0; rep4 < MK_REP4; ++rep4)
        if (ON(5) && IN(pb + 3)) {
            { pg8::Gemm g{R6, wl + W_BS5 / 2, M, D, S5W, S5W, S5W}; pg8::StaticOrder S; S.init(M, D, F.G, F.bx); pg8::EpiMerge<0> E{R1, D, R3, 2048, 0};
              pg8::gemm_phase<pg8::EpiMerge<0>, pg8::StaticOrder, true, true, 512, 512, 512>(ring, g, S, E); }
            VM_WAIT(); __syncthreads();
            OPQ(R2); OPQ(wl);
            { pg8::Gemm g{R2, wl + W_BHY / 2, M, D, HYW, HYW, HYW}; pg8::StaticOrder S; S.init(M, D, F.G, F.bx); pg8::EpiMerge<1> E{R1, D, R3, 2048, 1024};
              pg8::gemm_phase<pg8::EpiMerge<1>, pg8::StaticOrder, true, true, 1024, 1024, 1024>(ring, g, S, E); }
        }
        SEAM(pb + 3);
        if (ON(6) && IN(pb + 4)) {
            pg8::Gemm g{R1, wl + W_OUT / 2, M, D, D, D, D}; pg8::StaticOrder S; S.init(M, D, F.G, F.bx); pg8::EpiOut E{l == 0 ? F.inp(0) : (const float*)F.out, F.out, X, ssq};
            pg8::gemm_phase<pg8::EpiOut, pg8::StaticOrder, true, true, 1024, 1024, 1024>(ring, g, S, E);
        }
        SEAM(pb + 4);
    }
    if (ON(7) && IN(11)) final_norm(F);
#if defined(MK_TIMING)
    xcd_barrier(bar); STAMP(12); xcd_barrier(bar);
    { const unsigned long long a0 = __hip_atomic_load(&TS[MK_TA0], __ATOMIC_RELAXED, __HIP_MEMORY_SCOPE_AGENT), a1 = __hip_atomic_load(&TS[MK_TA1], __ATOMIC_RELAXED, __HIP_MEMORY_SCOPE_AGENT);
      const unsigned long long b0 = __hip_atomic_load(&TS[MK_TB0], __ATOMIC_RELAXED, __HIP_MEMORY_SCOPE_AGENT), b1 = __hip_atomic_load(&TS[MK_TB1], __ATOMIC_RELAXED, __HIP_MEMORY_SCOPE_AGENT);
      const float ta = (float)(a1 - a0) * 0.01f, tb = (float)(b1 - b0) * 0.01f;
      const float c = sqrtf(ta * 0.1f);
      for (size_t i = (size_t)blockIdx.x * NTHREADS + F.tid; i < (size_t)M * D; i += (size_t)gridDim.x * NTHREADS) F.out[i] = (i == 0) ? tb : c; }
#endif
#undef IN
#undef SEAM
}

#if defined(MK_DEBUG_HASH)
extern "C" void kernel_launch_dbg(void* const* d_in, void* d_out, void* d_ws, hipStream_t stream, int grid);
#endif
extern "C" void kernel_launch(void* const* d_in, const int* in_sizes, int n_in, void* d_out, int out_size, void* d_ws, size_t ws_size, hipStream_t stream) {
    static int grid = 0;
    if (grid == 0) {
        if (n_in != 27 || out_size != M * D || ws_size < WS_END) { fprintf(stderr, "kernel_launch: unexpected shapes (n_in %d out %d ws %zu)\n", n_in, out_size, ws_size); grid = -1; return; }
        int dev = 0, cus = 0, per_cu = 0;
        if (hipGetDevice(&dev) != hipSuccess || hipDeviceGetAttribute(&cus, hipDeviceAttributeMultiprocessorCount, dev) != hipSuccess) { grid = -1; return; }
        if (hipFuncSetAttribute((const void*)mk_fwd, hipFuncAttributeMaxDynamicSharedMemorySize, LDS_BYTES) != hipSuccess) { fprintf(stderr, "kernel_launch: hipFuncSetAttribute failed\n"); grid = -1; return; }
        if (hipOccupancyMaxActiveBlocksPerMultiprocessor(&per_cu, (const void*)mk_fwd, NTHREADS, LDS_BYTES) != hipSuccess || per_cu < 1) fprintf(stderr, "kernel_launch: occupancy query says %d\n", per_cu);
        (void)hipGetLastError();
        grid = cus;
    }
    if (grid < 0) return;
    (void)hipMemsetAsync((char*)d_ws + WS_CTL, 0, CTL_ZERO_BYTES, stream);
    Args a{};
    for (int i = 0; i < 27; ++i) a.in[i] = (const float*)d_in[i];
    a.out = (float*)d_out; a.ws = (unsigned char*)d_ws;
#if defined(MK_DEBUG_HASH)
    kernel_launch_dbg(d_in, d_out, d_ws, stream, grid);
#elif MK_PER_PHASE
    for (int p = 0; p < NPHASE; ++p) { a.ph_lo = p; a.ph_hi = p + 1; hipLaunchKernelGGL(mk_fwd, dim3(grid), dim3(NTHREADS), LDS_BYTES, stream, a); }
#else
    a.ph_lo = 0; a.ph_hi = NPHASE; hipLaunchKernelGGL(mk_fwd, dim3(grid), dim3(NTHREADS), LDS_BYTES, stream, a);
#endif
}

#if defined(MK_DEBUG_HASH)
__global__ void dbg_hash(const unsigned* p, size_t nwords, unsigned long long* out) {
    unsigned long long s = 0; for (size_t i = (size_t)blockIdx.x * blockDim.x + threadIdx.x; i < nwords; i += (size_t)gridDim.x * blockDim.x) s += p[i];
    atomicAdd(out, s);
}
__global__ void dbg_report(const unsigned long long* h, float* out, size_t n) {
    int first = -1; for (int p = 0; p < NPHASE && first < 0; ++p) for (int r = 0; r < 4; ++r) if (h[p * 4 + r] != h[NPHASE * 4 + p * 4 + r]) { first = p; break; }
    const float c = first < 0 ? 0.f : sqrtf((float)(first + 1));
    for (size_t i = (size_t)blockIdx.x * blockDim.x + threadIdx.x; i < n; i += (size_t)gridDim.x * blockDim.x) out[i] = c;
}
extern "C" void kernel_launch_dbg(void* const* d_in, void* d_out, void* d_ws, hipStream_t stream, int grid) {
    Args a{}; for (int i = 0; i < 27; ++i) a.in[i] = (const float*)d_in[i];
    a.out = (float*)d_out; a.ws = (unsigned char*)d_ws;
    unsigned long long* H = (unsigned long long*)((char*)d_ws + 253 * MiB);
    (void)hipMemsetAsync(H, 0, 2 * NPHASE * 4 * 8, stream);
    struct Reg { size_t off, len; bool out; };
    auto regs_of = [&](int p, Reg (&r)[4]) { for (int i = 0; i < 4; ++i) r[i] = Reg{0, 0, false};
        if (p == 0) { r[0] = Reg{1 * MiB, 1 * MiB, false}; r[1] = Reg{2 * MiB, 1 * MiB + 64 * 1024, false}; r[2] = Reg{4 * MiB, 39 * MiB, false}; r[3] = Reg{43 * MiB, 33 * MiB, false}; return; }
        if (p == 11) { r[0] = Reg{0, (size_t)M * D * 4, true}; return; }
        const int q = (p - 1) % 5;
        if (q == 0) { r[0] = Reg{WS_R1, 128 * MiB, false}; r[1] = Reg{WS_R5, 32 * MiB, false}; }
        if (q == 1) { r[0] = Reg{WS_R1, 32 * MiB, false}; r[1] = Reg{WS_R5, 32 * MiB, false}; }
        if (q == 2) { r[0] = Reg{WS_R3, 64 * MiB, false}; r[1] = Reg{WS_R6, 16 * MiB, false}; r[2] = Reg{WS_R2, 32 * MiB, false}; }
        if (q == 3) { r[0] = Reg{WS_R1, 32 * MiB, false}; }
        if (q == 4) { r[0] = Reg{0, (size_t)M * D * 4, true}; r[1] = Reg{WS_X, 32 * MiB, false}; r[2] = Reg{WS_SSQ, 1 * MiB, false}; } };
    for (int run = 0; run < 2; ++run) {
        if (run == 0) (void)hipMemsetAsync((char*)d_ws + 1 * MiB, 0xAA, 251 * MiB, stream);
        (void)hipMemsetAsync((char*)d_ws + WS_CTL, 0, CTL_ZERO_BYTES, stream);
        for (int p = 0; p < NPHASE; ++p) { a.ph_lo = p; a.ph_hi = p + 1; hipLaunchKernelGGL(mk_fwd, dim3(grid), dim3(NTHREADS), LDS_BYTES, stream, a);
            Reg r[4]; regs_of(p, r);
            for (int i = 0; i < 4; ++i) if (r[i].len) hipLaunchKernelGGL(dbg_hash, dim3(1024), dim3(256), 0, stream, (const unsigned*)((r[i].out ? (char*)d_out : (char*)d_ws) + r[i].off), r[i].len / 4, H + (run * NPHASE + p) * 4 + i); }
    }
    hipLaunchKernelGGL(dbg_report, dim3(1024), dim3(256), 0, stream, H, (float*)d_out, (size_t)M * D);
}
#endif
```

```cpp
#include <hip/hip_runtime.h>
#include <cstdio>
#include <cstdint>
#include <cmath>
#include <utility>
namespace pg8 {
#define PG8_LAS __attribute__((address_space(3)))
typedef unsigned short bf16_t;
typedef short bf16x8 __attribute__((ext_vector_type(8)));
typedef float f32x4 __attribute__((ext_vector_type(4)));
typedef unsigned u32x4 __attribute__((ext_vector_type(4)));
constexpr int BM = 256, BK = 64, HALF = 128, HTB = HALF * BK * 2  , STAGE_BYTES = 8 * HTB, NXCD = 8, WGM = 8;

__host__ __device__ __forceinline__ int lds_byte(int r, int c) { const int st = (r >> 4) * 2 + (c >> 5), rr = r & 15, cc = c & 31, ob = rr * 64 + cc * 2; return st * 1024 + (ob ^ (((ob >> 9) & 1) << 5)); }
__host__ __device__ __forceinline__ void stage_rc(int b, int& R, int& C) { const int st = b / 1024, sb = b % 1024, swz = sb ^ (((sb >> 9) & 1) << 5); R = (st >> 1) * 16 + swz / 64; C = (st & 1) * 32 + (swz % 64) / 2; }
__host__ __device__ __forceinline__ int perm32(int rho) { const int n = rho >> 4, i = rho & 15; return 8 * (i >> 2) + 4 * n + (i & 3); }

struct Unit { int pm, pn; };
struct Gemm { const bf16_t* A; const bf16_t* Bt; int M, N, K, lda, ldb; };

struct StaticOrder {
    int nM, nN, nwg, G, c;
    __host__ __device__ void init(int M, int N, int G_, int c_) { nM = M / BM; nN = N / BM; nwg = nM * nN; G = G_; c = c_; }
    __host__ __device__ bool next(int i, Unit& u) const {
        const long L = (long)i * G + c; if (L >= nwg) return false;
        int wgid = (int)L; { const int q = nwg / NXCD, r = nwg % NXCD, xcd = wgid % NXCD, off = wgid / NXCD; wgid = (xcd < r ? xcd * (q + 1) : r * (q + 1) + (xcd - r) * q) + off; }
        const int nig = WGM * nN, gid = wgid / nig, fm = gid * WGM, gsz = (nM - fm) < WGM ? (nM - fm) : WGM;
        u.pm = fm + ((wgid % nig) % gsz); u.pn = (wgid % nig) / gsz; return true;
    }
    __device__ __forceinline__ void a_ready(const Unit&) const {}
    __device__ __forceinline__ void done(const Unit&) const {}
};

typedef unsigned u32x2 __attribute__((ext_vector_type(2)));

typedef __bf16 bf16x2_t __attribute__((ext_vector_type(2)));
typedef float f32x2_t __attribute__((ext_vector_type(2)));
__device__ __forceinline__ unsigned cvt_pk_bf16(float lo, float hi) { const f32x2_t v = {lo, hi}; const bf16x2_t b = __builtin_convertvector(v, bf16x2_t); return __builtin_bit_cast(unsigned, b); }
__device__ __forceinline__ float bf_lo(unsigned w) { return __uint_as_float(w << 16); }
__device__ __forceinline__ float bf_hi(unsigned w) { return __uint_as_float(w & 0xffff0000u); }
__device__ __forceinline__ float fast_sigmoid(float x) { return __builtin_amdgcn_rcpf(1.0f + __builtin_amdgcn_exp2f(-1.4426950408889634f * x)); }
constexpr float RMS_EPS = 1e-6f;
__device__ __forceinline__ float rs_of(const float* ssq, int tok) {
    const f32x4* p = (const f32x4*)(ssq + (size_t)tok * 16); const f32x4 a = p[0], b = p[1], c = p[2], d = p[3];
    const float s = ((a[0] + a[1]) + (a[2] + a[3])) + ((b[0] + b[1]) + (b[2] + b[3])) + ((c[0] + c[1]) + (c[2] + c[3])) + ((d[0] + d[1]) + (d[2] + d[3]));
    return 1.0f / sqrtf(s * (1.0f / 1024.0f) + RMS_EPS);
}
struct EpiHT {
    static constexpr bool PERM = true, AFTER_DRAIN = false;
    bf16_t* O; int ldc; const float* ssq;
    __device__ __forceinline__ void operator()(const f32x4 (&acc)[2][2][4][2], const Unit& u, int wr, int wc, int fr, int fq) const {
        const int lane = (fq << 4) | fr;
        const int ctile = u.pn * BM + wc * 32 + 8 * fq;
        const float mine = rs_of(ssq, ctile + 128 * (fr >> 3) + (fr & 7));
        const int row0 = u.pm * BM + wr * 64 + fr;
#pragma unroll
        for (int bj = 0; bj < 2; ++bj) { float rsv[8];
#pragma unroll
            for (int i = 0; i < 8; ++i) rsv[i] = __shfl(mine, (lane & 48) | (8 * bj + i));
#pragma unroll
            for (int ai = 0; ai < 2; ++ai)
#pragma unroll
                for (int m = 0; m < 4; ++m) { bf16_t* rowp = O + (size_t)(row0 + ai * HALF + m * 16) * ldc + ctile + bj * HALF;
                    const f32x4 v0 = acc[ai][bj][m][0], v1 = acc[ai][bj][m][1]; u32x4 w;
                    w.x = cvt_pk_bf16(v0[0] * rsv[0], v0[1] * rsv[1]); w.y = cvt_pk_bf16(v0[2] * rsv[2], v0[3] * rsv[3]);
                    w.z = cvt_pk_bf16(v1[0] * rsv[4], v1[1] * rsv[5]); w.w = cvt_pk_bf16(v1[2] * rsv[6], v1[3] * rsv[7]);
                    *(u32x4*)rowp = w; }
            asm volatile("" ::: "memory"); }
    }
};
template <int SIG> struct EpiRow {
    static constexpr bool PERM = true, AFTER_DRAIN = false;
    bf16_t* O; int ldc; const float* ssq;
    __device__ __forceinline__ void operator()(const f32x4 (&acc)[2][2][4][2], const Unit& u, int wr, int wc, int fr, int fq) const {
        const int lane = (fq << 4) | fr;
        const int row0 = u.pm * BM + wr * 64 + fr;
        float mine[2];
#pragma unroll
        for (int i = 0; i < 2; ++i) { const int q = 2 * fq + i; mine[i] = rs_of(ssq, row0 + (q >> 2) * HALF + (q & 3) * 16); }
        const int col0 = u.pn * BM + wc * 32 + 8 * fq;
#pragma unroll
        for (int ai = 0; ai < 2; ++ai)
#pragma unroll
            for (int m = 0; m < 4; ++m) { const int q = ai * 4 + m; const float rs = __shfl(mine[q & 1], ((q >> 1) << 4) | (lane & 15));
                bf16_t* rowp = O + (size_t)(row0 + ai * HALF + m * 16) * ldc + col0;
#pragma unroll
                for (int bj = 0; bj < 2; ++bj) { f32x4 v0 = acc[ai][bj][m][0] * rs, v1 = acc[ai][bj][m][1] * rs;
                    if (SIG) {
#pragma unroll
                        for (int e = 0; e < 4; ++e) { v0[e] = fast_sigmoid(v0[e]); v1[e] = fast_sigmoid(v1[e]); } }
                    u32x4 w; w.x = cvt_pk_bf16(v0[0], v0[1]); w.y = cvt_pk_bf16(v0[2], v0[3]); w.z = cvt_pk_bf16(v1[0], v1[1]); w.w = cvt_pk_bf16(v1[2], v1[3]);
                    *(u32x4*)(rowp + bj * HALF) = w; }
                asm volatile("" ::: "memory"); }
    }
};
struct EpiGLU {
    static constexpr bool PERM = true, AFTER_DRAIN = false;
    bf16_t* O; int ldc; const bf16_t* YG; int ldy; const float* bglu;
    __device__ __forceinline__ void operator()(const f32x4 (&acc)[2][2][4][2], const Unit& u, int wr, int wc, int fr, int fq) const {
        const int row0 = u.pm * BM + wr * 64 + fr, col0 = u.pn * BM + wc * 32 + 8 * fq;
        f32x4 bv[2][2];
#pragma unroll
        for (int bj = 0; bj < 2; ++bj)
#pragma unroll
            for (int n = 0; n < 2; ++n) bv[bj][n] = *(const f32x4*)(bglu + col0 + bj * HALF + 4 * n);
#pragma unroll
        for (int ai = 0; ai < 2; ++ai)
#pragma unroll
            for (int m = 0; m < 4; ++m) { const size_t r = (size_t)(row0 + ai * HALF + m * 16);
#pragma unroll
                for (int bj = 0; bj < 2; ++bj) { const int c = col0 + bj * HALF;
                    const u32x4 yv = *(const u32x4*)(YG + r * ldy + c), gv = *(const u32x4*)(YG + r * ldy + 512 + c);
                    const f32x4 a0 = acc[ai][bj][m][0] + bv[bj][0], a1 = acc[ai][bj][m][1] + bv[bj][1];
                    float o[8]; const unsigned yw[4] = {yv.x, yv.y, yv.z, yv.w}, gw[4] = {gv.x, gv.y, gv.z, gv.w};
#pragma unroll
                    for (int e = 0; e < 8; ++e) { const float a = e < 4 ? a0[e & 3] : a1[e & 3]; const float y = (e & 1) ? bf_hi(yw[e >> 1]) : bf_lo(yw[e >> 1]);
                        const float g = (e & 1) ? bf_hi(gw[e >> 1]) : bf_lo(gw[e >> 1]); o[e] = y * fast_sigmoid(a) * (g * fast_sigmoid(g)); }
                    u32x4 w; w.x = cvt_pk_bf16(o[0], o[1]); w.y = cvt_pk_bf16(o[2], o[3]); w.z = cvt_pk_bf16(o[4], o[5]); w.w = cvt_pk_bf16(o[6], o[7]);
                    *(u32x4*)(O + r * ldc + c) = w; asm volatile("" ::: "memory"); } }
    }
};
template <int ADD> struct EpiMerge {
    static constexpr bool PERM = true, AFTER_DRAIN = false;
    bf16_t* O; int ldc; const bf16_t* G; int ldg; int goff;
    __device__ __forceinline__ void operator()(const f32x4 (&acc)[2][2][4][2], const Unit& u, int wr, int wc, int fr, int fq) const {
        const int row0 = u.pm * BM + wr * 64 + fr, col0 = u.pn * BM + wc * 32 + 8 * fq;
#pragma unroll
        for (int ai = 0; ai < 2; ++ai)
#pragma unroll
            for (int m = 0; m < 4; ++m) { const size_t r = (size_t)(row0 + ai * HALF + m * 16);
#pragma unroll
                for (int bj = 0; bj < 2; ++bj) { const int c = col0 + bj * HALF;
                    const u32x4 gv = *(const u32x4*)(G + r * ldg + goff + c); u32x4 tv = {0u, 0u, 0u, 0u}; if (ADD) tv = *(const u32x4*)(O + r * ldc + c);
                    const f32x4 a0 = acc[ai][bj][m][0], a1 = acc[ai][bj][m][1];
                    float o[8]; const unsigned gw[4] = {gv.x, gv.y, gv.z, gv.w}, tw[4] = {tv.x, tv.y, tv.z, tv.w};
#pragma unroll
                    for (int e = 0; e < 8; ++e) { const float a = e < 4 ? a0[e & 3] : a1[e & 3]; const float g = (e & 1) ? bf_hi(gw[e >> 1]) : bf_lo(gw[e >> 1]);
                        const float t = (e & 1) ? bf_hi(tw[e >> 1]) : bf_lo(tw[e >> 1]); o[e] = (ADD ? t : 0.f) + g * a; }
                    u32x4 w; w.x = cvt_pk_bf16(o[0], o[1]); w.y = cvt_pk_bf16(o[2], o[3]); w.z = cvt_pk_bf16(o[4], o[5]); w.w = cvt_pk_bf16(o[6], o[7]);
                    *(u32x4*)(O + r * ldc + c) = w; asm volatile("" ::: "memory"); } }
    }
};
struct EpiOut {
    static constexpr bool PERM = false, AFTER_DRAIN = false;
    const float* base; float* H; bf16_t* XN; float* ssq;
    __device__ __forceinline__ void operator()(const f32x4 (&acc)[2][2][4][2], const Unit& u, int wr, int wc, int fr, int fq) const {
        const int row0 = u.pm * BM + wr * 64 + fr, col0 = u.pn * BM + wc * 32 + 4 * fq;
#pragma unroll
        for (int ai = 0; ai < 2; ++ai)
#pragma unroll
            for (int m = 0; m < 4; ++m) { const size_t r = (size_t)(row0 + ai * HALF + m * 16); float s = 0.f;
#pragma unroll
                for (int bj = 0; bj < 2; ++bj)
#pragma unroll
                    for (int n = 0; n < 2; ++n) { const size_t off = r * 1024 + col0 + bj * HALF + n * 16;
                        const f32x4 h = *(const f32x4*)(base + off) + acc[ai][bj][m][n]; *(f32x4*)(H + off) = h;
                        s += (h[0] * h[0] + h[1] * h[1]) + (h[2] * h[2] + h[3] * h[3]);
                        u32x2 w; w.x = cvt_pk_bf16(h[0], h[1]); w.y = cvt_pk_bf16(h[2], h[3]); *(u32x2*)(XN + off) = w; }
                s += __shfl_xor(s, 16); s += __shfl_xor(s, 32);
                if (fq == 0) ssq[r * 16 + u.pn * 4 + wc] = s; }
    }
};
template <class Epi, class Sched, bool ALIGN_EPI, bool SP2, int KK, int LDA, int LDB>
__device__ __forceinline__ void gemm_phase(PG8_LAS unsigned char* lds, const Gemm g, const Sched& S, const Epi& E, int wave_id  ) {
    int lane_; asm volatile("v_mbcnt_lo_u32_b32 %0, -1, 0\n\tv_mbcnt_hi_u32_b32 %0, -1, %0" : "=&v"(lane_)); const int tid_ = wave_id * 64 + lane_;
    const int tid = tid_, wid = __builtin_amdgcn_readfirstlane(tid >> 6), lane = tid & 63, wr = wid >> 2, wc = wid & 3, fr = lane & 15, fq = lane >> 4;
    constexpr int K = KK, nt = K / BK;
    unsigned voffA[2], voffB[2];
#pragma unroll
    for (int i = 0; i < 2; ++i) { int R, C; stage_rc(tid * 16 + i * 8192, R, C); const int Rb = Epi::PERM ? ((R & ~31) + perm32(R & 31)) : R;
        voffA[i] = (unsigned)(R * LDA + C) * 2u; voffB[i] = (unsigned)(Rb * LDB + C) * 2u; }
    constexpr size_t kstep = (size_t)(BK * 2);
    constexpr size_t hstepA = (size_t)HALF * LDA * 2, hstepB = (size_t)HALF * LDB * 2;
    constexpr size_t tstepA = 2 * hstepA, tstepB = 2 * hstepB;
    const unsigned ldsw = (unsigned)wid * 1024u;
    const int aoff = lds_byte(wr * 64 + fr, fq * 8), boff = lds_byte(wc * 32 + fr, fq * 8);
#define PG8_SA(b, h) (((b) * 2 + (h)) * HTB)
#define PG8_SB(b, h) ((4 + (b) * 2 + (h)) * HTB)
#define PG8_STAGE(bufoff, gbase, voff) do { _Pragma("unroll") for (int _i = 0; _i < 2; ++_i) \
        __builtin_amdgcn_global_load_lds((const unsigned*)((const char*)(gbase) + (voff)[_i]), (PG8_LAS unsigned*)(lds + (bufoff) + ldsw + _i * 8192), 16, 0, 0); } while (0)
#define PG8_LDA(dst, b, h) do { _Pragma("unroll") for (int m = 0; m < 4; ++m) _Pragma("unroll") for (int k = 0; k < 2; ++k) dst[m][k] = *(const PG8_LAS bf16x8*)(lds + PG8_SA(b, h) + aoff + m * 2048 + k * 1024); } while (0)
#define PG8_LDB(dst, b, h) do { _Pragma("unroll") for (int n = 0; n < 2; ++n) _Pragma("unroll") for (int k = 0; k < 2; ++k) dst[n][k] = *(const PG8_LAS bf16x8*)(lds + PG8_SB(b, h) + boff + n * 2048 + k * 1024); } while (0)
#define PG8_MMA(ai, bj, At, Bt) do { __builtin_amdgcn_s_setprio(1); _Pragma("unroll") for (int m = 0; m < 4; ++m) _Pragma("unroll") for (int n = 0; n < 2; ++n) _Pragma("unroll") for (int k = 0; k < 2; ++k) \
        acc[ai][bj][m][n] = __builtin_amdgcn_mfma_f32_16x16x32_bf16(Bt[n][k], At[m][k], acc[ai][bj][m][n], 0, 0, 0); __builtin_amdgcn_s_setprio(0); } while (0)
#define PG8_WAIT_V(n) asm volatile("s_waitcnt vmcnt(" #n ")" ::: "memory")
#define PG8_WAIT_L(n) asm volatile("s_waitcnt lgkmcnt(" #n ")" ::: "memory")
#define PG8_BAR __builtin_amdgcn_s_barrier()
#define PG8_SCHED __builtin_amdgcn_sched_barrier(0)
    Unit cur, nxt; int ui = 0;
    if (!S.next(0, cur)) return;
    f32x4 acc[2][2][4][2];
#pragma unroll
    for (int a = 0; a < 2; ++a)
#pragma unroll
        for (int b = 0; b < 2; ++b)
#pragma unroll
            for (int m = 0; m < 4; ++m)
#pragma unroll
                for (int n = 0; n < 2; ++n) acc[a][b][m][n] = (f32x4){0.f, 0.f, 0.f, 0.f};
    bf16x8 At[4][2], B0[2][2], B1[2][2];
    const char* cA = (const char*)g.A + (size_t)cur.pm * tstepA; const char* cB = (const char*)g.Bt + (size_t)cur.pn * tstepB;
    S.a_ready(cur);
    if constexpr (SP2) {
        PG8_STAGE(PG8_SB(0, 0), cB, voffB); PG8_STAGE(PG8_SB(0, 1), cB + hstepB, voffB); PG8_STAGE(PG8_SA(0, 0), cA, voffA); PG8_STAGE(PG8_SA(0, 1), cA + hstepA, voffA);
        if (wr == 1) PG8_BAR;
        PG8_WAIT_V(2); PG8_BAR;
        PG8_STAGE(PG8_SB(1, 0), cB + kstep, voffB); PG8_STAGE(PG8_SA(1, 0), cA + kstep, voffA); PG8_STAGE(PG8_SB(1, 1), cB + hstepB + kstep, voffB);
        PG8_WAIT_V(6); PG8_BAR;
    } else {
        PG8_STAGE(PG8_SB(0, 0), cB, voffB); PG8_STAGE(PG8_SA(0, 0), cA, voffA); PG8_STAGE(PG8_SB(0, 1), cB + hstepB, voffB); PG8_STAGE(PG8_SA(0, 1), cA + hstepA, voffA);
        if (wr == 1) PG8_BAR;
        PG8_WAIT_V(4); PG8_BAR;
        PG8_STAGE(PG8_SB(1, 0), cB + kstep, voffB); PG8_STAGE(PG8_SA(1, 0), cA + kstep, voffA); PG8_STAGE(PG8_SB(1, 1), cB + hstepB + kstep, voffB);
        PG8_WAIT_V(6); PG8_BAR;
    }
    for (;;) {
        const bool has_next = S.next(ui + 1, nxt);
        const char* nA = has_next ? (const char*)g.A + (size_t)nxt.pm * tstepA : cA; const char* nB = has_next ? (const char*)g.Bt + (size_t)nxt.pn * tstepB : cB;
        for (int t = 0; t < nt; t += 2) {
            const bool last = (t == nt - 2);
            const char* a1 = cA + (size_t)(t + 1) * kstep;
            const char* a2 = last ? nA : cA + (size_t)(t + 2) * kstep; const char* b2 = last ? nB : cB + (size_t)(t + 2) * kstep;
            const char* a3 = a2 + kstep; const char* b3 = b2 + kstep;
            if (last && has_next) S.a_ready(nxt);
            if constexpr (SP2) {
            PG8_LDB(B0, 0, 0); PG8_LDB(B1, 0, 1); PG8_SCHED; PG8_LDA(At, 0, 0); PG8_STAGE(PG8_SA(1, 1), a1 + hstepA, voffA);
            PG8_WAIT_V(8); PG8_WAIT_L(0); PG8_BAR; PG8_MMA(0, 0, At, B0); PG8_MMA(0, 1, At, B1); PG8_BAR; PG8_SCHED;
            PG8_LDA(At, 0, 1); PG8_STAGE(PG8_SB(0, 0), b2, voffB); PG8_STAGE(PG8_SB(0, 1), b2 + hstepB, voffB); PG8_STAGE(PG8_SA(0, 0), a2, voffA);
            PG8_WAIT_V(8); PG8_WAIT_L(0); PG8_BAR; PG8_MMA(1, 0, At, B0); PG8_MMA(1, 1, At, B1); PG8_BAR; PG8_SCHED;
            PG8_LDB(B0, 1, 0); PG8_LDB(B1, 1, 1); PG8_SCHED; PG8_LDA(At, 1, 0); PG8_STAGE(PG8_SA(0, 1), a2 + hstepA, voffA);
            PG8_WAIT_V(8); PG8_WAIT_L(0); PG8_BAR; PG8_MMA(0, 0, At, B0); PG8_MMA(0, 1, At, B1); PG8_BAR; PG8_SCHED;
            PG8_LDA(At, 1, 1); PG8_STAGE(PG8_SB(1, 0), b3, voffB); PG8_STAGE(PG8_SB(1, 1), b3 + hstepB, voffB); PG8_STAGE(PG8_SA(1, 0), a3, voffA);
            PG8_WAIT_V(8); PG8_WAIT_L(0); PG8_BAR; PG8_MMA(1, 0, At, B0); PG8_MMA(1, 1, At, B1); PG8_BAR; PG8_SCHED;
            } else {
            PG8_LDB(B0, 0, 0); PG8_SCHED; PG8_LDA(At, 0, 0); PG8_STAGE(PG8_SA(1, 1), a1 + hstepA, voffA);
            PG8_WAIT_L(8); PG8_BAR; PG8_WAIT_L(0); PG8_MMA(0, 0, At, B0); PG8_BAR; PG8_SCHED;
            PG8_LDB(B1, 0, 1); PG8_STAGE(PG8_SB(0, 0), b2, voffB);
            PG8_BAR; PG8_WAIT_L(0); PG8_MMA(0, 1, At, B1); PG8_BAR;
            PG8_LDA(At, 0, 1); PG8_STAGE(PG8_SA(0, 0), a2, voffA);
            PG8_BAR; PG8_WAIT_L(0); PG8_MMA(1, 0, At, B0); PG8_BAR; PG8_SCHED;
            PG8_STAGE(PG8_SB(0, 1), b2 + hstepB, voffB);
            PG8_WAIT_V(6); PG8_BAR; PG8_MMA(1, 1, At, B1); PG8_BAR;
            PG8_LDB(B0, 1, 0); PG8_SCHED; PG8_LDA(At, 1, 0); PG8_STAGE(PG8_SA(0, 1), a2 + hstepA, voffA);
            PG8_WAIT_L(8); PG8_BAR; PG8_WAIT_L(0); PG8_MMA(0, 0, At, B0); PG8_BAR; PG8_SCHED;
            PG8_LDB(B1, 1, 1); PG8_STAGE(PG8_SB(1, 0), b3, voffB);
            PG8_BAR; PG8_WAIT_L(0); PG8_MMA(0, 1, At, B1); PG8_BAR;
            PG8_LDA(At, 1, 1); PG8_STAGE(PG8_SA(1, 0), a3, voffA);
            PG8_BAR; PG8_WAIT_L(0); PG8_MMA(1, 0, At, B0); PG8_BAR; PG8_SCHED;
            PG8_STAGE(PG8_SB(1, 1), b3 + hstepB, voffB);
            PG8_WAIT_V(6); PG8_BAR; PG8_MMA(1, 1, At, B1); PG8_BAR;
            }
        }
        if constexpr (ALIGN_EPI) { if (wr == 0) PG8_BAR; }
        if constexpr (!Epi::AFTER_DRAIN) { E(acc, cur, wr, wc, fr, fq); S.done(cur); }
        if (!has_next) break;
#pragma unroll
        for (int a = 0; a < 2; ++a)
#pragma unroll
            for (int b = 0; b < 2; ++b)
#pragma unroll
                for (int m = 0; m < 4; ++m)
#pragma unroll
                    for (int n = 0; n < 2; ++n) acc[a][b][m][n] = (f32x4){0.f, 0.f, 0.f, 0.f};
        cur = nxt; cA = nA; cB = nB; ++ui;
        if constexpr (ALIGN_EPI) { if (wr == 1) PG8_BAR; }
    }
    PG8_WAIT_V(0);
    if constexpr (!ALIGN_EPI) { if (wr == 0) PG8_BAR; }
    PG8_BAR;
    if constexpr (Epi::AFTER_DRAIN) { E.fused(acc, cur, wr, wc, fr, fq, lds, wid, lane); S.done(cur); }
#undef PG8_SA
#undef PG8_SB
#undef PG8_STAGE
#undef PG8_LDA
#undef PG8_LDB
#undef PG8_MMA
#undef PG8_WAIT_V
#undef PG8_WAIT_L
#undef PG8_BAR
#undef PG8_SCHED
}
}

constexpr int NWAVES = 8, NTHREADS = 512;
#ifndef MK_PER_PHASE
#define MK_PER_PHASE 0
#endif
constexpr int D = 1024, BATCH = 8, SEQ = 2048, M = BATCH * SEQ, DEPTH = 2;
constexpr int S5W = 512, S5H = 16, S5G = 32, S5P = 64;
constexpr int HYW = 1024, HYF = 4096, HYE = 33, HYN = 64;
constexpr int INC = 7168;
constexpr int NPHASE = 12;

constexpr size_t MiB = 1u << 20;
constexpr size_t WS_CTL = 0, CTL_ZERO_BYTES = 64 * 1024;
constexpr size_t WS_H2 = 1 * MiB;
constexpr size_t WS_LBAR = 2 * MiB;
constexpr size_t WS_BBT = 2 * MiB + 64 * 1024;
constexpr size_t WS_CT = WS_BBT + 512 * 1024;
constexpr size_t WS_W = 4 * MiB;
constexpr size_t W_IN = 0, W_GLU = 14 * MiB, W_BS5 = W_GLU + 512 * 1024, W_BHY = W_BS5 + 1 * MiB, W_OUT = W_BHY + 2 * MiB, W_LAYER = W_OUT + 2 * MiB;
constexpr size_t WS_SSQ = 43 * MiB;
constexpr size_t WS_X = 44 * MiB;
constexpr size_t WS_R1 = 76 * MiB, WS_R2 = 108 * MiB, WS_R3 = 140 * MiB, WS_R4 = 172 * MiB, WS_R5 = 204 * MiB, WS_R6 = 236 * MiB, WS_W3T = 252 * MiB  , WS_END = 254 * MiB;
static_assert(WS_W + 2 * W_LAYER <= WS_SSQ, "weights");
constexpr int LDS_BYTES = 163840 - 256;
constexpr int LDSCTL_OFF = LDS_BYTES - 512;

#define GAS __attribute__((address_space(1)))
#define LAS __attribute__((address_space(3)))
typedef unsigned short bf16;
typedef unsigned v4u __attribute__((ext_vector_type(4)));
typedef unsigned v2u __attribute__((ext_vector_type(2)));
typedef float f32x4 __attribute__((ext_vector_type(4)));
typedef float f32x2 __attribute__((ext_vector_type(2)));
typedef short bf16x8 __attribute__((ext_vector_type(8)));
typedef GAS unsigned gu32;
#define RLX_AGENT __ATOMIC_RELAXED, __HIP_MEMORY_SCOPE_AGENT
#define LDS_WAIT() asm volatile("s_waitcnt lgkmcnt(0)" ::: "memory")
#define VM_WAIT() asm volatile("s_waitcnt vmcnt(0)" ::: "memory")
__device__ __forceinline__ unsigned f2bf(float f) { unsigned u = __builtin_bit_cast(unsigned, f); return (u + 0x7fffu + ((u >> 16) & 1u)) >> 16; }
__device__ __forceinline__ unsigned pk2(float lo, float hi) { return f2bf(lo) | (f2bf(hi) << 16); }
__device__ __forceinline__ float bf2f(unsigned short h) { return __uint_as_float((unsigned)h << 16); }
using pg8::bf_lo; using pg8::bf_hi; using pg8::fast_sigmoid;

#define XB_TMO      128
#define XB_XCNT(j)  (256  + 64 * (j))
#define XB_XSUB(j)  (1280 + 64 * (j))
#define XB_XGEN(j)  (2304 + 64 * (j))
#define XB_TOP      3328
#define XB_TOPGEN   3392
#define XCD_BAR_WORDS 3456
#define XB_SPIN_CAP (1u << 18)
__device__ __forceinline__ unsigned xb_ld(unsigned* p)              { return __hip_atomic_load(p, __ATOMIC_RELAXED, __HIP_MEMORY_SCOPE_AGENT); }
__device__ __forceinline__ unsigned xb_add(unsigned* p, unsigned v) { return __hip_atomic_fetch_add(p, v, __ATOMIC_RELAXED, __HIP_MEMORY_SCOPE_AGENT); }
__device__ __forceinline__ unsigned xb_xcc_id() { return (unsigned)__builtin_amdgcn_s_getreg((3 << 11) | 20) & 0xFu; }
#define XB_SPIN(cond, bar) do { unsigned _sp = 0; while (cond) { __builtin_amdgcn_s_sleep(1); \
    if ((++_sp & 255u) == 0u) { if (xb_ld(&(bar)[XB_TMO])) break; if (_sp > XB_SPIN_CAP) { atomicAdd(&(bar)[XB_TMO], 1u); break; } } } } while (0)
struct XcdBarrier { unsigned* bar; unsigned x; volatile LAS unsigned* st; };
__device__ __forceinline__ int cur_lane() { int l; asm volatile("v_mbcnt_lo_u32_b32 %0, -1, 0\n\tv_mbcnt_hi_u32_b32 %0, -1, %0" : "=&v"(l)); return l; }
__device__ __forceinline__ XcdBarrier xcd_barrier_post(unsigned* bar, volatile LAS unsigned* st, bool leader) {
    XcdBarrier b; b.bar = bar; b.x = xb_xcc_id(); b.st = st;
    if (leader) (void)xb_add(&bar[XB_XCNT(b.x)], 1u);
    return b;
}
__device__ __forceinline__ void xcd_barrier_complete(unsigned* bar, unsigned x, unsigned& nloc, unsigned& nx) {
    const unsigned G = gridDim.x * gridDim.y * gridDim.z;
    unsigned sum, cnt, mine, sp = 0u;
    for (;;) {
        sum = 0u; cnt = 0u; mine = 0u;
#pragma unroll
        for (unsigned j = 0; j < 16; ++j) { const unsigned c = xb_ld(&bar[XB_XCNT(j)]); sum += c; cnt += (c > 0u) ? 1u : 0u; mine = (j == x) ? c : mine; }
        if (sum == G) break;
        __builtin_amdgcn_s_sleep(1);
        if ((++sp & 255u) == 0u) { if (xb_ld(&bar[XB_TMO])) break; if (sp > XB_SPIN_CAP) { atomicAdd(&bar[XB_TMO], 1u); break; } }
    }
    nloc = mine > 0u ? mine : 1u; nx = cnt > 0u ? cnt : 1u;
}
__device__ __forceinline__ void xcd_barrier(const XcdBarrier& b, int wave_id) {
    asm volatile("s_waitcnt vmcnt(0)" ::: "memory");
    __syncthreads();
    if (wave_id == 0 && cur_lane() == 0) {
        unsigned* bar = b.bar; asm volatile("" : "+s"(bar));
        __builtin_amdgcn_s_waitcnt(0);
        unsigned nloc = b.st[0], nx = b.st[1];
        if (nloc == 0u) { xcd_barrier_complete(bar, b.x, nloc, nx); b.st[0] = nloc; b.st[1] = nx; }
        const unsigned old = xb_add(&bar[XB_XSUB(b.x)], 1u);
        const unsigned gen = old / nloc;
        if (old + 1u == (gen + 1u) * nloc) {
            __builtin_amdgcn_fence(__ATOMIC_RELEASE, "agent");
            asm volatile("s_waitcnt vmcnt(0)" ::: "memory");
            const unsigned og = xb_add(&bar[XB_TOP], 1u);
            const unsigned tg = og / nx;
            if (og + 1u == (tg + 1u) * nx) xb_add(&bar[XB_TOPGEN], 1u);
            else XB_SPIN(xb_ld(&bar[XB_TOPGEN]) == tg, bar);
            __builtin_amdgcn_fence(__ATOMIC_ACQUIRE, "agent");
            xb_add(&bar[XB_XGEN(b.x)], 1u);
            asm volatile("s_waitcnt vmcnt(0)" ::: "memory");
        } else {
            XB_SPIN(xb_ld(&bar[XB_XGEN(b.x)]) == gen, bar);
            __builtin_amdgcn_fence(__ATOMIC_ACQUIRE, "agent");
            asm volatile("s_waitcnt vmcnt(0)" ::: "memory");
        }
    }
    __syncthreads();
}

struct Frame {
    LAS unsigned char* lds;
    int tid, lane, wave, G, bx;
    float* out; unsigned char* ws;
    __device__ __forceinline__ const float* inp(int i) const {
        const LAS unsigned* t = (const LAS unsigned*)(lds + LDSCTL_OFF + 256) + 2 * i;
        const unsigned lo = __builtin_amdgcn_readfirstlane(t[0]), hi = __builtin_amdgcn_readfirstlane(t[1]);
        return (const float*)(((unsigned long long)hi << 32) | lo);
    }
};
__device__ __forceinline__ float wave_sum(float v) {
#pragma unroll
    for (int o = 1; o < 64; o <<= 1) v += __shfl_xor(v, o);
    return v;
}

__device__ __forceinline__ void p0_transpose_item(const float* W, int K, int N, bf16* WT, int k0, int n0, int drow, const float* kscale, LAS float* scr, int lane, bf16* WTlo = nullptr) {
#pragma unroll 8
    for (int i = 0; i < 32; ++i) { const int kk = 2 * i + (lane >> 5); float v = W[(size_t)(k0 + kk) * N + n0 + (lane & 31)]; if (kscale) v *= kscale[k0 + kk]; scr[kk * 33 + (lane & 31)] = v; }
    LDS_WAIT(); asm volatile("" ::: "memory");
    const int c = lane & 7;
#pragma unroll
    for (int j = 0; j < 4; ++j) { const int n = (lane >> 3) + 8 * j; const LAS float* s = scr + (8 * c) * 33 + n;
        v4u o; o.x = pk2(s[0 * 33], s[1 * 33]); o.y = pk2(s[2 * 33], s[3 * 33]); o.z = pk2(s[4 * 33], s[5 * 33]); o.w = pk2(s[6 * 33], s[7 * 33]);
        *(GAS v4u*)(WT + (size_t)(drow + n) * K + k0 + 8 * c) = o;
        if (WTlo) { v4u q;
#define P0_LO2(a, b, hw) pk2((a) - __uint_as_float((hw) << 16), (b) - __uint_as_float((hw) & 0xffff0000u))
            q.x = P0_LO2(s[0 * 33], s[1 * 33], o.x); q.y = P0_LO2(s[2 * 33], s[3 * 33], o.y); q.z = P0_LO2(s[4 * 33], s[5 * 33], o.z); q.w = P0_LO2(s[6 * 33], s[7 * 33], o.w);
#undef P0_LO2
            *(GAS v4u*)(WTlo + (size_t)(drow + n) * K + k0 + 8 * c) = q; } }
    LDS_WAIT(); asm volatile("" ::: "memory");
}
__device__ __forceinline__ void p0_prologue(Frame& F) {
    LAS float* scr = (LAS float*)(F.lds + F.wave * 16384);
    const int gw = F.bx * NWAVES + F.wave, NGW = F.G * NWAVES, lane = F.lane;
    constexpr int I_IN = (D / 64) * (INC / 32), I_GLU = (S5W / 64) * (S5W / 32), I_BS5 = (S5W / 64) * (D / 32), I_BHY = (HYW / 64) * (D / 32), I_OUT = (D / 64) * (D / 32);
    constexpr int I_LAYER = I_IN + I_GLU + I_BS5 + I_BHY + I_OUT;
    for (int it = gw; it < DEPTH * I_LAYER; it += NGW) {
        const int l = it / I_LAYER; int r = it % I_LAYER; bf16* wl = (bf16*)(F.ws + WS_W + (size_t)l * W_LAYER);
        if (r < I_IN) { const int nblk = INC / 32, kb = r / nblk, nb = r % nblk, n0 = nb * 32;
            const int drow = (n0 >= 1024 && n0 < 5120) ? n0 - 1024 : (n0 < 1024 ? n0 + 4096 : n0);
            p0_transpose_item(F.inp(2) + (size_t)l * D * INC, D, INC, wl + W_IN / 2, kb * 64, n0, drow, F.inp(1) + l * D, scr, lane); continue; } r -= I_IN;
        if (r < I_GLU) { const int nblk = S5W / 32; p0_transpose_item(F.inp(11) + (size_t)l * S5W * S5W, S5W, S5W, wl + W_GLU / 2, (r / nblk) * 64, (r % nblk) * 32, (r % nblk) * 32, nullptr, scr, lane); continue; } r -= I_GLU;
        if (r < I_BS5) { const int nblk = D / 32; p0_transpose_item(F.inp(23) + (size_t)l * S5W * D, S5W, D, wl + W_BS5 / 2, (r / nblk) * 64, (r % nblk) * 32, (r % nblk) * 32, nullptr, scr, lane); continue; } r -= I_BS5;
        if (r < I_BHY) { const int nblk = D / 32; p0_transpose_item(F.inp(24) + (size_t)l * HYW * D, HYW, D, wl + W_BHY / 2, (r / nblk) * 64, (r % nblk) * 32, (r % nblk) * 32, nullptr, scr, lane); continue; } r -= I_BHY;
        { const int nblk = D / 32; p0_transpose_item(F.inp(25) + (size_t)l * D * D, D, D, wl + W_OUT / 2, (r / nblk) * 64, (r % nblk) * 32, (r % nblk) * 32, nullptr, scr, lane); }
    }
    for (int it = gw; it < DEPTH * (HYF / 32); it += NGW) { const int l = it / (HYF / 32), nb = it % (HYF / 32); bf16* hi = (bf16*)(F.ws + WS_W3T + (size_t)l * MiB);
        p0_transpose_item(F.inp(20) + (size_t)l * HYN * HYF, HYN, HYF, hi, 0, nb * 32, nb * 32, nullptr, scr, lane, hi + (size_t)HYF * HYN); }
    { bf16* X = (bf16*)(F.ws + WS_X); float* ssq = (float*)(F.ws + WS_SSQ);
      for (int m = gw; m < M; m += NGW) { const GAS f32x4* xr = (const GAS f32x4*)(F.inp(0) + (size_t)m * D) + lane; f32x4 v[4]; float s = 0.f;
#pragma unroll
        for (int j = 0; j < 4; ++j) { v[j] = xr[64 * j]; s += (v[j].x * v[j].x + v[j].y * v[j].y) + (v[j].z * v[j].z + v[j].w * v[j].w); }
        s = wave_sum(s);
        GAS unsigned long long* o8 = (GAS unsigned long long*)(X + (size_t)m * D) + lane;
#pragma unroll
        for (int j = 0; j < 4; ++j) o8[64 * j] = (unsigned long long)pk2(v[j].x, v[j].y) | ((unsigned long long)pk2(v[j].z, v[j].w) << 32);
        if (lane < 16) ssq[(size_t)m * 16 + lane] = lane == 0 ? s : 0.f; } }
    {
      for (int it = gw; it < DEPTH * SEQ; it += NGW) { const int l = it / SEQ, t = it % SEQ, j = lane;
        const float* w1 = F.inp(15) + (size_t)l * HYE * HYN; const float* b1 = F.inp(16) + l * HYN; const float* fr = F.inp(17) + l * HYN; const float* w2 = F.inp(18) + (size_t)l * HYN * HYN; const float* b2 = F.inp(19) + l * HYN;
        float f = 0.f;
        if (j == 0) f = (float)t / (float)(SEQ - 1);
        else if (j < 33) { const int bi = (j - 1) & 15; const float band = 1e-4f + (float)bi * ((15.f - 1e-4f) / 15.f); const float ang = band * (float)t * (float)(2.0 * 3.14159265358979323846 / SEQ); f = j < 17 ? cosf(ang) : -sinf(ang); }
        float a = b1[j];
        for (int i = 0; i < HYE; ++i) a += __shfl(f, i) * w1[i * HYN + j];
        const float h1 = sinf(fr[j] * a);
        float c = b2[j];
        for (int i = 0; i < HYN; ++i) c += __shfl(h1, i) * w2[i * HYN + j];
        const float hv = sinf(fr[j] * c); const unsigned hh = f2bf(hv);
        bf16* H2H = (bf16*)(F.ws + WS_H2 + (size_t)l * 512 * 1024);
        H2H[(size_t)t * HYN + j] = (bf16)hh; H2H[(size_t)SEQ * HYN + (size_t)t * HYN + j] = (bf16)f2bf(hv - __uint_as_float(hh << 16)); } }
    { float* LB = (float*)(F.ws + WS_LBAR); bf16* BBT = (bf16*)(F.ws + WS_BBT); bf16* CT = (bf16*)(F.ws + WS_CT);
      for (int q = gw; q < DEPTH * 2 * S5G; q += NGW) { const int p = lane; const int i = q * S5P + p;
        const float dt = expf(F.inp(5)[q]); const float lr = F.inp(3)[i], li = F.inp(4)[i]; const float mag = expf(lr * dt), ang = li * dt;
        const float br = mag * cosf(ang), bi = mag * sinf(ang); LB[2 * i] = br; LB[2 * i + 1] = bi;
        const float nr = br - 1.f, ni = bi, den = lr * lr + li * li; const float kr = (nr * lr + ni * li) / den, ki = (ni * lr - nr * li) / den;
        const float* bre = F.inp(6) + (size_t)i * S5H; const float* bim = F.inp(7) + (size_t)i * S5H;
        bf16* rowr = BBT + ((size_t)q * 128 + 2 * p) * 16; bf16* rowi = rowr + 16;
        for (int h = 0; h < S5H; ++h) { const float xr = bre[h], xi = bim[h]; rowr[h] = (bf16)f2bf(kr * xr - ki * xi); rowi[h] = (bf16)f2bf(kr * xi + ki * xr); }
        const float* cre = F.inp(8) + (size_t)q * S5H * S5P; const float* cim = F.inp(9) + (size_t)q * S5H * S5P;
        for (int h = 0; h < S5H; ++h) { *(unsigned*)(CT + ((size_t)q * 16 + h) * 128 + 2 * p) = pk2(cre[h * S5P + p], -cim[h * S5P + p]); } } }
}

constexpr int S5_YB = 0, S5_CH = 65536, S5_CHB = 8448, S5_SEND = S5_CH + 8 * S5_CHB;
__device__ __forceinline__ float gelu_tanh_fast(float x) {
    const float z = 0.7978845608028654f * (x + 0.044715f * x * x * x);
    const float e = __builtin_amdgcn_exp2f(2.0f * 1.4426950408889634f * z);
    const float th = 1.0f - 2.0f * __builtin_amdgcn_rcpf(e + 1.0f);
    return 0.5f * x * (1.0f + th);
}
template <int DIR, bool EMIT>
__device__ __forceinline__ void s5_pass(Frame& F, const bf16* Ub  , int tlo  , float ar, float ai, float& sr, float& si,
                                        const bf16x8 (&bbf)[8], const bf16x8 (&ctf)[4], const bf16x8& ddf, LAS unsigned char* ch, LAS unsigned char* yb, bf16* YGb) {
    const int lane = F.lane, fr = lane & 15, fq = lane >> 4;
    bf16x8 uf, ufn;
    auto load_u = [&](int tc0) -> bf16x8 { bf16x8 z = {0, 0, 0, 0, 0, 0, 0, 0}; if (fq < 2) z = *(const bf16x8*)(Ub + (size_t)(tc0 + fr) * 1024 + 8 * fq); return z; };
    uf = load_u(DIR ? tlo + 240 : tlo);
#pragma unroll 1
    for (int ci = 0; ci < 16; ++ci) {
        const int tc0 = DIR ? tlo + 16 * (15 - ci) : tlo + 16 * ci;
        if (ci < 15) ufn = load_u(DIR ? tc0 - 16 : tc0 + 16);
        LAS float* bu = (LAS float*)ch;
#pragma unroll
        for (int j = 0; j < 8; ++j) { f32x4 a = {0.f, 0.f, 0.f, 0.f}; a = __builtin_amdgcn_mfma_f32_16x16x32_bf16(bbf[j], uf, a, 0, 0, 0);
            *(LAS f32x4*)(bu + fr * 132 + 16 * j + 4 * fq) = a; }
        LDS_WAIT();
        f32x2 x[16];
#pragma unroll
        for (int tt = 0; tt < 16; ++tt) x[tt] = *(const LAS f32x2*)(bu + tt * 132 + 2 * lane);
        LDS_WAIT();
        unsigned spk[16];
#pragma unroll
        for (int i = 0; i < 16; ++i) { const int tt = DIR ? 15 - i : i;
            const float nr = ar * sr - ai * si + x[tt].x, ni = ar * si + ai * sr + x[tt].y; sr = nr; si = ni;
            if (EMIT) spk[tt] = pg8::cvt_pk_bf16(nr, ni); }
        if (EMIT) {
            LAS unsigned* sb = (LAS unsigned*)ch;
#pragma unroll
            for (int tt = 0; tt < 16; ++tt) sb[tt * 68 + lane] = spk[tt];
            LDS_WAIT();
            f32x4 y = {0.f, 0.f, 0.f, 0.f};
#pragma unroll
            for (int ks = 0; ks < 4; ++ks) { const bf16x8 sf = *(const LAS bf16x8*)(ch + fr * 272 + ks * 64 + fq * 16); y = __builtin_amdgcn_mfma_f32_16x16x32_bf16(ctf[ks], sf, y, 0, 0, 0); }
            LDS_WAIT();
            LAS v2u* ybp = (LAS v2u*)(yb + (size_t)(tc0 + fr) * 32 + 8 * fq);
            if (DIR == 0) { v2u w; w.x = pg8::cvt_pk_bf16(y[0], y[1]); w.y = pg8::cvt_pk_bf16(y[2], y[3]); *ybp = w; }
            else { y = __builtin_amdgcn_mfma_f32_16x16x32_bf16(ddf, uf, y, 0, 0, 0);
                const v2u f = *ybp; const float o0 = gelu_tanh_fast(y[0] + bf_lo(f.x)), o1 = gelu_tanh_fast(y[1] + bf_hi(f.x)), o2 = gelu_tanh_fast(y[2] + bf_lo(f.y)), o3 = gelu_tanh_fast(y[3] + bf_hi(f.y));
                v2u w; w.x = pg8::cvt_pk_bf16(o0, o1); w.y = pg8::cvt_pk_bf16(o2, o3);
                *(v2u*)(YGb + (size_t)(tc0 + fr) * 1024 + 4 * fq) = w; }
        }
        uf = ufn;
    }
}
__device__ __forceinline__ void s5_item(Frame& F, int l, int b, int g, bool dry = false) {
    const int lane = F.lane, fr = lane & 15, fq = lane >> 4, seg = F.wave;
    bf16* U = (bf16*)(F.ws + WS_R5) + (size_t)b * SEQ * 1024 + g * 16;
    LAS unsigned char* ch = F.lds + S5_CH + seg * S5_CHB; LAS unsigned char* yb = F.lds + S5_YB;
    LAS f32x2* send = (LAS f32x2*)(F.lds + S5_SEND);
#pragma unroll 1
    for (int dir = 0; dir < 2; ++dir) {
        const int q = (l * 2 + dir) * S5G + g;
        const float ar = ((const float*)(F.ws + WS_LBAR))[(size_t)(q * S5P + lane) * 2], ai = ((const float*)(F.ws + WS_LBAR))[(size_t)(q * S5P + lane) * 2 + 1];
        bf16x8 bbf[8], ctf[4], ddf; const bf16x8 zero8 = {0, 0, 0, 0, 0, 0, 0, 0};
        const bf16* BBT = (const bf16*)(F.ws + WS_BBT) + (size_t)q * 128 * 16; const bf16* CT = (const bf16*)(F.ws + WS_CT) + (size_t)q * 16 * 128;
#pragma unroll
        for (int j = 0; j < 8; ++j) bbf[j] = fq < 2 ? *(const bf16x8*)(BBT + (16 * j + fr) * 16 + 8 * fq) : zero8;
#pragma unroll
        for (int ks = 0; ks < 4; ++ks) ctf[ks] = *(const bf16x8*)(CT + fr * 128 + 32 * ks + 8 * fq);
        { const short dv = (short)f2bf(F.inp(10)[l * S5W + g * 16 + fr]); ddf = zero8;
#pragma unroll
          for (int jj = 0; jj < 8; ++jj) if (8 * fq + jj == fr) ddf[jj] = dv; }
        const int tlo = dir ? SEQ - 256 * (seg + 1) : 256 * seg;
        float sr = 0.f, si = 0.f;
        if (dir == 0) s5_pass<0, false>(F, U, tlo, ar, ai, sr, si, bbf, ctf, ddf, ch, yb, U); else s5_pass<1, false>(F, U, tlo, ar, ai, sr, si, bbf, ctf, ddf, ch, yb, U);
        send[seg * 64 + lane] = (f32x2){sr, si};
        LDS_WAIT(); __syncthreads();
        float pr = ar, pi = ai;
#pragma unroll
        for (int k = 0; k < 8; ++k) { const float nr = pr * pr - pi * pi, ni = 2.f * pr * pi; pr = nr; pi = ni; }
        sr = 0.f; si = 0.f;
        for (int k = 0; k < seg; ++k) { const f32x2 e = send[k * 64 + lane]; const float nr = pr * sr - pi * si + e.x, ni = pr * si + pi * sr + e.y; sr = nr; si = ni; }
        bf16* YGo = dry ? (bf16*)(F.ws + WS_R6) + (size_t)(b & 1) * SEQ * 1024 + g * 16 : U;
        if (dir == 0) s5_pass<0, true>(F, U, tlo, ar, ai, sr, si, bbf, ctf, ddf, ch, yb, YGo); else s5_pass<1, true>(F, U, tlo, ar, ai, sr, si, bbf, ctf, ddf, ch, yb, YGo);
        LDS_WAIT(); __syncthreads();
    }
}

constexpr int HY_WX = 0, HY_WXB = 8704, HY_KF = 8 * HY_WXB, HY_KFO = 33 * 64 * 8, HY_KFCH = 2 * HY_KFO, HY_RED = HY_KF + 2 * HY_KFCH, HY_RAWROW = 4128;
static_assert(HY_RED + 256 <= LDSCTL_OFF && 4 * 2048 * 4 <= HY_KFCH && 2 * HY_RAWROW <= HY_WXB, "hyena LDS map");
#define C64_LIST 1.000000000e+00f, 9.951847267e-01f, 9.807852804e-01f, 9.569403357e-01f, 9.238795325e-01f, 8.819212643e-01f, 8.314696123e-01f, 7.730104534e-01f, 7.071067812e-01f, 6.343932842e-01f, 5.555702330e-01f, 4.713967368e-01f, 3.826834324e-01f, 2.902846773e-01f, 1.950903220e-01f, 9.801714033e-02f, 0.0f, -9.801714033e-02f, -1.950903220e-01f, -2.902846773e-01f, -3.826834324e-01f, -4.713967368e-01f, -5.555702330e-01f, -6.343932842e-01f, -7.071067812e-01f, -7.730104534e-01f, -8.314696123e-01f, -8.819212643e-01f, -9.238795325e-01f, -9.569403357e-01f, -9.807852804e-01f, -9.951847267e-01f, -1.000000000e+00f, -9.951847267e-01f, -9.807852804e-01f, -9.569403357e-01f, -9.238795325e-01f, -8.819212643e-01f, -8.314696123e-01f, -7.730104534e-01f, -7.071067812e-01f, -6.343932842e-01f, -5.555702330e-01f, -4.713967368e-01f, -3.826834324e-01f, -2.902846773e-01f, -1.950903220e-01f, -9.801714033e-02f, 0.0f, 9.801714033e-02f, 1.950903220e-01f, 2.902846773e-01f, 3.826834324e-01f, 4.713967368e-01f, 5.555702330e-01f, 6.343932842e-01f, 7.071067812e-01f, 7.730104534e-01f, 8.314696123e-01f, 8.819212643e-01f, 9.238795325e-01f, 9.569403357e-01f, 9.807852804e-01f, 9.951847267e-01f
__host__ __device__ constexpr int rev6(int s) { return ((s >> 4) & 3) | (s & 12) | ((s & 3) << 4); }

template <bool INV> __device__ __forceinline__ void r4(float& x0r, float& x0i, float& x1r, float& x1i, float& x2r, float& x2i, float& x3r, float& x3i) {
    const float t0r = x0r + x2r, t0i = x0i + x2i, t1r = x0r - x2r, t1i = x0i - x2i, t2r = x1r + x3r, t2i = x1i + x3i, t3r = x1r - x3r, t3i = x1i - x3i;
    x0r = t0r + t2r; x0i = t0i + t2i; x2r = t0r - t2r; x2i = t0i - t2i;
    if (!INV) { x1r = t1r + t3i; x1i = t1i - t3r; x3r = t1r - t3i; x3i = t1i + t3r; }
    else      { x1r = t1r - t3i; x1i = t1i + t3r; x3r = t1r + t3i; x3i = t1i - t3r; }
}
constexpr float C64T[64] = { C64_LIST };
template <int... Is, class Fn> __device__ __forceinline__ void static_for_impl(std::integer_sequence<int, Is...>, Fn&& f) { (f(std::integral_constant<int, Is>{}), ...); }
template <int N, class Fn> __device__ __forceinline__ void static_for(Fn&& f) { static_for_impl(std::make_integer_sequence<int, N>{}, f); }
template <bool INV, int E> __device__ __forceinline__ void twc(float& xr, float& xi) {
    constexpr int e = E & 63;
    if constexpr (e == 0) { return; }
    else if constexpr (e == 16) { const float tr = xr, ti = xi; if (!INV) { xr = ti; xi = -tr; } else { xr = -ti; xi = tr; } }
    else if constexpr (e == 32) { xr = -xr; xi = -xi; }
    else if constexpr (e == 48) { const float tr = xr, ti = xi; if (!INV) { xr = -ti; xi = tr; } else { xr = ti; xi = -tr; } }
    else {
        constexpr float c = C64T[e], sn = C64T[(e + 48) & 63], wi = INV ? sn : -sn;
        constexpr unsigned cb = __builtin_bit_cast(unsigned, c), wb = __builtin_bit_cast(unsigned, wi), nwb = wb ^ 0x80000000u;
        const float tr = xr, ti = xi; float a, b;
        asm("v_mul_f32 %0, %1, %2" : "=v"(a) : "i"(cb), "v"(tr));
        asm("v_fmac_f32 %0, %1, %2" : "+v"(a) : "i"(nwb), "v"(ti));
        asm("v_mul_f32 %0, %1, %2" : "=v"(b) : "i"(wb), "v"(tr));
        asm("v_fmac_f32 %0, %1, %2" : "+v"(b) : "i"(cb), "v"(ti));
        xr = a; xi = b;
    }
}
#define SFOR(N, I, ...) static_for<N>([&](auto I##_) __attribute__((always_inline)) { constexpr int I = decltype(I##_)::value; __VA_ARGS__ })
template <bool INV> __device__ __forceinline__ void dft64(float (&re)[64], float (&im)[64]) {
    if constexpr (!INV) {
        SFOR(16, bc, r4<false>(re[bc], im[bc], re[bc + 16], im[bc + 16], re[bc + 32], im[bc + 32], re[bc + 48], im[bc + 48]););
        SFOR(48, i, constexpr int p = 1 + i / 16; constexpr int bc = i % 16; twc<false, bc * p>(re[16 * p + bc], im[16 * p + bc]););
        __builtin_amdgcn_sched_barrier(0);
        SFOR(16, i, constexpr int s = 16 * (i / 4) + (i % 4); r4<false>(re[s], im[s], re[s + 4], im[s + 4], re[s + 8], im[s + 8], re[s + 12], im[s + 12]););
        SFOR(64, i, constexpr int q = (i >> 2) & 3; constexpr int c = i & 3; twc<false, 4 * c * q>(re[i], im[i]););
        __builtin_amdgcn_sched_barrier(0);
        SFOR(16, pq, constexpr int s = 4 * pq; r4<false>(re[s], im[s], re[s + 1], im[s + 1], re[s + 2], im[s + 2], re[s + 3], im[s + 3]););
    } else {
        SFOR(16, pq, constexpr int s = 4 * pq; r4<true>(re[s], im[s], re[s + 1], im[s + 1], re[s + 2], im[s + 2], re[s + 3], im[s + 3]););
        SFOR(64, i, constexpr int q = (i >> 2) & 3; constexpr int c = i & 3; twc<true, 4 * c * q>(re[i], im[i]););
        __builtin_amdgcn_sched_barrier(0);
        SFOR(16, i, constexpr int s = 16 * (i / 4) + (i % 4); r4<true>(re[s], im[s], re[s + 4], im[s + 4], re[s + 8], im[s + 8], re[s + 12], im[s + 12]););
        SFOR(48, i, constexpr int p = 1 + i / 16; constexpr int bc = i % 16; twc<true, bc * p>(re[16 * p + bc], im[16 * p + bc]););
        __builtin_amdgcn_sched_barrier(0);
        SFOR(16, bc, r4<true>(re[bc], im[bc], re[bc + 16], im[bc + 16], re[bc + 32], im[bc + 32], re[bc + 48], im[bc + 48]););
    }
    __builtin_amdgcn_sched_barrier(0);
}
__device__ __forceinline__ void wtrans(float (&v)[64], LAS float* wx, int lane) {
#pragma unroll
    for (int i = 0; i < 32; ++i) { const auto r = __builtin_amdgcn_permlane32_swap(__float_as_uint(v[i]), __float_as_uint(v[32 + i]), false, false); v[i] = __uint_as_float(r[0]); v[32 + i] = __uint_as_float(r[1]); }
    __builtin_amdgcn_sched_barrier(0);
    const int rd = (lane & 31) * 68 + (lane >> 5) * 32;
#pragma unroll
    for (int step = 0; step < 2; ++step) {
        asm volatile("" ::: "memory");
#pragma unroll
        for (int i = 0; i < 32; ++i) wx[i * 68 + lane] = v[32 * step + i];
        asm volatile("" ::: "memory");
#pragma unroll
        for (int i4 = 0; i4 < 8; ++i4) { const f32x4 q = *(const LAS f32x4*)(wx + rd + 4 * i4);
#pragma unroll
            for (int e = 0; e < 4; ++e) v[32 * step + 4 * i4 + e] = q[e]; }
        asm volatile("" ::: "memory");
    }
}
__device__ __forceinline__ void wfft_fwd(float (&re)[64], float (&im)[64], LAS float* wx, int lane) {
    dft64<false>(re, im);
    { float f = (float)lane * (1.0f / 4096.0f); asm volatile("" : "+v"(f));
#pragma unroll
      for (int s = 1; s < 64; ++s) { const float a = (float)rev6(s) * f; const float c = __builtin_amdgcn_cosf(a), sn = __builtin_amdgcn_sinf(a);
          const float tr = re[s] * c + im[s] * sn, ti = im[s] * c - re[s] * sn; re[s] = tr; im[s] = ti; if ((s & 7) == 7) __builtin_amdgcn_sched_barrier(0); } }
    __builtin_amdgcn_sched_barrier(0);
    wtrans(re, wx, lane); wtrans(im, wx, lane);
    __builtin_amdgcn_sched_barrier(0);
    dft64<false>(re, im);
}
__device__ __forceinline__ void wfft_inv(float (&re)[64], float (&im)[64], LAS float* wx, int lane) {
    dft64<true>(re, im);
    { float f = (float)rev6(lane) * (1.0f / 4096.0f); asm volatile("" : "+v"(f));
#pragma unroll
      for (int s = 1; s < 64; ++s) { const float a = (float)s * f; const float c = __builtin_amdgcn_cosf(a), sn = __builtin_amdgcn_sinf(a);
          const float tr = re[s] * c - im[s] * sn, ti = im[s] * c + re[s] * sn; re[s] = tr; im[s] = ti; if ((s & 7) == 7) __builtin_amdgcn_sched_barrier(0); } }
    __builtin_amdgcn_sched_barrier(0);
    wtrans(re, wx, lane); wtrans(im, wx, lane);
    __builtin_amdgcn_sched_barrier(0);
    dft64<true>(re, im);
}
struct Stage2 { v4u a[4], b[4]; };
__device__ __forceinline__ void hy_load2a(Stage2& S, const bf16* row0, int lane) {
#pragma unroll
    for (int i = 0; i < 4; ++i) { const int q = lane + 64 * i; S.a[i] = *(const GAS v4u*)(row0 + 8 * q); }
}
__device__ __forceinline__ void hy_load2b(Stage2& S, const bf16* row0, int lane) {
#pragma unroll
    for (int i = 0; i < 4; ++i) { const int q = lane + 64 * i; S.b[i] = *(const GAS v4u*)(row0 + SEQ + 8 * q); }
}
__device__ __forceinline__ void hy_load2(Stage2& S, const bf16* row0, int lane) { hy_load2a(S, row0, lane); hy_load2b(S, row0, lane); }
__device__ __forceinline__ void hy_commit2(const Stage2& S, LAS unsigned char* wxb, int lane) {
    asm volatile("" ::: "memory");
#pragma unroll
    for (int i = 0; i < 4; ++i) { const int q = lane + 64 * i; *(LAS v4u*)(wxb + 16 + 16 * q) = S.a[i]; *(LAS v4u*)(wxb + HY_RAWROW + 16 + 16 * q) = S.b[i]; }
    if (lane < 4) { LAS unsigned short* row = (LAS unsigned short*)(wxb + (lane >> 1) * HY_RAWROW); row[(lane & 1) ? 8 + SEQ : 7] = 0; }
    asm volatile("" ::: "memory");
}
__device__ __forceinline__ float raw2(LAS unsigned char* wxb, int r, int t) { return bf2f(*(const LAS unsigned short*)(wxb + r * HY_RAWROW + 16 + 2 * t)); }
__device__ __forceinline__ unsigned hilo_pack(float x0, float x1, unsigned& lo) {
    const unsigned h0 = f2bf(x0), h1 = f2bf(x1); lo = f2bf(x0 - __uint_as_float(h0 << 16)) | (f2bf(x1 - __uint_as_float(h1 << 16)) << 16); return h0 | (h1 << 16);
}
__device__ __forceinline__ void hy_filter_gen4(Frame& F, int l, int c0, LAS unsigned char* kf0, float* tap2, LAS float* red) {
    int lane_ = F.lane; asm volatile("" : "+v"(lane_)); const int lane = lane_; const int fr = lane & 15, fq = lane >> 4, w = F.wave;
    const float* dec = F.inp(21) + (size_t)l * HYF;
    const bf16* H2H = (const bf16*)(F.ws + WS_H2 + (size_t)l * 512 * 1024); const bf16* H2L = H2H + SEQ * HYN;
    bf16x8 ah[2], al[2];
    { const int ch = c0 + (F.G) * (fr >> 2), f4 = fr & 3, col = (f4 >> 1) * 2 * HYW + (f4 & 1) * HYW + ch;
      const bf16* whi = (const bf16*)(F.ws + WS_W3T + (size_t)l * MiB) + (size_t)col * HYN; const bf16* wlo = whi + (size_t)HYF * HYN;
#pragma unroll
      for (int ks = 0; ks < 2; ++ks) { ah[ks] = *(const bf16x8*)(whi + 32 * ks + 8 * fq); al[ks] = *(const bf16x8*)(wlo + 32 * ks + 8 * fq); } }
    float dk[4];
#pragma unroll
    for (int r = 0; r < 4; ++r) dk[r] = fabsf(dec[(r >> 1) * 2 * HYW + (r & 1) * HYW + c0 + F.G * fq]);
    LAS float* stg = (LAS float*)(kf0 + (fq & 1) * HY_KFCH); float* tg = tap2 + (size_t)(fq & 1) * 4 * SEQ;
    float ss0 = 0.f, ss1 = 0.f;
#pragma unroll 1
    for (int tb = 0; tb < 2; ++tb) {
        bf16x8 bh[8][2], bl[8][2];
#pragma unroll
        for (int u = 0; u < 8; ++u)
#pragma unroll
            for (int ks = 0; ks < 2; ++ks) { const size_t off = (size_t)(256 * w + 128 * tb + 16 * u + fr) * HYN + 32 * ks + 8 * fq; bh[u][ks] = *(const bf16x8*)(H2H + off); bl[u][ks] = *(const bf16x8*)(H2L + off); }
#pragma unroll
        for (int u = 0; u < 8; ++u) { const int t = 256 * w + 128 * tb + 16 * u + fr; f32x4 acc = {0.f, 0.f, 0.f, 0.f};
#pragma unroll
            for (int ks = 0; ks < 2; ++ks) { acc = __builtin_amdgcn_mfma_f32_16x16x32_bf16(ah[ks], bh[u][ks], acc, 0, 0, 0); acc = __builtin_amdgcn_mfma_f32_16x16x32_bf16(ah[ks], bl[u][ks], acc, 0, 0, 0); acc = __builtin_amdgcn_mfma_f32_16x16x32_bf16(al[ks], bh[u][ks], acc, 0, 0, 0); }
            const float tn = (float)t * (1.0f / (float)(SEQ - 1));
#pragma unroll
            for (int r = 0; r < 4; ++r) { const float v = acc[r] * (__expf(-tn * dk[r]) + 0.05f);
                if (fq < 2) stg[r * SEQ + t] = v; else tg[(size_t)r * SEQ + t] = v;
                const float sq = ((r & 1) && t == 0) ? 0.f : v * v; if (r < 2) ss0 += sq; else ss1 += sq; } }
    }
#pragma unroll
    for (int o = 1; o < 16; o <<= 1) { ss0 += __shfl_xor(ss0, o); ss1 += __shfl_xor(ss1, o); }
    if (fr == 0) { red[2 * fq] = ss0; red[2 * fq + 1] = ss1; }
}
__device__ __forceinline__ void hy_filter_fft(Frame& F, int l, int c, LAS unsigned char* kfch, const LAS float* red4, LAS float* wx) {
    int lane_ = F.lane; asm volatile("" : "+v"(lane_)); const int lane = lane_; const LAS float* stg = (const LAS float*)kfch;
    float re[64], im[64];
#pragma unroll
    for (int n1 = 0; n1 < 32; ++n1) { re[n1] = stg[64 * n1 + lane]; im[n1] = stg[2 * SEQ + 64 * n1 + lane]; }
#pragma unroll
    for (int n1 = 32; n1 < 64; ++n1) { const int t = 64 * (64 - n1) - lane; float a = stg[SEQ + t], b = stg[3 * SEQ + t]; if (n1 == 32 && lane == 0) { a = 0.f; b = 0.f; } re[n1] = a; im[n1] = b; }
    float s0 = 0.f, s1 = 0.f;
#pragma unroll
    for (int w = 0; w < 8; ++w) { s0 += red4[8 * w]; s1 += red4[8 * w + 1]; }
    const float sc = 1.0f / 4096.0f; const float n0 = 0.5f * sc / sqrtf(s0 + 1e-6f), n1s = 0.5f * sc / sqrtf(s1 + 1e-6f);
    const float d0 = F.inp(22)[(size_t)l * 2 * HYW + c] * sc, d1 = F.inp(22)[(size_t)l * 2 * HYW + HYW + c] * sc;
    asm volatile("s_waitcnt lgkmcnt(0)" ::: "memory");
    wfft_fwd(re, im, wx, lane);
    const int k1 = rev6(lane), lc = rev6((64 - k1) & 63);
    LAS f32x2* kf0 = (LAS f32x2*)kfch + k1; LAS f32x2* kf1 = (LAS f32x2*)(kfch + HY_KFO) + k1;
#pragma unroll
    for (int k0 = 0; k0 <= 32; ++k0) { const int s = rev6(k0), sm = rev6(63 - k0), sz = rev6((64 - k0) & 63);
        float pr = __shfl(re[sm], lc), pi = __shfl(im[sm], lc); if (lane == 0) { pr = re[sz]; pi = im[sz]; }
        const float zr = re[s], zi = im[s];
        kf0[k0 * 64] = (f32x2){(zr + pr) * n0 + d0, (zi - pi) * n0};
        kf1[k0 * 64] = (f32x2){(zi + pi) * n1s + d1, -(zr - pr) * n1s}; if ((k0 & 3) == 3) __builtin_amdgcn_sched_barrier(0); }
}
__device__ __forceinline__ void hy_wave_main(Frame& F, int l, int c, int ws, LAS unsigned char* wxb, LAS unsigned char* kfch, Stage2& pre, bool dry = false) {
    int lane_ = F.lane; asm volatile("" : "+v"(lane_)); const int lane = lane_; LAS float* wx = (LAS float*)wxb;
    const size_t rowoff = (size_t)c * M + (size_t)(2 * ws) * SEQ;
    const bf16* PV = (const bf16*)(F.ws + WS_R1) + rowoff; const bf16* PX1 = (const bf16*)(F.ws + WS_R2) + rowoff; const bf16* PX2 = (const bf16*)(F.ws + WS_R3) + rowoff;
    const bf16* GH = (const bf16*)(F.ws + WS_R4) + rowoff; bf16* OUT = (bf16*)(F.ws + WS_R1) + rowoff;
    const float* cw = F.inp(13) + (size_t)l * 3 * 3 * HYW; const float* cb = F.inp(14) + (size_t)l * 3 * HYW;
    float re[64], im[64];
    hy_commit2(pre, wxb, lane);
    hy_load2a(pre, PX1, lane);
    { const float w0 = cw[c], w1 = cw[3 * HYW + c], w2 = cw[6 * HYW + c], b = cb[c];
#pragma unroll
      for (int n1 = 0; n1 < 32; ++n1) { const int t = 64 * n1 + lane;
          re[n1] = b + w0 * raw2(wxb, 0, t - 1) + w1 * raw2(wxb, 0, t) + w2 * raw2(wxb, 0, t + 1);
          im[n1] = b + w0 * raw2(wxb, 1, t - 1) + w1 * raw2(wxb, 1, t) + w2 * raw2(wxb, 1, t + 1); if ((n1 & 3) == 3) __builtin_amdgcn_sched_barrier(0); } }
#pragma unroll 1
    for (int o = 0; o < 2; ++o) {
        int lane_o = F.lane; asm volatile("" : "+v"(lane_o));
        const int lane = lane_o; const int k1 = rev6(lane);
#pragma unroll
        for (int n1 = 32; n1 < 64; ++n1) { re[n1] = 0.f; im[n1] = 0.f; }
        asm volatile("s_waitcnt lgkmcnt(0)" ::: "memory");
        wfft_fwd(re, im, wx, lane);
        { const LAS unsigned char* bd = kfch + o * HY_KFO + k1 * 8; const LAS unsigned char* bm = kfch + o * HY_KFO + ((k1 ? 0 : 64) + ((64 - k1) & 63)) * 8;
#pragma unroll
          for (int s = 0; s < 64; ++s) { const int k0 = rev6(s);
              if (k0 < 32) { const f32x2 kv = *(const LAS f32x2*)(bd + k0 * 512); const float tr = re[s] * kv.x - im[s] * kv.y, ti = re[s] * kv.y + im[s] * kv.x; re[s] = tr; im[s] = ti; }
              else { const f32x2 kv = *(const LAS f32x2*)(bm + (63 - k0) * 512); const float tr = re[s] * kv.x + im[s] * kv.y, ti = im[s] * kv.x - re[s] * kv.y; re[s] = tr; im[s] = ti; }
              if ((s & 7) == 7) __builtin_amdgcn_sched_barrier(0); } }
        __builtin_amdgcn_sched_barrier(0);
        wfft_inv(re, im, wx, lane);
        hy_load2b(pre, o == 0 ? PX1 : PX2, lane); hy_commit2(pre, wxb, lane);
        { const int xo = (o + 1) * HYW + c; const float w0 = cw[xo], w1 = cw[3 * HYW + xo], w2 = cw[6 * HYW + xo], b = cb[xo];
#pragma unroll
          for (int n1 = 0; n1 < 32; ++n1) { const int t = 64 * n1 + lane;
              const float g0 = b + w0 * raw2(wxb, 0, t - 1) + w1 * raw2(wxb, 0, t) + w2 * raw2(wxb, 0, t + 1);
              const float g1 = b + w0 * raw2(wxb, 1, t - 1) + w1 * raw2(wxb, 1, t) + w2 * raw2(wxb, 1, t + 1);
              re[n1] *= g0; im[n1] *= g1; if ((n1 & 3) == 3) __builtin_amdgcn_sched_barrier(0); } }
        hy_load2a(pre, o == 0 ? PX2 : GH, lane);
    }
    int lane_g = F.lane; asm volatile("" : "+v"(lane_g));
    hy_load2b(pre, GH, lane_g); hy_commit2(pre, wxb, lane_g);
    if (!dry)
#pragma unroll
    for (int n1 = 0; n1 < 32; ++n1) { const int t = 64 * n1 + lane_g; const float g0 = raw2(wxb, 0, t), g1 = raw2(wxb, 1, t);
        OUT[t] = (bf16)f2bf(re[n1] * g0 * fast_sigmoid(g0)); OUT[SEQ + t] = (bf16)f2bf(im[n1] * g1 * fast_sigmoid(g1)); if ((n1 & 3) == 3) __builtin_amdgcn_sched_barrier(0); }
    asm volatile("s_waitcnt lgkmcnt(0)" ::: "memory");
}
__device__ __forceinline__ void hy_quad(Frame& F, int l, int c0) {
    const int grp = F.wave >> 2, ws = F.wave & 3;
    LAS unsigned char* wxb = F.lds + HY_WX + F.wave * HY_WXB;
    LAS unsigned char* kf0 = F.lds + HY_KF; LAS unsigned char* kfch = kf0 + grp * HY_KFCH;
    LAS float* red = (LAS float*)(F.lds + HY_RED);
    float* tap2 = (float*)(F.ws + WS_R6) + (size_t)F.bx * 2 * 4 * SEQ;
    hy_filter_gen4(F, l, c0, kf0, tap2, red + 8 * F.wave);
    VM_WAIT(); LDS_WAIT(); __syncthreads();
#pragma unroll 1
    for (int rnd = 0; rnd < 2; ++rnd) {
        const int c = c0 + F.G * (2 * rnd + grp);
        if (rnd == 1) {
            const int t_ = F.wave * 64 + cur_lane();
#pragma unroll
            for (int i = 0; i < 8; ++i) { const int q = t_ + 512 * i;
                const v4u v = *(const GAS v4u*)(tap2 + 4 * (size_t)q); *(LAS v4u*)(kf0 + (q >> 11) * HY_KFCH + 16 * (q & 2047)) = v; }
            LDS_WAIT(); __syncthreads();
        }
        Stage2 pre;
        if (ws == 0) hy_filter_fft(F, l, c, kfch, red + 2 * (2 * rnd + grp), (LAS float*)wxb);
        hy_load2(pre, (const bf16*)(F.ws + WS_R1) + (size_t)c * M + (size_t)(2 * ws) * SEQ, F.lane);
        LDS_WAIT(); __syncthreads();
        hy_wave_main(F, l, c, ws, wxb, kfch, pre);
        LDS_WAIT(); __syncthreads();
    }
}

__device__ __forceinline__ void transpose_pass(Frame& F) {
    const bf16* src = (const bf16*)(F.ws + WS_R1); bf16* dst = (bf16*)(F.ws + WS_R2);
    LAS unsigned char* tile = F.lds + F.wave * 9216; const int lane = F.lane;
    const int gw = F.bx * NWAVES + F.wave, NGW = F.G * NWAVES;
    constexpr int NTC = HYW / 64, NTT = M / 64;
    for (int it = gw; it < NTC * NTT; it += NGW) { const int c0 = (it % NTC) * 64, t0 = (it / NTC) * 64;
#pragma unroll
        for (int i = 0; i < 8; ++i) { const int q = lane + 64 * i, cr = q >> 3, ch = q & 7;
            const v4u v = *(const GAS v4u*)(src + (size_t)(c0 + cr) * M + t0 + 8 * ch); *(LAS v4u*)(tile + cr * 144 + 16 * ch) = v; }
        LDS_WAIT(); asm volatile("" ::: "memory");
#pragma unroll
        for (int i = 0; i < 8; ++i) { const int q = lane + 64 * i, tr = q >> 3, ch = q & 7;
            unsigned short e[8];
#pragma unroll
            for (int k = 0; k < 8; ++k) e[k] = *(const LAS unsigned short*)(tile + (8 * ch + k) * 144 + 2 * tr);
            v4u o; o.x = e[0] | ((unsigned)e[1] << 16); o.y = e[2] | ((unsigned)e[3] << 16); o.z = e[4] | ((unsigned)e[5] << 16); o.w = e[6] | ((unsigned)e[7] << 16);
            *(GAS v4u*)(dst + (size_t)(t0 + tr) * HYW + c0 + 8 * ch) = o; }
        LDS_WAIT(); asm volatile("" ::: "memory");
    }
}
__device__ __forceinline__ void final_norm(Frame& F) {
    const int gw = F.bx * NWAVES + F.wave, NGW = F.G * NWAVES, lane = F.lane; const GAS f32x4* wv = (const GAS f32x4*)F.inp(26) + lane;
    f32x4 w[4];
#pragma unroll
    for (int j = 0; j < 4; ++j) w[j] = wv[64 * j];
    for (int m = gw; m < M; m += NGW) { GAS f32x4* xr = (GAS f32x4*)(F.out + (size_t)m * D) + lane; f32x4 v[4]; float s = 0.f;
#pragma unroll
        for (int j = 0; j < 4; ++j) { v[j] = xr[64 * j]; s += (v[j].x * v[j].x + v[j].y * v[j].y) + (v[j].z * v[j].z + v[j].w * v[j].w); }
        const float rs = 1.0f / sqrtf(wave_sum(s) * (1.0f / D) + 1e-6f);
#pragma unroll
        for (int j = 0; j < 4; ++j) xr[64 * j] = v[j] * rs * w[j]; }
}

struct Args { const float* in[27]; float* out; unsigned char* ws; int ph_lo, ph_hi; };
__global__ void __launch_bounds__(NTHREADS, 2) mk_fwd(Args args) {
    extern __shared__ __attribute__((aligned(16))) unsigned char lds[];
    Frame F; F.lds = (LAS unsigned char*)lds; F.wave = __builtin_amdgcn_readfirstlane(threadIdx.x >> 6); F.tid = 0; F.lane = 0; F.G = gridDim.x; F.bx = blockIdx.x;
    F.out = args.out; F.ws = args.ws;
    volatile LAS unsigned* MISC = (volatile LAS unsigned*)(F.lds + LDSCTL_OFF);
    if (threadIdx.x < 64) MISC[threadIdx.x] = 0u;
    if (threadIdx.x == 64) { LAS unsigned long long* tab = (LAS unsigned long long*)(F.lds + LDSCTL_OFF + 256);
#pragma unroll
        for (int i = 0; i < 27; ++i) tab[i] = (unsigned long long)args.in[i]; }
    __syncthreads();
    XcdBarrier bar; bar.bar = (unsigned*)(F.ws + WS_CTL) + 1024; bar.x = 0; bar.st = nullptr;
    if (!MK_PER_PHASE) bar = xcd_barrier_post((unsigned*)(F.ws + WS_CTL) + 1024, MISC + 8, threadIdx.x == 0);
    const int lo = args.ph_lo, hi = args.ph_hi;
#define IN(k) (lo <= (k) && (k) < hi)
#if defined(MK_TIMING)
    unsigned long long* TS = (unsigned long long*)(F.ws + WS_CTL + 32768);
#define STAMP(k) do { if (blockIdx.x == 0 && threadIdx.x == 0) __hip_atomic_store(&TS[k], (unsigned long long)__builtin_amdgcn_s_memrealtime(), __ATOMIC_RELAXED, __HIP_MEMORY_SCOPE_AGENT); } while (0)
#else
#define STAMP(k) do { } while (0)
#endif
#define SEAM(k) do { if (IN(k) && IN((k) + 1)) xcd_barrier(bar, F.wave); STAMP((k) + 1); } while (0)
    LAS unsigned char* ring = F.lds;
    STAMP(0);
#ifndef MK_ONLY
#define MK_ONLY -1
#endif
#define ON(k) (MK_ONLY < 0 || MK_ONLY == (k))
#define FRAME_P0(Fp) Frame Fp = F; { int l_ = cur_lane(); asm volatile("" : "+v"(l_)); Fp.lane = l_; Fp.tid = F.wave * 64 + l_; Fp.ws = wsl; }
#ifndef MK_REP0
#define MK_REP0 1
#endif
#pragma unroll 1
    for (int rep0 = 0; rep0 < MK_REP0; ++rep0)
    if (ON(0) && IN(0)) { unsigned char* wsl = F.ws; FRAME_P0(Fp); p0_prologue(Fp); }
    SEAM(0);
#pragma unroll 1
    for (int l = 0; l < DEPTH; ++l) {
        const int pb = 1 + 5 * l;
        unsigned char* wsl = F.ws; asm volatile("" : "+s"(wsl));
#define WSL(off) (wsl + (off))
#define OPQ(p) asm volatile("" : "+s"(p))
#define FRAME_P(Fp) Frame Fp = F; { int l_ = cur_lane(); asm volatile("" : "+v"(l_)); Fp.lane = l_; Fp.tid = F.wave * 64 + l_; Fp.ws = wsl; }
        bf16* wl = (bf16*)WSL(WS_W + (size_t)l * W_LAYER);
        bf16* X = (bf16*)WSL(WS_X); float* ssq = (float*)WSL(WS_SSQ);
        bf16 *R1 = (bf16*)WSL(WS_R1), *R2 = (bf16*)WSL(WS_R2), *R3 = (bf16*)WSL(WS_R3), *R5 = (bf16*)WSL(WS_R5), *R6 = (bf16*)WSL(WS_R6);
#ifndef MK_REP1
#define MK_REP1 1
#define MK_REP12 1
#define MK_REP3 1
#define MK_REP4 1
#endif
#pragma unroll 1
        for (int rep12 = 0; rep12 < MK_REP12; ++rep12) {
#pragma unroll 1
        for (int rep1 = 0; rep1 < MK_REP1; ++rep1)
        if (ON(1) && IN(pb)) {
            { pg8::Gemm g{wl + W_IN / 2, X, 4096, M, D, D, D}; pg8::StaticOrder S; S.init(4096, M, F.G, F.bx); pg8::EpiHT E{R1, M, ssq};
              pg8::gemm_phase<pg8::EpiHT, pg8::StaticOrder, true, true, 1024, 1024, 1024>(ring, g, S, E, F.wave); }
            OPQ(X); OPQ(wl);
            { pg8::Gemm g{X, wl + W_IN / 2 + (size_t)4096 * D, M, 1024, D, D, D}; pg8::StaticOrder S; S.init(M, 1024, F.G, F.bx); pg8::EpiRow<0> E{R5, 1024, ssq};
              pg8::gemm_phase<pg8::EpiRow<0>, pg8::StaticOrder, true, true, 1024, 1024, 1024>(ring, g, S, E, F.wave); }
        }
        SEAM(pb);
        if (IN(pb + 1)) {
#if defined(MK_S5DRY)
            if (ON(2)) { FRAME_P(Fq); for (int it = F.bx; it < BATCH * S5G; it += F.G) s5_item(Fq, l, it / S5G, it % S5G, true); }
#endif
            if (ON(2)) { FRAME_P(Fp); for (int it = F.bx; it < BATCH * S5G; it += F.G) s5_item(Fp, l, it / S5G, it % S5G); }
            if (ON(3)) { FRAME_P(Fp); if (4 * F.G == HYW) hy_quad(Fp, l, F.bx); }
        }
        if (rep12 + 1 < MK_REP12) xcd_barrier(bar, F.wave);
        }
        SEAM(pb + 1);
#pragma unroll 1
        for (int rep3 = 0; rep3 < MK_REP3; ++rep3)
        if (ON(4) && IN(pb + 2)) {
            { pg8::Gemm g{X, wl + W_IN / 2 + (size_t)5120 * D, M, 2048, D, D, D}; pg8::StaticOrder S; S.init(M, 2048, F.G, F.bx); pg8::EpiRow<1> E{R3, 2048, ssq};
              pg8::gemm_phase<pg8::EpiRow<1>, pg8::StaticOrder, true, true, 1024, 1024, 1024>(ring, g, S, E, F.wave); }
            OPQ(R5); OPQ(wl);
            { pg8::Gemm g{R5, wl + W_GLU / 2, M, S5W, S5W, 1024, S5W}; pg8::StaticOrder S; S.init(M, S5W, F.G, F.bx); pg8::EpiGLU E{R6, S5W, R5, 1024, F.inp(12) + l * S5W};
              pg8::gemm_phase<pg8::EpiGLU, pg8::StaticOrder, true, true, 512, 1024, 512>(ring, g, S, E, F.wave); }
            __syncthreads();
            { FRAME_P(Fp); transpose_pass(Fp); }
            __syncthreads();
        }
        SEAM(pb + 2);
#pragma unroll 1
        for (int rep4 = 0; rep4 < MK_REP4; ++rep4)
        if (ON(5) && IN(pb + 3)) {
            { pg8::Gemm g{R6, wl + W_BS5 / 2, M, D, S5W, S5W, S5W}; pg8::StaticOrder S; S.init(M, D, F.G, F.bx); pg8::EpiMerge<0> E{R1, D, R3, 2048, 0};
              pg8::gemm_phase<pg8::EpiMerge<0>, pg8::StaticOrder, true, true, 512, 512, 512>(ring, g, S, E, F.wave); }
            VM_WAIT(); __syncthreads();
            OPQ(R2); OPQ(wl);
            { pg8::Gemm g{R2, wl + W_BHY / 2, M, D, HYW, HYW, HYW}; pg8::StaticOrder S; S.init(M, D, F.G, F.bx); pg8::EpiMerge<1> E{R1, D, R3, 2048, 1024};
              pg8::gemm_phase<pg8::EpiMerge<1>, pg8::StaticOrder, true, true, 1024, 1024, 1024>(ring, g, S, E, F.wave); }
        }
        SEAM(pb + 3);
        if (ON(6) && IN(pb + 4)) {
            pg8::Gemm g{R1, wl + W_OUT / 2, M, D, D, D, D}; pg8::StaticOrder S; S.init(M, D, F.G, F.bx); pg8::EpiOut E{l == 0 ? F.inp(0) : (const float*)F.out, F.out, X, ssq};
            pg8::gemm_phase<pg8::EpiOut, pg8::StaticOrder, true, true, 1024, 1024, 1024>(ring, g, S, E, F.wave);
        }
        SEAM(pb + 4);
    }
    if (ON(7) && IN(11)) { unsigned char* wsl = F.ws; FRAME_P0(Fp); final_norm(Fp); }
#if defined(MK_TIMING)
    xcd_barrier(bar, F.wave); STAMP(12); xcd_barrier(bar, F.wave);
    { const unsigned long long a0 = __hip_atomic_load(&TS[MK_TA0], __ATOMIC_RELAXED, __HIP_MEMORY_SCOPE_AGENT), a1 = __hip_atomic_load(&TS[MK_TA1], __ATOMIC_RELAXED, __HIP_MEMORY_SCOPE_AGENT);
      const unsigned long long b0 = __hip_atomic_load(&TS[MK_TB0], __ATOMIC_RELAXED, __HIP_MEMORY_SCOPE_AGENT), b1 = __hip_atomic_load(&TS[MK_TB1], __ATOMIC_RELAXED, __HIP_MEMORY_SCOPE_AGENT);
      const float ta = (float)(a1 - a0) * 0.01f, tb = (float)(b1 - b0) * 0.01f;
      const float c = sqrtf(ta * 0.1f);
      for (size_t i = (size_t)blockIdx.x * NTHREADS + threadIdx.x; i < (size_t)M * D; i += (size_t)gridDim.x * NTHREADS) F.out[i] = (i == 0) ? tb : c; }
#endif
#undef IN
#undef SEAM
}

#if defined(MK_DEBUG_HASH)
extern "C" void kernel_launch_dbg(void* const* d_in, void* d_out, void* d_ws, hipStream_t stream, int grid);
#endif
extern "C" void kernel_launch(void* const* d_in, const int* in_sizes, int n_in, void* d_out, int out_size, void* d_ws, size_t ws_size, hipStream_t stream) {
    static int grid = 0;
    if (grid == 0) {
        if (n_in != 27 || out_size != M * D || ws_size < WS_END) { fprintf(stderr, "kernel_launch: unexpected shapes (n_in %d out %d ws %zu)\n", n_in, out_size, ws_size); grid = -1; return; }
        int dev = 0, cus = 0, per_cu = 0;
        if (hipGetDevice(&dev) != hipSuccess || hipDeviceGetAttribute(&cus, hipDeviceAttributeMultiprocessorCount, dev) != hipSuccess) { grid = -1; return; }
        if (hipFuncSetAttribute((const void*)mk_fwd, hipFuncAttributeMaxDynamicSharedMemorySize, LDS_BYTES) != hipSuccess) { fprintf(stderr, "kernel_launch: hipFuncSetAttribute failed\n"); grid = -1; return; }
        if (hipOccupancyMaxActiveBlocksPerMultiprocessor(&per_cu, (const void*)mk_fwd, NTHREADS, LDS_BYTES) != hipSuccess || per_cu < 1) fprintf(stderr, "kernel_launch: occupancy query says %d\n", per_cu);
        (void)hipGetLastError();
        grid = cus;
    }
    if (grid < 0) return;
    (void)hipMemsetAsync((char*)d_ws + WS_CTL, 0, CTL_ZERO_BYTES, stream);
    Args a{};
    for (int i = 0; i < 27; ++i) a.in[i] = (const float*)d_in[i];
    a.out = (float*)d_out; a.ws = (unsigned char*)d_ws;
#if defined(MK_DEBUG_HASH)
    kernel_launch_dbg(d_in, d_out, d_ws, stream, grid);
#elif MK_PER_PHASE
    for (int p = 0; p < NPHASE; ++p) { a.ph_lo = p; a.ph_hi = p + 1; hipLaunchKernelGGL(mk_fwd, dim3(grid), dim3(NTHREADS), LDS_BYTES, stream, a); }
#else
    a.ph_lo = 0; a.ph_hi = NPHASE; hipLaunchKernelGGL(mk_fwd, dim3(grid), dim3(NTHREADS), LDS_BYTES, stream, a);
#endif
}

#if defined(MK_DEBUG_HASH)
__global__ void dbg_hash(const unsigned* p, size_t nwords, unsigned long long* out) {
    unsigned long long s = 0; for (size_t i = (size_t)blockIdx.x * blockDim.x + threadIdx.x; i < nwords; i += (size_t)gridDim.x * blockDim.x) s += p[i];
    atomicAdd(out, s);
}
__global__ void dbg_report(const unsigned long long* h, float* out, size_t n) {
    int first = -1; for (int p = 0; p < NPHASE && first < 0; ++p) for (int r = 0; r < 4; ++r) if (h[p * 4 + r] != h[NPHASE * 4 + p * 4 + r]) { first = p; break; }
    const float c = first < 0 ? 0.f : sqrtf((float)(first + 1));
    for (size_t i = (size_t)blockIdx.x * blockDim.x + threadIdx.x; i < n; i += (size_t)gridDim.x * blockDim.x) out[i] = c;
}
extern "C" void kernel_launch_dbg(void* const* d_in, void* d_out, void* d_ws, hipStream_t stream, int grid) {
    Args a{}; for (int i = 0; i < 27; ++i) a.in[i] = (const float*)d_in[i];
    a.out = (float*)d_out; a.ws = (unsigned char*)d_ws;
    unsigned long long* H = (unsigned long long*)((char*)d_ws + 253 * MiB);
    (void)hipMemsetAsync(H, 0, 2 * NPHASE * 4 * 8, stream);
    struct Reg { size_t off, len; bool out; };
    auto regs_of = [&](int p, Reg (&r)[4]) { for (int i = 0; i < 4; ++i) r[i] = Reg{0, 0, false};
        if (p == 0) { r[0] = Reg{1 * MiB, 1 * MiB, false}; r[1] = Reg{2 * MiB, 1 * MiB + 64 * 1024, false}; r[2] = Reg{4 * MiB, 39 * MiB, false}; r[3] = Reg{43 * MiB, 33 * MiB, false}; return; }
        if (p == 11) { r[0] = Reg{0, (size_t)M * D * 4, true}; return; }
        const int q = (p - 1) % 5;
        if (q == 0) { r[0] = Reg{WS_R1, 128 * MiB, false}; r[1] = Reg{WS_R5, 32 * MiB, false}; }
        if (q == 1) { r[0] = Reg{WS_R1, 32 * MiB, false}; r[1] = Reg{WS_R5, 32 * MiB, false}; }
        if (q == 2) { r[0] = Reg{WS_R3, 64 * MiB, false}; r[1] = Reg{WS_R6, 16 * MiB, false}; r[2] = Reg{WS_R2, 32 * MiB, false}; }
        if (q == 3) { r[0] = Reg{WS_R1, 32 * MiB, false}; }
        if (q == 4) { r[0] = Reg{0, (size_t)M * D * 4, true}; r[1] = Reg{WS_X, 32 * MiB, false}; r[2] = Reg{WS_SSQ, 1 * MiB, false}; } };
    for (int run = 0; run < 2; ++run) {
        if (run == 0) (void)hipMemsetAsync((char*)d_ws + 1 * MiB, 0xAA, 251 * MiB, stream);
        (void)hipMemsetAsync((char*)d_ws + WS_CTL, 0, CTL_ZERO_BYTES, stream);
        for (int p = 0; p < NPHASE; ++p) { a.ph_lo = p; a.ph_hi = p + 1; hipLaunchKernelGGL(mk_fwd, dim3(grid), dim3(NTHREADS), LDS_BYTES, stream, a);
            Reg r[4]; regs_of(p, r);
            for (int i = 0; i < 4; ++i) if (r[i].len) hipLaunchKernelGGL(dbg_hash, dim3(1024), dim3(256), 0, stream, (const unsigned*)((r[i].out ? (char*)d_out : (char*)d_ws) + r[i].off), r[i].len / 4, H + (run * NPHASE + p) * 4 + i); }
    }
    hipLaunchKernelGGL(dbg_report, dim3(1024), dim3(256), 0, stream, H, (float*)d_out, (size_t)M * D);
}
#endif
```

```cpp
#include <hip/hip_runtime.h>
#include <cstdio>
#include <cstdint>
#include <cmath>
#include <utility>
namespace pg8 {
#define PG8_LAS __attribute__((address_space(3)))
typedef unsigned short bf16_t;
typedef short bf16x8 __attribute__((ext_vector_type(8)));
typedef float f32x4 __attribute__((ext_vector_type(4)));
typedef unsigned u32x4 __attribute__((ext_vector_type(4)));
constexpr int BM = 256, BK = 64, HALF = 128, HTB = HALF * BK * 2  , STAGE_BYTES = 8 * HTB, NXCD = 8, WGM = 8;

__host__ __device__ __forceinline__ int lds_byte(int r, int c) { const int st = (r >> 4) * 2 + (c >> 5), rr = r & 15, cc = c & 31, ob = rr * 64 + cc * 2; return st * 1024 + (ob ^ (((ob >> 9) & 1) << 5)); }
__host__ __device__ __forceinline__ void stage_rc(int b, int& R, int& C) { const int st = b / 1024, sb = b % 1024, swz = sb ^ (((sb >> 9) & 1) << 5); R = (st >> 1) * 16 + swz / 64; C = (st & 1) * 32 + (swz % 64) / 2; }
__host__ __device__ __forceinline__ int perm32(int rho) { const int n = rho >> 4, i = rho & 15; return 8 * (i >> 2) + 4 * n + (i & 3); }

struct Unit { int pm, pn; };
struct Gemm { const bf16_t* A; const bf16_t* Bt; int M, N, K, lda, ldb; };

struct StaticOrder {
    int nM, nN, nwg, G, c;
    __host__ __device__ void init(int M, int N, int G_, int c_) { nM = M / BM; nN = N / BM; nwg = nM * nN; G = G_; c = c_; }
    __host__ __device__ bool next(int i, Unit& u) const {
        const long L = (long)i * G + c; if (L >= nwg) return false;
        int wgid = (int)L; { const int q = nwg / NXCD, r = nwg % NXCD, xcd = wgid % NXCD, off = wgid / NXCD; wgid = (xcd < r ? xcd * (q + 1) : r * (q + 1) + (xcd - r) * q) + off; }
        const int nig = WGM * nN, gid = wgid / nig, fm = gid * WGM, gsz = (nM - fm) < WGM ? (nM - fm) : WGM;
        u.pm = fm + ((wgid % nig) % gsz); u.pn = (wgid % nig) / gsz; return true;
    }
    __device__ __forceinline__ void a_ready(const Unit&) const {}
    __device__ __forceinline__ void done(const Unit&) const {}
};

typedef unsigned u32x2 __attribute__((ext_vector_type(2)));

typedef __bf16 bf16x2_t __attribute__((ext_vector_type(2)));
typedef float f32x2_t __attribute__((ext_vector_type(2)));
__device__ __forceinline__ unsigned cvt_pk_bf16(float lo, float hi) { const f32x2_t v = {lo, hi}; const bf16x2_t b = __builtin_convertvector(v, bf16x2_t); return __builtin_bit_cast(unsigned, b); }
__device__ __forceinline__ float bf_lo(unsigned w) { return __uint_as_float(w << 16); }
__device__ __forceinline__ float bf_hi(unsigned w) { return __uint_as_float(w & 0xffff0000u); }
__device__ __forceinline__ float fast_sigmoid(float x) { return __builtin_amdgcn_rcpf(1.0f + __builtin_amdgcn_exp2f(-1.4426950408889634f * x)); }
constexpr float RMS_EPS = 1e-6f;
__device__ __forceinline__ float rs_of(const float* ssq, int tok) {
    const f32x4* p = (const f32x4*)(ssq + (size_t)tok * 16); const f32x4 a = p[0], b = p[1], c = p[2], d = p[3];
    const float s = ((a[0] + a[1]) + (a[2] + a[3])) + ((b[0] + b[1]) + (b[2] + b[3])) + ((c[0] + c[1]) + (c[2] + c[3])) + ((d[0] + d[1]) + (d[2] + d[3]));
    return 1.0f / sqrtf(s * (1.0f / 1024.0f) + RMS_EPS);
}
struct EpiHT {
    static constexpr bool PERM = true, AFTER_DRAIN = false;
    bf16_t* O; int ldc; const float* ssq;
    __device__ __forceinline__ void operator()(const f32x4 (&acc)[2][2][4][2], const Unit& u, int wr, int wc, int fr, int fq) const {
        const int lane = (fq << 4) | fr;
        const int ctile = u.pn * BM + wc * 32 + 8 * fq;
        const float mine = rs_of(ssq, ctile + 128 * (fr >> 3) + (fr & 7));
        const int row0 = u.pm * BM + wr * 64 + fr;
#pragma unroll
        for (int bj = 0; bj < 2; ++bj) { float rsv[8];
#pragma unroll
            for (int i = 0; i < 8; ++i) rsv[i] = __shfl(mine, (lane & 48) | (8 * bj + i));
#pragma unroll
            for (int ai = 0; ai < 2; ++ai)
#pragma unroll
                for (int m = 0; m < 4; ++m) { bf16_t* rowp = O + (size_t)(row0 + ai * HALF + m * 16) * ldc + ctile + bj * HALF;
                    const f32x4 v0 = acc[ai][bj][m][0], v1 = acc[ai][bj][m][1]; u32x4 w;
                    w.x = cvt_pk_bf16(v0[0] * rsv[0], v0[1] * rsv[1]); w.y = cvt_pk_bf16(v0[2] * rsv[2], v0[3] * rsv[3]);
                    w.z = cvt_pk_bf16(v1[0] * rsv[4], v1[1] * rsv[5]); w.w = cvt_pk_bf16(v1[2] * rsv[6], v1[3] * rsv[7]);
                    *(u32x4*)rowp = w; }
            asm volatile("" ::: "memory"); }
    }
};
template <int SIG> struct EpiRow {
    static constexpr bool PERM = true, AFTER_DRAIN = false;
    bf16_t* O; int ldc; const float* ssq;
    __device__ __forceinline__ void operator()(const f32x4 (&acc)[2][2][4][2], const Unit& u, int wr, int wc, int fr, int fq) const {
        const int lane = (fq << 4) | fr;
        const int row0 = u.pm * BM + wr * 64 + fr;
        float mine[2];
#pragma unroll
        for (int i = 0; i < 2; ++i) { const int q = 2 * fq + i; mine[i] = rs_of(ssq, row0 + (q >> 2) * HALF + (q & 3) * 16); }
        const int col0 = u.pn * BM + wc * 32 + 8 * fq;
#pragma unroll
        for (int ai = 0; ai < 2; ++ai)
#pragma unroll
            for (int m = 0; m < 4; ++m) { const int q = ai * 4 + m; const float rs = __shfl(mine[q & 1], ((q >> 1) << 4) | (lane & 15));
                bf16_t* rowp = O + (size_t)(row0 + ai * HALF + m * 16) * ldc + col0;
#pragma unroll
                for (int bj = 0; bj < 2; ++bj) { f32x4 v0 = acc[ai][bj][m][0] * rs, v1 = acc[ai][bj][m][1] * rs;
                    if (SIG) {
#pragma unroll
                        for (int e = 0; e < 4; ++e) { v0[e] = fast_sigmoid(v0[e]); v1[e] = fast_sigmoid(v1[e]); } }
                    u32x4 w; w.x = cvt_pk_bf16(v0[0], v0[1]); w.y = cvt_pk_bf16(v0[2], v0[3]); w.z = cvt_pk_bf16(v1[0], v1[1]); w.w = cvt_pk_bf16(v1[2], v1[3]);
                    *(u32x4*)(rowp + bj * HALF) = w; }
                asm volatile("" ::: "memory"); }
    }
};
struct EpiGLU {
    static constexpr bool PERM = true, AFTER_DRAIN = false;
    bf16_t* O; int ldc; const bf16_t* YG; int ldy; const float* bglu;
    __device__ __forceinline__ void operator()(const f32x4 (&acc)[2][2][4][2], const Unit& u, int wr, int wc, int fr, int fq) const {
        const int row0 = u.pm * BM + wr * 64 + fr, col0 = u.pn * BM + wc * 32 + 8 * fq;
        f32x4 bv[2][2];
#pragma unroll
        for (int bj = 0; bj < 2; ++bj)
#pragma unroll
            for (int n = 0; n < 2; ++n) bv[bj][n] = *(const f32x4*)(bglu + col0 + bj * HALF + 4 * n);
#pragma unroll
        for (int ai = 0; ai < 2; ++ai)
#pragma unroll
            for (int m = 0; m < 4; ++m) { const size_t r = (size_t)(row0 + ai * HALF + m * 16);
#pragma unroll
                for (int bj = 0; bj < 2; ++bj) { const int c = col0 + bj * HALF;
                    const u32x4 yv = *(const u32x4*)(YG + r * ldy + c), gv = *(const u32x4*)(YG + r * ldy + 512 + c);
                    const f32x4 a0 = acc[ai][bj][m][0] + bv[bj][0], a1 = acc[ai][bj][m][1] + bv[bj][1];
                    float o[8]; const unsigned yw[4] = {yv.x, yv.y, yv.z, yv.w}, gw[4] = {gv.x, gv.y, gv.z, gv.w};
#pragma unroll
                    for (int e = 0; e < 8; ++e) { const float a = e < 4 ? a0[e & 3] : a1[e & 3]; const float y = (e & 1) ? bf_hi(yw[e >> 1]) : bf_lo(yw[e >> 1]);
                        const float g = (e & 1) ? bf_hi(gw[e >> 1]) : bf_lo(gw[e >> 1]); o[e] = y * fast_sigmoid(a) * (g * fast_sigmoid(g)); }
                    u32x4 w; w.x = cvt_pk_bf16(o[0], o[1]); w.y = cvt_pk_bf16(o[2], o[3]); w.z = cvt_pk_bf16(o[4], o[5]); w.w = cvt_pk_bf16(o[6], o[7]);
                    *(u32x4*)(O + r * ldc + c) = w; asm volatile("" ::: "memory"); } }
    }
};
template <int ADD> struct EpiMerge {
    static constexpr bool PERM = true, AFTER_DRAIN = false;
    bf16_t* O; int ldc; const bf16_t* G; int ldg; int goff;
    __device__ __forceinline__ void operator()(const f32x4 (&acc)[2][2][4][2], const Unit& u, int wr, int wc, int fr, int fq) const {
        const int row0 = u.pm * BM + wr * 64 + fr, col0 = u.pn * BM + wc * 32 + 8 * fq;
#pragma unroll
        for (int ai = 0; ai < 2; ++ai)
#pragma unroll
            for (int m = 0; m < 4; ++m) { const size_t r = (size_t)(row0 + ai * HALF + m * 16);
#pragma unroll
                for (int bj = 0; bj < 2; ++bj) { const int c = col0 + bj * HALF;
                    const u32x4 gv = *(const u32x4*)(G + r * ldg + goff + c); u32x4 tv = {0u, 0u, 0u, 0u}; if (ADD) tv = *(const u32x4*)(O + r * ldc + c);
                    const f32x4 a0 = acc[ai][bj][m][0], a1 = acc[ai][bj][m][1];
                    float o[8]; const unsigned gw[4] = {gv.x, gv.y, gv.z, gv.w}, tw[4] = {tv.x, tv.y, tv.z, tv.w};
#pragma unroll
                    for (int e = 0; e < 8; ++e) { const float a = e < 4 ? a0[e & 3] : a1[e & 3]; const float g = (e & 1) ? bf_hi(gw[e >> 1]) : bf_lo(gw[e >> 1]);
                        const float t = (e & 1) ? bf_hi(tw[e >> 1]) : bf_lo(tw[e >> 1]); o[e] = (ADD ? t : 0.f) + g * a; }
                    u32x4 w; w.x = cvt_pk_bf16(o[0], o[1]); w.y = cvt_pk_bf16(o[2], o[3]); w.z = cvt_pk_bf16(o[4], o[5]); w.w = cvt_pk_bf16(o[6], o[7]);
                    *(u32x4*)(O + r * ldc + c) = w; asm volatile("" ::: "memory"); } }
    }
};
struct EpiOut {
    static constexpr bool PERM = false, AFTER_DRAIN = false;
    const float* base; float* H; bf16_t* XN; float* ssq; int last;
    __device__ __forceinline__ void operator()(const f32x4 (&acc)[2][2][4][2], const Unit& u, int wr, int wc, int fr, int fq) const {
        const int row0 = u.pm * BM + wr * 64 + fr, col0 = u.pn * BM + wc * 32 + 4 * fq;
#pragma unroll
        for (int ai = 0; ai < 2; ++ai)
#pragma unroll
            for (int m = 0; m < 4; ++m) { const size_t r = (size_t)(row0 + ai * HALF + m * 16); float s = 0.f;
#pragma unroll
                for (int bj = 0; bj < 2; ++bj)
#pragma unroll
                    for (int n = 0; n < 2; ++n) { const size_t off = r * 1024 + col0 + bj * HALF + n * 16;
                        const f32x4 h = *(const f32x4*)(base + off) + acc[ai][bj][m][n]; *(f32x4*)(H + off) = h;
                        s += (h[0] * h[0] + h[1] * h[1]) + (h[2] * h[2] + h[3] * h[3]);
                        if (!last) { u32x2 w; w.x = cvt_pk_bf16(h[0], h[1]); w.y = cvt_pk_bf16(h[2], h[3]); *(u32x2*)(XN + off) = w; } }
                s += __shfl_xor(s, 16); s += __shfl_xor(s, 32);
                if (fq == 0 && !last) ssq[r * 16 + u.pn * 4 + wc] = s; }
    }
};
template <class Epi, class Sched, bool ALIGN_EPI, bool SP2, int KK, int LDA, int LDB>
__device__ __forceinline__ void gemm_phase(PG8_LAS unsigned char* lds, const Gemm g, const Sched& S, const Epi& E, int wave_id  ) {
    int lane_; asm volatile("v_mbcnt_lo_u32_b32 %0, -1, 0\n\tv_mbcnt_hi_u32_b32 %0, -1, %0" : "=&v"(lane_)); const int tid_ = wave_id * 64 + lane_;
    const int tid = tid_, wid = __builtin_amdgcn_readfirstlane(tid >> 6), lane = tid & 63, wr = wid >> 2, wc = wid & 3, fr = lane & 15, fq = lane >> 4;
    constexpr int K = KK, nt = K / BK;
    unsigned voffA[2], voffB[2];
#pragma unroll
    for (int i = 0; i < 2; ++i) { int R, C; stage_rc(tid * 16 + i * 8192, R, C); const int Rb = Epi::PERM ? ((R & ~31) + perm32(R & 31)) : R;
        voffA[i] = (unsigned)(R * LDA + C) * 2u; voffB[i] = (unsigned)(Rb * LDB + C) * 2u; }
    constexpr size_t kstep = (size_t)(BK * 2);
    constexpr size_t hstepA = (size_t)HALF * LDA * 2, hstepB = (size_t)HALF * LDB * 2;
    constexpr size_t tstepA = 2 * hstepA, tstepB = 2 * hstepB;
    const unsigned ldsw = (unsigned)wid * 1024u;
    const int aoff = lds_byte(wr * 64 + fr, fq * 8), boff = lds_byte(wc * 32 + fr, fq * 8);
#define PG8_SA(b, h) (((b) * 2 + (h)) * HTB)
#define PG8_SB(b, h) ((4 + (b) * 2 + (h)) * HTB)
#define PG8_STAGE(bufoff, gbase, voff) do { _Pragma("unroll") for (int _i = 0; _i < 2; ++_i) \
        __builtin_amdgcn_global_load_lds((const unsigned*)((const char*)(gbase) + (voff)[_i]), (PG8_LAS unsigned*)(lds + (bufoff) + ldsw + _i * 8192), 16, 0, 0); } while (0)
#define PG8_LDA(dst, b, h) do { _Pragma("unroll") for (int m = 0; m < 4; ++m) _Pragma("unroll") for (int k = 0; k < 2; ++k) dst[m][k] = *(const PG8_LAS bf16x8*)(lds + PG8_SA(b, h) + aoff + m * 2048 + k * 1024); } while (0)
#define PG8_LDB(dst, b, h) do { _Pragma("unroll") for (int n = 0; n < 2; ++n) _Pragma("unroll") for (int k = 0; k < 2; ++k) dst[n][k] = *(const PG8_LAS bf16x8*)(lds + PG8_SB(b, h) + boff + n * 2048 + k * 1024); } while (0)
#define PG8_MMA(ai, bj, At, Bt) do { __builtin_amdgcn_s_setprio(1); _Pragma("unroll") for (int m = 0; m < 4; ++m) _Pragma("unroll") for (int n = 0; n < 2; ++n) _Pragma("unroll") for (int k = 0; k < 2; ++k) \
        acc[ai][bj][m][n] = __builtin_amdgcn_mfma_f32_16x16x32_bf16(Bt[n][k], At[m][k], acc[ai][bj][m][n], 0, 0, 0); __builtin_amdgcn_s_setprio(0); } while (0)
#define PG8_WAIT_V(n) asm volatile("s_waitcnt vmcnt(" #n ")" ::: "memory")
#define PG8_WAIT_L(n) asm volatile("s_waitcnt lgkmcnt(" #n ")" ::: "memory")
#define PG8_BAR __builtin_amdgcn_s_barrier()
#define PG8_SCHED __builtin_amdgcn_sched_barrier(0)
    Unit cur, nxt; int ui = 0;
    if (!S.next(0, cur)) return;
    f32x4 acc[2][2][4][2];
#pragma unroll
    for (int a = 0; a < 2; ++a)
#pragma unroll
        for (int b = 0; b < 2; ++b)
#pragma unroll
            for (int m = 0; m < 4; ++m)
#pragma unroll
                for (int n = 0; n < 2; ++n) acc[a][b][m][n] = (f32x4){0.f, 0.f, 0.f, 0.f};
    bf16x8 At[4][2], B0[2][2], B1[2][2];
    const char* cA = (const char*)g.A + (size_t)cur.pm * tstepA; const char* cB = (const char*)g.Bt + (size_t)cur.pn * tstepB;
    S.a_ready(cur);
    if constexpr (SP2) {
        PG8_STAGE(PG8_SB(0, 0), cB, voffB); PG8_STAGE(PG8_SB(0, 1), cB + hstepB, voffB); PG8_STAGE(PG8_SA(0, 0), cA, voffA); PG8_STAGE(PG8_SA(0, 1), cA + hstepA, voffA);
        if (wr == 1) PG8_BAR;
        PG8_WAIT_V(2); PG8_BAR;
        PG8_STAGE(PG8_SB(1, 0), cB + kstep, voffB); PG8_STAGE(PG8_SA(1, 0), cA + kstep, voffA); PG8_STAGE(PG8_SB(1, 1), cB + hstepB + kstep, voffB);
        PG8_WAIT_V(6); PG8_BAR;
    } else {
        PG8_STAGE(PG8_SB(0, 0), cB, voffB); PG8_STAGE(PG8_SA(0, 0), cA, voffA); PG8_STAGE(PG8_SB(0, 1), cB + hstepB, voffB); PG8_STAGE(PG8_SA(0, 1), cA + hstepA, voffA);
        if (wr == 1) PG8_BAR;
        PG8_WAIT_V(4); PG8_BAR;
        PG8_STAGE(PG8_SB(1, 0), cB + kstep, voffB); PG8_STAGE(PG8_SA(1, 0), cA + kstep, voffA); PG8_STAGE(PG8_SB(1, 1), cB + hstepB + kstep, voffB);
        PG8_WAIT_V(6); PG8_BAR;
    }
    for (;;) {
        const bool has_next = S.next(ui + 1, nxt);
        const char* nA = has_next ? (const char*)g.A + (size_t)nxt.pm * tstepA : cA; const char* nB = has_next ? (const char*)g.Bt + (size_t)nxt.pn * tstepB : cB;
        for (int t = 0; t < nt; t += 2) {
            const bool last = (t == nt - 2);
            const char* a1 = cA + (size_t)(t + 1) * kstep;
            const char* a2 = last ? nA : cA + (size_t)(t + 2) * kstep; const char* b2 = last ? nB : cB + (size_t)(t + 2) * kstep;
            const char* a3 = a2 + kstep; const char* b3 = b2 + kstep;
            if (last && has_next) S.a_ready(nxt);
            if constexpr (SP2) {
            PG8_LDB(B0, 0, 0); PG8_LDB(B1, 0, 1); PG8_SCHED; PG8_LDA(At, 0, 0); PG8_STAGE(PG8_SA(1, 1), a1 + hstepA, voffA);
            PG8_WAIT_V(8); PG8_WAIT_L(0); PG8_BAR; PG8_MMA(0, 0, At, B0); PG8_MMA(0, 1, At, B1); PG8_BAR; PG8_SCHED;
            PG8_LDA(At, 0, 1); PG8_STAGE(PG8_SB(0, 0), b2, voffB); PG8_STAGE(PG8_SB(0, 1), b2 + hstepB, voffB); PG8_STAGE(PG8_SA(0, 0), a2, voffA);
            PG8_WAIT_V(8); PG8_WAIT_L(0); PG8_BAR; PG8_MMA(1, 0, At, B0); PG8_MMA(1, 1, At, B1); PG8_BAR; PG8_SCHED;
            PG8_LDB(B0, 1, 0); PG8_LDB(B1, 1, 1); PG8_SCHED; PG8_LDA(At, 1, 0); PG8_STAGE(PG8_SA(0, 1), a2 + hstepA, voffA);
            PG8_WAIT_V(8); PG8_WAIT_L(0); PG8_BAR; PG8_MMA(0, 0, At, B0); PG8_MMA(0, 1, At, B1); PG8_BAR; PG8_SCHED;
            PG8_LDA(At, 1, 1); PG8_STAGE(PG8_SB(1, 0), b3, voffB); PG8_STAGE(PG8_SB(1, 1), b3 + hstepB, voffB); PG8_STAGE(PG8_SA(1, 0), a3, voffA);
            PG8_WAIT_V(8); PG8_WAIT_L(0); PG8_BAR; PG8_MMA(1, 0, At, B0); PG8_MMA(1, 1, At, B1); PG8_BAR; PG8_SCHED;
            } else {
            PG8_LDB(B0, 0, 0); PG8_SCHED; PG8_LDA(At, 0, 0); PG8_STAGE(PG8_SA(1, 1), a1 + hstepA, voffA);
            PG8_WAIT_L(8); PG8_BAR; PG8_WAIT_L(0); PG8_MMA(0, 0, At, B0); PG8_BAR; PG8_SCHED;
            PG8_LDB(B1, 0, 1); PG8_STAGE(PG8_SB(0, 0), b2, voffB);
            PG8_BAR; PG8_WAIT_L(0); PG8_MMA(0, 1, At, B1); PG8_BAR;
            PG8_LDA(At, 0, 1); PG8_STAGE(PG8_SA(0, 0), a2, voffA);
            PG8_BAR; PG8_WAIT_L(0); PG8_MMA(1, 0, At, B0); PG8_BAR; PG8_SCHED;
            PG8_STAGE(PG8_SB(0, 1), b2 + hstepB, voffB);
            PG8_WAIT_V(6); PG8_BAR; PG8_MMA(1, 1, At, B1); PG8_BAR;
            PG8_LDB(B0, 1, 0); PG8_SCHED; PG8_LDA(At, 1, 0); PG8_STAGE(PG8_SA(0, 1), a2 + hstepA, voffA);
            PG8_WAIT_L(8); PG8_BAR; PG8_WAIT_L(0); PG8_MMA(0, 0, At, B0); PG8_BAR; PG8_SCHED;
            PG8_LDB(B1, 1, 1); PG8_STAGE(PG8_SB(1, 0), b3, voffB);
            PG8_BAR; PG8_WAIT_L(0); PG8_MMA(0, 1, At, B1); PG8_BAR;
            PG8_LDA(At, 1, 1); PG8_STAGE(PG8_SA(1, 0), a3, voffA);
            PG8_BAR; PG8_WAIT_L(0); PG8_MMA(1, 0, At, B0); PG8_BAR; PG8_SCHED;
            PG8_STAGE(PG8_SB(1, 1), b3 + hstepB, voffB);
            PG8_WAIT_V(6); PG8_BAR; PG8_MMA(1, 1, At, B1); PG8_BAR;
            }
        }
        if constexpr (ALIGN_EPI) { if (wr == 0) PG8_BAR; }
        if constexpr (!Epi::AFTER_DRAIN) { E(acc, cur, wr, wc, fr, fq); S.done(cur); }
        if (!has_next) break;
#pragma unroll
        for (int a = 0; a < 2; ++a)
#pragma unroll
            for (int b = 0; b < 2; ++b)
#pragma unroll
                for (int m = 0; m < 4; ++m)
#pragma unroll
                    for (int n = 0; n < 2; ++n) acc[a][b][m][n] = (f32x4){0.f, 0.f, 0.f, 0.f};
        cur = nxt; cA = nA; cB = nB; ++ui;
        if constexpr (ALIGN_EPI) { if (wr == 1) PG8_BAR; }
    }
    PG8_WAIT_V(0);
    if constexpr (!ALIGN_EPI) { if (wr == 0) PG8_BAR; }
    PG8_BAR;
    if constexpr (Epi::AFTER_DRAIN) { E.fused(acc, cur, wr, wc, fr, fq, lds, wid, lane); S.done(cur); }
#undef PG8_SA
#undef PG8_SB
#undef PG8_STAGE
#undef PG8_LDA
#undef PG8_LDB
#undef PG8_MMA
#undef PG8_WAIT_V
#undef PG8_WAIT_L
#undef PG8_BAR
#undef PG8_SCHED
}
}

constexpr int NWAVES = 8, NTHREADS = 512;
#ifndef MK_PER_PHASE
#define MK_PER_PHASE 0
#endif
constexpr int D = 1024, BATCH = 8, SEQ = 2048, M = BATCH * SEQ, DEPTH = 2;
constexpr int S5W = 512, S5H = 16, S5G = 32, S5P = 64;
constexpr int HYW = 1024, HYF = 4096, HYE = 33, HYN = 64;
constexpr int INC = 7168;
constexpr int NPHASE = 12;

constexpr size_t MiB = 1u << 20;
constexpr size_t WS_CTL = 0, CTL_ZERO_BYTES = 64 * 1024;
constexpr size_t WS_H2 = 1 * MiB;
constexpr size_t WS_LBAR = 2 * MiB;
constexpr size_t WS_BBT = 2 * MiB + 64 * 1024;
constexpr size_t WS_CT = WS_BBT + 512 * 1024;
constexpr size_t WS_W = 4 * MiB;
constexpr size_t W_IN = 0, W_GLU = 14 * MiB, W_BS5 = W_GLU + 512 * 1024, W_BHY = W_BS5 + 1 * MiB, W_OUT = W_BHY + 2 * MiB, W_LAYER = W_OUT + 2 * MiB;
constexpr size_t WS_SSQ = 43 * MiB;
constexpr size_t WS_X = 44 * MiB;
constexpr size_t WS_R1 = 76 * MiB, WS_R2 = 108 * MiB, WS_R3 = 140 * MiB, WS_R4 = 172 * MiB, WS_R5 = 204 * MiB, WS_R6 = 236 * MiB, WS_W3T = 252 * MiB  , WS_END = 254 * MiB;
static_assert(WS_W + 2 * W_LAYER <= WS_SSQ, "weights");
constexpr int LDS_BYTES = 163840 - 256;
constexpr int LDSCTL_OFF = LDS_BYTES - 512;

#define GAS __attribute__((address_space(1)))
#define LAS __attribute__((address_space(3)))
typedef unsigned short bf16;
typedef unsigned v4u __attribute__((ext_vector_type(4)));
typedef unsigned v2u __attribute__((ext_vector_type(2)));
typedef float f32x4 __attribute__((ext_vector_type(4)));
typedef float f32x2 __attribute__((ext_vector_type(2)));
typedef short bf16x8 __attribute__((ext_vector_type(8)));
typedef GAS unsigned gu32;
#define RLX_AGENT __ATOMIC_RELAXED, __HIP_MEMORY_SCOPE_AGENT
#define LDS_WAIT() asm volatile("s_waitcnt lgkmcnt(0)" ::: "memory")
#define VM_WAIT() asm volatile("s_waitcnt vmcnt(0)" ::: "memory")
__device__ __forceinline__ unsigned f2bf(float f) { unsigned u = __builtin_bit_cast(unsigned, f); return (u + 0x7fffu + ((u >> 16) & 1u)) >> 16; }
__device__ __forceinline__ unsigned pk2(float lo, float hi) { return f2bf(lo) | (f2bf(hi) << 16); }
__device__ __forceinline__ float bf2f(unsigned short h) { return __uint_as_float((unsigned)h << 16); }
using pg8::bf_lo; using pg8::bf_hi; using pg8::fast_sigmoid;

#define XB_TMO      128
#define XB_XCNT(j)  (256  + 64 * (j))
#define XB_XSUB(j)  (1280 + 64 * (j))
#define XB_XGEN(j)  (2304 + 64 * (j))
#define XB_TOP      3328
#define XB_TOPGEN   3392
#define XCD_BAR_WORDS 3456
#define XB_SPIN_CAP (1u << 18)
__device__ __forceinline__ unsigned xb_ld(unsigned* p)              { return __hip_atomic_load(p, __ATOMIC_RELAXED, __HIP_MEMORY_SCOPE_AGENT); }
__device__ __forceinline__ unsigned xb_add(unsigned* p, unsigned v) { return __hip_atomic_fetch_add(p, v, __ATOMIC_RELAXED, __HIP_MEMORY_SCOPE_AGENT); }
__device__ __forceinline__ unsigned xb_xcc_id() { return (unsigned)__builtin_amdgcn_s_getreg((3 << 11) | 20) & 0xFu; }
#define XB_SPIN(cond, bar) do { unsigned _sp = 0; while (cond) { __builtin_amdgcn_s_sleep(1); \
    if ((++_sp & 255u) == 0u) { if (xb_ld(&(bar)[XB_TMO])) break; if (_sp > XB_SPIN_CAP) { atomicAdd(&(bar)[XB_TMO], 1u); break; } } } } while (0)
struct XcdBarrier { unsigned* bar; unsigned x; volatile LAS unsigned* st; };
__device__ __forceinline__ int cur_lane() { int l; asm volatile("v_mbcnt_lo_u32_b32 %0, -1, 0\n\tv_mbcnt_hi_u32_b32 %0, -1, %0" : "=&v"(l)); return l; }
__device__ __forceinline__ XcdBarrier xcd_barrier_post(unsigned* bar, volatile LAS unsigned* st, bool leader) {
    XcdBarrier b; b.bar = bar; b.x = xb_xcc_id(); b.st = st;
    if (leader) (void)xb_add(&bar[XB_XCNT(b.x)], 1u);
    return b;
}
__device__ __forceinline__ void xcd_barrier_complete(unsigned* bar, unsigned x, unsigned& nloc, unsigned& nx) {
    const unsigned G = gridDim.x * gridDim.y * gridDim.z;
    unsigned sum, cnt, mine, sp = 0u;
    for (;;) {
        sum = 0u; cnt = 0u; mine = 0u;
#pragma unroll
        for (unsigned j = 0; j < 16; ++j) { const unsigned c = xb_ld(&bar[XB_XCNT(j)]); sum += c; cnt += (c > 0u) ? 1u : 0u; mine = (j == x) ? c : mine; }
        if (sum == G) break;
        __builtin_amdgcn_s_sleep(1);
        if ((++sp & 255u) == 0u) { if (xb_ld(&bar[XB_TMO])) break; if (sp > XB_SPIN_CAP) { atomicAdd(&bar[XB_TMO], 1u); break; } }
    }
    nloc = mine > 0u ? mine : 1u; nx = cnt > 0u ? cnt : 1u;
}
__device__ __forceinline__ void xcd_barrier(const XcdBarrier& b, int wave_id) {
    asm volatile("s_waitcnt vmcnt(0)" ::: "memory");
    __syncthreads();
    if (wave_id == 0 && cur_lane() == 0) {
        unsigned* bar = b.bar; asm volatile("" : "+s"(bar));
        __builtin_amdgcn_s_waitcnt(0);
        unsigned nloc = b.st[0], nx = b.st[1];
        if (nloc == 0u) { xcd_barrier_complete(bar, b.x, nloc, nx); b.st[0] = nloc; b.st[1] = nx; }
        const unsigned old = xb_add(&bar[XB_XSUB(b.x)], 1u);
        const unsigned gen = old / nloc;
        if (old + 1u == (gen + 1u) * nloc) {
            __builtin_amdgcn_fence(__ATOMIC_RELEASE, "agent");
            asm volatile("s_waitcnt vmcnt(0)" ::: "memory");
            const unsigned og = xb_add(&bar[XB_TOP], 1u);
            const unsigned tg = og / nx;
            if (og + 1u == (tg + 1u) * nx) xb_add(&bar[XB_TOPGEN], 1u);
            else XB_SPIN(xb_ld(&bar[XB_TOPGEN]) == tg, bar);
            __builtin_amdgcn_fence(__ATOMIC_ACQUIRE, "agent");
            xb_add(&bar[XB_XGEN(b.x)], 1u);
            asm volatile("s_waitcnt vmcnt(0)" ::: "memory");
        } else {
            XB_SPIN(xb_ld(&bar[XB_XGEN(b.x)]) == gen, bar);
            __builtin_amdgcn_fence(__ATOMIC_ACQUIRE, "agent");
            asm volatile("s_waitcnt vmcnt(0)" ::: "memory");
        }
    }
    __syncthreads();
}

struct Frame {
    LAS unsigned char* lds;
    int tid, lane, wave, G, bx;
    float* out; unsigned char* ws;
    __device__ __forceinline__ const float* inp(int i) const {
        const LAS unsigned* t = (const LAS unsigned*)(lds + LDSCTL_OFF + 256) + 2 * i;
        const unsigned lo = __builtin_amdgcn_readfirstlane(t[0]), hi = __builtin_amdgcn_readfirstlane(t[1]);
        return (const float*)(((unsigned long long)hi << 32) | lo);
    }
};
__device__ __forceinline__ float wave_sum(float v) {
#pragma unroll
    for (int o = 1; o < 64; o <<= 1) v += __shfl_xor(v, o);
    return v;
}

__device__ __forceinline__ void p0_transpose_item(const float* W, int K, int N, bf16* WT, int k0, int n0, int drow, const float* kscale, LAS float* scr, int lane, bf16* WTlo = nullptr) {
    const int lr = lane >> 4, lc = (lane & 15) * 4;
    f32x4 v[16];
#pragma unroll
    for (int i = 0; i < 16; ++i) v[i] = *(const GAS f32x4*)(W + (size_t)(k0 + 4 * i + lr) * N + n0 + lc);
#pragma unroll
    for (int i = 0; i < 16; ++i) { const int kk = 4 * i + lr; f32x4 x = v[i]; if (kscale) x = x * kscale[k0 + kk];
        LAS float* d = scr + kk * 65 + lc; d[0] = x[0]; d[1] = x[1]; d[2] = x[2]; d[3] = x[3]; }
    LDS_WAIT(); asm volatile("" ::: "memory");
    const int c = lane & 7;
#pragma unroll
    for (int j = 0; j < 8; ++j) { const int n = (lane >> 3) + 8 * j; const LAS float* s = scr + (8 * c) * 65 + n;
        v4u o; o.x = pk2(s[0 * 65], s[1 * 65]); o.y = pk2(s[2 * 65], s[3 * 65]); o.z = pk2(s[4 * 65], s[5 * 65]); o.w = pk2(s[6 * 65], s[7 * 65]);
        *(GAS v4u*)(WT + (size_t)(drow + n) * K + k0 + 8 * c) = o;
        if (WTlo) { v4u q;
#define P0_LO2(a, b, hw) pk2((a) - __uint_as_float((hw) << 16), (b) - __uint_as_float((hw) & 0xffff0000u))
            q.x = P0_LO2(s[0 * 65], s[1 * 65], o.x); q.y = P0_LO2(s[2 * 65], s[3 * 65], o.y); q.z = P0_LO2(s[4 * 65], s[5 * 65], o.z); q.w = P0_LO2(s[6 * 65], s[7 * 65], o.w);
#undef P0_LO2
            *(GAS v4u*)(WTlo + (size_t)(drow + n) * K + k0 + 8 * c) = q; } }
    LDS_WAIT(); asm volatile("" ::: "memory");
}
__device__ __forceinline__ void p0_prologue(Frame& F) {
    LAS float* scr = (LAS float*)(F.lds + F.wave * 17408);
    const int gw = F.bx * NWAVES + F.wave, NGW = F.G * NWAVES, lane = F.lane;
    constexpr int I_IN = (D / 64) * (INC / 64), I_GLU = (S5W / 64) * (S5W / 64), I_BS5 = (S5W / 64) * (D / 64), I_BHY = (HYW / 64) * (D / 64), I_OUT = (D / 64) * (D / 64);
    constexpr int I_LAYER = I_IN + I_GLU + I_BS5 + I_BHY + I_OUT;
    for (int it = gw; it < DEPTH * I_LAYER; it += NGW) {
        const int l = it / I_LAYER; int r = it % I_LAYER; bf16* wl = (bf16*)(F.ws + WS_W + (size_t)l * W_LAYER);
        if (r < I_IN) { const int nblk = INC / 64, kb = r / nblk, nb = r % nblk, n0 = nb * 64;
            const int drow = (n0 >= 1024 && n0 < 5120) ? n0 - 1024 : (n0 < 1024 ? n0 + 4096 : n0);
            p0_transpose_item(F.inp(2) + (size_t)l * D * INC, D, INC, wl + W_IN / 2, kb * 64, n0, drow, F.inp(1) + l * D, scr, lane); continue; } r -= I_IN;
        if (r < I_GLU) { const int nblk = S5W / 64; p0_transpose_item(F.inp(11) + (size_t)l * S5W * S5W, S5W, S5W, wl + W_GLU / 2, (r / nblk) * 64, (r % nblk) * 64, (r % nblk) * 64, nullptr, scr, lane); continue; } r -= I_GLU;
        if (r < I_BS5) { const int nblk = D / 64; p0_transpose_item(F.inp(23) + (size_t)l * S5W * D, S5W, D, wl + W_BS5 / 2, (r / nblk) * 64, (r % nblk) * 64, (r % nblk) * 64, nullptr, scr, lane); continue; } r -= I_BS5;
        if (r < I_BHY) { const int nblk = D / 64; p0_transpose_item(F.inp(24) + (size_t)l * HYW * D, HYW, D, wl + W_BHY / 2, (r / nblk) * 64, (r % nblk) * 64, (r % nblk) * 64, nullptr, scr, lane); continue; } r -= I_BHY;
        { const int nblk = D / 64; p0_transpose_item(F.inp(25) + (size_t)l * D * D, D, D, wl + W_OUT / 2, (r / nblk) * 64, (r % nblk) * 64, (r % nblk) * 64, nullptr, scr, lane); }
    }
    for (int it = gw; it < DEPTH * (HYF / 64); it += NGW) { const int l = it / (HYF / 64), nb = it % (HYF / 64); bf16* hi = (bf16*)(F.ws + WS_W3T + (size_t)l * MiB);
        p0_transpose_item(F.inp(20) + (size_t)l * HYN * HYF, HYN, HYF, hi, 0, nb * 64, nb * 64, nullptr, scr, lane, hi + (size_t)HYF * HYN); }
    { bf16* X = (bf16*)(F.ws + WS_X); float* ssq = (float*)(F.ws + WS_SSQ);
      for (int m0 = 2 * gw; m0 < M; m0 += 2 * NGW) { f32x4 v[2][4]; float s[2];
#pragma unroll
        for (int r = 0; r < 2; ++r) { const GAS f32x4* xr = (const GAS f32x4*)(F.inp(0) + (size_t)(m0 + r) * D) + lane;
#pragma unroll
            for (int j = 0; j < 4; ++j) v[r][j] = xr[64 * j]; }
#pragma unroll
        for (int r = 0; r < 2; ++r) { float a = 0.f;
#pragma unroll
            for (int j = 0; j < 4; ++j) a += (v[r][j].x * v[r][j].x + v[r][j].y * v[r][j].y) + (v[r][j].z * v[r][j].z + v[r][j].w * v[r][j].w);
            s[r] = wave_sum(a);
            GAS unsigned long long* o8 = (GAS unsigned long long*)(X + (size_t)(m0 + r) * D) + lane;
#pragma unroll
            for (int j = 0; j < 4; ++j) o8[64 * j] = (unsigned long long)pk2(v[r][j].x, v[r][j].y) | ((unsigned long long)pk2(v[r][j].z, v[r][j].w) << 32);
            if (lane < 16) ssq[(size_t)(m0 + r) * 16 + lane] = lane == 0 ? s[r] : 0.f; } } }
    {
      for (int it = gw; it < DEPTH * SEQ; it += NGW) { const int l = it / SEQ, t = it % SEQ, j = lane;
        const float* w1 = F.inp(15) + (size_t)l * HYE * HYN; const float* b1 = F.inp(16) + l * HYN; const float* fr = F.inp(17) + l * HYN; const float* w2 = F.inp(18) + (size_t)l * HYN * HYN; const float* b2 = F.inp(19) + l * HYN;
        float f = 0.f;
        if (j == 0) f = (float)t / (float)(SEQ - 1);
        else if (j < 33) { const int bi = (j - 1) & 15; const float band = 1e-4f + (float)bi * ((15.f - 1e-4f) / 15.f); const float ang = band * (float)t * (float)(2.0 * 3.14159265358979323846 / SEQ); f = j < 17 ? cosf(ang) : -sinf(ang); }
        float a = b1[j];
        for (int i = 0; i < HYE; ++i) a += __shfl(f, i) * w1[i * HYN + j];
        const float h1 = sinf(fr[j] * a);
        float c = b2[j];
        for (int i = 0; i < HYN; ++i) c += __shfl(h1, i) * w2[i * HYN + j];
        const float hv = sinf(fr[j] * c); const unsigned hh = f2bf(hv);
        bf16* H2H = (bf16*)(F.ws + WS_H2 + (size_t)l * 512 * 1024);
        H2H[(size_t)t * HYN + j] = (bf16)hh; H2H[(size_t)SEQ * HYN + (size_t)t * HYN + j] = (bf16)f2bf(hv - __uint_as_float(hh << 16)); } }
    { float* LB = (float*)(F.ws + WS_LBAR); bf16* BBT = (bf16*)(F.ws + WS_BBT); bf16* CT = (bf16*)(F.ws + WS_CT);
      for (int q = gw; q < DEPTH * 2 * S5G; q += NGW) { const int p = lane; const int i = q * S5P + p;
        const float dt = expf(F.inp(5)[q]); const float lr = F.inp(3)[i], li = F.inp(4)[i]; const float mag = expf(lr * dt), ang = li * dt;
        const float br = mag * cosf(ang), bi = mag * sinf(ang); LB[2 * i] = br; LB[2 * i + 1] = bi;
        const float nr = br - 1.f, ni = bi, den = lr * lr + li * li; const float kr = (nr * lr + ni * li) / den, ki = (ni * lr - nr * li) / den;
        const float* bre = F.inp(6) + (size_t)i * S5H; const float* bim = F.inp(7) + (size_t)i * S5H;
        bf16* rowr = BBT + ((size_t)q * 128 + 2 * p) * 16; bf16* rowi = rowr + 16;
        for (int h = 0; h < S5H; ++h) { const float xr = bre[h], xi = bim[h]; rowr[h] = (bf16)f2bf(kr * xr - ki * xi); rowi[h] = (bf16)f2bf(kr * xi + ki * xr); }
        const float* cre = F.inp(8) + (size_t)q * S5H * S5P; const float* cim = F.inp(9) + (size_t)q * S5H * S5P;
        for (int h = 0; h < S5H; ++h) { *(unsigned*)(CT + ((size_t)q * 16 + h) * 128 + 2 * p) = pk2(cre[h * S5P + p], -cim[h * S5P + p]); } } }
}

constexpr int S5_YB = 0, S5_CH = 65536, S5_CHB = 8448, S5_SEND = S5_CH + 8 * S5_CHB;
__device__ __forceinline__ float gelu_tanh_fast(float x) {
    const float z = 0.7978845608028654f * (x + 0.044715f * x * x * x);
    const float e = __builtin_amdgcn_exp2f(2.0f * 1.4426950408889634f * z);
    const float th = 1.0f - 2.0f * __builtin_amdgcn_rcpf(e + 1.0f);
    return 0.5f * x * (1.0f + th);
}
template <int DIR, bool EMIT>
__device__ __forceinline__ void s5_pass(Frame& F, const bf16* Ub  , int tlo  , float ar, float ai, float& sr, float& si,
                                        const bf16x8 (&bbf)[8], const bf16x8 (&ctf)[4], const bf16x8& ddf, LAS unsigned char* ch, LAS unsigned char* yb, bf16* YGb) {
    const int lane = F.lane, fr = lane & 15, fq = lane >> 4;
    bf16x8 uf, ufn;
    auto load_u = [&](int tc0) -> bf16x8 { bf16x8 z = {0, 0, 0, 0, 0, 0, 0, 0}; if (fq < 2) z = *(const bf16x8*)(Ub + (size_t)(tc0 + fr) * 1024 + 8 * fq); return z; };
    uf = load_u(DIR ? tlo + 240 : tlo);
#pragma unroll 1
    for (int ci = 0; ci < 16; ++ci) {
        const int tc0 = DIR ? tlo + 16 * (15 - ci) : tlo + 16 * ci;
        if (ci < 15) ufn = load_u(DIR ? tc0 - 16 : tc0 + 16);
        LAS float* bu = (LAS float*)ch;
#pragma unroll
        for (int j = 0; j < 8; ++j) { f32x4 a = {0.f, 0.f, 0.f, 0.f}; a = __builtin_amdgcn_mfma_f32_16x16x32_bf16(bbf[j], uf, a, 0, 0, 0);
            *(LAS f32x4*)(bu + fr * 132 + 16 * j + 4 * fq) = a; }
        LDS_WAIT();
        f32x2 x[16];
#pragma unroll
        for (int tt = 0; tt < 16; ++tt) x[tt] = *(const LAS f32x2*)(bu + tt * 132 + 2 * lane);
        LDS_WAIT();
        unsigned spk[16];
#pragma unroll
        for (int i = 0; i < 16; ++i) { const int tt = DIR ? 15 - i : i;
            const float nr = ar * sr - ai * si + x[tt].x, ni = ar * si + ai * sr + x[tt].y; sr = nr; si = ni;
            if (EMIT) spk[tt] = pg8::cvt_pk_bf16(nr, ni); }
        if (EMIT) {
            LAS unsigned* sb = (LAS unsigned*)ch;
#pragma unroll
            for (int tt = 0; tt < 16; ++tt) sb[tt * 68 + lane] = spk[tt];
            LDS_WAIT();
            f32x4 y = {0.f, 0.f, 0.f, 0.f};
#pragma unroll
            for (int ks = 0; ks < 4; ++ks) { const bf16x8 sf = *(const LAS bf16x8*)(ch + fr * 272 + ks * 64 + fq * 16); y = __builtin_amdgcn_mfma_f32_16x16x32_bf16(ctf[ks], sf, y, 0, 0, 0); }
            LDS_WAIT();
            LAS v2u* ybp = (LAS v2u*)(yb + (size_t)(tc0 + fr) * 32 + 8 * fq);
            if (DIR == 0) { v2u w; w.x = pg8::cvt_pk_bf16(y[0], y[1]); w.y = pg8::cvt_pk_bf16(y[2], y[3]); *ybp = w; }
            else { y = __builtin_amdgcn_mfma_f32_16x16x32_bf16(ddf, uf, y, 0, 0, 0);
                const v2u f = *ybp; const float o0 = gelu_tanh_fast(y[0] + bf_lo(f.x)), o1 = gelu_tanh_fast(y[1] + bf_hi(f.x)), o2 = gelu_tanh_fast(y[2] + bf_lo(f.y)), o3 = gelu_tanh_fast(y[3] + bf_hi(f.y));
                v2u w; w.x = pg8::cvt_pk_bf16(o0, o1); w.y = pg8::cvt_pk_bf16(o2, o3);
                *(v2u*)(YGb + (size_t)(tc0 + fr) * 1024 + 4 * fq) = w; }
        }
        uf = ufn;
    }
}
__device__ __forceinline__ void s5_item(Frame& F, int l, int b, int g, bool dry = false) {
    const int lane = F.lane, fr = lane & 15, fq = lane >> 4, seg = F.wave;
    bf16* U = (bf16*)(F.ws + WS_R5) + (size_t)b * SEQ * 1024 + g * 16;
    LAS unsigned char* ch = F.lds + S5_CH + seg * S5_CHB; LAS unsigned char* yb = F.lds + S5_YB;
    LAS f32x2* send = (LAS f32x2*)(F.lds + S5_SEND);
#pragma unroll 1
    for (int dir = 0; dir < 2; ++dir) {
        const int q = (l * 2 + dir) * S5G + g;
        const float ar = ((const float*)(F.ws + WS_LBAR))[(size_t)(q * S5P + lane) * 2], ai = ((const float*)(F.ws + WS_LBAR))[(size_t)(q * S5P + lane) * 2 + 1];
        bf16x8 bbf[8], ctf[4], ddf; const bf16x8 zero8 = {0, 0, 0, 0, 0, 0, 0, 0};
        const bf16* BBT = (const bf16*)(F.ws + WS_BBT) + (size_t)q * 128 * 16; const bf16* CT = (const bf16*)(F.ws + WS_CT) + (size_t)q * 16 * 128;
#pragma unroll
        for (int j = 0; j < 8; ++j) bbf[j] = fq < 2 ? *(const bf16x8*)(BBT + (16 * j + fr) * 16 + 8 * fq) : zero8;
#pragma unroll
        for (int ks = 0; ks < 4; ++ks) ctf[ks] = *(const bf16x8*)(CT + fr * 128 + 32 * ks + 8 * fq);
        { const short dv = (short)f2bf(F.inp(10)[l * S5W + g * 16 + fr]); ddf = zero8;
#pragma unroll
          for (int jj = 0; jj < 8; ++jj) if (8 * fq + jj == fr) ddf[jj] = dv; }
        const int tlo = dir ? SEQ - 256 * (seg + 1) : 256 * seg;
        float sr = 0.f, si = 0.f;
        if (dir == 0) s5_pass<0, false>(F, U, tlo, ar, ai, sr, si, bbf, ctf, ddf, ch, yb, U); else s5_pass<1, false>(F, U, tlo, ar, ai, sr, si, bbf, ctf, ddf, ch, yb, U);
        send[seg * 64 + lane] = (f32x2){sr, si};
        LDS_WAIT(); __syncthreads();
        float pr = ar, pi = ai;
#pragma unroll
        for (int k = 0; k < 8; ++k) { const float nr = pr * pr - pi * pi, ni = 2.f * pr * pi; pr = nr; pi = ni; }
        sr = 0.f; si = 0.f;
        for (int k = 0; k < seg; ++k) { const f32x2 e = send[k * 64 + lane]; const float nr = pr * sr - pi * si + e.x, ni = pr * si + pi * sr + e.y; sr = nr; si = ni; }
        bf16* YGo = dry ? (bf16*)(F.ws + WS_R6) + (size_t)(b & 1) * SEQ * 1024 + g * 16 : U;
        if (dir == 0) s5_pass<0, true>(F, U, tlo, ar, ai, sr, si, bbf, ctf, ddf, ch, yb, YGo); else s5_pass<1, true>(F, U, tlo, ar, ai, sr, si, bbf, ctf, ddf, ch, yb, YGo);
        LDS_WAIT(); __syncthreads();
    }
}

constexpr int HY_WX = 0, HY_WXB = 8704, HY_KF = 8 * HY_WXB, HY_KFO = 33 * 64 * 8, HY_KFCH = 2 * HY_KFO, HY_RED = HY_KF + 2 * HY_KFCH, HY_RAWROW = 4128;
static_assert(HY_RED + 256 <= LDSCTL_OFF && 4 * 2048 * 4 <= HY_KFCH && 2 * HY_RAWROW <= HY_WXB, "hyena LDS map");
#define C64_LIST 1.000000000e+00f, 9.951847267e-01f, 9.807852804e-01f, 9.569403357e-01f, 9.238795325e-01f, 8.819212643e-01f, 8.314696123e-01f, 7.730104534e-01f, 7.071067812e-01f, 6.343932842e-01f, 5.555702330e-01f, 4.713967368e-01f, 3.826834324e-01f, 2.902846773e-01f, 1.950903220e-01f, 9.801714033e-02f, 0.0f, -9.801714033e-02f, -1.950903220e-01f, -2.902846773e-01f, -3.826834324e-01f, -4.713967368e-01f, -5.555702330e-01f, -6.343932842e-01f, -7.071067812e-01f, -7.730104534e-01f, -8.314696123e-01f, -8.819212643e-01f, -9.238795325e-01f, -9.569403357e-01f, -9.807852804e-01f, -9.951847267e-01f, -1.000000000e+00f, -9.951847267e-01f, -9.807852804e-01f, -9.569403357e-01f, -9.238795325e-01f, -8.819212643e-01f, -8.314696123e-01f, -7.730104534e-01f, -7.071067812e-01f, -6.343932842e-01f, -5.555702330e-01f, -4.713967368e-01f, -3.826834324e-01f, -2.902846773e-01f, -1.950903220e-01f, -9.801714033e-02f, 0.0f, 9.801714033e-02f, 1.950903220e-01f, 2.902846773e-01f, 3.826834324e-01f, 4.713967368e-01f, 5.555702330e-01f, 6.343932842e-01f, 7.071067812e-01f, 7.730104534e-01f, 8.314696123e-01f, 8.819212643e-01f, 9.238795325e-01f, 9.569403357e-01f, 9.807852804e-01f, 9.951847267e-01f
__host__ __device__ constexpr int rev6(int s) { return ((s >> 4) & 3) | (s & 12) | ((s & 3) << 4); }

template <bool INV> __device__ __forceinline__ void r4(float& x0r, float& x0i, float& x1r, float& x1i, float& x2r, float& x2i, float& x3r, float& x3i) {
    const float t0r = x0r + x2r, t0i = x0i + x2i, t1r = x0r - x2r, t1i = x0i - x2i, t2r = x1r + x3r, t2i = x1i + x3i, t3r = x1r - x3r, t3i = x1i - x3i;
    x0r = t0r + t2r; x0i = t0i + t2i; x2r = t0r - t2r; x2i = t0i - t2i;
    if (!INV) { x1r = t1r + t3i; x1i = t1i - t3r; x3r = t1r - t3i; x3i = t1i + t3r; }
    else      { x1r = t1r - t3i; x1i = t1i + t3r; x3r = t1r + t3i; x3i = t1i - t3r; }
}
constexpr float C64T[64] = { C64_LIST };
template <int... Is, class Fn> __device__ __forceinline__ void static_for_impl(std::integer_sequence<int, Is...>, Fn&& f) { (f(std::integral_constant<int, Is>{}), ...); }
template <int N, class Fn> __device__ __forceinline__ void static_for(Fn&& f) { static_for_impl(std::make_integer_sequence<int, N>{}, f); }
template <bool INV, int E> __device__ __forceinline__ void twc(float& xr, float& xi) {
    constexpr int e = E & 63;
    if constexpr (e == 0) { return; }
    else if constexpr (e == 16) { const float tr = xr, ti = xi; if (!INV) { xr = ti; xi = -tr; } else { xr = -ti; xi = tr; } }
    else if constexpr (e == 32) { xr = -xr; xi = -xi; }
    else if constexpr (e == 48) { const float tr = xr, ti = xi; if (!INV) { xr = -ti; xi = tr; } else { xr = ti; xi = -tr; } }
    else {
        constexpr float c = C64T[e], sn = C64T[(e + 48) & 63], wi = INV ? sn : -sn;
        constexpr unsigned cb = __builtin_bit_cast(unsigned, c), wb = __builtin_bit_cast(unsigned, wi), nwb = wb ^ 0x80000000u;
        const float tr = xr, ti = xi; float a, b;
        asm("v_mul_f32 %0, %1, %2" : "=v"(a) : "i"(cb), "v"(tr));
        asm("v_fmac_f32 %0, %1, %2" : "+v"(a) : "i"(nwb), "v"(ti));
        asm("v_mul_f32 %0, %1, %2" : "=v"(b) : "i"(wb), "v"(tr));
        asm("v_fmac_f32 %0, %1, %2" : "+v"(b) : "i"(cb), "v"(ti));
        xr = a; xi = b;
    }
}
#define SFOR(N, I, ...) static_for<N>([&](auto I##_) __attribute__((always_inline)) { constexpr int I = decltype(I##_)::value; __VA_ARGS__ })
template <bool INV> __device__ __forceinline__ void dft64(float (&re)[64], float (&im)[64]) {
    if constexpr (!INV) {
        SFOR(16, bc, r4<false>(re[bc], im[bc], re[bc + 16], im[bc + 16], re[bc + 32], im[bc + 32], re[bc + 48], im[bc + 48]););
        SFOR(48, i, constexpr int p = 1 + i / 16; constexpr int bc = i % 16; twc<false, bc * p>(re[16 * p + bc], im[16 * p + bc]););
        __builtin_amdgcn_sched_barrier(0);
        SFOR(16, i, constexpr int s = 16 * (i / 4) + (i % 4); r4<false>(re[s], im[s], re[s + 4], im[s + 4], re[s + 8], im[s + 8], re[s + 12], im[s + 12]););
        SFOR(64, i, constexpr int q = (i >> 2) & 3; constexpr int c = i & 3; twc<false, 4 * c * q>(re[i], im[i]););
        __builtin_amdgcn_sched_barrier(0);
        SFOR(16, pq, constexpr int s = 4 * pq; r4<false>(re[s], im[s], re[s + 1], im[s + 1], re[s + 2], im[s + 2], re[s + 3], im[s + 3]););
    } else {
        SFOR(16, pq, constexpr int s = 4 * pq; r4<true>(re[s], im[s], re[s + 1], im[s + 1], re[s + 2], im[s + 2], re[s + 3], im[s + 3]););
        SFOR(64, i, constexpr int q = (i >> 2) & 3; constexpr int c = i & 3; twc<true, 4 * c * q>(re[i], im[i]););
        __builtin_amdgcn_sched_barrier(0);
        SFOR(16, i, constexpr int s = 16 * (i / 4) + (i % 4); r4<true>(re[s], im[s], re[s + 4], im[s + 4], re[s + 8], im[s + 8], re[s + 12], im[s + 12]););
        SFOR(48, i, constexpr int p = 1 + i / 16; constexpr int bc = i % 16; twc<true, bc * p>(re[16 * p + bc], im[16 * p + bc]););
        __builtin_amdgcn_sched_barrier(0);
        SFOR(16, bc, r4<true>(re[bc], im[bc], re[bc + 16], im[bc + 16], re[bc + 32], im[bc + 32], re[bc + 48], im[bc + 48]););
    }
    __builtin_amdgcn_sched_barrier(0);
}
__device__ __forceinline__ void wtrans(float (&v)[64], LAS float* wx, int lane) {
#pragma unroll
    for (int i = 0; i < 32; ++i) { const auto r = __builtin_amdgcn_permlane32_swap(__float_as_uint(v[i]), __float_as_uint(v[32 + i]), false, false); v[i] = __uint_as_float(r[0]); v[32 + i] = __uint_as_float(r[1]); }
    __builtin_amdgcn_sched_barrier(0);
    const int rd = (lane & 31) * 68 + (lane >> 5) * 32;
#pragma unroll
    for (int step = 0; step < 2; ++step) {
        asm volatile("" ::: "memory");
#pragma unroll
        for (int i = 0; i < 32; ++i) wx[i * 68 + lane] = v[32 * step + i];
        asm volatile("" ::: "memory");
#pragma unroll
        for (int i4 = 0; i4 < 8; ++i4) { const f32x4 q = *(const LAS f32x4*)(wx + rd + 4 * i4);
#pragma unroll
            for (int e = 0; e < 4; ++e) v[32 * step + 4 * i4 + e] = q[e]; }
        asm volatile("" ::: "memory");
    }
}
__device__ __forceinline__ void wfft_fwd(float (&re)[64], float (&im)[64], LAS float* wx, int lane) {
    dft64<false>(re, im);
    { float f = (float)lane * (1.0f / 4096.0f); asm volatile("" : "+v"(f));
#pragma unroll
      for (int s = 1; s < 64; ++s) { const float a = (float)rev6(s) * f; const float c = __builtin_amdgcn_cosf(a), sn = __builtin_amdgcn_sinf(a);
          const float tr = re[s] * c + im[s] * sn, ti = im[s] * c - re[s] * sn; re[s] = tr; im[s] = ti; if ((s & 7) == 7) __builtin_amdgcn_sched_barrier(0); } }
    __builtin_amdgcn_sched_barrier(0);
    wtrans(re, wx, lane); wtrans(im, wx, lane);
    __builtin_amdgcn_sched_barrier(0);
    dft64<false>(re, im);
}
__device__ __forceinline__ void wfft_inv(float (&re)[64], float (&im)[64], LAS float* wx, int lane) {
    dft64<true>(re, im);
    { float f = (float)rev6(lane) * (1.0f / 4096.0f); asm volatile("" : "+v"(f));
#pragma unroll
      for (int s = 1; s < 64; ++s) { const float a = (float)s * f; const float c = __builtin_amdgcn_cosf(a), sn = __builtin_amdgcn_sinf(a);
          const float tr = re[s] * c - im[s] * sn, ti = im[s] * c + re[s] * sn; re[s] = tr; im[s] = ti; if ((s & 7) == 7) __builtin_amdgcn_sched_barrier(0); } }
    __builtin_amdgcn_sched_barrier(0);
    wtrans(re, wx, lane); wtrans(im, wx, lane);
    __builtin_amdgcn_sched_barrier(0);
    dft64<true>(re, im);
}
struct Stage2 { v4u a[4], b[4]; };
__device__ __forceinline__ void hy_load2a(Stage2& S, const bf16* row0, int lane) {
#pragma unroll
    for (int i = 0; i < 4; ++i) { const int q = lane + 64 * i; S.a[i] = *(const GAS v4u*)(row0 + 8 * q); }
}
__device__ __forceinline__ void hy_load2b(Stage2& S, const bf16* row0, int lane) {
#pragma unroll
    for (int i = 0; i < 4; ++i) { const int q = lane + 64 * i; S.b[i] = *(const GAS v4u*)(row0 + SEQ + 8 * q); }
}
__device__ __forceinline__ void hy_load2(Stage2& S, const bf16* row0, int lane) { hy_load2a(S, row0, lane); hy_load2b(S, row0, lane); }
__device__ __forceinline__ void hy_commit2(const Stage2& S, LAS unsigned char* wxb, int lane) {
    asm volatile("" ::: "memory");
#pragma unroll
    for (int i = 0; i < 4; ++i) { const int q = lane + 64 * i; *(LAS v4u*)(wxb + 16 + 16 * q) = S.a[i]; *(LAS v4u*)(wxb + HY_RAWROW + 16 + 16 * q) = S.b[i]; }
    if (lane < 4) { LAS unsigned short* row = (LAS unsigned short*)(wxb + (lane >> 1) * HY_RAWROW); row[(lane & 1) ? 8 + SEQ : 7] = 0; }
    asm volatile("" ::: "memory");
}
__device__ __forceinline__ float raw2(LAS unsigned char* wxb, int r, int t) { return bf2f(*(const LAS unsigned short*)(wxb + r * HY_RAWROW + 16 + 2 * t)); }
__device__ __forceinline__ unsigned hilo_pack(float x0, float x1, unsigned& lo) {
    const unsigned h0 = f2bf(x0), h1 = f2bf(x1); lo = f2bf(x0 - __uint_as_float(h0 << 16)) | (f2bf(x1 - __uint_as_float(h1 << 16)) << 16); return h0 | (h1 << 16);
}
__device__ __forceinline__ void hy_filter_gen4(Frame& F, int l, int c0, LAS unsigned char* kf0, float* tap2, LAS float* red) {
    int lane_ = F.lane; asm volatile("" : "+v"(lane_)); const int lane = lane_; const int fr = lane & 15, fq = lane >> 4, w = F.wave;
    const float* dec = F.inp(21) + (size_t)l * HYF;
    const bf16* H2H = (const bf16*)(F.ws + WS_H2 + (size_t)l * 512 * 1024); const bf16* H2L = H2H + SEQ * HYN;
    bf16x8 ah[2], al[2];
    { const int ch = c0 + (F.G) * (fr >> 2), f4 = fr & 3, col = (f4 >> 1) * 2 * HYW + (f4 & 1) * HYW + ch;
      const bf16* whi = (const bf16*)(F.ws + WS_W3T + (size_t)l * MiB) + (size_t)col * HYN; const bf16* wlo = whi + (size_t)HYF * HYN;
#pragma unroll
      for (int ks = 0; ks < 2; ++ks) { ah[ks] = *(const bf16x8*)(whi + 32 * ks + 8 * fq); al[ks] = *(const bf16x8*)(wlo + 32 * ks + 8 * fq); } }
    float dk[4];
#pragma unroll
    for (int r = 0; r < 4; ++r) dk[r] = fabsf(dec[(r >> 1) * 2 * HYW + (r & 1) * HYW + c0 + F.G * fq]);
    LAS float* stg = (LAS float*)(kf0 + (fq & 1) * HY_KFCH); float* tg = tap2 + (size_t)(fq & 1) * 4 * SEQ;
    float ss0 = 0.f, ss1 = 0.f;
#pragma unroll 1
    for (int tb = 0; tb < 2; ++tb) {
        bf16x8 bh[8][2], bl[8][2];
#pragma unroll
        for (int u = 0; u < 8; ++u)
#pragma unroll
            for (int ks = 0; ks < 2; ++ks) { const size_t off = (size_t)(256 * w + 128 * tb + 16 * u + fr) * HYN + 32 * ks + 8 * fq; bh[u][ks] = *(const bf16x8*)(H2H + off); bl[u][ks] = *(const bf16x8*)(H2L + off); }
#pragma unroll
        for (int u = 0; u < 8; ++u) { const int t = 256 * w + 128 * tb + 16 * u + fr; f32x4 acc = {0.f, 0.f, 0.f, 0.f};
#pragma unroll
            for (int ks = 0; ks < 2; ++ks) { acc = __builtin_amdgcn_mfma_f32_16x16x32_bf16(ah[ks], bh[u][ks], acc, 0, 0, 0); acc = __builtin_amdgcn_mfma_f32_16x16x32_bf16(ah[ks], bl[u][ks], acc, 0, 0, 0); acc = __builtin_amdgcn_mfma_f32_16x16x32_bf16(al[ks], bh[u][ks], acc, 0, 0, 0); }
            const float tn = (float)t * (1.0f / (float)(SEQ - 1));
#pragma unroll
            for (int r = 0; r < 4; ++r) { const float v = acc[r] * (__expf(-tn * dk[r]) + 0.05f);
                if (fq < 2) stg[r * SEQ + t] = v; else tg[(size_t)r * SEQ + t] = v;
                const float sq = ((r & 1) && t == 0) ? 0.f : v * v; if (r < 2) ss0 += sq; else ss1 += sq; } }
    }
#pragma unroll
    for (int o = 1; o < 16; o <<= 1) { ss0 += __shfl_xor(ss0, o); ss1 += __shfl_xor(ss1, o); }
    if (fr == 0) { red[2 * fq] = ss0; red[2 * fq + 1] = ss1; }
}
__device__ __forceinline__ void hy_filter_fft(Frame& F, int l, int c, LAS unsigned char* kfch, const LAS float* red4, LAS float* wx) {
    int lane_ = F.lane; asm volatile("" : "+v"(lane_)); const int lane = lane_; const LAS float* stg = (const LAS float*)kfch;
    float re[64], im[64];
#pragma unroll
    for (int n1 = 0; n1 < 32; ++n1) { re[n1] = stg[64 * n1 + lane]; im[n1] = stg[2 * SEQ + 64 * n1 + lane]; }
#pragma unroll
    for (int n1 = 32; n1 < 64; ++n1) { const int t = 64 * (64 - n1) - lane; float a = stg[SEQ + t], b = stg[3 * SEQ + t]; if (n1 == 32 && lane == 0) { a = 0.f; b = 0.f; } re[n1] = a; im[n1] = b; }
    float s0 = 0.f, s1 = 0.f;
#pragma unroll
    for (int w = 0; w < 8; ++w) { s0 += red4[8 * w]; s1 += red4[8 * w + 1]; }
    const float sc = 1.0f / 4096.0f; const float n0 = 0.5f * sc / sqrtf(s0 + 1e-6f), n1s = 0.5f * sc / sqrtf(s1 + 1e-6f);
    const float d0 = F.inp(22)[(size_t)l * 2 * HYW + c] * sc, d1 = F.inp(22)[(size_t)l * 2 * HYW + HYW + c] * sc;
    asm volatile("s_waitcnt lgkmcnt(0)" ::: "memory");
    wfft_fwd(re, im, wx, lane);
    const int k1 = rev6(lane), lc = rev6((64 - k1) & 63);
    LAS f32x2* kf0 = (LAS f32x2*)kfch + k1; LAS f32x2* kf1 = (LAS f32x2*)(kfch + HY_KFO) + k1;
#pragma unroll
    for (int k0 = 0; k0 <= 32; ++k0) { const int s = rev6(k0), sm = rev6(63 - k0), sz = rev6((64 - k0) & 63);
        float pr = __shfl(re[sm], lc), pi = __shfl(im[sm], lc); if (lane == 0) { pr = re[sz]; pi = im[sz]; }
        const float zr = re[s], zi = im[s];
        kf0[k0 * 64] = (f32x2){(zr + pr) * n0 + d0, (zi - pi) * n0};
        kf1[k0 * 64] = (f32x2){(zi + pi) * n1s + d1, -(zr - pr) * n1s}; if ((k0 & 3) == 3) __builtin_amdgcn_sched_barrier(0); }
}
__device__ __forceinline__ void hy_wave_main(Frame& F, int l, int c, int ws, LAS unsigned char* wxb, LAS unsigned char* kfch, Stage2& pre, bool dry = false) {
    int lane_ = F.lane; asm volatile("" : "+v"(lane_)); const int lane = lane_; LAS float* wx = (LAS float*)wxb;
    const size_t rowoff = (size_t)c * M + (size_t)(2 * ws) * SEQ;
    const bf16* PV = (const bf16*)(F.ws + WS_R1) + rowoff; const bf16* PX1 = (const bf16*)(F.ws + WS_R2) + rowoff; const bf16* PX2 = (const bf16*)(F.ws + WS_R3) + rowoff;
    const bf16* GH = (const bf16*)(F.ws + WS_R4) + rowoff; bf16* OUT = (bf16*)(F.ws + WS_R1) + rowoff;
    const float* cw = F.inp(13) + (size_t)l * 3 * 3 * HYW; const float* cb = F.inp(14) + (size_t)l * 3 * HYW;
    float re[64], im[64];
    hy_commit2(pre, wxb, lane);
    hy_load2a(pre, PX1, lane);
    { const float w0 = cw[c], w1 = cw[3 * HYW + c], w2 = cw[6 * HYW + c], b = cb[c];
#pragma unroll
      for (int n1 = 0; n1 < 32; ++n1) { const int t = 64 * n1 + lane;
          re[n1] = b + w0 * raw2(wxb, 0, t - 1) + w1 * raw2(wxb, 0, t) + w2 * raw2(wxb, 0, t + 1);
          im[n1] = b + w0 * raw2(wxb, 1, t - 1) + w1 * raw2(wxb, 1, t) + w2 * raw2(wxb, 1, t + 1); if ((n1 & 3) == 3) __builtin_amdgcn_sched_barrier(0); } }
#pragma unroll 1
    for (int o = 0; o < 2; ++o) {
        int lane_o = F.lane; asm volatile("" : "+v"(lane_o));
        const int lane = lane_o; const int k1 = rev6(lane);
#pragma unroll
        for (int n1 = 32; n1 < 64; ++n1) { re[n1] = 0.f; im[n1] = 0.f; }
        asm volatile("s_waitcnt lgkmcnt(0)" ::: "memory");
        wfft_fwd(re, im, wx, lane);
        { const LAS unsigned char* bd = kfch + o * HY_KFO + k1 * 8; const LAS unsigned char* bm = kfch + o * HY_KFO + ((k1 ? 0 : 64) + ((64 - k1) & 63)) * 8;
#pragma unroll
          for (int s = 0; s < 64; ++s) { const int k0 = rev6(s);
              if (k0 < 32) { const f32x2 kv = *(const LAS f32x2*)(bd + k0 * 512); const float tr = re[s] * kv.x - im[s] * kv.y, ti = re[s] * kv.y + im[s] * kv.x; re[s] = tr; im[s] = ti; }
              else { const f32x2 kv = *(const LAS f32x2*)(bm + (63 - k0) * 512); const float tr = re[s] * kv.x + im[s] * kv.y, ti = im[s] * kv.x - re[s] * kv.y; re[s] = tr; im[s] = ti; }
              if ((s & 7) == 7) __builtin_amdgcn_sched_barrier(0); } }
        __builtin_amdgcn_sched_barrier(0);
        wfft_inv(re, im, wx, lane);
        hy_load2b(pre, o == 0 ? PX1 : PX2, lane); hy_commit2(pre, wxb, lane);
        { const int xo = (o + 1) * HYW + c; const float w0 = cw[xo], w1 = cw[3 * HYW + xo], w2 = cw[6 * HYW + xo], b = cb[xo];
#pragma unroll
          for (int n1 = 0; n1 < 32; ++n1) { const int t = 64 * n1 + lane;
              const float g0 = b + w0 * raw2(wxb, 0, t - 1) + w1 * raw2(wxb, 0, t) + w2 * raw2(wxb, 0, t + 1);
              const float g1 = b + w0 * raw2(wxb, 1, t - 1) + w1 * raw2(wxb, 1, t) + w2 * raw2(wxb, 1, t + 1);
              re[n1] *= g0; im[n1] *= g1; if ((n1 & 3) == 3) __builtin_amdgcn_sched_barrier(0); } }
        hy_load2a(pre, o == 0 ? PX2 : GH, lane);
    }
    int lane_g = F.lane; asm volatile("" : "+v"(lane_g));
    hy_load2b(pre, GH, lane_g); hy_commit2(pre, wxb, lane_g);
    if (!dry)
#pragma unroll
    for (int n1 = 0; n1 < 32; ++n1) { const int t = 64 * n1 + lane_g; const float g0 = raw2(wxb, 0, t), g1 = raw2(wxb, 1, t);
        OUT[t] = (bf16)f2bf(re[n1] * g0 * fast_sigmoid(g0)); OUT[SEQ + t] = (bf16)f2bf(im[n1] * g1 * fast_sigmoid(g1)); if ((n1 & 3) == 3) __builtin_amdgcn_sched_barrier(0); }
    asm volatile("s_waitcnt lgkmcnt(0)" ::: "memory");
}
__device__ __forceinline__ void hy_quad(Frame& F, int l, int c0) {
    const int grp = F.wave >> 2, ws = F.wave & 3;
    LAS unsigned char* wxb = F.lds + HY_WX + F.wave * HY_WXB;
    LAS unsigned char* kf0 = F.lds + HY_KF; LAS unsigned char* kfch = kf0 + grp * HY_KFCH;
    LAS float* red = (LAS float*)(F.lds + HY_RED);
    float* tap2 = (float*)(F.ws + WS_R6) + (size_t)F.bx * 2 * 4 * SEQ;
    hy_filter_gen4(F, l, c0, kf0, tap2, red + 8 * F.wave);
    VM_WAIT(); LDS_WAIT(); __syncthreads();
#pragma unroll 1
    for (int rnd = 0; rnd < 2; ++rnd) {
        const int c = c0 + F.G * (2 * rnd + grp);
        if (rnd == 1) {
            const int t_ = F.wave * 64 + cur_lane();
#pragma unroll
            for (int i = 0; i < 8; ++i) { const int q = t_ + 512 * i;
                const v4u v = *(const GAS v4u*)(tap2 + 4 * (size_t)q); *(LAS v4u*)(kf0 + (q >> 11) * HY_KFCH + 16 * (q & 2047)) = v; }
            LDS_WAIT(); __syncthreads();
        }
        Stage2 pre;
        if (ws == 0) hy_filter_fft(F, l, c, kfch, red + 2 * (2 * rnd + grp), (LAS float*)wxb);
        hy_load2(pre, (const bf16*)(F.ws + WS_R1) + (size_t)c * M + (size_t)(2 * ws) * SEQ, F.lane);
        LDS_WAIT(); __syncthreads();
        hy_wave_main(F, l, c, ws, wxb, kfch, pre);
        LDS_WAIT(); __syncthreads();
    }
}

__device__ __forceinline__ void transpose_pass(Frame& F) {
    const bf16* src = (const bf16*)(F.ws + WS_R1); bf16* dst = (bf16*)(F.ws + WS_R2);
    LAS unsigned char* tile = F.lds + F.wave * 9216; const int lane = F.lane;
    const int gw = F.bx * NWAVES + F.wave, NGW = F.G * NWAVES;
    constexpr int NTC = HYW / 64, NTT = M / 64;
    for (int it = gw; it < NTC * NTT; it += NGW) { const int c0 = (it % NTC) * 64, t0 = (it / NTC) * 64;
#pragma unroll
        for (int i = 0; i < 8; ++i) { const int q = lane + 64 * i, cr = q >> 3, ch = q & 7;
            const v4u v = *(const GAS v4u*)(src + (size_t)(c0 + cr) * M + t0 + 8 * ch); *(LAS v4u*)(tile + cr * 144 + 16 * ch) = v; }
        LDS_WAIT(); asm volatile("" ::: "memory");
#pragma unroll
        for (int i = 0; i < 8; ++i) { const int q = lane + 64 * i, tr = q >> 3, ch = q & 7;
            unsigned short e[8];
#pragma unroll
            for (int k = 0; k < 8; ++k) e[k] = *(const LAS unsigned short*)(tile + (8 * ch + k) * 144 + 2 * tr);
            v4u o; o.x = e[0] | ((unsigned)e[1] << 16); o.y = e[2] | ((unsigned)e[3] << 16); o.z = e[4] | ((unsigned)e[5] << 16); o.w = e[6] | ((unsigned)e[7] << 16);
            *(GAS v4u*)(dst + (size_t)(t0 + tr) * HYW + c0 + 8 * ch) = o; }
        LDS_WAIT(); asm volatile("" ::: "memory");
    }
}
__device__ __forceinline__ void final_norm(Frame& F) {
    const int gw = F.bx * NWAVES + F.wave, NGW = F.G * NWAVES, lane = F.lane; const GAS f32x4* wv = (const GAS f32x4*)F.inp(26) + lane;
    f32x4 w[4];
#pragma unroll
    for (int j = 0; j < 4; ++j) w[j] = wv[64 * j];
    for (int m = gw; m < M; m += NGW) { GAS f32x4* xr = (GAS f32x4*)(F.out + (size_t)m * D) + lane; f32x4 v[4]; float s = 0.f;
#pragma unroll
        for (int j = 0; j < 4; ++j) { v[j] = xr[64 * j]; s += (v[j].x * v[j].x + v[j].y * v[j].y) + (v[j].z * v[j].z + v[j].w * v[j].w); }
        const float rs = 1.0f / sqrtf(wave_sum(s) * (1.0f / D) + 1e-6f);
#pragma unroll
        for (int j = 0; j < 4; ++j) xr[64 * j] = v[j] * rs * w[j]; }
}

struct Args { const float* in[27]; float* out; unsigned char* ws; int ph_lo, ph_hi; };
__global__ void __launch_bounds__(NTHREADS, 2) mk_fwd(Args args) {
    extern __shared__ __attribute__((aligned(16))) unsigned char lds[];
    Frame F; F.lds = (LAS unsigned char*)lds; F.wave = __builtin_amdgcn_readfirstlane(threadIdx.x >> 6); F.tid = 0; F.lane = 0; F.G = gridDim.x; F.bx = blockIdx.x;
    F.out = args.out; F.ws = args.ws;
    volatile LAS unsigned* MISC = (volatile LAS unsigned*)(F.lds + LDSCTL_OFF);
    if (threadIdx.x < 64) MISC[threadIdx.x] = 0u;
    if (threadIdx.x == 64) { LAS unsigned long long* tab = (LAS unsigned long long*)(F.lds + LDSCTL_OFF + 256);
#pragma unroll
        for (int i = 0; i < 27; ++i) tab[i] = (unsigned long long)args.in[i]; }
    __syncthreads();
    XcdBarrier bar; bar.bar = (unsigned*)(F.ws + WS_CTL) + 1024; bar.x = 0; bar.st = nullptr;
    if (!MK_PER_PHASE) bar = xcd_barrier_post((unsigned*)(F.ws + WS_CTL) + 1024, MISC + 8, threadIdx.x == 0);
    const int lo = args.ph_lo, hi = args.ph_hi;
#define IN(k) (lo <= (k) && (k) < hi)
#if defined(MK_TIMING)
    unsigned long long* TS = (unsigned long long*)(F.ws + WS_CTL + 32768);
#define STAMP(k) do { if (blockIdx.x == 0 && threadIdx.x == 0) __hip_atomic_store(&TS[k], (unsigned long long)__builtin_amdgcn_s_memrealtime(), __ATOMIC_RELAXED, __HIP_MEMORY_SCOPE_AGENT); } while (0)
#else
#define STAMP(k) do { } while (0)
#endif
#define SEAM(k) do { if (IN(k) && IN((k) + 1)) xcd_barrier(bar, F.wave); STAMP((k) + 1); } while (0)
    LAS unsigned char* ring = F.lds;
    STAMP(0);
#ifndef MK_ONLY
#define MK_ONLY -1
#endif
#define ON(k) (MK_ONLY < 0 || MK_ONLY == (k))
#define FRAME_P0(Fp) Frame Fp = F; { int l_ = cur_lane(); asm volatile("" : "+v"(l_)); Fp.lane = l_; Fp.tid = F.wave * 64 + l_; Fp.ws = wsl; }
#ifndef MK_REP0
#define MK_REP0 1
#endif
#pragma unroll 1
    for (int rep0 = 0; rep0 < MK_REP0; ++rep0)
    if (ON(0) && IN(0)) { unsigned char* wsl = F.ws; FRAME_P0(Fp); p0_prologue(Fp); }
    SEAM(0);
#pragma unroll 1
    for (int l = 0; l < DEPTH; ++l) {
        const int pb = 1 + 5 * l;
        unsigned char* wsl = F.ws; asm volatile("" : "+s"(wsl));
#define WSL(off) (wsl + (off))
#define OPQ(p) asm volatile("" : "+s"(p))
#define FRAME_P(Fp) Frame Fp = F; { int l_ = cur_lane(); asm volatile("" : "+v"(l_)); Fp.lane = l_; Fp.tid = F.wave * 64 + l_; Fp.ws = wsl; }
        bf16* wl = (bf16*)WSL(WS_W + (size_t)l * W_LAYER);
        bf16* X = (bf16*)WSL(WS_X); float* ssq = (float*)WSL(WS_SSQ);
        bf16 *R1 = (bf16*)WSL(WS_R1), *R2 = (bf16*)WSL(WS_R2), *R3 = (bf16*)WSL(WS_R3), *R5 = (bf16*)WSL(WS_R5), *R6 = (bf16*)WSL(WS_R6);
#ifndef MK_REP1
#define MK_REP1 1
#define MK_REP12 1
#define MK_REP3 1
#define MK_REP4 1
#endif
#pragma unroll 1
        for (int rep12 = 0; rep12 < MK_REP12; ++rep12) {
#pragma unroll 1
        for (int rep1 = 0; rep1 < MK_REP1; ++rep1)
        if (ON(1) && IN(pb)) {
            { pg8::Gemm g{wl + W_IN / 2, X, 4096, M, D, D, D}; pg8::StaticOrder S; S.init(4096, M, F.G, F.bx); pg8::EpiHT E{R1, M, ssq};
              pg8::gemm_phase<pg8::EpiHT, pg8::StaticOrder, true, true, 1024, 1024, 1024>(ring, g, S, E, F.wave); }
            OPQ(X); OPQ(wl);
            { pg8::Gemm g{X, wl + W_IN / 2 + (size_t)4096 * D, M, 1024, D, D, D}; pg8::StaticOrder S; S.init(M, 1024, F.G, F.bx); pg8::EpiRow<0> E{R5, 1024, ssq};
              pg8::gemm_phase<pg8::EpiRow<0>, pg8::StaticOrder, true, true, 1024, 1024, 1024>(ring, g, S, E, F.wave); }
        }
        SEAM(pb);
        if (IN(pb + 1)) {
#if defined(MK_S5DRY)
            if (ON(2)) { FRAME_P(Fq); for (int it = F.bx; it < BATCH * S5G; it += F.G) s5_item(Fq, l, it / S5G, it % S5G, true); }
#endif
            if (ON(2)) { FRAME_P(Fp); for (int it = F.bx; it < BATCH * S5G; it += F.G) s5_item(Fp, l, it / S5G, it % S5G); }
            if (ON(3)) { FRAME_P(Fp); if (4 * F.G == HYW) hy_quad(Fp, l, F.bx); }
        }
        if (rep12 + 1 < MK_REP12) xcd_barrier(bar, F.wave);
        }
        SEAM(pb + 1);
#pragma unroll 1
        for (int rep3 = 0; rep3 < MK_REP3; ++rep3)
        if (ON(4) && IN(pb + 2)) {
            { pg8::Gemm g{X, wl + W_IN / 2 + (size_t)5120 * D, M, 2048, D, D, D}; pg8::StaticOrder S; S.init(M, 2048, F.G, F.bx); pg8::EpiRow<1> E{R3, 2048, ssq};
              pg8::gemm_phase<pg8::EpiRow<1>, pg8::StaticOrder, true, true, 1024, 1024, 1024>(ring, g, S, E, F.wave); }
            OPQ(R5); OPQ(wl);
            { pg8::Gemm g{R5, wl + W_GLU / 2, M, S5W, S5W, 1024, S5W}; pg8::StaticOrder S; S.init(M, S5W, F.G, F.bx); pg8::EpiGLU E{R6, S5W, R5, 1024, F.inp(12) + l * S5W};
              pg8::gemm_phase<pg8::EpiGLU, pg8::StaticOrder, true, true, 512, 1024, 512>(ring, g, S, E, F.wave); }
            __syncthreads();
            { FRAME_P(Fp); transpose_pass(Fp); }
            __syncthreads();
        }
        SEAM(pb + 2);
#pragma unroll 1
        for (int rep4 = 0; rep4 < MK_REP4; ++rep4)
        if (ON(5) && IN(pb + 3)) {
            { pg8::Gemm g{R6, wl + W_BS5 / 2, M, D, S5W, S5W, S5W}; pg8::StaticOrder S; S.init(M, D, F.G, F.bx); pg8::EpiMerge<0> E{R1, D, R3, 2048, 0};
              pg8::gemm_phase<pg8::EpiMerge<0>, pg8::StaticOrder, true, true, 512, 512, 512>(ring, g, S, E, F.wave); }
            VM_WAIT(); __syncthreads();
            OPQ(R2); OPQ(wl);
            { pg8::Gemm g{R2, wl + W_BHY / 2, M, D, HYW, HYW, HYW}; pg8::StaticOrder S; S.init(M, D, F.G, F.bx); pg8::EpiMerge<1> E{R1, D, R3, 2048, 1024};
              pg8::gemm_phase<pg8::EpiMerge<1>, pg8::StaticOrder, true, true, 1024, 1024, 1024>(ring, g, S, E, F.wave); }
        }
        SEAM(pb + 3);
        if (ON(6) && IN(pb + 4)) {
            pg8::Gemm g{R1, wl + W_OUT / 2, M, D, D, D, D}; pg8::StaticOrder S; S.init(M, D, F.G, F.bx); pg8::EpiOut E{l == 0 ? F.inp(0) : (const float*)F.out, F.out, X, ssq, l == DEPTH - 1};
            pg8::gemm_phase<pg8::EpiOut, pg8::StaticOrder, true, true, 1024, 1024, 1024>(ring, g, S, E, F.wave);
        }
        SEAM(pb + 4);
    }
    if (ON(7) && IN(11)) { unsigned char* wsl = F.ws; FRAME_P0(Fp); final_norm(Fp); }
#if defined(MK_TIMING)
    xcd_barrier(bar, F.wave); STAMP(12); xcd_barrier(bar, F.wave);
    { const unsigned long long a0 = __hip_atomic_load(&TS[MK_TA0], __ATOMIC_RELAXED, __HIP_MEMORY_SCOPE_AGENT), a1 = __hip_atomic_load(&TS[MK_TA1], __ATOMIC_RELAXED, __HIP_MEMORY_SCOPE_AGENT);
      const unsigned long long b0 = __hip_atomic_load(&TS[MK_TB0], __ATOMIC_RELAXED, __HIP_MEMORY_SCOPE_AGENT), b1 = __hip_atomic_load(&TS[MK_TB1], __ATOMIC_RELAXED, __HIP_MEMORY_SCOPE_AGENT);
      const float ta = (float)(a1 - a0) * 0.01f, tb = (float)(b1 - b0) * 0.01f;
      const float c = sqrtf(ta * 0.1f);
      for (size_t i = (size_t)blockIdx.x * NTHREADS + threadIdx.x; i < (size_t)M * D; i += (size_t)gridDim.x * NTHREADS) F.out[i] = (i == 0) ? tb : c; }
#endif
#undef IN
#undef SEAM
}

#if defined(MK_DEBUG_HASH)
extern "C" void kernel_launch_dbg(void* const* d_in, void* d_out, void* d_ws, hipStream_t stream, int grid);
#endif
extern "C" void kernel_launch(void* const* d_in, const int* in_sizes, int n_in, void* d_out, int out_size, void* d_ws, size_t ws_size, hipStream_t stream) {
    static int grid = 0;
    if (grid == 0) {
        if (n_in != 27 || out_size != M * D || ws_size < WS_END) { fprintf(stderr, "kernel_launch: unexpected shapes (n_in %d out %d ws %zu)\n", n_in, out_size, ws_size); grid = -1; return; }
        int dev = 0, cus = 0, per_cu = 0;
        if (hipGetDevice(&dev) != hipSuccess || hipDeviceGetAttribute(&cus, hipDeviceAttributeMultiprocessorCount, dev) != hipSuccess) { grid = -1; return; }
        if (hipFuncSetAttribute((const void*)mk_fwd, hipFuncAttributeMaxDynamicSharedMemorySize, LDS_BYTES) != hipSuccess) { fprintf(stderr, "kernel_launch: hipFuncSetAttribute failed\n"); grid = -1; return; }
        if (hipOccupancyMaxActiveBlocksPerMultiprocessor(&per_cu, (const void*)mk_fwd, NTHREADS, LDS_BYTES) != hipSuccess || per_cu < 1) fprintf(stderr, "kernel_launch: occupancy query says %d\n", per_cu);
        (void)hipGetLastError();
        grid = cus;
    }
    if (grid < 0) return;
    (void)hipMemsetAsync((char*)d_ws + WS_CTL, 0, CTL_ZERO_BYTES, stream);
    Args a{};
    for (int i = 0; i < 27; ++i) a.in[i] = (const float*)d_in[i];
    a.out = (float*)d_out; a.ws = (unsigned char*)d_ws;
#if defined(MK_DEBUG_HASH)
    kernel_launch_dbg(d_in, d_out, d_ws, stream, grid);
#elif MK_PER_PHASE
    for (int p = 0; p < NPHASE; ++p) { a.ph_lo = p; a.ph_hi = p + 1; hipLaunchKernelGGL(mk_fwd, dim3(grid), dim3(NTHREADS), LDS_BYTES, stream, a); }
#else
    a.ph_lo = 0; a.ph_hi = NPHASE; hipLaunchKernelGGL(mk_fwd, dim3(grid), dim3(NTHREADS), LDS_BYTES, stream, a);
#endif
}

#if defined(MK_DEBUG_HASH)
__global__ void dbg_hash(const unsigned* p, size_t nwords, unsigned long long* out) {
    unsigned long long s = 0; for (size_t i = (size_t)blockIdx.x * blockDim.x + threadIdx.x; i < nwords; i += (size_t)gridDim.x * blockDim.x) s += p[i];
    atomicAdd(out, s);
}
__global__ void dbg_report(const unsigned long long* h, float* out, size_t n) {
    int first = -1; for (int p = 0; p < NPHASE && first < 0; ++p) for (int r = 0; r < 4; ++r) if (h[p * 4 + r] != h[NPHASE * 4 + p * 4 + r]) { first = p; break; }
    const float c = first < 0 ? 0.f : sqrtf((float)(first + 1));
    for (size_t i = (size_t)blockIdx.x * blockDim.x + threadIdx.x; i < n; i += (size_t)gridDim.x * blockDim.x) out[i] = c;
}
extern "C" void kernel_launch_dbg(void* const* d_in, void* d_out, void* d_ws, hipStream_t stream, int grid) {
    Args a{}; for (int i = 0; i < 27; ++i) a.in[i] = (const float*)d_in[i];
    a.out = (float*)d_out; a.ws = (unsigned char*)d_ws;
    unsigned long long* H = (unsigned long long*)((char*)d_ws + 253 * MiB);
    (void)hipMemsetAsync(H, 0, 2 * NPHASE * 4 * 8, stream);
    struct Reg { size_t off, len; bool out; };
    auto regs_of = [&](int p, Reg (&r)[4]) { for (int i = 0; i < 4; ++i) r[i] = Reg{0, 0, false};
        if (p == 0) { r[0] = Reg{1 * MiB, 1 * MiB, false}; r[1] = Reg{2 * MiB, 1 * MiB + 64 * 1024, false}; r[2] = Reg{4 * MiB, 39 * MiB, false}; r[3] = Reg{43 * MiB, 33 * MiB, false}; return; }
        if (p == 11) { r[0] = Reg{0, (size_t)M * D * 4, true}; return; }
        const int q = (p - 1) % 5;
        if (q == 0) { r[0] = Reg{WS_R1, 128 * MiB, false}; r[1] = Reg{WS_R5, 32 * MiB, false}; }
        if (q == 1) { r[0] = Reg{WS_R1, 32 * MiB, false}; r[1] = Reg{WS_R5, 32 * MiB, false}; }
        if (q == 2) { r[0] = Reg{WS_R3, 64 * MiB, false}; r[1] = Reg{WS_R6, 16 * MiB, false}; r[2] = Reg{WS_R2, 32 * MiB, false}; }
        if (q == 3) { r[0] = Reg{WS_R1, 32 * MiB, false}; }
        if (q == 4) { r[0] = Reg{0, (size_t)M * D * 4, true}; r[1] = Reg{WS_X, 32 * MiB, false}; r[2] = Reg{WS_SSQ, 1 * MiB, false}; } };
    for (int run = 0; run < 2; ++run) {
        if (run == 0) (void)hipMemsetAsync((char*)d_ws + 1 * MiB, 0xAA, 251 * MiB, stream);
        (void)hipMemsetAsync((char*)d_ws + WS_CTL, 0, CTL_ZERO_BYTES, stream);
        for (int p = 0; p < NPHASE; ++p) { a.ph_lo = p; a.ph_hi = p + 1; hipLaunchKernelGGL(mk_fwd, dim3(grid), dim3(NTHREADS), LDS_BYTES, stream, a);
            Reg r[4]; regs_of(p, r);
            for (int i = 0; i < 4; ++i) if (r[i].len) hipLaunchKernelGGL(dbg_hash, dim3(1024), dim3(256), 0, stream, (const unsigned*)((r[i].out ? (char*)d_out : (char*)d_ws) + r[i].off), r[i].len / 4, H + (run * NPHASE + p) * 4 + i); }
    }
    hipLaunchKernelGGL(dbg_report, dim3(1024), dim3(256), 0, stream, H, (float*)d_out, (size_t)M * D);
}
#endif
```

```cpp
#include <hip/hip_runtime.h>
#include <cstdio>
#include <cstdint>
#include <cmath>
#include <utility>
namespace pg8 {
#define PG8_LAS __attribute__((address_space(3)))
typedef unsigned short bf16_t;
typedef short bf16x8 __attribute__((ext_vector_type(8)));
typedef float f32x4 __attribute__((ext_vector_type(4)));
typedef unsigned u32x4 __attribute__((ext_vector_type(4)));
constexpr int BM = 256, BK = 64, HALF = 128, HTB = HALF * BK * 2  , STAGE_BYTES = 8 * HTB, NXCD = 8, WGM = 8;

__host__ __device__ __forceinline__ int lds_byte(int r, int c) { const int st = (r >> 4) * 2 + (c >> 5), rr = r & 15, cc = c & 31, ob = rr * 64 + cc * 2; return st * 1024 + (ob ^ (((ob >> 9) & 1) << 5)); }
__host__ __device__ __forceinline__ void stage_rc(int b, int& R, int& C) { const int st = b / 1024, sb = b % 1024, swz = sb ^ (((sb >> 9) & 1) << 5); R = (st >> 1) * 16 + swz / 64; C = (st & 1) * 32 + (swz % 64) / 2; }
__host__ __device__ __forceinline__ int perm32(int rho) { const int n = rho >> 4, i = rho & 15; return 8 * (i >> 2) + 4 * n + (i & 3); }

struct Unit { int pm, pn; };
struct Gemm { const bf16_t* A; const bf16_t* Bt; int M, N, K, lda, ldb; };

struct StaticOrder {
    int nM, nN, nwg, G, c;
    __host__ __device__ void init(int M, int N, int G_, int c_) { nM = M / BM; nN = N / BM; nwg = nM * nN; G = G_; c = c_; }
    __host__ __device__ bool next(int i, Unit& u) const {
        const long L = (long)i * G + c; if (L >= nwg) return false;
        int wgid = (int)L; { const int q = nwg / NXCD, r = nwg % NXCD, xcd = wgid % NXCD, off = wgid / NXCD; wgid = (xcd < r ? xcd * (q + 1) : r * (q + 1) + (xcd - r) * q) + off; }
        const int nig = WGM * nN, gid = wgid / nig, fm = gid * WGM, gsz = (nM - fm) < WGM ? (nM - fm) : WGM;
        u.pm = fm + ((wgid % nig) % gsz); u.pn = (wgid % nig) / gsz; return true;
    }
    __device__ __forceinline__ void a_ready(const Unit&) const {}
    __device__ __forceinline__ void done(const Unit&) const {}
};

typedef unsigned u32x2 __attribute__((ext_vector_type(2)));

typedef __bf16 bf16x2_t __attribute__((ext_vector_type(2)));
typedef float f32x2_t __attribute__((ext_vector_type(2)));
__device__ __forceinline__ unsigned cvt_pk_bf16(float lo, float hi) { const f32x2_t v = {lo, hi}; const bf16x2_t b = __builtin_convertvector(v, bf16x2_t); return __builtin_bit_cast(unsigned, b); }
__device__ __forceinline__ float bf_lo(unsigned w) { return __uint_as_float(w << 16); }
__device__ __forceinline__ float bf_hi(unsigned w) { return __uint_as_float(w & 0xffff0000u); }
__device__ __forceinline__ float fast_sigmoid(float x) { return __builtin_amdgcn_rcpf(1.0f + __builtin_amdgcn_exp2f(-1.4426950408889634f * x)); }
constexpr float RMS_EPS = 1e-6f;
#define GAS_ __attribute__((address_space(1)))
__device__ __forceinline__ float rs_of(const float* ssq, int tok) {
    const GAS_ f32x4* p = (const GAS_ f32x4*)(ssq + (size_t)tok * 16); const f32x4 a = p[0], b = p[1], c = p[2], d = p[3];
    const float s = ((a[0] + a[1]) + (a[2] + a[3])) + ((b[0] + b[1]) + (b[2] + b[3])) + ((c[0] + c[1]) + (c[2] + c[3])) + ((d[0] + d[1]) + (d[2] + d[3]));
    return 1.0f / sqrtf(s * (1.0f / 1024.0f) + RMS_EPS);
}
struct EpiHT {
    static constexpr bool PERM = true, AFTER_DRAIN = false;
    bf16_t* O; int ldc; const float* ssq;
    __device__ __forceinline__ void operator()(const f32x4 (&acc)[2][2][4][2], const Unit& u, int wr, int wc, int fr, int fq) const {
        const int lane = (fq << 4) | fr;
        const int ctile = u.pn * BM + wc * 32 + 8 * fq;
        const float mine = rs_of(ssq, ctile + 128 * (fr >> 3) + (fr & 7));
        const int row0 = u.pm * BM + wr * 64 + fr;
#pragma unroll
        for (int bj = 0; bj < 2; ++bj) { float rsv[8];
#pragma unroll
            for (int i = 0; i < 8; ++i) rsv[i] = __shfl(mine, (lane & 48) | (8 * bj + i));
#pragma unroll
            for (int ai = 0; ai < 2; ++ai)
#pragma unroll
                for (int m = 0; m < 4; ++m) { bf16_t* rowp = O + (size_t)(row0 + ai * HALF + m * 16) * ldc + ctile + bj * HALF;
                    const f32x4 v0 = acc[ai][bj][m][0], v1 = acc[ai][bj][m][1]; u32x4 w;
                    w.x = cvt_pk_bf16(v0[0] * rsv[0], v0[1] * rsv[1]); w.y = cvt_pk_bf16(v0[2] * rsv[2], v0[3] * rsv[3]);
                    w.z = cvt_pk_bf16(v1[0] * rsv[4], v1[1] * rsv[5]); w.w = cvt_pk_bf16(v1[2] * rsv[6], v1[3] * rsv[7]);
                    *(GAS_ u32x4*)rowp = w; }
            asm volatile("" ::: "memory"); }
    }
};
template <int SIG> struct EpiRow {
    static constexpr bool PERM = true, AFTER_DRAIN = false;
    bf16_t* O; int ldc; const float* ssq;
    __device__ __forceinline__ void operator()(const f32x4 (&acc)[2][2][4][2], const Unit& u, int wr, int wc, int fr, int fq) const {
        const int lane = (fq << 4) | fr;
        const int row0 = u.pm * BM + wr * 64 + fr;
        float mine[2];
#pragma unroll
        for (int i = 0; i < 2; ++i) { const int q = 2 * fq + i; mine[i] = rs_of(ssq, row0 + (q >> 2) * HALF + (q & 3) * 16); }
        const int col0 = u.pn * BM + wc * 32 + 8 * fq;
#pragma unroll
        for (int ai = 0; ai < 2; ++ai)
#pragma unroll
            for (int m = 0; m < 4; ++m) { const int q = ai * 4 + m; const float rs = __shfl(mine[q & 1], ((q >> 1) << 4) | (lane & 15));
                bf16_t* rowp = O + (size_t)(row0 + ai * HALF + m * 16) * ldc + col0;
#pragma unroll
                for (int bj = 0; bj < 2; ++bj) { f32x4 v0 = acc[ai][bj][m][0] * rs, v1 = acc[ai][bj][m][1] * rs;
                    if (SIG) {
#pragma unroll
                        for (int e = 0; e < 4; ++e) { v0[e] = fast_sigmoid(v0[e]); v1[e] = fast_sigmoid(v1[e]); } }
                    u32x4 w; w.x = cvt_pk_bf16(v0[0], v0[1]); w.y = cvt_pk_bf16(v0[2], v0[3]); w.z = cvt_pk_bf16(v1[0], v1[1]); w.w = cvt_pk_bf16(v1[2], v1[3]);
                    *(GAS_ u32x4*)(rowp + bj * HALF) = w; }
                asm volatile("" ::: "memory"); }
    }
};
struct EpiGLU {
    static constexpr bool PERM = true, AFTER_DRAIN = false;
    bf16_t* O; int ldc; const bf16_t* YG; int ldy; const float* bglu;
    __device__ __forceinline__ void operator()(const f32x4 (&acc)[2][2][4][2], const Unit& u, int wr, int wc, int fr, int fq) const {
        const int row0 = u.pm * BM + wr * 64 + fr, col0 = u.pn * BM + wc * 32 + 8 * fq;
        f32x4 bv[2][2];
#pragma unroll
        for (int bj = 0; bj < 2; ++bj)
#pragma unroll
            for (int n = 0; n < 2; ++n) bv[bj][n] = *(const GAS_ f32x4*)(bglu + col0 + bj * HALF + 4 * n);
#pragma unroll
        for (int ai = 0; ai < 2; ++ai)
#pragma unroll
            for (int m = 0; m < 4; ++m) { const size_t r = (size_t)(row0 + ai * HALF + m * 16);
#pragma unroll
                for (int bj = 0; bj < 2; ++bj) { const int c = col0 + bj * HALF;
                    const u32x4 yv = *(const GAS_ u32x4*)(YG + r * ldy + c), gv = *(const GAS_ u32x4*)(YG + r * ldy + 512 + c);
                    const f32x4 a0 = acc[ai][bj][m][0] + bv[bj][0], a1 = acc[ai][bj][m][1] + bv[bj][1];
                    float o[8]; const unsigned yw[4] = {yv.x, yv.y, yv.z, yv.w}, gw[4] = {gv.x, gv.y, gv.z, gv.w};
#pragma unroll
                    for (int e = 0; e < 8; ++e) { const float a = e < 4 ? a0[e & 3] : a1[e & 3]; const float y = (e & 1) ? bf_hi(yw[e >> 1]) : bf_lo(yw[e >> 1]);
                        const float g = (e & 1) ? bf_hi(gw[e >> 1]) : bf_lo(gw[e >> 1]); o[e] = y * fast_sigmoid(a) * (g * fast_sigmoid(g)); }
                    u32x4 w; w.x = cvt_pk_bf16(o[0], o[1]); w.y = cvt_pk_bf16(o[2], o[3]); w.z = cvt_pk_bf16(o[4], o[5]); w.w = cvt_pk_bf16(o[6], o[7]);
                    *(GAS_ u32x4*)(O + r * ldc + c) = w; asm volatile("" ::: "memory"); } }
    }
};
template <int ADD> struct EpiMerge {
    static constexpr bool PERM = true, AFTER_DRAIN = false;
    bf16_t* O; int ldc; const bf16_t* G; int ldg; int goff;
    __device__ __forceinline__ void operator()(const f32x4 (&acc)[2][2][4][2], const Unit& u, int wr, int wc, int fr, int fq) const {
        const int row0 = u.pm * BM + wr * 64 + fr, col0 = u.pn * BM + wc * 32 + 8 * fq;
#pragma unroll
        for (int ai = 0; ai < 2; ++ai)
#pragma unroll
            for (int m = 0; m < 4; ++m) { const size_t r = (size_t)(row0 + ai * HALF + m * 16);
#pragma unroll
                for (int bj = 0; bj < 2; ++bj) { const int c = col0 + bj * HALF;
                    const u32x4 gv = *(const GAS_ u32x4*)(G + r * ldg + goff + c); u32x4 tv = {0u, 0u, 0u, 0u}; if (ADD) tv = *(const GAS_ u32x4*)(O + r * ldc + c);
                    const f32x4 a0 = acc[ai][bj][m][0], a1 = acc[ai][bj][m][1];
                    float o[8]; const unsigned gw[4] = {gv.x, gv.y, gv.z, gv.w}, tw[4] = {tv.x, tv.y, tv.z, tv.w};
#pragma unroll
                    for (int e = 0; e < 8; ++e) { const float a = e < 4 ? a0[e & 3] : a1[e & 3]; const float g = (e & 1) ? bf_hi(gw[e >> 1]) : bf_lo(gw[e >> 1]);
                        const float t = (e & 1) ? bf_hi(tw[e >> 1]) : bf_lo(tw[e >> 1]); o[e] = (ADD ? t : 0.f) + g * a; }
                    u32x4 w; w.x = cvt_pk_bf16(o[0], o[1]); w.y = cvt_pk_bf16(o[2], o[3]); w.z = cvt_pk_bf16(o[4], o[5]); w.w = cvt_pk_bf16(o[6], o[7]);
                    *(GAS_ u32x4*)(O + r * ldc + c) = w; asm volatile("" ::: "memory"); } }
    }
};
struct EpiOut {
    static constexpr bool PERM = false, AFTER_DRAIN = false;
    const float* base; float* H; bf16_t* XN; float* ssq; int last;
    __device__ __forceinline__ void operator()(const f32x4 (&acc)[2][2][4][2], const Unit& u, int wr, int wc, int fr, int fq) const {
        const int row0 = u.pm * BM + wr * 64 + fr, col0 = u.pn * BM + wc * 32 + 4 * fq;
#pragma unroll
        for (int ai = 0; ai < 2; ++ai)
#pragma unroll
            for (int m = 0; m < 4; ++m) { const size_t r = (size_t)(row0 + ai * HALF + m * 16); float s = 0.f;
#pragma unroll
                for (int bj = 0; bj < 2; ++bj)
#pragma unroll
                    for (int n = 0; n < 2; ++n) { const size_t off = r * 1024 + col0 + bj * HALF + n * 16;
                        const f32x4 h = *(const GAS_ f32x4*)(base + off) + acc[ai][bj][m][n]; *(GAS_ f32x4*)(H + off) = h;
                        s += (h[0] * h[0] + h[1] * h[1]) + (h[2] * h[2] + h[3] * h[3]);
                        if (!last) { u32x2 w; w.x = cvt_pk_bf16(h[0], h[1]); w.y = cvt_pk_bf16(h[2], h[3]); *(GAS_ u32x2*)(XN + off) = w; } }
                s += __shfl_xor(s, 16); s += __shfl_xor(s, 32);
                if (fq == 0 && !last) ((GAS_ float*)ssq)[r * 16 + u.pn * 4 + wc] = s; }
    }
};
template <class Epi, class Sched, bool ALIGN_EPI, bool SP2, int KK, int LDA, int LDB>
__device__ __forceinline__ void gemm_phase(PG8_LAS unsigned char* lds, const Gemm g, const Sched& S, const Epi& E, int wave_id  ) {
    int lane_; asm volatile("v_mbcnt_lo_u32_b32 %0, -1, 0\n\tv_mbcnt_hi_u32_b32 %0, -1, %0" : "=&v"(lane_)); const int tid_ = wave_id * 64 + lane_;
    const int tid = tid_, wid = __builtin_amdgcn_readfirstlane(tid >> 6), lane = tid & 63, wr = wid >> 2, wc = wid & 3, fr = lane & 15, fq = lane >> 4;
    constexpr int K = KK, nt = K / BK;
    unsigned voffA[2], voffB[2];
#pragma unroll
    for (int i = 0; i < 2; ++i) { int R, C; stage_rc(tid * 16 + i * 8192, R, C); const int Rb = Epi::PERM ? ((R & ~31) + perm32(R & 31)) : R;
        voffA[i] = (unsigned)(R * LDA + C) * 2u; voffB[i] = (unsigned)(Rb * LDB + C) * 2u; }
    constexpr size_t kstep = (size_t)(BK * 2);
    constexpr size_t hstepA = (size_t)HALF * LDA * 2, hstepB = (size_t)HALF * LDB * 2;
    constexpr size_t tstepA = 2 * hstepA, tstepB = 2 * hstepB;
    const unsigned ldsw = (unsigned)wid * 1024u;
    const int aoff = lds_byte(wr * 64 + fr, fq * 8), boff = lds_byte(wc * 32 + fr, fq * 8);
#define PG8_SA(b, h) (((b) * 2 + (h)) * HTB)
#define PG8_SB(b, h) ((4 + (b) * 2 + (h)) * HTB)
#define PG8_STAGE(bufoff, gbase, voff) do { _Pragma("unroll") for (int _i = 0; _i < 2; ++_i) \
        __builtin_amdgcn_global_load_lds((const unsigned*)((const char*)(gbase) + (voff)[_i]), (PG8_LAS unsigned*)(lds + (bufoff) + ldsw + _i * 8192), 16, 0, 0); } while (0)
#define PG8_LDA(dst, b, h) do { _Pragma("unroll") for (int m = 0; m < 4; ++m) _Pragma("unroll") for (int k = 0; k < 2; ++k) dst[m][k] = *(const PG8_LAS bf16x8*)(lds + PG8_SA(b, h) + aoff + m * 2048 + k * 1024); } while (0)
#define PG8_LDB(dst, b, h) do { _Pragma("unroll") for (int n = 0; n < 2; ++n) _Pragma("unroll") for (int k = 0; k < 2; ++k) dst[n][k] = *(const PG8_LAS bf16x8*)(lds + PG8_SB(b, h) + boff + n * 2048 + k * 1024); } while (0)
#define PG8_MMA(ai, bj, At, Bt) do { __builtin_amdgcn_s_setprio(1); _Pragma("unroll") for (int m = 0; m < 4; ++m) _Pragma("unroll") for (int n = 0; n < 2; ++n) _Pragma("unroll") for (int k = 0; k < 2; ++k) \
        acc[ai][bj][m][n] = __builtin_amdgcn_mfma_f32_16x16x32_bf16(Bt[n][k], At[m][k], acc[ai][bj][m][n], 0, 0, 0); __builtin_amdgcn_s_setprio(0); } while (0)
#define PG8_WAIT_V(n) asm volatile("s_waitcnt vmcnt(" #n ")" ::: "memory")
#define PG8_WAIT_L(n) asm volatile("s_waitcnt lgkmcnt(" #n ")" ::: "memory")
#define PG8_BAR __builtin_amdgcn_s_barrier()
#define PG8_SCHED __builtin_amdgcn_sched_barrier(0)
    Unit cur, nxt; int ui = 0;
    if (!S.next(0, cur)) return;
    f32x4 acc[2][2][4][2];
#pragma unroll
    for (int a = 0; a < 2; ++a)
#pragma unroll
        for (int b = 0; b < 2; ++b)
#pragma unroll
            for (int m = 0; m < 4; ++m)
#pragma unroll
                for (int n = 0; n < 2; ++n) acc[a][b][m][n] = (f32x4){0.f, 0.f, 0.f, 0.f};
    bf16x8 At[4][2], B0[2][2], B1[2][2];
    const char* cA = (const char*)g.A + (size_t)cur.pm * tstepA; const char* cB = (const char*)g.Bt + (size_t)cur.pn * tstepB;
    S.a_ready(cur);
    if constexpr (SP2) {
        PG8_STAGE(PG8_SB(0, 0), cB, voffB); PG8_STAGE(PG8_SB(0, 1), cB + hstepB, voffB); PG8_STAGE(PG8_SA(0, 0), cA, voffA); PG8_STAGE(PG8_SA(0, 1), cA + hstepA, voffA);
        if (wr == 1) PG8_BAR;
        PG8_WAIT_V(2); PG8_BAR;
        PG8_STAGE(PG8_SB(1, 0), cB + kstep, voffB); PG8_STAGE(PG8_SA(1, 0), cA + kstep, voffA); PG8_STAGE(PG8_SB(1, 1), cB + hstepB + kstep, voffB);
        PG8_WAIT_V(6); PG8_BAR;
    } else {
        PG8_STAGE(PG8_SB(0, 0), cB, voffB); PG8_STAGE(PG8_SA(0, 0), cA, voffA); PG8_STAGE(PG8_SB(0, 1), cB + hstepB, voffB); PG8_STAGE(PG8_SA(0, 1), cA + hstepA, voffA);
        if (wr == 1) PG8_BAR;
        PG8_WAIT_V(4); PG8_BAR;
        PG8_STAGE(PG8_SB(1, 0), cB + kstep, voffB); PG8_STAGE(PG8_SA(1, 0), cA + kstep, voffA); PG8_STAGE(PG8_SB(1, 1), cB + hstepB + kstep, voffB);
        PG8_WAIT_V(6); PG8_BAR;
    }
    for (;;) {
        const bool has_next = S.next(ui + 1, nxt);
        const char* nA = has_next ? (const char*)g.A + (size_t)nxt.pm * tstepA : cA; const char* nB = has_next ? (const char*)g.Bt + (size_t)nxt.pn * tstepB : cB;
        for (int t = 0; t < nt; t += 2) {
            const bool last = (t == nt - 2);
            const char* a1 = cA + (size_t)(t + 1) * kstep;
            const char* a2 = last ? nA : cA + (size_t)(t + 2) * kstep; const char* b2 = last ? nB : cB + (size_t)(t + 2) * kstep;
            const char* a3 = a2 + kstep; const char* b3 = b2 + kstep;
            if (last && has_next) S.a_ready(nxt);
            if constexpr (SP2) {
            PG8_LDB(B0, 0, 0); PG8_LDB(B1, 0, 1); PG8_SCHED; PG8_LDA(At, 0, 0); PG8_STAGE(PG8_SA(1, 1), a1 + hstepA, voffA);
            PG8_WAIT_V(8); PG8_WAIT_L(0); PG8_BAR; PG8_MMA(0, 0, At, B0); PG8_MMA(0, 1, At, B1); PG8_BAR; PG8_SCHED;
            PG8_LDA(At, 0, 1); PG8_STAGE(PG8_SB(0, 0), b2, voffB); PG8_STAGE(PG8_SB(0, 1), b2 + hstepB, voffB); PG8_STAGE(PG8_SA(0, 0), a2, voffA);
            PG8_WAIT_V(8); PG8_WAIT_L(0); PG8_BAR; PG8_MMA(1, 0, At, B0); PG8_MMA(1, 1, At, B1); PG8_BAR; PG8_SCHED;
            PG8_LDB(B0, 1, 0); PG8_LDB(B1, 1, 1); PG8_SCHED; PG8_LDA(At, 1, 0); PG8_STAGE(PG8_SA(0, 1), a2 + hstepA, voffA);
            PG8_WAIT_V(8); PG8_WAIT_L(0); PG8_BAR; PG8_MMA(0, 0, At, B0); PG8_MMA(0, 1, At, B1); PG8_BAR; PG8_SCHED;
            PG8_LDA(At, 1, 1); PG8_STAGE(PG8_SB(1, 0), b3, voffB); PG8_STAGE(PG8_SB(1, 1), b3 + hstepB, voffB); PG8_STAGE(PG8_SA(1, 0), a3, voffA);
            PG8_WAIT_V(8); PG8_WAIT_L(0); PG8_BAR; PG8_MMA(1, 0, At, B0); PG8_MMA(1, 1, At, B1); PG8_BAR; PG8_SCHED;
            } else {
            PG8_LDB(B0, 0, 0); PG8_SCHED; PG8_LDA(At, 0, 0); PG8_STAGE(PG8_SA(1, 1), a1 + hstepA, voffA);
            PG8_WAIT_L(8); PG8_BAR; PG8_WAIT_L(0); PG8_MMA(0, 0, At, B0); PG8_BAR; PG8_SCHED;
            PG8_LDB(B1, 0, 1); PG8_STAGE(PG8_SB(0, 0), b2, voffB);
            PG8_BAR; PG8_WAIT_L(0); PG8_MMA(0, 1, At, B1); PG8_BAR;
            PG8_LDA(At, 0, 1); PG8_STAGE(PG8_SA(0, 0), a2, voffA);
            PG8_BAR; PG8_WAIT_L(0); PG8_MMA(1, 0, At, B0); PG8_BAR; PG8_SCHED;
            PG8_STAGE(PG8_SB(0, 1), b2 + hstepB, voffB);
            PG8_WAIT_V(6); PG8_BAR; PG8_MMA(1, 1, At, B1); PG8_BAR;
            PG8_LDB(B0, 1, 0); PG8_SCHED; PG8_LDA(At, 1, 0); PG8_STAGE(PG8_SA(0, 1), a2 + hstepA, voffA);
            PG8_WAIT_L(8); PG8_BAR; PG8_WAIT_L(0); PG8_MMA(0, 0, At, B0); PG8_BAR; PG8_SCHED;
            PG8_LDB(B1, 1, 1); PG8_STAGE(PG8_SB(1, 0), b3, voffB);
            PG8_BAR; PG8_WAIT_L(0); PG8_MMA(0, 1, At, B1); PG8_BAR;
            PG8_LDA(At, 1, 1); PG8_STAGE(PG8_SA(1, 0), a3, voffA);
            PG8_BAR; PG8_WAIT_L(0); PG8_MMA(1, 0, At, B0); PG8_BAR; PG8_SCHED;
            PG8_STAGE(PG8_SB(1, 1), b3 + hstepB, voffB);
            PG8_WAIT_V(6); PG8_BAR; PG8_MMA(1, 1, At, B1); PG8_BAR;
            }
        }
        if constexpr (ALIGN_EPI) { if (wr == 0) PG8_BAR; }
        if constexpr (!Epi::AFTER_DRAIN) { E(acc, cur, wr, wc, fr, fq); S.done(cur); }
        if (!has_next) break;
#pragma unroll
        for (int a = 0; a < 2; ++a)
#pragma unroll
            for (int b = 0; b < 2; ++b)
#pragma unroll
                for (int m = 0; m < 4; ++m)
#pragma unroll
                    for (int n = 0; n < 2; ++n) acc[a][b][m][n] = (f32x4){0.f, 0.f, 0.f, 0.f};
        cur = nxt; cA = nA; cB = nB; ++ui;
        if constexpr (ALIGN_EPI) { if (wr == 1) PG8_BAR; }
    }
    PG8_WAIT_V(0);
    if constexpr (!ALIGN_EPI) { if (wr == 0) PG8_BAR; }
    PG8_BAR;
    if constexpr (Epi::AFTER_DRAIN) { E.fused(acc, cur, wr, wc, fr, fq, lds, wid, lane); S.done(cur); }
#undef PG8_SA
#undef PG8_SB
#undef PG8_STAGE
#undef PG8_LDA
#undef PG8_LDB
#undef PG8_MMA
#undef PG8_WAIT_V
#undef PG8_WAIT_L
#undef PG8_BAR
#undef PG8_SCHED
}
}

constexpr int NWAVES = 8, NTHREADS = 512;
#ifndef MK_PER_PHASE
#define MK_PER_PHASE 0
#endif
constexpr int D = 1024, BATCH = 8, SEQ = 2048, M = BATCH * SEQ, DEPTH = 2;
constexpr int S5W = 512, S5H = 16, S5G = 32, S5P = 64;
constexpr int HYW = 1024, HYF = 4096, HYE = 33, HYN = 64;
constexpr int INC = 7168;
constexpr int NPHASE = 12;

constexpr size_t MiB = 1u << 20;
constexpr size_t WS_CTL = 0, CTL_ZERO_BYTES = 64 * 1024;
constexpr size_t WS_H2 = 1 * MiB;
constexpr size_t WS_LBAR = 2 * MiB;
constexpr size_t WS_BBT = 2 * MiB + 64 * 1024;
constexpr size_t WS_CT = WS_BBT + 512 * 1024;
constexpr size_t WS_W = 4 * MiB;
constexpr size_t W_IN = 0, W_GLU = 14 * MiB, W_BS5 = W_GLU + 512 * 1024, W_BHY = W_BS5 + 1 * MiB, W_OUT = W_BHY + 2 * MiB, W_LAYER = W_OUT + 2 * MiB;
constexpr size_t WS_SSQ = 43 * MiB;
constexpr size_t WS_X = 44 * MiB;
constexpr size_t WS_R1 = 76 * MiB, WS_R2 = 108 * MiB, WS_R3 = 140 * MiB, WS_R4 = 172 * MiB, WS_R5 = 204 * MiB, WS_R6 = 236 * MiB, WS_W3T = 252 * MiB  , WS_END = 254 * MiB;
static_assert(WS_W + 2 * W_LAYER <= WS_SSQ, "weights");
constexpr int LDS_BYTES = 163840 - 256;
constexpr int LDSCTL_OFF = LDS_BYTES - 512;

#define GAS __attribute__((address_space(1)))
#define LAS __attribute__((address_space(3)))
typedef unsigned short bf16;
typedef unsigned v4u __attribute__((ext_vector_type(4)));
typedef unsigned v2u __attribute__((ext_vector_type(2)));
typedef float f32x4 __attribute__((ext_vector_type(4)));
typedef float f32x2 __attribute__((ext_vector_type(2)));
typedef short bf16x8 __attribute__((ext_vector_type(8)));
typedef GAS unsigned gu32;
#define RLX_AGENT __ATOMIC_RELAXED, __HIP_MEMORY_SCOPE_AGENT
#define LDS_WAIT() asm volatile("s_waitcnt lgkmcnt(0)" ::: "memory")
#define VM_WAIT() asm volatile("s_waitcnt vmcnt(0)" ::: "memory")
__device__ __forceinline__ unsigned f2bf(float f) { unsigned u = __builtin_bit_cast(unsigned, f); return (u + 0x7fffu + ((u >> 16) & 1u)) >> 16; }
__device__ __forceinline__ unsigned pk2(float lo, float hi) { return f2bf(lo) | (f2bf(hi) << 16); }
__device__ __forceinline__ float bf2f(unsigned short h) { return __uint_as_float((unsigned)h << 16); }
using pg8::bf_lo; using pg8::bf_hi; using pg8::fast_sigmoid;

#define XB_TMO      128
#define XB_XCNT(j)  (256  + 64 * (j))
#define XB_XSUB(j)  (1280 + 64 * (j))
#define XB_XGEN(j)  (2304 + 64 * (j))
#define XB_TOP      3328
#define XB_TOPGEN   3392
#define XCD_BAR_WORDS 3456
#define XB_SPIN_CAP (1u << 18)
__device__ __forceinline__ unsigned xb_ld(unsigned* p)              { return __hip_atomic_load(p, __ATOMIC_RELAXED, __HIP_MEMORY_SCOPE_AGENT); }
__device__ __forceinline__ unsigned xb_add(unsigned* p, unsigned v) { return __hip_atomic_fetch_add(p, v, __ATOMIC_RELAXED, __HIP_MEMORY_SCOPE_AGENT); }
__device__ __forceinline__ unsigned xb_xcc_id() { return (unsigned)__builtin_amdgcn_s_getreg((3 << 11) | 20) & 0xFu; }
#define XB_SPIN(cond, bar) do { unsigned _sp = 0; while (cond) { __builtin_amdgcn_s_sleep(1); \
    if ((++_sp & 255u) == 0u) { if (xb_ld(&(bar)[XB_TMO])) break; if (_sp > XB_SPIN_CAP) { atomicAdd(&(bar)[XB_TMO], 1u); break; } } } } while (0)
struct XcdBarrier { unsigned* bar; unsigned x; volatile LAS unsigned* st; };
__device__ __forceinline__ int cur_lane() { int l; asm volatile("v_mbcnt_lo_u32_b32 %0, -1, 0\n\tv_mbcnt_hi_u32_b32 %0, -1, %0" : "=&v"(l)); return l; }
__device__ __forceinline__ XcdBarrier xcd_barrier_post(unsigned* bar, volatile LAS unsigned* st, bool leader) {
    XcdBarrier b; b.bar = bar; b.x = xb_xcc_id(); b.st = st;
    if (leader) (void)xb_add(&bar[XB_XCNT(b.x)], 1u);
    return b;
}
__device__ __forceinline__ void xcd_barrier_complete(unsigned* bar, unsigned x, unsigned& nloc, unsigned& nx) {
    const unsigned G = gridDim.x * gridDim.y * gridDim.z;
    unsigned sum, cnt, mine, sp = 0u;
    for (;;) {
        sum = 0u; cnt = 0u; mine = 0u;
#pragma unroll
        for (unsigned j = 0; j < 16; ++j) { const unsigned c = xb_ld(&bar[XB_XCNT(j)]); sum += c; cnt += (c > 0u) ? 1u : 0u; mine = (j == x) ? c : mine; }
        if (sum == G) break;
        __builtin_amdgcn_s_sleep(1);
        if ((++sp & 255u) == 0u) { if (xb_ld(&bar[XB_TMO])) break; if (sp > XB_SPIN_CAP) { atomicAdd(&bar[XB_TMO], 1u); break; } }
    }
    nloc = mine > 0u ? mine : 1u; nx = cnt > 0u ? cnt : 1u;
}
__device__ __forceinline__ void xcd_barrier(const XcdBarrier& b, int wave_id) {
    asm volatile("s_waitcnt vmcnt(0)" ::: "memory");
    __syncthreads();
    if (wave_id == 0 && cur_lane() == 0) {
        unsigned* bar = b.bar; asm volatile("" : "+s"(bar));
        __builtin_amdgcn_s_waitcnt(0);
        unsigned nloc = b.st[0], nx = b.st[1];
        if (nloc == 0u) { xcd_barrier_complete(bar, b.x, nloc, nx); b.st[0] = nloc; b.st[1] = nx; }
        const unsigned old = xb_add(&bar[XB_XSUB(b.x)], 1u);
        const unsigned gen = old / nloc;
        if (old + 1u == (gen + 1u) * nloc) {
            __builtin_amdgcn_fence(__ATOMIC_RELEASE, "agent");
            asm volatile("s_waitcnt vmcnt(0)" ::: "memory");
            const unsigned og = xb_add(&bar[XB_TOP], 1u);
            const unsigned tg = og / nx;
            if (og + 1u == (tg + 1u) * nx) xb_add(&bar[XB_TOPGEN], 1u);
            else XB_SPIN(xb_ld(&bar[XB_TOPGEN]) == tg, bar);
            __builtin_amdgcn_fence(__ATOMIC_ACQUIRE, "agent");
            xb_add(&bar[XB_XGEN(b.x)], 1u);
            asm volatile("s_waitcnt vmcnt(0)" ::: "memory");
        } else {
            XB_SPIN(xb_ld(&bar[XB_XGEN(b.x)]) == gen, bar);
            __builtin_amdgcn_fence(__ATOMIC_ACQUIRE, "agent");
            asm volatile("s_waitcnt vmcnt(0)" ::: "memory");
        }
    }
    __syncthreads();
}

struct Frame {
    LAS unsigned char* lds;
    int tid, lane, wave, G, bx;
    float* out; unsigned char* ws;
    __device__ __forceinline__ const float* inp(int i) const {
        const LAS unsigned* t = (const LAS unsigned*)(lds + LDSCTL_OFF + 256) + 2 * i;
        const unsigned lo = __builtin_amdgcn_readfirstlane(t[0]), hi = __builtin_amdgcn_readfirstlane(t[1]);
        return (const float*)(((unsigned long long)hi << 32) | lo);
    }
};
__device__ __forceinline__ float wave_sum(float v) {
#pragma unroll
    for (int o = 1; o < 64; o <<= 1) v += __shfl_xor(v, o);
    return v;
}

__device__ __forceinline__ void p0_transpose_item(const float* W, int K, int N, bf16* WT, int k0, int n0, int drow, const float* kscale, LAS float* scr, int lane, bf16* WTlo = nullptr) {
    const int lr = lane >> 4, lc = (lane & 15) * 4;
    f32x4 v[16];
#pragma unroll
    for (int i = 0; i < 16; ++i) v[i] = *(const GAS f32x4*)(W + (size_t)(k0 + 4 * i + lr) * N + n0 + lc);
#pragma unroll
    for (int i = 0; i < 16; ++i) { const int kk = 4 * i + lr; f32x4 x = v[i]; if (kscale) x = x * kscale[k0 + kk];
        LAS float* d = scr + kk * 65 + lc; d[0] = x[0]; d[1] = x[1]; d[2] = x[2]; d[3] = x[3]; }
    LDS_WAIT(); asm volatile("" ::: "memory");
    const int c = lane & 7;
#pragma unroll
    for (int j = 0; j < 8; ++j) { const int n = (lane >> 3) + 8 * j; const LAS float* s = scr + (8 * c) * 65 + n;
        v4u o; o.x = pk2(s[0 * 65], s[1 * 65]); o.y = pk2(s[2 * 65], s[3 * 65]); o.z = pk2(s[4 * 65], s[5 * 65]); o.w = pk2(s[6 * 65], s[7 * 65]);
        *(GAS v4u*)(WT + (size_t)(drow + n) * K + k0 + 8 * c) = o;
        if (WTlo) { v4u q;
#define P0_LO2(a, b, hw) pk2((a) - __uint_as_float((hw) << 16), (b) - __uint_as_float((hw) & 0xffff0000u))
            q.x = P0_LO2(s[0 * 65], s[1 * 65], o.x); q.y = P0_LO2(s[2 * 65], s[3 * 65], o.y); q.z = P0_LO2(s[4 * 65], s[5 * 65], o.z); q.w = P0_LO2(s[6 * 65], s[7 * 65], o.w);
#undef P0_LO2
            *(GAS v4u*)(WTlo + (size_t)(drow + n) * K + k0 + 8 * c) = q; } }
    LDS_WAIT(); asm volatile("" ::: "memory");
}
__device__ __forceinline__ void p0_prologue(Frame& F) {
    LAS float* scr = (LAS float*)(F.lds + F.wave * 17408);
    const int gw = F.bx * NWAVES + F.wave, NGW = F.G * NWAVES, lane = F.lane;
    constexpr int I_IN = (D / 64) * (INC / 64), I_GLU = (S5W / 64) * (S5W / 64), I_BS5 = (S5W / 64) * (D / 64), I_BHY = (HYW / 64) * (D / 64), I_OUT = (D / 64) * (D / 64);
    constexpr int I_LAYER = I_IN + I_GLU + I_BS5 + I_BHY + I_OUT;
    for (int it = gw; it < DEPTH * I_LAYER; it += NGW) {
        const int l = it / I_LAYER; int r = it % I_LAYER; bf16* wl = (bf16*)(F.ws + WS_W + (size_t)l * W_LAYER);
        if (r < I_IN) { const int nblk = INC / 64, kb = r / nblk, nb = r % nblk, n0 = nb * 64;
            const int drow = (n0 >= 1024 && n0 < 5120) ? n0 - 1024 : (n0 < 1024 ? n0 + 4096 : n0);
            p0_transpose_item(F.inp(2) + (size_t)l * D * INC, D, INC, wl + W_IN / 2, kb * 64, n0, drow, F.inp(1) + l * D, scr, lane); continue; } r -= I_IN;
        if (r < I_GLU) { const int nblk = S5W / 64; p0_transpose_item(F.inp(11) + (size_t)l * S5W * S5W, S5W, S5W, wl + W_GLU / 2, (r / nblk) * 64, (r % nblk) * 64, (r % nblk) * 64, nullptr, scr, lane); continue; } r -= I_GLU;
        if (r < I_BS5) { const int nblk = D / 64; p0_transpose_item(F.inp(23) + (size_t)l * S5W * D, S5W, D, wl + W_BS5 / 2, (r / nblk) * 64, (r % nblk) * 64, (r % nblk) * 64, nullptr, scr, lane); continue; } r -= I_BS5;
        if (r < I_BHY) { const int nblk = D / 64; p0_transpose_item(F.inp(24) + (size_t)l * HYW * D, HYW, D, wl + W_BHY / 2, (r / nblk) * 64, (r % nblk) * 64, (r % nblk) * 64, nullptr, scr, lane); continue; } r -= I_BHY;
        { const int nblk = D / 64; p0_transpose_item(F.inp(25) + (size_t)l * D * D, D, D, wl + W_OUT / 2, (r / nblk) * 64, (r % nblk) * 64, (r % nblk) * 64, nullptr, scr, lane); }
    }
    for (int it = gw; it < DEPTH * (HYF / 64); it += NGW) { const int l = it / (HYF / 64), nb = it % (HYF / 64); bf16* hi = (bf16*)(F.ws + WS_W3T + (size_t)l * MiB);
        p0_transpose_item(F.inp(20) + (size_t)l * HYN * HYF, HYN, HYF, hi, 0, nb * 64, nb * 64, nullptr, scr, lane, hi + (size_t)HYF * HYN); }
    { bf16* X = (bf16*)(F.ws + WS_X); float* ssq = (float*)(F.ws + WS_SSQ);
      for (int m0 = 2 * gw; m0 < M; m0 += 2 * NGW) { f32x4 v[2][4]; float s[2];
#pragma unroll
        for (int r = 0; r < 2; ++r) { const GAS f32x4* xr = (const GAS f32x4*)(F.inp(0) + (size_t)(m0 + r) * D) + lane;
#pragma unroll
            for (int j = 0; j < 4; ++j) v[r][j] = xr[64 * j]; }
#pragma unroll
        for (int r = 0; r < 2; ++r) { float a = 0.f;
#pragma unroll
            for (int j = 0; j < 4; ++j) a += (v[r][j].x * v[r][j].x + v[r][j].y * v[r][j].y) + (v[r][j].z * v[r][j].z + v[r][j].w * v[r][j].w);
            s[r] = wave_sum(a);
            GAS unsigned long long* o8 = (GAS unsigned long long*)(X + (size_t)(m0 + r) * D) + lane;
#pragma unroll
            for (int j = 0; j < 4; ++j) o8[64 * j] = (unsigned long long)pk2(v[r][j].x, v[r][j].y) | ((unsigned long long)pk2(v[r][j].z, v[r][j].w) << 32);
            if (lane < 16) ssq[(size_t)(m0 + r) * 16 + lane] = lane == 0 ? s[r] : 0.f; } } }
    {
      for (int it = gw; it < DEPTH * SEQ; it += NGW) { const int l = it / SEQ, t = it % SEQ, j = lane;
        const float* w1 = F.inp(15) + (size_t)l * HYE * HYN; const float* b1 = F.inp(16) + l * HYN; const float* fr = F.inp(17) + l * HYN; const float* w2 = F.inp(18) + (size_t)l * HYN * HYN; const float* b2 = F.inp(19) + l * HYN;
        float f = 0.f;
        if (j == 0) f = (float)t / (float)(SEQ - 1);
        else if (j < 33) { const int bi = (j - 1) & 15; const float band = 1e-4f + (float)bi * ((15.f - 1e-4f) / 15.f); const float ang = band * (float)t * (float)(2.0 * 3.14159265358979323846 / SEQ); f = j < 17 ? cosf(ang) : -sinf(ang); }
        float a = b1[j];
        for (int i = 0; i < HYE; ++i) a += __shfl(f, i) * w1[i * HYN + j];
        const float h1 = sinf(fr[j] * a);
        float c = b2[j];
        for (int i = 0; i < HYN; ++i) c += __shfl(h1, i) * w2[i * HYN + j];
        const float hv = sinf(fr[j] * c); const unsigned hh = f2bf(hv);
        bf16* H2H = (bf16*)(F.ws + WS_H2 + (size_t)l * 512 * 1024);
        H2H[(size_t)t * HYN + j] = (bf16)hh; H2H[(size_t)SEQ * HYN + (size_t)t * HYN + j] = (bf16)f2bf(hv - __uint_as_float(hh << 16)); } }
    { float* LB = (float*)(F.ws + WS_LBAR); bf16* BBT = (bf16*)(F.ws + WS_BBT); bf16* CT = (bf16*)(F.ws + WS_CT);
      for (int q = gw; q < DEPTH * 2 * S5G; q += NGW) { const int p = lane; const int i = q * S5P + p;
        const float dt = expf(F.inp(5)[q]); const float lr = F.inp(3)[i], li = F.inp(4)[i]; const float mag = expf(lr * dt), ang = li * dt;
        const float br = mag * cosf(ang), bi = mag * sinf(ang); LB[2 * i] = br; LB[2 * i + 1] = bi;
        const float nr = br - 1.f, ni = bi, den = lr * lr + li * li; const float kr = (nr * lr + ni * li) / den, ki = (ni * lr - nr * li) / den;
        const float* bre = F.inp(6) + (size_t)i * S5H; const float* bim = F.inp(7) + (size_t)i * S5H;
        bf16* rowr = BBT + ((size_t)q * 128 + 2 * p) * 16; bf16* rowi = rowr + 16;
        for (int h = 0; h < S5H; ++h) { const float xr = bre[h], xi = bim[h]; rowr[h] = (bf16)f2bf(kr * xr - ki * xi); rowi[h] = (bf16)f2bf(kr * xi + ki * xr); }
        const float* cre = F.inp(8) + (size_t)q * S5H * S5P; const float* cim = F.inp(9) + (size_t)q * S5H * S5P;
        for (int h = 0; h < S5H; ++h) { *(unsigned*)(CT + ((size_t)q * 16 + h) * 128 + 2 * p) = pk2(cre[h * S5P + p], -cim[h * S5P + p]); } } }
}

constexpr int S5_YB = 0, S5_CH = 65536, S5_CHB = 8448, S5_SEND = S5_CH + 8 * S5_CHB;
__device__ __forceinline__ float gelu_tanh_fast(float x) {
    const float z = 0.7978845608028654f * (x + 0.044715f * x * x * x);
    const float e = __builtin_amdgcn_exp2f(2.0f * 1.4426950408889634f * z);
    const float th = 1.0f - 2.0f * __builtin_amdgcn_rcpf(e + 1.0f);
    return 0.5f * x * (1.0f + th);
}
template <int DIR, bool EMIT>
__device__ __forceinline__ void s5_pass(Frame& F, const bf16* Ub  , int tlo  , float ar, float ai, float& sr, float& si,
                                        const bf16x8 (&bbf)[8], const bf16x8 (&ctf)[4], const bf16x8& ddf, LAS unsigned char* ch, LAS unsigned char* yb, bf16* YGb) {
    const int lane = F.lane, fr = lane & 15, fq = lane >> 4;
    auto load_u = [&](int tc0) -> bf16x8 { bf16x8 z = {0, 0, 0, 0, 0, 0, 0, 0}; int row = tc0 + fr; asm volatile("" : "+v"(row));
        if (fq < 2) z = *(const GAS bf16x8*)(Ub + (size_t)row * 1024 + 8 * fq); return z; };
    bf16x8 ufr[4];
#pragma unroll
    for (int i = 0; i < 4; ++i) ufr[i] = load_u(DIR ? tlo + 16 * (15 - i) : tlo + 16 * i);
#pragma unroll 1
    for (int cb = 0; cb < 4; ++cb)
#pragma unroll
    for (int ci4 = 0; ci4 < 4; ++ci4) { const int ci = 4 * cb + ci4;
        const int tc0 = DIR ? tlo + 16 * (15 - ci) : tlo + 16 * ci;
        const bf16x8 uf = ufr[ci4];
        LAS float* bu = (LAS float*)ch;
#pragma unroll
        for (int j = 0; j < 8; ++j) { f32x4 a = {0.f, 0.f, 0.f, 0.f}; a = __builtin_amdgcn_mfma_f32_16x16x32_bf16(bbf[j], uf, a, 0, 0, 0);
            *(LAS f32x4*)(bu + fr * 132 + 16 * j + 4 * fq) = a; }
        LDS_WAIT();
        f32x2 x[16];
#pragma unroll
        for (int tt = 0; tt < 16; ++tt) x[tt] = *(const LAS f32x2*)(bu + tt * 132 + 2 * lane);
        LDS_WAIT();
        unsigned spk[16];
#pragma unroll
        for (int i = 0; i < 16; ++i) { const int tt = DIR ? 15 - i : i;
            const float nr = ar * sr - ai * si + x[tt].x, ni = ar * si + ai * sr + x[tt].y; sr = nr; si = ni;
            if (EMIT) spk[tt] = pg8::cvt_pk_bf16(nr, ni); }
        if (EMIT) {
            LAS unsigned* sb = (LAS unsigned*)ch;
#pragma unroll
            for (int tt = 0; tt < 16; ++tt) sb[tt * 68 + lane] = spk[tt];
            LDS_WAIT();
            f32x4 y = {0.f, 0.f, 0.f, 0.f};
#pragma unroll
            for (int ks = 0; ks < 4; ++ks) { const bf16x8 sf = *(const LAS bf16x8*)(ch + fr * 272 + ks * 64 + fq * 16); y = __builtin_amdgcn_mfma_f32_16x16x32_bf16(ctf[ks], sf, y, 0, 0, 0); }
            LDS_WAIT();
            LAS v2u* ybp = (LAS v2u*)(yb + (size_t)(tc0 + fr) * 32 + 8 * fq);
            if (DIR == 0) { v2u w; w.x = pg8::cvt_pk_bf16(y[0], y[1]); w.y = pg8::cvt_pk_bf16(y[2], y[3]); *ybp = w; }
            else { y = __builtin_amdgcn_mfma_f32_16x16x32_bf16(ddf, uf, y, 0, 0, 0);
                const v2u f = *ybp; const float o0 = gelu_tanh_fast(y[0] + bf_lo(f.x)), o1 = gelu_tanh_fast(y[1] + bf_hi(f.x)), o2 = gelu_tanh_fast(y[2] + bf_lo(f.y)), o3 = gelu_tanh_fast(y[3] + bf_hi(f.y));
                v2u w; w.x = pg8::cvt_pk_bf16(o0, o1); w.y = pg8::cvt_pk_bf16(o2, o3);
                *(GAS v2u*)(YGb + (size_t)(tc0 + fr) * 1024 + 4 * fq) = w; }
        }
        if (ci + 4 < 16) ufr[ci4] = load_u(DIR ? tlo + 16 * (15 - (ci + 4)) : tlo + 16 * (ci + 4));
        __builtin_amdgcn_sched_barrier(0);
    }
}
__device__ __forceinline__ void s5_item(Frame& F, int l, int b, int g, bool dry = false) {
    const int lane = F.lane, fr = lane & 15, fq = lane >> 4, seg = F.wave;
    bf16* U = (bf16*)(F.ws + WS_R5) + (size_t)b * SEQ * 1024 + g * 16;
    LAS unsigned char* ch = F.lds + S5_CH + seg * S5_CHB; LAS unsigned char* yb = F.lds + S5_YB;
    LAS f32x2* send = (LAS f32x2*)(F.lds + S5_SEND);
#pragma unroll 1
    for (int dir = 0; dir < 2; ++dir) {
        const int q = (l * 2 + dir) * S5G + g;
        const float ar = ((const GAS float*)(F.ws + WS_LBAR))[(size_t)(q * S5P + lane) * 2], ai = ((const GAS float*)(F.ws + WS_LBAR))[(size_t)(q * S5P + lane) * 2 + 1];
        bf16x8 bbf[8], ctf[4], ddf; const bf16x8 zero8 = {0, 0, 0, 0, 0, 0, 0, 0};
        const bf16* BBT = (const bf16*)(F.ws + WS_BBT) + (size_t)q * 128 * 16; const bf16* CT = (const bf16*)(F.ws + WS_CT) + (size_t)q * 16 * 128;
#pragma unroll
        for (int j = 0; j < 8; ++j) bbf[j] = fq < 2 ? *(const GAS bf16x8*)(BBT + (16 * j + fr) * 16 + 8 * fq) : zero8;
#pragma unroll
        for (int ks = 0; ks < 4; ++ks) ctf[ks] = *(const GAS bf16x8*)(CT + fr * 128 + 32 * ks + 8 * fq);
        { const short dv = (short)f2bf(F.inp(10)[l * S5W + g * 16 + fr]); ddf = zero8;
#pragma unroll
          for (int jj = 0; jj < 8; ++jj) if (8 * fq + jj == fr) ddf[jj] = dv; }
        const int tlo = dir ? SEQ - 256 * (seg + 1) : 256 * seg;
        float sr = 0.f, si = 0.f;
        if (dir == 0) s5_pass<0, false>(F, U, tlo, ar, ai, sr, si, bbf, ctf, ddf, ch, yb, U); else s5_pass<1, false>(F, U, tlo, ar, ai, sr, si, bbf, ctf, ddf, ch, yb, U);
        send[seg * 64 + lane] = (f32x2){sr, si};
        LDS_WAIT(); __syncthreads();
        float pr = ar, pi = ai;
#pragma unroll
        for (int k = 0; k < 8; ++k) { const float nr = pr * pr - pi * pi, ni = 2.f * pr * pi; pr = nr; pi = ni; }
        sr = 0.f; si = 0.f;
        for (int k = 0; k < seg; ++k) { const f32x2 e = send[k * 64 + lane]; const float nr = pr * sr - pi * si + e.x, ni = pr * si + pi * sr + e.y; sr = nr; si = ni; }
        bf16* YGo = dry ? (bf16*)(F.ws + WS_R6) + (size_t)(b & 1) * SEQ * 1024 + g * 16 : U;
        if (dir == 0) s5_pass<0, true>(F, U, tlo, ar, ai, sr, si, bbf, ctf, ddf, ch, yb, YGo); else s5_pass<1, true>(F, U, tlo, ar, ai, sr, si, bbf, ctf, ddf, ch, yb, YGo);
        LDS_WAIT(); __syncthreads();
    }
}

constexpr int HY_WX = 0, HY_WXB = 8704, HY_KF = 8 * HY_WXB, HY_KFO = 33 * 64 * 8, HY_KFCH = 2 * HY_KFO, HY_RED = HY_KF + 2 * HY_KFCH, HY_RAWROW = 4128;
static_assert(HY_RED + 256 <= LDSCTL_OFF && 4 * 2048 * 4 <= HY_KFCH && 2 * HY_RAWROW <= HY_WXB, "hyena LDS map");
#define C64_LIST 1.000000000e+00f, 9.951847267e-01f, 9.807852804e-01f, 9.569403357e-01f, 9.238795325e-01f, 8.819212643e-01f, 8.314696123e-01f, 7.730104534e-01f, 7.071067812e-01f, 6.343932842e-01f, 5.555702330e-01f, 4.713967368e-01f, 3.826834324e-01f, 2.902846773e-01f, 1.950903220e-01f, 9.801714033e-02f, 0.0f, -9.801714033e-02f, -1.950903220e-01f, -2.902846773e-01f, -3.826834324e-01f, -4.713967368e-01f, -5.555702330e-01f, -6.343932842e-01f, -7.071067812e-01f, -7.730104534e-01f, -8.314696123e-01f, -8.819212643e-01f, -9.238795325e-01f, -9.569403357e-01f, -9.807852804e-01f, -9.951847267e-01f, -1.000000000e+00f, -9.951847267e-01f, -9.807852804e-01f, -9.569403357e-01f, -9.238795325e-01f, -8.819212643e-01f, -8.314696123e-01f, -7.730104534e-01f, -7.071067812e-01f, -6.343932842e-01f, -5.555702330e-01f, -4.713967368e-01f, -3.826834324e-01f, -2.902846773e-01f, -1.950903220e-01f, -9.801714033e-02f, 0.0f, 9.801714033e-02f, 1.950903220e-01f, 2.902846773e-01f, 3.826834324e-01f, 4.713967368e-01f, 5.555702330e-01f, 6.343932842e-01f, 7.071067812e-01f, 7.730104534e-01f, 8.314696123e-01f, 8.819212643e-01f, 9.238795325e-01f, 9.569403357e-01f, 9.807852804e-01f, 9.951847267e-01f
__host__ __device__ constexpr int rev6(int s) { return ((s >> 4) & 3) | (s & 12) | ((s & 3) << 4); }

template <bool INV> __device__ __forceinline__ void r4(float& x0r, float& x0i, float& x1r, float& x1i, float& x2r, float& x2i, float& x3r, float& x3i) {
    const float t0r = x0r + x2r, t0i = x0i + x2i, t1r = x0r - x2r, t1i = x0i - x2i, t2r = x1r + x3r, t2i = x1i + x3i, t3r = x1r - x3r, t3i = x1i - x3i;
    x0r = t0r + t2r; x0i = t0i + t2i; x2r = t0r - t2r; x2i = t0i - t2i;
    if (!INV) { x1r = t1r + t3i; x1i = t1i - t3r; x3r = t1r - t3i; x3i = t1i + t3r; }
    else      { x1r = t1r - t3i; x1i = t1i + t3r; x3r = t1r + t3i; x3i = t1i - t3r; }
}
constexpr float C64T[64] = { C64_LIST };
template <int... Is, class Fn> __device__ __forceinline__ void static_for_impl(std::integer_sequence<int, Is...>, Fn&& f) { (f(std::integral_constant<int, Is>{}), ...); }
template <int N, class Fn> __device__ __forceinline__ void static_for(Fn&& f) { static_for_impl(std::make_integer_sequence<int, N>{}, f); }
template <bool INV, int E> __device__ __forceinline__ void twc(float& xr, float& xi) {
    constexpr int e = E & 63;
    if constexpr (e == 0) { return; }
    else if constexpr (e == 16) { const float tr = xr, ti = xi; if (!INV) { xr = ti; xi = -tr; } else { xr = -ti; xi = tr; } }
    else if constexpr (e == 32) { xr = -xr; xi = -xi; }
    else if constexpr (e == 48) { const float tr = xr, ti = xi; if (!INV) { xr = -ti; xi = tr; } else { xr = ti; xi = -tr; } }
    else {
        constexpr float c = C64T[e], sn = C64T[(e + 48) & 63], wi = INV ? sn : -sn;
        constexpr unsigned cb = __builtin_bit_cast(unsigned, c), wb = __builtin_bit_cast(unsigned, wi), nwb = wb ^ 0x80000000u;
        const float tr = xr, ti = xi; float a, b;
        asm("v_mul_f32 %0, %1, %2" : "=v"(a) : "i"(cb), "v"(tr));
        asm("v_fmac_f32 %0, %1, %2" : "+v"(a) : "i"(nwb), "v"(ti));
        asm("v_mul_f32 %0, %1, %2" : "=v"(b) : "i"(wb), "v"(tr));
        asm("v_fmac_f32 %0, %1, %2" : "+v"(b) : "i"(cb), "v"(ti));
        xr = a; xi = b;
    }
}
#define SFOR(N, I, ...) static_for<N>([&](auto I##_) __attribute__((always_inline)) { constexpr int I = decltype(I##_)::value; __VA_ARGS__ })
template <bool INV> __device__ __forceinline__ void dft64(float (&re)[64], float (&im)[64]) {
    if constexpr (!INV) {
        SFOR(16, bc, r4<false>(re[bc], im[bc], re[bc + 16], im[bc + 16], re[bc + 32], im[bc + 32], re[bc + 48], im[bc + 48]););
        SFOR(48, i, constexpr int p = 1 + i / 16; constexpr int bc = i % 16; twc<false, bc * p>(re[16 * p + bc], im[16 * p + bc]););
        __builtin_amdgcn_sched_barrier(0);
        SFOR(16, i, constexpr int s = 16 * (i / 4) + (i % 4); r4<false>(re[s], im[s], re[s + 4], im[s + 4], re[s + 8], im[s + 8], re[s + 12], im[s + 12]););
        SFOR(64, i, constexpr int q = (i >> 2) & 3; constexpr int c = i & 3; twc<false, 4 * c * q>(re[i], im[i]););
        __builtin_amdgcn_sched_barrier(0);
        SFOR(16, pq, constexpr int s = 4 * pq; r4<false>(re[s], im[s], re[s + 1], im[s + 1], re[s + 2], im[s + 2], re[s + 3], im[s + 3]););
    } else {
        SFOR(16, pq, constexpr int s = 4 * pq; r4<true>(re[s], im[s], re[s + 1], im[s + 1], re[s + 2], im[s + 2], re[s + 3], im[s + 3]););
        SFOR(64, i, constexpr int q = (i >> 2) & 3; constexpr int c = i & 3; twc<true, 4 * c * q>(re[i], im[i]););
        __builtin_amdgcn_sched_barrier(0);
        SFOR(16, i, constexpr int s = 16 * (i / 4) + (i % 4); r4<true>(re[s], im[s], re[s + 4], im[s + 4], re[s + 8], im[s + 8], re[s + 12], im[s + 12]););
        SFOR(48, i, constexpr int p = 1 + i / 16; constexpr int bc = i % 16; twc<true, bc * p>(re[16 * p + bc], im[16 * p + bc]););
        __builtin_amdgcn_sched_barrier(0);
        SFOR(16, bc, r4<true>(re[bc], im[bc], re[bc + 16], im[bc + 16], re[bc + 32], im[bc + 32], re[bc + 48], im[bc + 48]););
    }
    __builtin_amdgcn_sched_barrier(0);
}
__device__ __forceinline__ void wtrans(float (&v)[64], LAS float* wx, int lane) {
#pragma unroll
    for (int i = 0; i < 32; ++i) { const auto r = __builtin_amdgcn_permlane32_swap(__float_as_uint(v[i]), __float_as_uint(v[32 + i]), false, false); v[i] = __uint_as_float(r[0]); v[32 + i] = __uint_as_float(r[1]); }
    __builtin_amdgcn_sched_barrier(0);
    const int rd = (lane & 31) * 68 + (lane >> 5) * 32;
#pragma unroll
    for (int step = 0; step < 2; ++step) {
        asm volatile("" ::: "memory");
#pragma unroll
        for (int i = 0; i < 32; ++i) wx[i * 68 + lane] = v[32 * step + i];
        asm volatile("" ::: "memory");
#pragma unroll
        for (int i4 = 0; i4 < 8; ++i4) { const f32x4 q = *(const LAS f32x4*)(wx + rd + 4 * i4);
#pragma unroll
            for (int e = 0; e < 4; ++e) v[32 * step + 4 * i4 + e] = q[e]; }
        asm volatile("" ::: "memory");
    }
}
__device__ __forceinline__ void wfft_fwd(float (&re)[64], float (&im)[64], LAS float* wx, int lane) {
    dft64<false>(re, im);
    { float f = (float)lane * (1.0f / 4096.0f); asm volatile("" : "+v"(f));
#pragma unroll
      for (int s = 1; s < 64; ++s) { const float a = (float)rev6(s) * f; const float c = __builtin_amdgcn_cosf(a), sn = __builtin_amdgcn_sinf(a);
          const float tr = re[s] * c + im[s] * sn, ti = im[s] * c - re[s] * sn; re[s] = tr; im[s] = ti; if ((s & 7) == 7) __builtin_amdgcn_sched_barrier(0); } }
    __builtin_amdgcn_sched_barrier(0);
    wtrans(re, wx, lane); wtrans(im, wx, lane);
    __builtin_amdgcn_sched_barrier(0);
    dft64<false>(re, im);
}
__device__ __forceinline__ void wfft_inv(float (&re)[64], float (&im)[64], LAS float* wx, int lane) {
    dft64<true>(re, im);
    { float f = (float)rev6(lane) * (1.0f / 4096.0f); asm volatile("" : "+v"(f));
#pragma unroll
      for (int s = 1; s < 64; ++s) { const float a = (float)s * f; const float c = __builtin_amdgcn_cosf(a), sn = __builtin_amdgcn_sinf(a);
          const float tr = re[s] * c - im[s] * sn, ti = im[s] * c + re[s] * sn; re[s] = tr; im[s] = ti; if ((s & 7) == 7) __builtin_amdgcn_sched_barrier(0); } }
    __builtin_amdgcn_sched_barrier(0);
    wtrans(re, wx, lane); wtrans(im, wx, lane);
    __builtin_amdgcn_sched_barrier(0);
    dft64<true>(re, im);
}
struct Stage2 { v4u a[4], b[4]; };
__device__ __forceinline__ void hy_load2a(Stage2& S, const bf16* row0, int lane) {
#pragma unroll
    for (int i = 0; i < 4; ++i) { const int q = lane + 64 * i; S.a[i] = *(const GAS v4u*)(row0 + 8 * q); }
}
__device__ __forceinline__ void hy_load2b(Stage2& S, const bf16* row0, int lane) {
#pragma unroll
    for (int i = 0; i < 4; ++i) { const int q = lane + 64 * i; S.b[i] = *(const GAS v4u*)(row0 + SEQ + 8 * q); }
}
__device__ __forceinline__ void hy_load2(Stage2& S, const bf16* row0, int lane) { hy_load2a(S, row0, lane); hy_load2b(S, row0, lane); }
__device__ __forceinline__ void hy_commit2(const Stage2& S, LAS unsigned char* wxb, int lane) {
    asm volatile("" ::: "memory");
#pragma unroll
    for (int i = 0; i < 4; ++i) { const int q = lane + 64 * i; *(LAS v4u*)(wxb + 16 + 16 * q) = S.a[i]; *(LAS v4u*)(wxb + HY_RAWROW + 16 + 16 * q) = S.b[i]; }
    if (lane < 4) { LAS unsigned short* row = (LAS unsigned short*)(wxb + (lane >> 1) * HY_RAWROW); row[(lane & 1) ? 8 + SEQ : 7] = 0; }
    asm volatile("" ::: "memory");
}
__device__ __forceinline__ float raw2(LAS unsigned char* wxb, int r, int t) { return bf2f(*(const LAS unsigned short*)(wxb + r * HY_RAWROW + 16 + 2 * t)); }
__device__ __forceinline__ unsigned hilo_pack(float x0, float x1, unsigned& lo) {
    const unsigned h0 = f2bf(x0), h1 = f2bf(x1); lo = f2bf(x0 - __uint_as_float(h0 << 16)) | (f2bf(x1 - __uint_as_float(h1 << 16)) << 16); return h0 | (h1 << 16);
}
__device__ __forceinline__ void hy_filter_gen4(Frame& F, int l, int c0, LAS unsigned char* kf0, float* tap2, LAS float* red) {
    int lane_ = F.lane; asm volatile("" : "+v"(lane_)); const int lane = lane_; const int fr = lane & 15, fq = lane >> 4, w = F.wave;
    const float* dec = F.inp(21) + (size_t)l * HYF;
    const bf16* H2H = (const bf16*)(F.ws + WS_H2 + (size_t)l * 512 * 1024); const bf16* H2L = H2H + SEQ * HYN;
    bf16x8 ah[2], al[2];
    { const int ch = c0 + (F.G) * (fr >> 2), f4 = fr & 3, col = (f4 >> 1) * 2 * HYW + (f4 & 1) * HYW + ch;
      const bf16* whi = (const bf16*)(F.ws + WS_W3T + (size_t)l * MiB) + (size_t)col * HYN; const bf16* wlo = whi + (size_t)HYF * HYN;
#pragma unroll
      for (int ks = 0; ks < 2; ++ks) { ah[ks] = *(const GAS bf16x8*)(whi + 32 * ks + 8 * fq); al[ks] = *(const GAS bf16x8*)(wlo + 32 * ks + 8 * fq); } }
    float dk[4];
#pragma unroll
    for (int r = 0; r < 4; ++r) dk[r] = fabsf(((const GAS float*)dec)[(r >> 1) * 2 * HYW + (r & 1) * HYW + c0 + F.G * fq]);
    LAS float* stg = (LAS float*)(kf0 + (fq & 1) * HY_KFCH); float* tg = tap2 + (size_t)(fq & 1) * 4 * SEQ;
    float ss0 = 0.f, ss1 = 0.f;
#pragma unroll 1
    for (int tb = 0; tb < 2; ++tb) {
        bf16x8 bh[8][2], bl[8][2];
#pragma unroll
        for (int u = 0; u < 8; ++u)
#pragma unroll
            for (int ks = 0; ks < 2; ++ks) { const size_t off = (size_t)(256 * w + 128 * tb + 16 * u + fr) * HYN + 32 * ks + 8 * fq; bh[u][ks] = *(const GAS bf16x8*)(H2H + off); bl[u][ks] = *(const GAS bf16x8*)(H2L + off); }
#pragma unroll
        for (int u = 0; u < 8; ++u) { const int t = 256 * w + 128 * tb + 16 * u + fr; f32x4 acc = {0.f, 0.f, 0.f, 0.f};
#pragma unroll
            for (int ks = 0; ks < 2; ++ks) { acc = __builtin_amdgcn_mfma_f32_16x16x32_bf16(ah[ks], bh[u][ks], acc, 0, 0, 0); acc = __builtin_amdgcn_mfma_f32_16x16x32_bf16(ah[ks], bl[u][ks], acc, 0, 0, 0); acc = __builtin_amdgcn_mfma_f32_16x16x32_bf16(al[ks], bh[u][ks], acc, 0, 0, 0); }
            const float tn = (float)t * (1.0f / (float)(SEQ - 1));
#pragma unroll
            for (int r = 0; r < 4; ++r) { const float v = acc[r] * (__expf(-tn * dk[r]) + 0.05f);
                if (fq < 2) stg[r * SEQ + t] = v; else ((GAS float*)tg)[(size_t)r * SEQ + t] = v;
                const float sq = ((r & 1) && t == 0) ? 0.f : v * v; if (r < 2) ss0 += sq; else ss1 += sq; } }
    }
#pragma unroll
    for (int o = 1; o < 16; o <<= 1) { ss0 += __shfl_xor(ss0, o); ss1 += __shfl_xor(ss1, o); }
    if (fr == 0) { red[2 * fq] = ss0; red[2 * fq + 1] = ss1; }
}
__device__ __forceinline__ void hy_filter_fft(Frame& F, int l, int c, LAS unsigned char* kfch, const LAS float* red4, LAS float* wx) {
    int lane_ = F.lane; asm volatile("" : "+v"(lane_)); const int lane = lane_; const LAS float* stg = (const LAS float*)kfch;
    float re[64], im[64];
#pragma unroll
    for (int n1 = 0; n1 < 32; ++n1) { re[n1] = stg[64 * n1 + lane]; im[n1] = stg[2 * SEQ + 64 * n1 + lane]; }
#pragma unroll
    for (int n1 = 32; n1 < 64; ++n1) { const int t = 64 * (64 - n1) - lane; float a = stg[SEQ + t], b = stg[3 * SEQ + t]; if (n1 == 32 && lane == 0) { a = 0.f; b = 0.f; } re[n1] = a; im[n1] = b; }
    float s0 = 0.f, s1 = 0.f;
#pragma unroll
    for (int w = 0; w < 8; ++w) { s0 += red4[8 * w]; s1 += red4[8 * w + 1]; }
    const float sc = 1.0f / 4096.0f; const float n0 = 0.5f * sc / sqrtf(s0 + 1e-6f), n1s = 0.5f * sc / sqrtf(s1 + 1e-6f);
    const float d0 = F.inp(22)[(size_t)l * 2 * HYW + c] * sc, d1 = F.inp(22)[(size_t)l * 2 * HYW + HYW + c] * sc;
    asm volatile("s_waitcnt lgkmcnt(0)" ::: "memory");
    wfft_fwd(re, im, wx, lane);
    const int k1 = rev6(lane), lc = rev6((64 - k1) & 63);
    LAS f32x2* kf0 = (LAS f32x2*)kfch + k1; LAS f32x2* kf1 = (LAS f32x2*)(kfch + HY_KFO) + k1;
#pragma unroll
    for (int k0 = 0; k0 <= 32; ++k0) { const int s = rev6(k0), sm = rev6(63 - k0), sz = rev6((64 - k0) & 63);
        float pr = __shfl(re[sm], lc), pi = __shfl(im[sm], lc); if (lane == 0) { pr = re[sz]; pi = im[sz]; }
        const float zr = re[s], zi = im[s];
        kf0[k0 * 64] = (f32x2){(zr + pr) * n0 + d0, (zi - pi) * n0};
        kf1[k0 * 64] = (f32x2){(zi + pi) * n1s + d1, -(zr - pr) * n1s}; if ((k0 & 3) == 3) __builtin_amdgcn_sched_barrier(0); }
}
__device__ __forceinline__ void hy_wave_main(Frame& F, int l, int c, int ws, LAS unsigned char* wxb, LAS unsigned char* kfch, Stage2& pre, bool dry = false) {
    int lane_ = F.lane; asm volatile("" : "+v"(lane_)); const int lane = lane_; LAS float* wx = (LAS float*)wxb;
    const size_t rowoff = (size_t)c * M + (size_t)(2 * ws) * SEQ;
    const bf16* PV = (const bf16*)(F.ws + WS_R1) + rowoff; const bf16* PX1 = (const bf16*)(F.ws + WS_R2) + rowoff; const bf16* PX2 = (const bf16*)(F.ws + WS_R3) + rowoff;
    const bf16* GH = (const bf16*)(F.ws + WS_R4) + rowoff; bf16* OUT = (bf16*)(F.ws + WS_R1) + rowoff;
    const float* cw = F.inp(13) + (size_t)l * 3 * 3 * HYW; const float* cb = F.inp(14) + (size_t)l * 3 * HYW;
    float re[64], im[64];
    hy_commit2(pre, wxb, lane);
    hy_load2a(pre, PX1, lane);
    { const float w0 = cw[c], w1 = cw[3 * HYW + c], w2 = cw[6 * HYW + c], b = cb[c];
#pragma unroll
      for (int n1 = 0; n1 < 32; ++n1) { const int t = 64 * n1 + lane;
          re[n1] = b + w0 * raw2(wxb, 0, t - 1) + w1 * raw2(wxb, 0, t) + w2 * raw2(wxb, 0, t + 1);
          im[n1] = b + w0 * raw2(wxb, 1, t - 1) + w1 * raw2(wxb, 1, t) + w2 * raw2(wxb, 1, t + 1); if ((n1 & 3) == 3) __builtin_amdgcn_sched_barrier(0); } }
#pragma unroll 1
    for (int o = 0; o < 2; ++o) {
        int lane_o = F.lane; asm volatile("" : "+v"(lane_o));
        const int lane = lane_o; const int k1 = rev6(lane);
#pragma unroll
        for (int n1 = 32; n1 < 64; ++n1) { re[n1] = 0.f; im[n1] = 0.f; }
        asm volatile("s_waitcnt lgkmcnt(0)" ::: "memory");
        wfft_fwd(re, im, wx, lane);
        { const LAS unsigned char* bd = kfch + o * HY_KFO + k1 * 8; const LAS unsigned char* bm = kfch + o * HY_KFO + ((k1 ? 0 : 64) + ((64 - k1) & 63)) * 8;
#pragma unroll
          for (int s = 0; s < 64; ++s) { const int k0 = rev6(s);
              if (k0 < 32) { const f32x2 kv = *(const LAS f32x2*)(bd + k0 * 512); const float tr = re[s] * kv.x - im[s] * kv.y, ti = re[s] * kv.y + im[s] * kv.x; re[s] = tr; im[s] = ti; }
              else { const f32x2 kv = *(const LAS f32x2*)(bm + (63 - k0) * 512); const float tr = re[s] * kv.x + im[s] * kv.y, ti = im[s] * kv.x - re[s] * kv.y; re[s] = tr; im[s] = ti; }
              if ((s & 7) == 7) __builtin_amdgcn_sched_barrier(0); } }
        __builtin_amdgcn_sched_barrier(0);
        wfft_inv(re, im, wx, lane);
        hy_load2b(pre, o == 0 ? PX1 : PX2, lane); hy_commit2(pre, wxb, lane);
        { const int xo = (o + 1) * HYW + c; const float w0 = cw[xo], w1 = cw[3 * HYW + xo], w2 = cw[6 * HYW + xo], b = cb[xo];
#pragma unroll
          for (int n1 = 0; n1 < 32; ++n1) { const int t = 64 * n1 + lane;
              const float g0 = b + w0 * raw2(wxb, 0, t - 1) + w1 * raw2(wxb, 0, t) + w2 * raw2(wxb, 0, t + 1);
              const float g1 = b + w0 * raw2(wxb, 1, t - 1) + w1 * raw2(wxb, 1, t) + w2 * raw2(wxb, 1, t + 1);
              re[n1] *= g0; im[n1] *= g1; if ((n1 & 3) == 3) __builtin_amdgcn_sched_barrier(0); } }
        hy_load2a(pre, o == 0 ? PX2 : GH, lane);
    }
    int lane_g = F.lane; asm volatile("" : "+v"(lane_g));
    hy_load2b(pre, GH, lane_g); hy_commit2(pre, wxb, lane_g);
    if (!dry)
#pragma unroll
    for (int n1 = 0; n1 < 32; ++n1) { const int t = 64 * n1 + lane_g; const float g0 = raw2(wxb, 0, t), g1 = raw2(wxb, 1, t);
        ((GAS bf16*)OUT)[t] = (bf16)f2bf(re[n1] * g0 * fast_sigmoid(g0)); ((GAS bf16*)OUT)[SEQ + t] = (bf16)f2bf(im[n1] * g1 * fast_sigmoid(g1)); if ((n1 & 3) == 3) __builtin_amdgcn_sched_barrier(0); }
    asm volatile("s_waitcnt lgkmcnt(0)" ::: "memory");
}
__device__ __forceinline__ void hy_quad(Frame& F, int l, int c0) {
    const int grp = F.wave >> 2, ws = F.wave & 3;
    LAS unsigned char* wxb = F.lds + HY_WX + F.wave * HY_WXB;
    LAS unsigned char* kf0 = F.lds + HY_KF; LAS unsigned char* kfch = kf0 + grp * HY_KFCH;
    LAS float* red = (LAS float*)(F.lds + HY_RED);
    float* tap2 = (float*)(F.ws + WS_R6) + (size_t)F.bx * 2 * 4 * SEQ;
    hy_filter_gen4(F, l, c0, kf0, tap2, red + 8 * F.wave);
    VM_WAIT(); LDS_WAIT(); __syncthreads();
#pragma unroll 1
    for (int rnd = 0; rnd < 2; ++rnd) {
        const int c = c0 + F.G * (2 * rnd + grp);
        if (rnd == 1) {
            const int t_ = F.wave * 64 + cur_lane();
#pragma unroll
            for (int i = 0; i < 8; ++i) { const int q = t_ + 512 * i;
                const v4u v = *(const GAS v4u*)(tap2 + 4 * (size_t)q); *(LAS v4u*)(kf0 + (q >> 11) * HY_KFCH + 16 * (q & 2047)) = v; }
            LDS_WAIT(); __syncthreads();
        }
        Stage2 pre;
        if (ws == 0) hy_filter_fft(F, l, c, kfch, red + 2 * (2 * rnd + grp), (LAS float*)wxb);
        hy_load2(pre, (const bf16*)(F.ws + WS_R1) + (size_t)c * M + (size_t)(2 * ws) * SEQ, F.lane);
        LDS_WAIT(); __syncthreads();
        hy_wave_main(F, l, c, ws, wxb, kfch, pre);
        LDS_WAIT(); __syncthreads();
    }
}

__device__ __forceinline__ void transpose_pass(Frame& F) {
    const bf16* src = (const bf16*)(F.ws + WS_R1); bf16* dst = (bf16*)(F.ws + WS_R2);
    LAS unsigned char* tile = F.lds + F.wave * 18432; const int lane = F.lane;
    const int gw = F.bx * NWAVES + F.wave, NGW = F.G * NWAVES;
    constexpr int NTC = HYW / 64, NTT = M / 64;
    for (int it0 = 2 * gw; it0 < NTC * NTT; it0 += 2 * NGW) {
        v4u ld[2][8];
#pragma unroll
        for (int u = 0; u < 2; ++u) { const int it = it0 + u, c0 = (it % NTC) * 64, t0 = (it / NTC) * 64;
#pragma unroll
            for (int i = 0; i < 8; ++i) { const int q = lane + 64 * i, cr = q >> 3, ch = q & 7; ld[u][i] = *(const GAS v4u*)(src + (size_t)(c0 + cr) * M + t0 + 8 * ch); } }
#pragma unroll
        for (int u = 0; u < 2; ++u)
#pragma unroll
            for (int i = 0; i < 8; ++i) { const int q = lane + 64 * i, cr = q >> 3, ch = q & 7; *(LAS v4u*)(tile + u * 9216 + cr * 144 + 16 * ch) = ld[u][i]; }
        LDS_WAIT(); asm volatile("" ::: "memory");
#pragma unroll
        for (int u = 0; u < 2; ++u) { const int it = it0 + u, c0 = (it % NTC) * 64, t0 = (it / NTC) * 64;
#pragma unroll
            for (int i = 0; i < 8; ++i) { const int q = lane + 64 * i, tr = q >> 3, ch = q & 7;
                unsigned short e[8];
#pragma unroll
                for (int kk = 0; kk < 8; ++kk) e[kk] = *(const LAS unsigned short*)(tile + u * 9216 + (8 * ch + kk) * 144 + 2 * tr);
                v4u o; o.x = e[0] | ((unsigned)e[1] << 16); o.y = e[2] | ((unsigned)e[3] << 16); o.z = e[4] | ((unsigned)e[5] << 16); o.w = e[6] | ((unsigned)e[7] << 16);
                *(GAS v4u*)(dst + (size_t)(t0 + tr) * HYW + c0 + 8 * ch) = o; } }
        LDS_WAIT(); asm volatile("" ::: "memory");
    }
}
__device__ __forceinline__ void final_norm(Frame& F) {
    const int gw = F.bx * NWAVES + F.wave, NGW = F.G * NWAVES, lane = F.lane; const GAS f32x4* wv = (const GAS f32x4*)F.inp(26) + lane;
    f32x4 w[4];
#pragma unroll
    for (int j = 0; j < 4; ++j) w[j] = wv[64 * j];
    for (int m0 = 2 * gw; m0 < M; m0 += 2 * NGW) { f32x4 v[2][4];
#pragma unroll
        for (int r = 0; r < 2; ++r) { const GAS f32x4* xr = (const GAS f32x4*)(F.out + (size_t)(m0 + r) * D) + lane;
#pragma unroll
            for (int j = 0; j < 4; ++j) v[r][j] = xr[64 * j]; }
#pragma unroll
        for (int r = 0; r < 2; ++r) { float s = 0.f; GAS f32x4* xo = (GAS f32x4*)(F.out + (size_t)(m0 + r) * D) + lane;
#pragma unroll
            for (int j = 0; j < 4; ++j) s += (v[r][j].x * v[r][j].x + v[r][j].y * v[r][j].y) + (v[r][j].z * v[r][j].z + v[r][j].w * v[r][j].w);
            const float rs = 1.0f / sqrtf(wave_sum(s) * (1.0f / D) + 1e-6f);
#pragma unroll
            for (int j = 0; j < 4; ++j) xo[64 * j] = v[r][j] * rs * w[j]; } }
}

struct Args { const float* in[27]; float* out; unsigned char* ws; int ph_lo, ph_hi; };
__global__ void __launch_bounds__(NTHREADS, 2) mk_fwd(Args args) {
    extern __shared__ __attribute__((aligned(16))) unsigned char lds[];
    Frame F; F.lds = (LAS unsigned char*)lds; F.wave = __builtin_amdgcn_readfirstlane(threadIdx.x >> 6); F.tid = 0; F.lane = 0; F.G = gridDim.x; F.bx = blockIdx.x;
    F.out = args.out; F.ws = args.ws;
    volatile LAS unsigned* MISC = (volatile LAS unsigned*)(F.lds + LDSCTL_OFF);
    if (threadIdx.x < 64) MISC[threadIdx.x] = 0u;
    if (threadIdx.x == 64) { LAS unsigned long long* tab = (LAS unsigned long long*)(F.lds + LDSCTL_OFF + 256);
#pragma unroll
        for (int i = 0; i < 27; ++i) tab[i] = (unsigned long long)args.in[i]; }
    __syncthreads();
    XcdBarrier bar; bar.bar = (unsigned*)(F.ws + WS_CTL) + 1024; bar.x = 0; bar.st = nullptr;
    if (!MK_PER_PHASE) bar = xcd_barrier_post((unsigned*)(F.ws + WS_CTL) + 1024, MISC + 8, threadIdx.x == 0);
    const int lo = args.ph_lo, hi = args.ph_hi;
#define IN(k) (lo <= (k) && (k) < hi)
#if defined(MK_TIMING)
    unsigned long long* TS = (unsigned long long*)(F.ws + WS_CTL + 32768);
#define STAMP(k) do { if (blockIdx.x == 0 && threadIdx.x == 0) __hip_atomic_store(&TS[k], (unsigned long long)__builtin_amdgcn_s_memrealtime(), __ATOMIC_RELAXED, __HIP_MEMORY_SCOPE_AGENT); } while (0)
#else
#define STAMP(k) do { } while (0)
#endif
#define SEAM(k) do { if (IN(k) && IN((k) + 1)) xcd_barrier(bar, F.wave); STAMP((k) + 1); } while (0)
    LAS unsigned char* ring = F.lds;
    STAMP(0);
#ifndef MK_ONLY
#define MK_ONLY -1
#endif
#define ON(k) (MK_ONLY < 0 || MK_ONLY == (k))
#define FRAME_P0(Fp) Frame Fp = F; { int l_ = cur_lane(); asm volatile("" : "+v"(l_)); Fp.lane = l_; Fp.tid = F.wave * 64 + l_; Fp.ws = wsl; }
#ifndef MK_REP0
#define MK_REP0 1
#endif
#pragma unroll 1
    for (int rep0 = 0; rep0 < MK_REP0; ++rep0)
    if (ON(0) && IN(0)) { unsigned char* wsl = F.ws; FRAME_P0(Fp); p0_prologue(Fp); }
    SEAM(0);
#pragma unroll 1
    for (int l = 0; l < DEPTH; ++l) {
        const int pb = 1 + 5 * l;
        unsigned char* wsl = F.ws; asm volatile("" : "+s"(wsl));
#define WSL(off) (wsl + (off))
#define OPQ(p) asm volatile("" : "+s"(p))
#define FRAME_P(Fp) Frame Fp = F; { int l_ = cur_lane(); asm volatile("" : "+v"(l_)); Fp.lane = l_; Fp.tid = F.wave * 64 + l_; Fp.ws = wsl; }
        bf16* wl = (bf16*)WSL(WS_W + (size_t)l * W_LAYER);
        bf16* X = (bf16*)WSL(WS_X); float* ssq = (float*)WSL(WS_SSQ);
        bf16 *R1 = (bf16*)WSL(WS_R1), *R2 = (bf16*)WSL(WS_R2), *R3 = (bf16*)WSL(WS_R3), *R5 = (bf16*)WSL(WS_R5), *R6 = (bf16*)WSL(WS_R6);
#ifndef MK_REP1
#define MK_REP1 1
#define MK_REP12 1
#define MK_REP3 1
#define MK_REP4 1
#endif
#pragma unroll 1
        for (int rep12 = 0; rep12 < MK_REP12; ++rep12) {
#pragma unroll 1
        for (int rep1 = 0; rep1 < MK_REP1; ++rep1)
        if (ON(1) && IN(pb)) {
            { pg8::Gemm g{wl + W_IN / 2, X, 4096, M, D, D, D}; pg8::StaticOrder S; S.init(4096, M, F.G, F.bx); pg8::EpiHT E{R1, M, ssq};
              pg8::gemm_phase<pg8::EpiHT, pg8::StaticOrder, true, true, 1024, 1024, 1024>(ring, g, S, E, F.wave); }
            OPQ(X); OPQ(wl);
            { pg8::Gemm g{X, wl + W_IN / 2 + (size_t)4096 * D, M, 1024, D, D, D}; pg8::StaticOrder S; S.init(M, 1024, F.G, F.bx); pg8::EpiRow<0> E{R5, 1024, ssq};
              pg8::gemm_phase<pg8::EpiRow<0>, pg8::StaticOrder, true, true, 1024, 1024, 1024>(ring, g, S, E, F.wave); }
        }
        SEAM(pb);
        if (IN(pb + 1)) {
#if defined(MK_S5DRY)
            if (ON(2)) { FRAME_P(Fq); for (int it = F.bx; it < BATCH * S5G; it += F.G) s5_item(Fq, l, it / S5G, it % S5G, true); }
#endif
            if (ON(2)) { FRAME_P(Fp); for (int it = F.bx; it < BATCH * S5G; it += F.G) s5_item(Fp, l, it / S5G, it % S5G); }
            if (ON(3)) { FRAME_P(Fp); if (4 * F.G == HYW) hy_quad(Fp, l, F.bx); }
        }
        if (rep12 + 1 < MK_REP12) xcd_barrier(bar, F.wave);
        }
        SEAM(pb + 1);
#pragma unroll 1
        for (int rep3 = 0; rep3 < MK_REP3; ++rep3)
        if (ON(4) && IN(pb + 2)) {
            { pg8::Gemm g{X, wl + W_IN / 2 + (size_t)5120 * D, M, 2048, D, D, D}; pg8::StaticOrder S; S.init(M, 2048, F.G, F.bx); pg8::EpiRow<1> E{R3, 2048, ssq};
              pg8::gemm_phase<pg8::EpiRow<1>, pg8::StaticOrder, true, true, 1024, 1024, 1024>(ring, g, S, E, F.wave); }
            OPQ(R5); OPQ(wl);
            { pg8::Gemm g{R5, wl + W_GLU / 2, M, S5W, S5W, 1024, S5W}; pg8::StaticOrder S; S.init(M, S5W, F.G, F.bx); pg8::EpiGLU E{R6, S5W, R5, 1024, F.inp(12) + l * S5W};
              pg8::gemm_phase<pg8::EpiGLU, pg8::StaticOrder, true, true, 512, 1024, 512>(ring, g, S, E, F.wave); }
            __syncthreads();
            { FRAME_P(Fp); transpose_pass(Fp); }
            __syncthreads();
        }
        SEAM(pb + 2);
#pragma unroll 1
        for (int rep4 = 0; rep4 < MK_REP4; ++rep4)
        if (ON(5) && IN(pb + 3)) {
            { pg8::Gemm g{R6, wl + W_BS5 / 2, M, D, S5W, S5W, S5W}; pg8::StaticOrder S; S.init(M, D, F.G, F.bx); pg8::EpiMerge<0> E{R1, D, R3, 2048, 0};
              pg8::gemm_phase<pg8::EpiMerge<0>, pg8::StaticOrder, true, true, 512, 512, 512>(ring, g, S, E, F.wave); }
            VM_WAIT(); __syncthreads();
            OPQ(R2); OPQ(wl);
            { pg8::Gemm g{R2, wl + W_BHY / 2, M, D, HYW, HYW, HYW}; pg8::StaticOrder S; S.init(M, D, F.G, F.bx); pg8::EpiMerge<1> E{R1, D, R3, 2048, 1024};
              pg8::gemm_phase<pg8::EpiMerge<1>, pg8::StaticOrder, true, true, 1024, 1024, 1024>(ring, g, S, E, F.wave); }
        }
        SEAM(pb + 3);
        if (ON(6) && IN(pb + 4)) {
            pg8::Gemm g{R1, wl + W_OUT / 2, M, D, D, D, D}; pg8::StaticOrder S; S.init(M, D, F.G, F.bx); pg8::EpiOut E{l == 0 ? F.inp(0) : (const float*)F.out, F.out, X, ssq, l == DEPTH - 1};
            pg8::gemm_phase<pg8::EpiOut, pg8::StaticOrder, true, true, 1024, 1024, 1024>(ring, g, S, E, F.wave);
        }
        SEAM(pb + 4);
    }
    if (ON(7) && IN(11)) { unsigned char* wsl = F.ws; FRAME_P0(Fp); final_norm(Fp); }
#if defined(MK_TIMING)
    xcd_barrier(bar, F.wave); STAMP(12); xcd_barrier(bar, F.wave);
    { const unsigned long long a0 = __hip_atomic_load(&TS[MK_TA0], __ATOMIC_RELAXED, __HIP_MEMORY_SCOPE_AGENT), a1 = __hip_atomic_load(&TS[MK_TA1], __ATOMIC_RELAXED, __HIP_MEMORY_SCOPE_AGENT);
      const unsigned long long b0 = __hip_atomic_load(&TS[MK_TB0], __ATOMIC_RELAXED, __HIP_MEMORY_SCOPE_AGENT), b1 = __hip_atomic_load(&TS[MK_TB1], __ATOMIC_RELAXED, __HIP_MEMORY_SCOPE_AGENT);
      const float ta = (float)(a1 - a0) * 0.01f, tb = (float)(b1 - b0) * 0.01f;
      const float c = sqrtf(ta * 0.1f);
      for (size_t i = (size_t)blockIdx.x * NTHREADS + threadIdx.x; i < (size_t)M * D; i += (size_t)gridDim.x * NTHREADS) F.out[i] = (i == 0) ? tb : c; }
#endif
#undef IN
#undef SEAM
}

#if defined(MK_DEBUG_HASH)
extern "C" void kernel_launch_dbg(void* const* d_in, void* d_out, void* d_ws, hipStream_t stream, int grid);
#endif
extern "C" void kernel_launch(void* const* d_in, const int* in_sizes, int n_in, void* d_out, int out_size, void* d_ws, size_t ws_size, hipStream_t stream) {
    static int grid = 0;
    if (grid == 0) {
        if (n_in != 27 || out_size != M * D || ws_size < WS_END) { fprintf(stderr, "kernel_launch: unexpected shapes (n_in %d out %d ws %zu)\n", n_in, out_size, ws_size); grid = -1; return; }
        int dev = 0, cus = 0, per_cu = 0;
        if (hipGetDevice(&dev) != hipSuccess || hipDeviceGetAttribute(&cus, hipDeviceAttributeMultiprocessorCount, dev) != hipSuccess) { grid = -1; return; }
        if (hipFuncSetAttribute((const void*)mk_fwd, hipFuncAttributeMaxDynamicSharedMemorySize, LDS_BYTES) != hipSuccess) { fprintf(stderr, "kernel_launch: hipFuncSetAttribute failed\n"); grid = -1; return; }
        if (hipOccupancyMaxActiveBlocksPerMultiprocessor(&per_cu, (const void*)mk_fwd, NTHREADS, LDS_BYTES) != hipSuccess || per_cu < 1) fprintf(stderr, "kernel_launch: occupancy query says %d\n", per_cu);
        (void)hipGetLastError();
        grid = cus;
    }
    if (grid < 0) return;
    (void)hipMemsetAsync((char*)d_ws + WS_CTL, 0, CTL_ZERO_BYTES, stream);
    Args a{};
    for (int i = 0; i < 27; ++i) a.in[i] = (const float*)d_in[i];
    a.out = (float*)d_out; a.ws = (unsigned char*)d_ws;
#if defined(MK_DEBUG_HASH)
    kernel_launch_dbg(d_in, d_out, d_ws, stream, grid);
#elif MK_PER_PHASE
    for (int p = 0; p < NPHASE; ++p) { a.ph_lo = p; a.ph_hi = p + 1; hipLaunchKernelGGL(mk_fwd, dim3(grid), dim3(NTHREADS), LDS_BYTES, stream, a); }
#else
    a.ph_lo = 0; a.ph_hi = NPHASE; hipLaunchKernelGGL(mk_fwd, dim3(grid), dim3(NTHREADS), LDS_BYTES, stream, a);
#endif
}

#if defined(MK_DEBUG_HASH)
__global__ void dbg_hash(const unsigned* p, size_t nwords, unsigned long long* out) {
    unsigned long long s = 0; for (size_t i = (size_t)blockIdx.x * blockDim.x + threadIdx.x; i < nwords; i += (size_t)gridDim.x * blockDim.x) s += p[i];
    atomicAdd(out, s);
}
__global__ void dbg_report(const unsigned long long* h, float* out, size_t n) {
    int first = -1; for (int p = 0; p < NPHASE && first < 0; ++p) for (int r = 0; r < 4; ++r) if (h[p * 4 + r] != h[NPHASE * 4 + p * 4 + r]) { first = p; break; }
    const float c = first < 0 ? 0.f : sqrtf((float)(first + 1));
    for (size_t i = (size_t)blockIdx.x * blockDim.x + threadIdx.x; i < n; i += (size_t)gridDim.x * blockDim.x) out[i] = c;
}
extern "C" void kernel_launch_dbg(void* const* d_in, void* d_out, void* d_ws, hipStream_t stream, int grid) {
    Args a{}; for (int i = 0; i < 27; ++i) a.in[i] = (const float*)d_in[i];
    a.out = (float*)d_out; a.ws = (unsigned char*)d_ws;
    unsigned long long* H = (unsigned long long*)((char*)d_ws + 253 * MiB);
    (void)hipMemsetAsync(H, 0, 2 * NPHASE * 4 * 8, stream);
    struct Reg { size_t off, len; bool out; };
    auto regs_of = [&](int p, Reg (&r)[4]) { for (int i = 0; i < 4; ++i) r[i] = Reg{0, 0, false};
        if (p == 0) { r[0] = Reg{1 * MiB, 1 * MiB, false}; r[1] = Reg{2 * MiB, 1 * MiB + 64 * 1024, false}; r[2] = Reg{4 * MiB, 39 * MiB, false}; r[3] = Reg{43 * MiB, 33 * MiB, false}; return; }
        if (p == 11) { r[0] = Reg{0, (size_t)M * D * 4, true}; return; }
        const int q = (p - 1) % 5;
        if (q == 0) { r[0] = Reg{WS_R1, 128 * MiB, false}; r[1] = Reg{WS_R5, 32 * MiB, false}; }
        if (q == 1) { r[0] = Reg{WS_R1, 32 * MiB, false}; r[1] = Reg{WS_R5, 32 * MiB, false}; }
        if (q == 2) { r[0] = Reg{WS_R3, 64 * MiB, false}; r[1] = Reg{WS_R6, 16 * MiB, false}; r[2] = Reg{WS_R2, 32 * MiB, false}; }
        if (q == 3) { r[0] = Reg{WS_R1, 32 * MiB, false}; }
        if (q == 4) { r[0] = Reg{0, (size_t)M * D * 4, true}; r[1] = Reg{WS_X, 32 * MiB, false}; r[2] = Reg{WS_SSQ, 1 * MiB, false}; } };
    for (int run = 0; run < 2; ++run) {
        if (run == 0) (void)hipMemsetAsync((char*)d_ws + 1 * MiB, 0xAA, 251 * MiB, stream);
        (void)hipMemsetAsync((char*)d_ws + WS_CTL, 0, CTL_ZERO_BYTES, stream);
        for (int p = 0; p < NPHASE; ++p) { a.ph_lo = p; a.ph_hi = p + 1; hipLaunchKernelGGL(mk_fwd, dim3(grid), dim3(NTHREADS), LDS_BYTES, stream, a);
            Reg r[4]; regs_of(p, r);
            for (int i = 0; i < 4; ++i) if (r[i].len) hipLaunchKernelGGL(dbg_hash, dim3(1024), dim3(256), 0, stream, (const unsigned*)((r[i].out ? (char*)d_out : (char*)d_ws) + r[i].off), r[i].len / 4, H + (run * NPHASE + p) * 4 + i); }
    }
    hipLaunchKernelGGL(dbg_report, dim3(1024), dim3(256), 0, stream, H, (float*)d_out, (size_t)M * D);
}
#endif
```

```cpp
#include <hip/hip_runtime.h>
#include <cstdio>
#include <cstdint>
#include <cmath>
#include <utility>
namespace pg8 {
#define PG8_LAS __attribute__((address_space(3)))
typedef unsigned short bf16_t;
typedef short bf16x8 __attribute__((ext_vector_type(8)));
typedef float f32x4 __attribute__((ext_vector_type(4)));
typedef unsigned u32x4 __attribute__((ext_vector_type(4)));
constexpr int BM = 256, BK = 64, HALF = 128, HTB = HALF * BK * 2  , STAGE_BYTES = 8 * HTB, NXCD = 8, WGM = 8;

__host__ __device__ __forceinline__ int lds_byte(int r, int c) { const int st = (r >> 4) * 2 + (c >> 5), rr = r & 15, cc = c & 31, ob = rr * 64 + cc * 2; return st * 1024 + (ob ^ (((ob >> 9) & 1) << 5)); }
__host__ __device__ __forceinline__ void stage_rc(int b, int& R, int& C) { const int st = b / 1024, sb = b % 1024, swz = sb ^ (((sb >> 9) & 1) << 5); R = (st >> 1) * 16 + swz / 64; C = (st & 1) * 32 + (swz % 64) / 2; }
__host__ __device__ __forceinline__ int perm32(int rho) { const int n = rho >> 4, i = rho & 15; return 8 * (i >> 2) + 4 * n + (i & 3); }

struct Unit { int pm, pn; };
struct Gemm { const bf16_t* A; const bf16_t* Bt; int M, N, K, lda, ldb; };

struct StaticOrder {
    int nM, nN, nwg, G, c;
    __host__ __device__ void init(int M, int N, int G_, int c_) { nM = M / BM; nN = N / BM; nwg = nM * nN; G = G_; c = c_; }
    __host__ __device__ bool next(int i, Unit& u) const {
        const long L = (long)i * G + c; if (L >= nwg) return false;
        int wgid = (int)L; { const int q = nwg / NXCD, r = nwg % NXCD, xcd = wgid % NXCD, off = wgid / NXCD; wgid = (xcd < r ? xcd * (q + 1) : r * (q + 1) + (xcd - r) * q) + off; }
        const int nig = WGM * nN, gid = wgid / nig, fm = gid * WGM, gsz = (nM - fm) < WGM ? (nM - fm) : WGM;
        u.pm = fm + ((wgid % nig) % gsz); u.pn = (wgid % nig) / gsz; return true;
    }
    __device__ __forceinline__ void a_ready(const Unit&) const {}
    __device__ __forceinline__ void done(const Unit&) const {}
};

typedef unsigned u32x2 __attribute__((ext_vector_type(2)));

typedef __bf16 bf16x2_t __attribute__((ext_vector_type(2)));
typedef float f32x2_t __attribute__((ext_vector_type(2)));
__device__ __forceinline__ unsigned cvt_pk_bf16(float lo, float hi) { const f32x2_t v = {lo, hi}; const bf16x2_t b = __builtin_convertvector(v, bf16x2_t); return __builtin_bit_cast(unsigned, b); }
__device__ __forceinline__ float bf_lo(unsigned w) { return __uint_as_float(w << 16); }
__device__ __forceinline__ float bf_hi(unsigned w) { return __uint_as_float(w & 0xffff0000u); }
__device__ __forceinline__ float fast_sigmoid(float x) { return __builtin_amdgcn_rcpf(1.0f + __builtin_amdgcn_exp2f(-1.4426950408889634f * x)); }
constexpr float RMS_EPS = 1e-6f;
#define GAS_ __attribute__((address_space(1)))
__device__ __forceinline__ float rs_of(const float* ssq, int tok) {
    const GAS_ f32x4* p = (const GAS_ f32x4*)(ssq + (size_t)tok * 16); const f32x4 a = p[0], b = p[1], c = p[2], d = p[3];
    const float s = ((a[0] + a[1]) + (a[2] + a[3])) + ((b[0] + b[1]) + (b[2] + b[3])) + ((c[0] + c[1]) + (c[2] + c[3])) + ((d[0] + d[1]) + (d[2] + d[3]));
    return 1.0f / sqrtf(s * (1.0f / 1024.0f) + RMS_EPS);
}
struct EpiHT {
    static constexpr bool PERM = true, AFTER_DRAIN = false;
    bf16_t* O; int ldc; const float* ssq;
    __device__ __forceinline__ void operator()(const f32x4 (&acc)[2][2][4][2], const Unit& u, int wr, int wc, int fr, int fq) const {
        const int lane = (fq << 4) | fr;
        const int ctile = u.pn * BM + wc * 32 + 8 * fq;
        const float mine = rs_of(ssq, ctile + 128 * (fr >> 3) + (fr & 7));
        const int row0 = u.pm * BM + wr * 64 + fr;
#pragma unroll
        for (int bj = 0; bj < 2; ++bj) { float rsv[8];
#pragma unroll
            for (int i = 0; i < 8; ++i) rsv[i] = __shfl(mine, (lane & 48) | (8 * bj + i));
#pragma unroll
            for (int ai = 0; ai < 2; ++ai)
#pragma unroll
                for (int m = 0; m < 4; ++m) { bf16_t* rowp = O + (size_t)(row0 + ai * HALF + m * 16) * ldc + ctile + bj * HALF;
                    const f32x4 v0 = acc[ai][bj][m][0], v1 = acc[ai][bj][m][1]; u32x4 w;
                    w.x = cvt_pk_bf16(v0[0] * rsv[0], v0[1] * rsv[1]); w.y = cvt_pk_bf16(v0[2] * rsv[2], v0[3] * rsv[3]);
                    w.z = cvt_pk_bf16(v1[0] * rsv[4], v1[1] * rsv[5]); w.w = cvt_pk_bf16(v1[2] * rsv[6], v1[3] * rsv[7]);
                    *(GAS_ u32x4*)rowp = w; }
            asm volatile("" ::: "memory"); }
    }
};
template <int SIG> struct EpiRow {
    static constexpr bool PERM = true, AFTER_DRAIN = false;
    bf16_t* O; int ldc; const float* ssq;
    __device__ __forceinline__ void operator()(const f32x4 (&acc)[2][2][4][2], const Unit& u, int wr, int wc, int fr, int fq) const {
        const int lane = (fq << 4) | fr;
        const int row0 = u.pm * BM + wr * 64 + fr;
        float mine[2];
#pragma unroll
        for (int i = 0; i < 2; ++i) { const int q = 2 * fq + i; mine[i] = rs_of(ssq, row0 + (q >> 2) * HALF + (q & 3) * 16); }
        const int col0 = u.pn * BM + wc * 32 + 8 * fq;
#pragma unroll
        for (int ai = 0; ai < 2; ++ai)
#pragma unroll
            for (int m = 0; m < 4; ++m) { const int q = ai * 4 + m; const float rs = __shfl(mine[q & 1], ((q >> 1) << 4) | (lane & 15));
                bf16_t* rowp = O + (size_t)(row0 + ai * HALF + m * 16) * ldc + col0;
#pragma unroll
                for (int bj = 0; bj < 2; ++bj) { f32x4 v0 = acc[ai][bj][m][0] * rs, v1 = acc[ai][bj][m][1] * rs;
                    if (SIG) {
#pragma unroll
                        for (int e = 0; e < 4; ++e) { v0[e] = fast_sigmoid(v0[e]); v1[e] = fast_sigmoid(v1[e]); } }
                    u32x4 w; w.x = cvt_pk_bf16(v0[0], v0[1]); w.y = cvt_pk_bf16(v0[2], v0[3]); w.z = cvt_pk_bf16(v1[0], v1[1]); w.w = cvt_pk_bf16(v1[2], v1[3]);
                    *(GAS_ u32x4*)(rowp + bj * HALF) = w; }
                asm volatile("" ::: "memory"); }
    }
};
struct EpiGLU {
    static constexpr bool PERM = true, AFTER_DRAIN = false;
    bf16_t* O; int ldc; const bf16_t* YG; int ldy; const float* bglu;
    __device__ __forceinline__ void operator()(const f32x4 (&acc)[2][2][4][2], const Unit& u, int wr, int wc, int fr, int fq) const {
        const int row0 = u.pm * BM + wr * 64 + fr, col0 = u.pn * BM + wc * 32 + 8 * fq;
        f32x4 bv[2][2];
#pragma unroll
        for (int bj = 0; bj < 2; ++bj)
#pragma unroll
            for (int n = 0; n < 2; ++n) bv[bj][n] = *(const GAS_ f32x4*)(bglu + col0 + bj * HALF + 4 * n);
#pragma unroll
        for (int ai = 0; ai < 2; ++ai)
#pragma unroll
            for (int m = 0; m < 4; ++m) { const size_t r = (size_t)(row0 + ai * HALF + m * 16);
#pragma unroll
                for (int bj = 0; bj < 2; ++bj) { const int c = col0 + bj * HALF;
                    const u32x4 yv = *(const GAS_ u32x4*)(YG + r * ldy + c), gv = *(const GAS_ u32x4*)(YG + r * ldy + 512 + c);
                    const f32x4 a0 = acc[ai][bj][m][0] + bv[bj][0], a1 = acc[ai][bj][m][1] + bv[bj][1];
                    float o[8]; const unsigned yw[4] = {yv.x, yv.y, yv.z, yv.w}, gw[4] = {gv.x, gv.y, gv.z, gv.w};
#pragma unroll
                    for (int e = 0; e < 8; ++e) { const float a = e < 4 ? a0[e & 3] : a1[e & 3]; const float y = (e & 1) ? bf_hi(yw[e >> 1]) : bf_lo(yw[e >> 1]);
                        const float g = (e & 1) ? bf_hi(gw[e >> 1]) : bf_lo(gw[e >> 1]); o[e] = y * fast_sigmoid(a) * (g * fast_sigmoid(g)); }
                    u32x4 w; w.x = cvt_pk_bf16(o[0], o[1]); w.y = cvt_pk_bf16(o[2], o[3]); w.z = cvt_pk_bf16(o[4], o[5]); w.w = cvt_pk_bf16(o[6], o[7]);
                    *(GAS_ u32x4*)(O + r * ldc + c) = w; asm volatile("" ::: "memory"); } }
    }
};
template <int ADD> struct EpiMerge {
    static constexpr bool PERM = true, AFTER_DRAIN = false;
    bf16_t* O; int ldc; const bf16_t* G; int ldg; int goff;
    __device__ __forceinline__ void operator()(const f32x4 (&acc)[2][2][4][2], const Unit& u, int wr, int wc, int fr, int fq) const {
        const int row0 = u.pm * BM + wr * 64 + fr, col0 = u.pn * BM + wc * 32 + 8 * fq;
#pragma unroll
        for (int ai = 0; ai < 2; ++ai)
#pragma unroll
            for (int m = 0; m < 4; ++m) { const size_t r = (size_t)(row0 + ai * HALF + m * 16);
#pragma unroll
                for (int bj = 0; bj < 2; ++bj) { const int c = col0 + bj * HALF;
                    const u32x4 gv = *(const GAS_ u32x4*)(G + r * ldg + goff + c); u32x4 tv = {0u, 0u, 0u, 0u}; if (ADD) tv = *(const GAS_ u32x4*)(O + r * ldc + c);
                    const f32x4 a0 = acc[ai][bj][m][0], a1 = acc[ai][bj][m][1];
                    float o[8]; const unsigned gw[4] = {gv.x, gv.y, gv.z, gv.w}, tw[4] = {tv.x, tv.y, tv.z, tv.w};
#pragma unroll
                    for (int e = 0; e < 8; ++e) { const float a = e < 4 ? a0[e & 3] : a1[e & 3]; const float g = (e & 1) ? bf_hi(gw[e >> 1]) : bf_lo(gw[e >> 1]);
                        const float t = (e & 1) ? bf_hi(tw[e >> 1]) : bf_lo(tw[e >> 1]); o[e] = (ADD ? t : 0.f) + g * a; }
                    u32x4 w; w.x = cvt_pk_bf16(o[0], o[1]); w.y = cvt_pk_bf16(o[2], o[3]); w.z = cvt_pk_bf16(o[4], o[5]); w.w = cvt_pk_bf16(o[6], o[7]);
                    *(GAS_ u32x4*)(O + r * ldc + c) = w; asm volatile("" ::: "memory"); } }
    }
};
struct EpiOut {
    static constexpr bool PERM = false, AFTER_DRAIN = false;
    const float* base; float* H; bf16_t* XN; float* ssq; int last;
    __device__ __forceinline__ void operator()(const f32x4 (&acc)[2][2][4][2], const Unit& u, int wr, int wc, int fr, int fq) const {
        const int row0 = u.pm * BM + wr * 64 + fr, col0 = u.pn * BM + wc * 32 + 4 * fq;
#pragma unroll
        for (int ai = 0; ai < 2; ++ai)
#pragma unroll
            for (int m = 0; m < 4; ++m) { const size_t r = (size_t)(row0 + ai * HALF + m * 16); float s = 0.f;
#pragma unroll
                for (int bj = 0; bj < 2; ++bj)
#pragma unroll
                    for (int n = 0; n < 2; ++n) { const size_t off = r * 1024 + col0 + bj * HALF + n * 16;
                        const f32x4 h = *(const GAS_ f32x4*)(base + off) + acc[ai][bj][m][n]; *(GAS_ f32x4*)(H + off) = h;
                        s += (h[0] * h[0] + h[1] * h[1]) + (h[2] * h[2] + h[3] * h[3]);
                        if (!last) { u32x2 w; w.x = cvt_pk_bf16(h[0], h[1]); w.y = cvt_pk_bf16(h[2], h[3]); *(GAS_ u32x2*)(XN + off) = w; } }
                s += __shfl_xor(s, 16); s += __shfl_xor(s, 32);
                if (fq == 0 && !last) ((GAS_ float*)ssq)[r * 16 + u.pn * 4 + wc] = s; }
    }
};
template <class Epi, class Sched, bool ALIGN_EPI, bool SP2, int KK, int LDA, int LDB>
__device__ __forceinline__ void gemm_phase(PG8_LAS unsigned char* lds, const Gemm g, const Sched& S, const Epi& E, int wave_id  ) {
    int lane_; asm volatile("v_mbcnt_lo_u32_b32 %0, -1, 0\n\tv_mbcnt_hi_u32_b32 %0, -1, %0" : "=&v"(lane_)); const int tid_ = wave_id * 64 + lane_;
    const int tid = tid_, wid = __builtin_amdgcn_readfirstlane(tid >> 6), lane = tid & 63, wr = wid >> 2, wc = wid & 3, fr = lane & 15, fq = lane >> 4;
    constexpr int K = KK, nt = K / BK;
    unsigned voffA[2], voffB[2];
#pragma unroll
    for (int i = 0; i < 2; ++i) { int R, C; stage_rc(tid * 16 + i * 8192, R, C); const int Rb = Epi::PERM ? ((R & ~31) + perm32(R & 31)) : R;
        voffA[i] = (unsigned)(R * LDA + C) * 2u; voffB[i] = (unsigned)(Rb * LDB + C) * 2u; }
    constexpr size_t kstep = (size_t)(BK * 2);
    constexpr size_t hstepA = (size_t)HALF * LDA * 2, hstepB = (size_t)HALF * LDB * 2;
    constexpr size_t tstepA = 2 * hstepA, tstepB = 2 * hstepB;
    const unsigned ldsw = (unsigned)wid * 1024u;
    const int aoff = lds_byte(wr * 64 + fr, fq * 8), boff = lds_byte(wc * 32 + fr, fq * 8);
#define PG8_SA(b, h) (((b) * 2 + (h)) * HTB)
#define PG8_SB(b, h) ((4 + (b) * 2 + (h)) * HTB)
#define PG8_STAGE(bufoff, gbase, voff) do { _Pragma("unroll") for (int _i = 0; _i < 2; ++_i) \
        __builtin_amdgcn_global_load_lds((const unsigned*)((const char*)(gbase) + (voff)[_i]), (PG8_LAS unsigned*)(lds + (bufoff) + ldsw + _i * 8192), 16, 0, 0); } while (0)
#define PG8_LDA(dst, b, h) do { _Pragma("unroll") for (int m = 0; m < 4; ++m) _Pragma("unroll") for (int k = 0; k < 2; ++k) dst[m][k] = *(const PG8_LAS bf16x8*)(lds + PG8_SA(b, h) + aoff + m * 2048 + k * 1024); } while (0)
#define PG8_LDB(dst, b, h) do { _Pragma("unroll") for (int n = 0; n < 2; ++n) _Pragma("unroll") for (int k = 0; k < 2; ++k) dst[n][k] = *(const PG8_LAS bf16x8*)(lds + PG8_SB(b, h) + boff + n * 2048 + k * 1024); } while (0)
#define PG8_MMA(ai, bj, At, Bt) do { __builtin_amdgcn_s_setprio(1); _Pragma("unroll") for (int m = 0; m < 4; ++m) _Pragma("unroll") for (int n = 0; n < 2; ++n) _Pragma("unroll") for (int k = 0; k < 2; ++k) \
        acc[ai][bj][m][n] = __builtin_amdgcn_mfma_f32_16x16x32_bf16(Bt[n][k], At[m][k], acc[ai][bj][m][n], 0, 0, 0); __builtin_amdgcn_s_setprio(0); } while (0)
#define PG8_WAIT_V(n) asm volatile("s_waitcnt vmcnt(" #n ")" ::: "memory")
#define PG8_WAIT_L(n) asm volatile("s_waitcnt lgkmcnt(" #n ")" ::: "memory")
#define PG8_BAR __builtin_amdgcn_s_barrier()
#define PG8_SCHED __builtin_amdgcn_sched_barrier(0)
    Unit cur, nxt; int ui = 0;
    if (!S.next(0, cur)) return;
    f32x4 acc[2][2][4][2];
#pragma unroll
    for (int a = 0; a < 2; ++a)
#pragma unroll
        for (int b = 0; b < 2; ++b)
#pragma unroll
            for (int m = 0; m < 4; ++m)
#pragma unroll
                for (int n = 0; n < 2; ++n) acc[a][b][m][n] = (f32x4){0.f, 0.f, 0.f, 0.f};
    bf16x8 At[4][2], B0[2][2], B1[2][2];
    const char* cA = (const char*)g.A + (size_t)cur.pm * tstepA; const char* cB = (const char*)g.Bt + (size_t)cur.pn * tstepB;
    S.a_ready(cur);
    if constexpr (SP2) {
        PG8_STAGE(PG8_SB(0, 0), cB, voffB); PG8_STAGE(PG8_SB(0, 1), cB + hstepB, voffB); PG8_STAGE(PG8_SA(0, 0), cA, voffA); PG8_STAGE(PG8_SA(0, 1), cA + hstepA, voffA);
        if (wr == 1) PG8_BAR;
        PG8_WAIT_V(2); PG8_BAR;
        PG8_STAGE(PG8_SB(1, 0), cB + kstep, voffB); PG8_STAGE(PG8_SA(1, 0), cA + kstep, voffA); PG8_STAGE(PG8_SB(1, 1), cB + hstepB + kstep, voffB);
        PG8_WAIT_V(6); PG8_BAR;
    } else {
        PG8_STAGE(PG8_SB(0, 0), cB, voffB); PG8_STAGE(PG8_SA(0, 0), cA, voffA); PG8_STAGE(PG8_SB(0, 1), cB + hstepB, voffB); PG8_STAGE(PG8_SA(0, 1), cA + hstepA, voffA);
        if (wr == 1) PG8_BAR;
        PG8_WAIT_V(4); PG8_BAR;
        PG8_STAGE(PG8_SB(1, 0), cB + kstep, voffB); PG8_STAGE(PG8_SA(1, 0), cA + kstep, voffA); PG8_STAGE(PG8_SB(1, 1), cB + hstepB + kstep, voffB);
        PG8_WAIT_V(6); PG8_BAR;
    }
    for (;;) {
        const bool has_next = S.next(ui + 1, nxt);
        const char* nA = has_next ? (const char*)g.A + (size_t)nxt.pm * tstepA : cA; const char* nB = has_next ? (const char*)g.Bt + (size_t)nxt.pn * tstepB : cB;
        for (int t = 0; t < nt; t += 2) {
            const bool last = (t == nt - 2);
            const char* a1 = cA + (size_t)(t + 1) * kstep;
            const char* a2 = last ? nA : cA + (size_t)(t + 2) * kstep; const char* b2 = last ? nB : cB + (size_t)(t + 2) * kstep;
            const char* a3 = a2 + kstep; const char* b3 = b2 + kstep;
            if (last && has_next) S.a_ready(nxt);
            if constexpr (SP2) {
            PG8_LDB(B0, 0, 0); PG8_LDB(B1, 0, 1); PG8_SCHED; PG8_LDA(At, 0, 0); PG8_STAGE(PG8_SA(1, 1), a1 + hstepA, voffA);
            PG8_WAIT_V(8); PG8_WAIT_L(0); PG8_BAR; PG8_MMA(0, 0, At, B0); PG8_MMA(0, 1, At, B1); PG8_BAR; PG8_SCHED;
            PG8_LDA(At, 0, 1); PG8_STAGE(PG8_SB(0, 0), b2, voffB); PG8_STAGE(PG8_SB(0, 1), b2 + hstepB, voffB); PG8_STAGE(PG8_SA(0, 0), a2, voffA);
            PG8_WAIT_V(8); PG8_WAIT_L(0); PG8_BAR; PG8_MMA(1, 0, At, B0); PG8_MMA(1, 1, At, B1); PG8_BAR; PG8_SCHED;
            PG8_LDB(B0, 1, 0); PG8_LDB(B1, 1, 1); PG8_SCHED; PG8_LDA(At, 1, 0); PG8_STAGE(PG8_SA(0, 1), a2 + hstepA, voffA);
            PG8_WAIT_V(8); PG8_WAIT_L(0); PG8_BAR; PG8_MMA(0, 0, At, B0); PG8_MMA(0, 1, At, B1); PG8_BAR; PG8_SCHED;
            PG8_LDA(At, 1, 1); PG8_STAGE(PG8_SB(1, 0), b3, voffB); PG8_STAGE(PG8_SB(1, 1), b3 + hstepB, voffB); PG8_STAGE(PG8_SA(1, 0), a3, voffA);
            PG8_WAIT_V(8); PG8_WAIT_L(0); PG8_BAR; PG8_MMA(1, 0, At, B0); PG8_MMA(1, 1, At, B1); PG8_BAR; PG8_SCHED;
            } else {
            PG8_LDB(B0, 0, 0); PG8_SCHED; PG8_LDA(At, 0, 0); PG8_STAGE(PG8_SA(1, 1), a1 + hstepA, voffA);
            PG8_WAIT_L(8); PG8_BAR; PG8_WAIT_L(0); PG8_MMA(0, 0, At, B0); PG8_BAR; PG8_SCHED;
            PG8_LDB(B1, 0, 1); PG8_STAGE(PG8_SB(0, 0), b2, voffB);
            PG8_BAR; PG8_WAIT_L(0); PG8_MMA(0, 1, At, B1); PG8_BAR;
            PG8_LDA(At, 0, 1); PG8_STAGE(PG8_SA(0, 0), a2, voffA);
            PG8_BAR; PG8_WAIT_L(0); PG8_MMA(1, 0, At, B0); PG8_BAR; PG8_SCHED;
            PG8_STAGE(PG8_SB(0, 1), b2 + hstepB, voffB);
            PG8_WAIT_V(6); PG8_BAR; PG8_MMA(1, 1, At, B1); PG8_BAR;
            PG8_LDB(B0, 1, 0); PG8_SCHED; PG8_LDA(At, 1, 0); PG8_STAGE(PG8_SA(0, 1), a2 + hstepA, voffA);
            PG8_WAIT_L(8); PG8_BAR; PG8_WAIT_L(0); PG8_MMA(0, 0, At, B0); PG8_BAR; PG8_SCHED;
            PG8_LDB(B1, 1, 1); PG8_STAGE(PG8_SB(1, 0), b3, voffB);
            PG8_BAR; PG8_WAIT_L(0); PG8_MMA(0, 1, At, B1); PG8_BAR;
            PG8_LDA(At, 1, 1); PG8_STAGE(PG8_SA(1, 0), a3, voffA);
            PG8_BAR; PG8_WAIT_L(0); PG8_MMA(1, 0, At, B0); PG8_BAR; PG8_SCHED;
            PG8_STAGE(PG8_SB(1, 1), b3 + hstepB, voffB);
            PG8_WAIT_V(6); PG8_BAR; PG8_MMA(1, 1, At, B1); PG8_BAR;
            }
        }
        if constexpr (ALIGN_EPI) { if (wr == 0) PG8_BAR; }
        if constexpr (!Epi::AFTER_DRAIN) { E(acc, cur, wr, wc, fr, fq); S.done(cur); }
        if (!has_next) break;
#pragma unroll
        for (int a = 0; a < 2; ++a)
#pragma unroll
            for (int b = 0; b < 2; ++b)
#pragma unroll
                for (int m = 0; m < 4; ++m)
#pragma unroll
                    for (int n = 0; n < 2; ++n) acc[a][b][m][n] = (f32x4){0.f, 0.f, 0.f, 0.f};
        cur = nxt; cA = nA; cB = nB; ++ui;
        if constexpr (ALIGN_EPI) { if (wr == 1) PG8_BAR; }
    }
    PG8_WAIT_V(0);
    if constexpr (!ALIGN_EPI) { if (wr == 0) PG8_BAR; }
    PG8_BAR;
    if constexpr (Epi::AFTER_DRAIN) { E.fused(acc, cur, wr, wc, fr, fq, lds, wid, lane); S.done(cur); }
#undef PG8_SA
#undef PG8_SB
#undef PG8_STAGE
#undef PG8_LDA
#undef PG8_LDB
#undef PG8_MMA
#undef PG8_WAIT_V
#undef PG8_WAIT_L
#undef PG8_BAR
#undef PG8_SCHED
}
}

constexpr int NWAVES = 8, NTHREADS = 512;
#ifndef MK_PER_PHASE
#define MK_PER_PHASE 0
#endif
constexpr int D = 1024, BATCH = 8, SEQ = 2048, M = BATCH * SEQ, DEPTH = 2;
constexpr int S5W = 512, S5H = 16, S5G = 32, S5P = 64;
constexpr int HYW = 1024, HYF = 4096, HYE = 33, HYN = 64;
constexpr int INC = 7168;
constexpr int NPHASE = 12;

constexpr size_t MiB = 1u << 20;
constexpr size_t WS_CTL = 0, CTL_ZERO_BYTES = 64 * 1024;
constexpr size_t WS_H2 = 1 * MiB;
constexpr size_t WS_LBAR = 2 * MiB;
constexpr size_t WS_BBT = 2 * MiB + 64 * 1024;
constexpr size_t WS_CT = WS_BBT + 512 * 1024;
constexpr size_t WS_W = 4 * MiB;
constexpr size_t W_IN = 0, W_GLU = 14 * MiB, W_BS5 = W_GLU + 512 * 1024, W_BHY = W_BS5 + 1 * MiB, W_OUT = W_BHY + 2 * MiB, W_LAYER = W_OUT + 2 * MiB;
constexpr size_t WS_SSQ = 43 * MiB;
constexpr size_t WS_X = 44 * MiB;
constexpr size_t WS_R1 = 76 * MiB, WS_R2 = 108 * MiB, WS_R3 = 140 * MiB, WS_R4 = 172 * MiB, WS_R5 = 204 * MiB, WS_R6 = 236 * MiB, WS_W3T = 252 * MiB  , WS_END = 254 * MiB;
static_assert(WS_W + 2 * W_LAYER <= WS_SSQ, "weights");
constexpr int LDS_BYTES = 163840 - 256;
constexpr int LDSCTL_OFF = LDS_BYTES - 512;

#define GAS __attribute__((address_space(1)))
#define LAS __attribute__((address_space(3)))
typedef unsigned short bf16;
typedef unsigned v4u __attribute__((ext_vector_type(4)));
typedef unsigned v2u __attribute__((ext_vector_type(2)));
typedef float f32x4 __attribute__((ext_vector_type(4)));
typedef float f32x2 __attribute__((ext_vector_type(2)));
typedef short bf16x8 __attribute__((ext_vector_type(8)));
typedef GAS unsigned gu32;
#define RLX_AGENT __ATOMIC_RELAXED, __HIP_MEMORY_SCOPE_AGENT
#define LDS_WAIT() asm volatile("s_waitcnt lgkmcnt(0)" ::: "memory")
#define VM_WAIT() asm volatile("s_waitcnt vmcnt(0)" ::: "memory")
__device__ __forceinline__ unsigned f2bf(float f) { unsigned u = __builtin_bit_cast(unsigned, f); return (u + 0x7fffu + ((u >> 16) & 1u)) >> 16; }
__device__ __forceinline__ unsigned pk2(float lo, float hi) { return f2bf(lo) | (f2bf(hi) << 16); }
__device__ __forceinline__ float bf2f(unsigned short h) { return __uint_as_float((unsigned)h << 16); }
using pg8::bf_lo; using pg8::bf_hi; using pg8::fast_sigmoid;

#define XB_TMO      128
#define XB_XCNT(j)  (256  + 64 * (j))
#define XB_XSUB(j)  (1280 + 64 * (j))
#define XB_XGEN(j)  (2304 + 64 * (j))
#define XB_TOP      3328
#define XB_TOPGEN   3392
#define XCD_BAR_WORDS 3456
#define XB_SPIN_CAP (1u << 18)
__device__ __forceinline__ unsigned xb_ld(unsigned* p)              { return __hip_atomic_load(p, __ATOMIC_RELAXED, __HIP_MEMORY_SCOPE_AGENT); }
__device__ __forceinline__ unsigned xb_add(unsigned* p, unsigned v) { return __hip_atomic_fetch_add(p, v, __ATOMIC_RELAXED, __HIP_MEMORY_SCOPE_AGENT); }
__device__ __forceinline__ unsigned xb_xcc_id() { return (unsigned)__builtin_amdgcn_s_getreg((3 << 11) | 20) & 0xFu; }
#define XB_SPIN(cond, bar) do { unsigned _sp = 0; while (cond) { __builtin_amdgcn_s_sleep(1); \
    if ((++_sp & 255u) == 0u) { if (xb_ld(&(bar)[XB_TMO])) break; if (_sp > XB_SPIN_CAP) { atomicAdd(&(bar)[XB_TMO], 1u); break; } } } } while (0)
struct XcdBarrier { unsigned* bar; unsigned x; volatile LAS unsigned* st; };
__device__ __forceinline__ int cur_lane() { int l; asm volatile("v_mbcnt_lo_u32_b32 %0, -1, 0\n\tv_mbcnt_hi_u32_b32 %0, -1, %0" : "=&v"(l)); return l; }
__device__ __forceinline__ XcdBarrier xcd_barrier_post(unsigned* bar, volatile LAS unsigned* st, bool leader) {
    XcdBarrier b; b.bar = bar; b.x = xb_xcc_id(); b.st = st;
    if (leader) (void)xb_add(&bar[XB_XCNT(b.x)], 1u);
    return b;
}
__device__ __forceinline__ void xcd_barrier_complete(unsigned* bar, unsigned x, unsigned& nloc, unsigned& nx) {
    const unsigned G = gridDim.x * gridDim.y * gridDim.z;
    unsigned sum, cnt, mine, sp = 0u;
    for (;;) {
        sum = 0u; cnt = 0u; mine = 0u;
#pragma unroll
        for (unsigned j = 0; j < 16; ++j) { const unsigned c = xb_ld(&bar[XB_XCNT(j)]); sum += c; cnt += (c > 0u) ? 1u : 0u; mine = (j == x) ? c : mine; }
        if (sum == G) break;
        __builtin_amdgcn_s_sleep(1);
        if ((++sp & 255u) == 0u) { if (xb_ld(&bar[XB_TMO])) break; if (sp > XB_SPIN_CAP) { atomicAdd(&bar[XB_TMO], 1u); break; } }
    }
    nloc = mine > 0u ? mine : 1u; nx = cnt > 0u ? cnt : 1u;
}
__device__ __forceinline__ void xcd_barrier(const XcdBarrier& b, int wave_id) {
    asm volatile("s_waitcnt vmcnt(0)" ::: "memory");
    __syncthreads();
    if (wave_id == 0 && cur_lane() == 0) {
        unsigned* bar = b.bar; asm volatile("" : "+s"(bar));
        __builtin_amdgcn_s_waitcnt(0);
        unsigned nloc = b.st[0], nx = b.st[1];
        if (nloc == 0u) { xcd_barrier_complete(bar, b.x, nloc, nx); b.st[0] = nloc; b.st[1] = nx; }
        const unsigned old = xb_add(&bar[XB_XSUB(b.x)], 1u);
        const unsigned gen = old / nloc;
        if (old + 1u == (gen + 1u) * nloc) {
            __builtin_amdgcn_fence(__ATOMIC_RELEASE, "agent");
            asm volatile("s_waitcnt vmcnt(0)" ::: "memory");
            const unsigned og = xb_add(&bar[XB_TOP], 1u);
            const unsigned tg = og / nx;
            if (og + 1u == (tg + 1u) * nx) xb_add(&bar[XB_TOPGEN], 1u);
            else XB_SPIN(xb_ld(&bar[XB_TOPGEN]) == tg, bar);
            __builtin_amdgcn_fence(__ATOMIC_ACQUIRE, "agent");
            xb_add(&bar[XB_XGEN(b.x)], 1u);
            asm volatile("s_waitcnt vmcnt(0)" ::: "memory");
        } else {
            XB_SPIN(xb_ld(&bar[XB_XGEN(b.x)]) == gen, bar);
            __builtin_amdgcn_fence(__ATOMIC_ACQUIRE, "agent");
            asm volatile("s_waitcnt vmcnt(0)" ::: "memory");
        }
    }
    __syncthreads();
}

struct Frame {
    LAS unsigned char* lds;
    int tid, lane, wave, G, bx;
    float* out; unsigned char* ws;
    __device__ __forceinline__ const float* inp(int i) const {
        const LAS unsigned* t = (const LAS unsigned*)(lds + LDSCTL_OFF + 256) + 2 * i;
        const unsigned lo = __builtin_amdgcn_readfirstlane(t[0]), hi = __builtin_amdgcn_readfirstlane(t[1]);
        return (const float*)(((unsigned long long)hi << 32) | lo);
    }
};
__device__ __forceinline__ float wave_sum(float v) {
#pragma unroll
    for (int o = 1; o < 64; o <<= 1) v += __shfl_xor(v, o);
    return v;
}

__device__ __forceinline__ void p0_transpose_item(const float* W, int K, int N, bf16* WT, int k0, int n0, int drow, const float* kscale, LAS float* scr, int lane, bf16* WTlo = nullptr) {
    const int lr = lane >> 4, lc = (lane & 15) * 4;
    f32x4 v[16];
#pragma unroll
    for (int i = 0; i < 16; ++i) v[i] = *(const GAS f32x4*)(W + (size_t)(k0 + 4 * i + lr) * N + n0 + lc);
#pragma unroll
    for (int i = 0; i < 16; ++i) { const int kk = 4 * i + lr; f32x4 x = v[i]; if (kscale) x = x * kscale[k0 + kk];
        LAS float* d = scr + kk * 65 + lc; d[0] = x[0]; d[1] = x[1]; d[2] = x[2]; d[3] = x[3]; }
    LDS_WAIT(); asm volatile("" ::: "memory");
    const int c = lane & 7;
#pragma unroll
    for (int j = 0; j < 8; ++j) { const int n = (lane >> 3) + 8 * j; const LAS float* s = scr + (8 * c) * 65 + n;
        v4u o; o.x = pk2(s[0 * 65], s[1 * 65]); o.y = pk2(s[2 * 65], s[3 * 65]); o.z = pk2(s[4 * 65], s[5 * 65]); o.w = pk2(s[6 * 65], s[7 * 65]);
        *(GAS v4u*)(WT + (size_t)(drow + n) * K + k0 + 8 * c) = o;
        if (WTlo) { v4u q;
#define P0_LO2(a, b, hw) pk2((a) - __uint_as_float((hw) << 16), (b) - __uint_as_float((hw) & 0xffff0000u))
            q.x = P0_LO2(s[0 * 65], s[1 * 65], o.x); q.y = P0_LO2(s[2 * 65], s[3 * 65], o.y); q.z = P0_LO2(s[4 * 65], s[5 * 65], o.z); q.w = P0_LO2(s[6 * 65], s[7 * 65], o.w);
#undef P0_LO2
            *(GAS v4u*)(WTlo + (size_t)(drow + n) * K + k0 + 8 * c) = q; } }
    LDS_WAIT(); asm volatile("" ::: "memory");
}
__device__ __forceinline__ void p0_prologue(Frame& F) {
    LAS float* scr = (LAS float*)(F.lds + F.wave * 17408);
    const int gw = F.bx * NWAVES + F.wave, NGW = F.G * NWAVES, lane = F.lane;
    constexpr int I_IN = (D / 64) * (INC / 64), I_GLU = (S5W / 64) * (S5W / 64), I_BS5 = (S5W / 64) * (D / 64), I_BHY = (HYW / 64) * (D / 64), I_OUT = (D / 64) * (D / 64);
    constexpr int I_LAYER = I_IN + I_GLU + I_BS5 + I_BHY + I_OUT;
    for (int it = gw; it < DEPTH * I_LAYER; it += NGW) {
        const int l = it / I_LAYER; int r = it % I_LAYER; bf16* wl = (bf16*)(F.ws + WS_W + (size_t)l * W_LAYER);
        if (r < I_IN) { const int nblk = INC / 64, kb = r / nblk, nb = r % nblk, n0 = nb * 64;
            const int drow = (n0 >= 1024 && n0 < 5120) ? n0 - 1024 : (n0 < 1024 ? n0 + 4096 : n0);
            p0_transpose_item(F.inp(2) + (size_t)l * D * INC, D, INC, wl + W_IN / 2, kb * 64, n0, drow, F.inp(1) + l * D, scr, lane); continue; } r -= I_IN;
        if (r < I_GLU) { const int nblk = S5W / 64; p0_transpose_item(F.inp(11) + (size_t)l * S5W * S5W, S5W, S5W, wl + W_GLU / 2, (r / nblk) * 64, (r % nblk) * 64, (r % nblk) * 64, nullptr, scr, lane); continue; } r -= I_GLU;
        if (r < I_BS5) { const int nblk = D / 64; p0_transpose_item(F.inp(23) + (size_t)l * S5W * D, S5W, D, wl + W_BS5 / 2, (r / nblk) * 64, (r % nblk) * 64, (r % nblk) * 64, nullptr, scr, lane); continue; } r -= I_BS5;
        if (r < I_BHY) { const int nblk = D / 64; p0_transpose_item(F.inp(24) + (size_t)l * HYW * D, HYW, D, wl + W_BHY / 2, (r / nblk) * 64, (r % nblk) * 64, (r % nblk) * 64, nullptr, scr, lane); continue; } r -= I_BHY;
        { const int nblk = D / 64; p0_transpose_item(F.inp(25) + (size_t)l * D * D, D, D, wl + W_OUT / 2, (r / nblk) * 64, (r % nblk) * 64, (r % nblk) * 64, nullptr, scr, lane); }
    }
    for (int it = gw; it < DEPTH * (HYF / 64); it += NGW) { const int l = it / (HYF / 64), nb = it % (HYF / 64); bf16* hi = (bf16*)(F.ws + WS_W3T + (size_t)l * MiB);
        p0_transpose_item(F.inp(20) + (size_t)l * HYN * HYF, HYN, HYF, hi, 0, nb * 64, nb * 64, nullptr, scr, lane, hi + (size_t)HYF * HYN); }
    { bf16* X = (bf16*)(F.ws + WS_X); float* ssq = (float*)(F.ws + WS_SSQ);
      for (int m0 = 2 * gw; m0 < M; m0 += 2 * NGW) { f32x4 v[2][4]; float s[2];
#pragma unroll
        for (int r = 0; r < 2; ++r) { const GAS f32x4* xr = (const GAS f32x4*)(F.inp(0) + (size_t)(m0 + r) * D) + lane;
#pragma unroll
            for (int j = 0; j < 4; ++j) v[r][j] = xr[64 * j]; }
#pragma unroll
        for (int r = 0; r < 2; ++r) { float a = 0.f;
#pragma unroll
            for (int j = 0; j < 4; ++j) a += (v[r][j].x * v[r][j].x + v[r][j].y * v[r][j].y) + (v[r][j].z * v[r][j].z + v[r][j].w * v[r][j].w);
            s[r] = wave_sum(a);
            GAS unsigned long long* o8 = (GAS unsigned long long*)(X + (size_t)(m0 + r) * D) + lane;
#pragma unroll
            for (int j = 0; j < 4; ++j) o8[64 * j] = (unsigned long long)pk2(v[r][j].x, v[r][j].y) | ((unsigned long long)pk2(v[r][j].z, v[r][j].w) << 32);
            if (lane < 16) ssq[(size_t)(m0 + r) * 16 + lane] = lane == 0 ? s[r] : 0.f; } } }
    {
      for (int it = gw; it < DEPTH * SEQ; it += NGW) { const int l = it / SEQ, t = it % SEQ, j = lane;
        const float* w1 = F.inp(15) + (size_t)l * HYE * HYN; const float* b1 = F.inp(16) + l * HYN; const float* fr = F.inp(17) + l * HYN; const float* w2 = F.inp(18) + (size_t)l * HYN * HYN; const float* b2 = F.inp(19) + l * HYN;
        float f = 0.f;
        if (j == 0) f = (float)t / (float)(SEQ - 1);
        else if (j < 33) { const int bi = (j - 1) & 15; const float band = 1e-4f + (float)bi * ((15.f - 1e-4f) / 15.f); const float ang = band * (float)t * (float)(2.0 * 3.14159265358979323846 / SEQ); f = j < 17 ? cosf(ang) : -sinf(ang); }
        float a = b1[j];
        for (int i = 0; i < HYE; ++i) a += __shfl(f, i) * w1[i * HYN + j];
        const float h1 = sinf(fr[j] * a);
        float c = b2[j];
        for (int i = 0; i < HYN; ++i) c += __shfl(h1, i) * w2[i * HYN + j];
        const float hv = sinf(fr[j] * c); const unsigned hh = f2bf(hv);
        bf16* H2H = (bf16*)(F.ws + WS_H2 + (size_t)l * 512 * 1024);
        H2H[(size_t)t * HYN + j] = (bf16)hh; H2H[(size_t)SEQ * HYN + (size_t)t * HYN + j] = (bf16)f2bf(hv - __uint_as_float(hh << 16)); } }
    { float* LB = (float*)(F.ws + WS_LBAR); bf16* BBT = (bf16*)(F.ws + WS_BBT); bf16* CT = (bf16*)(F.ws + WS_CT);
      for (int q = gw; q < DEPTH * 2 * S5G; q += NGW) { const int p = lane; const int i = q * S5P + p;
        const float dt = expf(F.inp(5)[q]); const float lr = F.inp(3)[i], li = F.inp(4)[i]; const float mag = expf(lr * dt), ang = li * dt;
        const float br = mag * cosf(ang), bi = mag * sinf(ang); LB[2 * i] = br; LB[2 * i + 1] = bi;
        const float nr = br - 1.f, ni = bi, den = lr * lr + li * li; const float kr = (nr * lr + ni * li) / den, ki = (ni * lr - nr * li) / den;
        const float* bre = F.inp(6) + (size_t)i * S5H; const float* bim = F.inp(7) + (size_t)i * S5H;
        bf16* rowr = BBT + ((size_t)q * 128 + 2 * p) * 16; bf16* rowi = rowr + 16;
        for (int h = 0; h < S5H; ++h) { const float xr = bre[h], xi = bim[h]; rowr[h] = (bf16)f2bf(kr * xr - ki * xi); rowi[h] = (bf16)f2bf(kr * xi + ki * xr); }
        const float* cre = F.inp(8) + (size_t)q * S5H * S5P; const float* cim = F.inp(9) + (size_t)q * S5H * S5P;
        for (int h = 0; h < S5H; ++h) { *(unsigned*)(CT + ((size_t)q * 16 + h) * 128 + 2 * p) = pk2(cre[h * S5P + p], -cim[h * S5P + p]); } } }
}

constexpr int S5_YB = 0, S5_CH = 65536, S5_CHB = 8448, S5_SEND = S5_CH + 8 * S5_CHB;
__device__ __forceinline__ float gelu_tanh_fast(float x) {
    const float z = 0.7978845608028654f * (x + 0.044715f * x * x * x);
    const float e = __builtin_amdgcn_exp2f(2.0f * 1.4426950408889634f * z);
    const float th = 1.0f - 2.0f * __builtin_amdgcn_rcpf(e + 1.0f);
    return 0.5f * x * (1.0f + th);
}
template <int DIR, bool EMIT>
__device__ __forceinline__ void s5_pass(Frame& F, const bf16* Ub  , int tlo  , float ar, float ai, float& sr, float& si,
                                        const bf16x8 (&bbf)[8], const bf16x8 (&ctf)[4], const bf16x8& ddf, LAS unsigned char* ch, LAS unsigned char* yb, bf16* YGb) {
    const int lane = F.lane, fr = lane & 15, fq = lane >> 4;
    auto load_u = [&](int tc0) -> bf16x8 { bf16x8 z = {0, 0, 0, 0, 0, 0, 0, 0}; int row = tc0 + fr; asm volatile("" : "+v"(row));
        if (fq < 2) z = *(const GAS bf16x8*)(Ub + (size_t)row * 1024 + 8 * fq); return z; };
    bf16x8 ufr[4];
#pragma unroll
    for (int i = 0; i < 4; ++i) ufr[i] = load_u(DIR ? tlo + 16 * (15 - i) : tlo + 16 * i);
#pragma unroll 1
    for (int cb = 0; cb < 4; ++cb)
#pragma unroll
    for (int ci4 = 0; ci4 < 4; ++ci4) { const int ci = 4 * cb + ci4;
        const int tc0 = DIR ? tlo + 16 * (15 - ci) : tlo + 16 * ci;
        const bf16x8 uf = ufr[ci4];
#pragma unroll
        for (int j = 0; j < 8; ++j) { f32x4 a = {0.f, 0.f, 0.f, 0.f}; a = __builtin_amdgcn_mfma_f32_16x16x32_bf16(bbf[j], uf, a, 0, 0, 0);
            v2u w; w.x = pg8::cvt_pk_bf16(a[0], a[1]); w.y = pg8::cvt_pk_bf16(a[2], a[3]); *(LAS v2u*)(ch + fr * 264 + (16 * j + 4 * fq) * 2) = w; }
        LDS_WAIT();
        f32x2 x[16];
#pragma unroll
        for (int tt = 0; tt < 16; ++tt) { const unsigned w = *(const LAS unsigned*)(ch + tt * 264 + 4 * lane); x[tt] = (f32x2){bf_lo(w), bf_hi(w)}; }
        LDS_WAIT();
        unsigned spk[16];
#pragma unroll
        for (int i = 0; i < 16; ++i) { const int tt = DIR ? 15 - i : i;
            const float nr = ar * sr - ai * si + x[tt].x, ni = ar * si + ai * sr + x[tt].y; sr = nr; si = ni;
            if (EMIT) spk[tt] = pg8::cvt_pk_bf16(nr, ni); }
        if (EMIT) {
            LAS unsigned* sb = (LAS unsigned*)ch;
#pragma unroll
            for (int tt = 0; tt < 16; ++tt) sb[tt * 68 + lane] = spk[tt];
            LDS_WAIT();
            f32x4 y = {0.f, 0.f, 0.f, 0.f};
#pragma unroll
            for (int ks = 0; ks < 4; ++ks) { const bf16x8 sf = *(const LAS bf16x8*)(ch + fr * 272 + ks * 64 + fq * 16); y = __builtin_amdgcn_mfma_f32_16x16x32_bf16(ctf[ks], sf, y, 0, 0, 0); }
            LDS_WAIT();
            LAS v2u* ybp = (LAS v2u*)(yb + (size_t)(tc0 + fr) * 32 + 8 * fq);
            if (DIR == 0) { v2u w; w.x = pg8::cvt_pk_bf16(y[0], y[1]); w.y = pg8::cvt_pk_bf16(y[2], y[3]); *ybp = w; }
            else { y = __builtin_amdgcn_mfma_f32_16x16x32_bf16(ddf, uf, y, 0, 0, 0);
                const v2u f = *ybp; const float o0 = gelu_tanh_fast(y[0] + bf_lo(f.x)), o1 = gelu_tanh_fast(y[1] + bf_hi(f.x)), o2 = gelu_tanh_fast(y[2] + bf_lo(f.y)), o3 = gelu_tanh_fast(y[3] + bf_hi(f.y));
                v2u w; w.x = pg8::cvt_pk_bf16(o0, o1); w.y = pg8::cvt_pk_bf16(o2, o3);
                *(GAS v2u*)(YGb + (size_t)(tc0 + fr) * 1024 + 4 * fq) = w; }
        }
        if (ci + 4 < 16) ufr[ci4] = load_u(DIR ? tlo + 16 * (15 - (ci + 4)) : tlo + 16 * (ci + 4));
        __builtin_amdgcn_sched_barrier(0);
    }
}
__device__ __forceinline__ void s5_item(Frame& F, int l, int b, int g, bool dry = false) {
    const int lane = F.lane, fr = lane & 15, fq = lane >> 4, seg = F.wave;
    bf16* U = (bf16*)(F.ws + WS_R5) + (size_t)b * SEQ * 1024 + g * 16;
    LAS unsigned char* ch = F.lds + S5_CH + seg * S5_CHB; LAS unsigned char* yb = F.lds + S5_YB;
    LAS f32x2* send = (LAS f32x2*)(F.lds + S5_SEND);
#pragma unroll 1
    for (int dir = 0; dir < 2; ++dir) {
        const int q = (l * 2 + dir) * S5G + g;
        const float ar = ((const GAS float*)(F.ws + WS_LBAR))[(size_t)(q * S5P + lane) * 2], ai = ((const GAS float*)(F.ws + WS_LBAR))[(size_t)(q * S5P + lane) * 2 + 1];
        bf16x8 bbf[8], ctf[4], ddf; const bf16x8 zero8 = {0, 0, 0, 0, 0, 0, 0, 0};
        const bf16* BBT = (const bf16*)(F.ws + WS_BBT) + (size_t)q * 128 * 16; const bf16* CT = (const bf16*)(F.ws + WS_CT) + (size_t)q * 16 * 128;
#pragma unroll
        for (int j = 0; j < 8; ++j) bbf[j] = fq < 2 ? *(const GAS bf16x8*)(BBT + (16 * j + fr) * 16 + 8 * fq) : zero8;
#pragma unroll
        for (int ks = 0; ks < 4; ++ks) ctf[ks] = *(const GAS bf16x8*)(CT + fr * 128 + 32 * ks + 8 * fq);
        { const short dv = (short)f2bf(F.inp(10)[l * S5W + g * 16 + fr]); ddf = zero8;
#pragma unroll
          for (int jj = 0; jj < 8; ++jj) if (8 * fq + jj == fr) ddf[jj] = dv; }
        const int tlo = dir ? SEQ - 256 * (seg + 1) : 256 * seg;
        float sr = 0.f, si = 0.f;
        if (dir == 0) s5_pass<0, false>(F, U, tlo, ar, ai, sr, si, bbf, ctf, ddf, ch, yb, U); else s5_pass<1, false>(F, U, tlo, ar, ai, sr, si, bbf, ctf, ddf, ch, yb, U);
        send[seg * 64 + lane] = (f32x2){sr, si};
        LDS_WAIT(); __syncthreads();
        float pr = ar, pi = ai;
#pragma unroll
        for (int k = 0; k < 8; ++k) { const float nr = pr * pr - pi * pi, ni = 2.f * pr * pi; pr = nr; pi = ni; }
        sr = 0.f; si = 0.f;
        for (int k = 0; k < seg; ++k) { const f32x2 e = send[k * 64 + lane]; const float nr = pr * sr - pi * si + e.x, ni = pr * si + pi * sr + e.y; sr = nr; si = ni; }
        bf16* YGo = dry ? (bf16*)(F.ws + WS_R6) + (size_t)(b & 1) * SEQ * 1024 + g * 16 : U;
        if (dir == 0) s5_pass<0, true>(F, U, tlo, ar, ai, sr, si, bbf, ctf, ddf, ch, yb, YGo); else s5_pass<1, true>(F, U, tlo, ar, ai, sr, si, bbf, ctf, ddf, ch, yb, YGo);
        LDS_WAIT(); __syncthreads();
    }
}

constexpr int HY_WX = 0, HY_WXB = 8704, HY_KF = 8 * HY_WXB, HY_KFO = 33 * 64 * 8, HY_KFCH = 2 * HY_KFO, HY_RED = HY_KF + 2 * HY_KFCH, HY_RAWROW = 4128;
static_assert(HY_RED + 256 <= LDSCTL_OFF && 4 * 2048 * 4 <= HY_KFCH && 2 * HY_RAWROW <= HY_WXB, "hyena LDS map");
#define C64_LIST 1.000000000e+00f, 9.951847267e-01f, 9.807852804e-01f, 9.569403357e-01f, 9.238795325e-01f, 8.819212643e-01f, 8.314696123e-01f, 7.730104534e-01f, 7.071067812e-01f, 6.343932842e-01f, 5.555702330e-01f, 4.713967368e-01f, 3.826834324e-01f, 2.902846773e-01f, 1.950903220e-01f, 9.801714033e-02f, 0.0f, -9.801714033e-02f, -1.950903220e-01f, -2.902846773e-01f, -3.826834324e-01f, -4.713967368e-01f, -5.555702330e-01f, -6.343932842e-01f, -7.071067812e-01f, -7.730104534e-01f, -8.314696123e-01f, -8.819212643e-01f, -9.238795325e-01f, -9.569403357e-01f, -9.807852804e-01f, -9.951847267e-01f, -1.000000000e+00f, -9.951847267e-01f, -9.807852804e-01f, -9.569403357e-01f, -9.238795325e-01f, -8.819212643e-01f, -8.314696123e-01f, -7.730104534e-01f, -7.071067812e-01f, -6.343932842e-01f, -5.555702330e-01f, -4.713967368e-01f, -3.826834324e-01f, -2.902846773e-01f, -1.950903220e-01f, -9.801714033e-02f, 0.0f, 9.801714033e-02f, 1.950903220e-01f, 2.902846773e-01f, 3.826834324e-01f, 4.713967368e-01f, 5.555702330e-01f, 6.343932842e-01f, 7.071067812e-01f, 7.730104534e-01f, 8.314696123e-01f, 8.819212643e-01f, 9.238795325e-01f, 9.569403357e-01f, 9.807852804e-01f, 9.951847267e-01f
__host__ __device__ constexpr int rev6(int s) { return ((s >> 4) & 3) | (s & 12) | ((s & 3) << 4); }

template <bool INV> __device__ __forceinline__ void r4(float& x0r, float& x0i, float& x1r, float& x1i, float& x2r, float& x2i, float& x3r, float& x3i) {
    const float t0r = x0r + x2r, t0i = x0i + x2i, t1r = x0r - x2r, t1i = x0i - x2i, t2r = x1r + x3r, t2i = x1i + x3i, t3r = x1r - x3r, t3i = x1i - x3i;
    x0r = t0r + t2r; x0i = t0i + t2i; x2r = t0r - t2r; x2i = t0i - t2i;
    if (!INV) { x1r = t1r + t3i; x1i = t1i - t3r; x3r = t1r - t3i; x3i = t1i + t3r; }
    else      { x1r = t1r - t3i; x1i = t1i + t3r; x3r = t1r + t3i; x3i = t1i - t3r; }
}
constexpr float C64T[64] = { C64_LIST };
template <int... Is, class Fn> __device__ __forceinline__ void static_for_impl(std::integer_sequence<int, Is...>, Fn&& f) { (f(std::integral_constant<int, Is>{}), ...); }
template <int N, class Fn> __device__ __forceinline__ void static_for(Fn&& f) { static_for_impl(std::make_integer_sequence<int, N>{}, f); }
template <bool INV, int E> __device__ __forceinline__ void twc(float& xr, float& xi) {
    constexpr int e = E & 63;
    if constexpr (e == 0) { return; }
    else if constexpr (e == 16) { const float tr = xr, ti = xi; if (!INV) { xr = ti; xi = -tr; } else { xr = -ti; xi = tr; } }
    else if constexpr (e == 32) { xr = -xr; xi = -xi; }
    else if constexpr (e == 48) { const float tr = xr, ti = xi; if (!INV) { xr = -ti; xi = tr; } else { xr = ti; xi = -tr; } }
    else {
        constexpr float c = C64T[e], sn = C64T[(e + 48) & 63], wi = INV ? sn : -sn;
        constexpr unsigned cb = __builtin_bit_cast(unsigned, c), wb = __builtin_bit_cast(unsigned, wi), nwb = wb ^ 0x80000000u;
        const float tr = xr, ti = xi; float a, b;
        asm("v_mul_f32 %0, %1, %2" : "=v"(a) : "i"(cb), "v"(tr));
        asm("v_fmac_f32 %0, %1, %2" : "+v"(a) : "i"(nwb), "v"(ti));
        asm("v_mul_f32 %0, %1, %2" : "=v"(b) : "i"(wb), "v"(tr));
        asm("v_fmac_f32 %0, %1, %2" : "+v"(b) : "i"(cb), "v"(ti));
        xr = a; xi = b;
    }
}
#define SFOR(N, I, ...) static_for<N>([&](auto I##_) __attribute__((always_inline)) { constexpr int I = decltype(I##_)::value; __VA_ARGS__ })
template <bool INV> __device__ __forceinline__ void dft64(float (&re)[64], float (&im)[64]) {
    if constexpr (!INV) {
        SFOR(16, bc, r4<false>(re[bc], im[bc], re[bc + 16], im[bc + 16], re[bc + 32], im[bc + 32], re[bc + 48], im[bc + 48]););
        SFOR(48, i, constexpr int p = 1 + i / 16; constexpr int bc = i % 16; twc<false, bc * p>(re[16 * p + bc], im[16 * p + bc]););
        __builtin_amdgcn_sched_barrier(0);
        SFOR(16, i, constexpr int s = 16 * (i / 4) + (i % 4); r4<false>(re[s], im[s], re[s + 4], im[s + 4], re[s + 8], im[s + 8], re[s + 12], im[s + 12]););
        SFOR(64, i, constexpr int q = (i >> 2) & 3; constexpr int c = i & 3; twc<false, 4 * c * q>(re[i], im[i]););
        __builtin_amdgcn_sched_barrier(0);
        SFOR(16, pq, constexpr int s = 4 * pq; r4<false>(re[s], im[s], re[s + 1], im[s + 1], re[s + 2], im[s + 2], re[s + 3], im[s + 3]););
    } else {
        SFOR(16, pq, constexpr int s = 4 * pq; r4<true>(re[s], im[s], re[s + 1], im[s + 1], re[s + 2], im[s + 2], re[s + 3], im[s + 3]););
        SFOR(64, i, constexpr int q = (i >> 2) & 3; constexpr int c = i & 3; twc<true, 4 * c * q>(re[i], im[i]););
        __builtin_amdgcn_sched_barrier(0);
        SFOR(16, i, constexpr int s = 16 * (i / 4) + (i % 4); r4<true>(re[s], im[s], re[s + 4], im[s + 4], re[s + 8], im[s + 8], re[s + 12], im[s + 12]););
        SFOR(48, i, constexpr int p = 1 + i / 16; constexpr int bc = i % 16; twc<true, bc * p>(re[16 * p + bc], im[16 * p + bc]););
        __builtin_amdgcn_sched_barrier(0);
        SFOR(16, bc, r4<true>(re[bc], im[bc], re[bc + 16], im[bc + 16], re[bc + 32], im[bc + 32], re[bc + 48], im[bc + 48]););
    }
    __builtin_amdgcn_sched_barrier(0);
}
__device__ __forceinline__ void wtrans(float (&v)[64], LAS float* wx, int lane) {
#pragma unroll
    for (int i = 0; i < 32; ++i) { const auto r = __builtin_amdgcn_permlane32_swap(__float_as_uint(v[i]), __float_as_uint(v[32 + i]), false, false); v[i] = __uint_as_float(r[0]); v[32 + i] = __uint_as_float(r[1]); }
    __builtin_amdgcn_sched_barrier(0);
    const int rd = (lane & 31) * 68 + (lane >> 5) * 32;
#pragma unroll
    for (int step = 0; step < 2; ++step) {
        asm volatile("" ::: "memory");
#pragma unroll
        for (int i = 0; i < 32; ++i) wx[i * 68 + lane] = v[32 * step + i];
        asm volatile("" ::: "memory");
#pragma unroll
        for (int i4 = 0; i4 < 8; ++i4) { const f32x4 q = *(const LAS f32x4*)(wx + rd + 4 * i4);
#pragma unroll
            for (int e = 0; e < 4; ++e) v[32 * step + 4 * i4 + e] = q[e]; }
        asm volatile("" ::: "memory");
    }
}
__device__ __forceinline__ void wfft_fwd(float (&re)[64], float (&im)[64], LAS float* wx, int lane) {
    dft64<false>(re, im);
    { float f = (float)lane * (1.0f / 4096.0f); asm volatile("" : "+v"(f));
#pragma unroll
      for (int s = 1; s < 64; ++s) { const float a = (float)rev6(s) * f; const float c = __builtin_amdgcn_cosf(a), sn = __builtin_amdgcn_sinf(a);
          const float tr = re[s] * c + im[s] * sn, ti = im[s] * c - re[s] * sn; re[s] = tr; im[s] = ti; if ((s & 7) == 7) __builtin_amdgcn_sched_barrier(0); } }
    __builtin_amdgcn_sched_barrier(0);
    wtrans(re, wx, lane); wtrans(im, wx, lane);
    __builtin_amdgcn_sched_barrier(0);
    dft64<false>(re, im);
}
__device__ __forceinline__ void wfft_inv(float (&re)[64], float (&im)[64], LAS float* wx, int lane) {
    dft64<true>(re, im);
    { float f = (float)rev6(lane) * (1.0f / 4096.0f); asm volatile("" : "+v"(f));
#pragma unroll
      for (int s = 1; s < 64; ++s) { const float a = (float)s * f; const float c = __builtin_amdgcn_cosf(a), sn = __builtin_amdgcn_sinf(a);
          const float tr = re[s] * c - im[s] * sn, ti = im[s] * c + re[s] * sn; re[s] = tr; im[s] = ti; if ((s & 7) == 7) __builtin_amdgcn_sched_barrier(0); } }
    __builtin_amdgcn_sched_barrier(0);
    wtrans(re, wx, lane); wtrans(im, wx, lane);
    __builtin_amdgcn_sched_barrier(0);
    dft64<true>(re, im);
}
struct Stage2 { v4u a[4], b[4]; };
__device__ __forceinline__ void hy_load2a(Stage2& S, const bf16* row0, int lane) {
#pragma unroll
    for (int i = 0; i < 4; ++i) { const int q = lane + 64 * i; S.a[i] = *(const GAS v4u*)(row0 + 8 * q); }
}
__device__ __forceinline__ void hy_load2b(Stage2& S, const bf16* row0, int lane) {
#pragma unroll
    for (int i = 0; i < 4; ++i) { const int q = lane + 64 * i; S.b[i] = *(const GAS v4u*)(row0 + SEQ + 8 * q); }
}
__device__ __forceinline__ void hy_load2(Stage2& S, const bf16* row0, int lane) { hy_load2a(S, row0, lane); hy_load2b(S, row0, lane); }
__device__ __forceinline__ void hy_commit2(const Stage2& S, LAS unsigned char* wxb, int lane) {
    asm volatile("" ::: "memory");
#pragma unroll
    for (int i = 0; i < 4; ++i) { const int q = lane + 64 * i; *(LAS v4u*)(wxb + 16 + 16 * q) = S.a[i]; *(LAS v4u*)(wxb + HY_RAWROW + 16 + 16 * q) = S.b[i]; }
    if (lane < 4) { LAS unsigned short* row = (LAS unsigned short*)(wxb + (lane >> 1) * HY_RAWROW); row[(lane & 1) ? 8 + SEQ : 7] = 0; }
    asm volatile("" ::: "memory");
}
__device__ __forceinline__ float raw2(LAS unsigned char* wxb, int r, int t) { return bf2f(*(const LAS unsigned short*)(wxb + r * HY_RAWROW + 16 + 2 * t)); }
__device__ __forceinline__ unsigned hilo_pack(float x0, float x1, unsigned& lo) {
    const unsigned h0 = f2bf(x0), h1 = f2bf(x1); lo = f2bf(x0 - __uint_as_float(h0 << 16)) | (f2bf(x1 - __uint_as_float(h1 << 16)) << 16); return h0 | (h1 << 16);
}
__device__ __forceinline__ void hy_filter_gen4(Frame& F, int l, int c0, LAS unsigned char* kf0, float* tap2, LAS float* red) {
    int lane_ = F.lane; asm volatile("" : "+v"(lane_)); const int lane = lane_; const int fr = lane & 15, fq = lane >> 4, w = F.wave;
    const float* dec = F.inp(21) + (size_t)l * HYF;
    const bf16* H2H = (const bf16*)(F.ws + WS_H2 + (size_t)l * 512 * 1024); const bf16* H2L = H2H + SEQ * HYN;
    bf16x8 ah[2], al[2];
    { const int ch = c0 + (F.G) * (fr >> 2), f4 = fr & 3, col = (f4 >> 1) * 2 * HYW + (f4 & 1) * HYW + ch;
      const bf16* whi = (const bf16*)(F.ws + WS_W3T + (size_t)l * MiB) + (size_t)col * HYN; const bf16* wlo = whi + (size_t)HYF * HYN;
#pragma unroll
      for (int ks = 0; ks < 2; ++ks) { ah[ks] = *(const GAS bf16x8*)(whi + 32 * ks + 8 * fq); al[ks] = *(const GAS bf16x8*)(wlo + 32 * ks + 8 * fq); } }
    float dk[4];
#pragma unroll
    for (int r = 0; r < 4; ++r) dk[r] = fabsf(((const GAS float*)dec)[(r >> 1) * 2 * HYW + (r & 1) * HYW + c0 + F.G * fq]);
    LAS float* stg = (LAS float*)(kf0 + (fq & 1) * HY_KFCH); float* tg = tap2 + (size_t)(fq & 1) * 4 * SEQ;
    float ss0 = 0.f, ss1 = 0.f;
#pragma unroll 1
    for (int tb = 0; tb < 2; ++tb) {
        bf16x8 bh[8][2], bl[8][2];
#pragma unroll
        for (int u = 0; u < 8; ++u)
#pragma unroll
            for (int ks = 0; ks < 2; ++ks) { const size_t off = (size_t)(256 * w + 128 * tb + 16 * u + fr) * HYN + 32 * ks + 8 * fq; bh[u][ks] = *(const GAS bf16x8*)(H2H + off); bl[u][ks] = *(const GAS bf16x8*)(H2L + off); }
#pragma unroll
        for (int u = 0; u < 8; ++u) { const int t = 256 * w + 128 * tb + 16 * u + fr; f32x4 acc = {0.f, 0.f, 0.f, 0.f};
#pragma unroll
            for (int ks = 0; ks < 2; ++ks) { acc = __builtin_amdgcn_mfma_f32_16x16x32_bf16(ah[ks], bh[u][ks], acc, 0, 0, 0); acc = __builtin_amdgcn_mfma_f32_16x16x32_bf16(ah[ks], bl[u][ks], acc, 0, 0, 0); acc = __builtin_amdgcn_mfma_f32_16x16x32_bf16(al[ks], bh[u][ks], acc, 0, 0, 0); }
            const float tn = (float)t * (1.0f / (float)(SEQ - 1));
#pragma unroll
            for (int r = 0; r < 4; ++r) { const float v = acc[r] * (__expf(-tn * dk[r]) + 0.05f);
                if (fq < 2) stg[r * SEQ + t] = v; else ((GAS float*)tg)[(size_t)r * SEQ + t] = v;
                const float sq = ((r & 1) && t == 0) ? 0.f : v * v; if (r < 2) ss0 += sq; else ss1 += sq; } }
    }
#pragma unroll
    for (int o = 1; o < 16; o <<= 1) { ss0 += __shfl_xor(ss0, o); ss1 += __shfl_xor(ss1, o); }
    if (fr == 0) { red[2 * fq] = ss0; red[2 * fq + 1] = ss1; }
}
__device__ __forceinline__ void hy_filter_fft(Frame& F, int l, int c, LAS unsigned char* kfch, const LAS float* red4, LAS float* wx) {
    int lane_ = F.lane; asm volatile("" : "+v"(lane_)); const int lane = lane_; const LAS float* stg = (const LAS float*)kfch;
    float re[64], im[64];
#pragma unroll
    for (int n1 = 0; n1 < 32; ++n1) { re[n1] = stg[64 * n1 + lane]; im[n1] = stg[2 * SEQ + 64 * n1 + lane]; }
#pragma unroll
    for (int n1 = 32; n1 < 64; ++n1) { const int t = 64 * (64 - n1) - lane; float a = stg[SEQ + t], b = stg[3 * SEQ + t]; if (n1 == 32 && lane == 0) { a = 0.f; b = 0.f; } re[n1] = a; im[n1] = b; }
    float s0 = 0.f, s1 = 0.f;
#pragma unroll
    for (int w = 0; w < 8; ++w) { s0 += red4[8 * w]; s1 += red4[8 * w + 1]; }
    const float sc = 1.0f / 4096.0f; const float n0 = 0.5f * sc / sqrtf(s0 + 1e-6f), n1s = 0.5f * sc / sqrtf(s1 + 1e-6f);
    const float d0 = F.inp(22)[(size_t)l * 2 * HYW + c] * sc, d1 = F.inp(22)[(size_t)l * 2 * HYW + HYW + c] * sc;
    asm volatile("s_waitcnt lgkmcnt(0)" ::: "memory");
    wfft_fwd(re, im, wx, lane);
    const int k1 = rev6(lane), lc = rev6((64 - k1) & 63);
    LAS f32x2* kf0 = (LAS f32x2*)kfch + k1; LAS f32x2* kf1 = (LAS f32x2*)(kfch + HY_KFO) + k1;
#pragma unroll
    for (int k0 = 0; k0 <= 32; ++k0) { const int s = rev6(k0), sm = rev6(63 - k0), sz = rev6((64 - k0) & 63);
        float pr = __shfl(re[sm], lc), pi = __shfl(im[sm], lc); if (lane == 0) { pr = re[sz]; pi = im[sz]; }
        const float zr = re[s], zi = im[s];
        kf0[k0 * 64] = (f32x2){(zr + pr) * n0 + d0, (zi - pi) * n0};
        kf1[k0 * 64] = (f32x2){(zi + pi) * n1s + d1, -(zr - pr) * n1s}; if ((k0 & 3) == 3) __builtin_amdgcn_sched_barrier(0); }
}
__device__ __forceinline__ void hy_wave_main(Frame& F, int l, int c, int ws, LAS unsigned char* wxb, LAS unsigned char* kfch, Stage2& pre, bool dry = false) {
    int lane_ = F.lane; asm volatile("" : "+v"(lane_)); const int lane = lane_; LAS float* wx = (LAS float*)wxb;
    const size_t rowoff = (size_t)c * M + (size_t)(2 * ws) * SEQ;
    const bf16* PV = (const bf16*)(F.ws + WS_R1) + rowoff; const bf16* PX1 = (const bf16*)(F.ws + WS_R2) + rowoff; const bf16* PX2 = (const bf16*)(F.ws + WS_R3) + rowoff;
    const bf16* GH = (const bf16*)(F.ws + WS_R4) + rowoff; bf16* OUT = (bf16*)(F.ws + WS_R1) + rowoff;
    const float* cw = F.inp(13) + (size_t)l * 3 * 3 * HYW; const float* cb = F.inp(14) + (size_t)l * 3 * HYW;
    float re[64], im[64];
    hy_commit2(pre, wxb, lane);
    hy_load2a(pre, PX1, lane);
    { const float w0 = cw[c], w1 = cw[3 * HYW + c], w2 = cw[6 * HYW + c], b = cb[c];
#pragma unroll
      for (int n1 = 0; n1 < 32; ++n1) { const int t = 64 * n1 + lane;
          re[n1] = b + w0 * raw2(wxb, 0, t - 1) + w1 * raw2(wxb, 0, t) + w2 * raw2(wxb, 0, t + 1);
          im[n1] = b + w0 * raw2(wxb, 1, t - 1) + w1 * raw2(wxb, 1, t) + w2 * raw2(wxb, 1, t + 1); if ((n1 & 3) == 3) __builtin_amdgcn_sched_barrier(0); } }
#pragma unroll 1
    for (int o = 0; o < 2; ++o) {
        int lane_o = F.lane; asm volatile("" : "+v"(lane_o));
        const int lane = lane_o; const int k1 = rev6(lane);
#pragma unroll
        for (int n1 = 32; n1 < 64; ++n1) { re[n1] = 0.f; im[n1] = 0.f; }
        asm volatile("s_waitcnt lgkmcnt(0)" ::: "memory");
        wfft_fwd(re, im, wx, lane);
        { const LAS unsigned char* bd = kfch + o * HY_KFO + k1 * 8; const LAS unsigned char* bm = kfch + o * HY_KFO + ((k1 ? 0 : 64) + ((64 - k1) & 63)) * 8;
#pragma unroll
          for (int s = 0; s < 64; ++s) { const int k0 = rev6(s);
              if (k0 < 32) { const f32x2 kv = *(const LAS f32x2*)(bd + k0 * 512); const float tr = re[s] * kv.x - im[s] * kv.y, ti = re[s] * kv.y + im[s] * kv.x; re[s] = tr; im[s] = ti; }
              else { const f32x2 kv = *(const LAS f32x2*)(bm + (63 - k0) * 512); const float tr = re[s] * kv.x + im[s] * kv.y, ti = im[s] * kv.x - re[s] * kv.y; re[s] = tr; im[s] = ti; }
              if ((s & 7) == 7) __builtin_amdgcn_sched_barrier(0); } }
        __builtin_amdgcn_sched_barrier(0);
        wfft_inv(re, im, wx, lane);
        hy_load2b(pre, o == 0 ? PX1 : PX2, lane); hy_commit2(pre, wxb, lane);
        { const int xo = (o + 1) * HYW + c; const float w0 = cw[xo], w1 = cw[3 * HYW + xo], w2 = cw[6 * HYW + xo], b = cb[xo];
#pragma unroll
          for (int n1 = 0; n1 < 32; ++n1) { const int t = 64 * n1 + lane;
              const float g0 = b + w0 * raw2(wxb, 0, t - 1) + w1 * raw2(wxb, 0, t) + w2 * raw2(wxb, 0, t + 1);
              const float g1 = b + w0 * raw2(wxb, 1, t - 1) + w1 * raw2(wxb, 1, t) + w2 * raw2(wxb, 1, t + 1);
              re[n1] *= g0; im[n1] *= g1; if ((n1 & 3) == 3) __builtin_amdgcn_sched_barrier(0); } }
        hy_load2a(pre, o == 0 ? PX2 : GH, lane);
    }
    int lane_g = F.lane; asm volatile("" : "+v"(lane_g));
    hy_load2b(pre, GH, lane_g); hy_commit2(pre, wxb, lane_g);
    if (!dry)
#pragma unroll
    for (int n1 = 0; n1 < 32; ++n1) { const int t = 64 * n1 + lane_g; const float g0 = raw2(wxb, 0, t), g1 = raw2(wxb, 1, t);
        ((GAS bf16*)OUT)[t] = (bf16)f2bf(re[n1] * g0 * fast_sigmoid(g0)); ((GAS bf16*)OUT)[SEQ + t] = (bf16)f2bf(im[n1] * g1 * fast_sigmoid(g1)); if ((n1 & 3) == 3) __builtin_amdgcn_sched_barrier(0); }
    asm volatile("s_waitcnt lgkmcnt(0)" ::: "memory");
}
__device__ __forceinline__ void hy_quad(Frame& F, int l, int c0) {
    const int grp = F.wave >> 2, ws = F.wave & 3;
    LAS unsigned char* wxb = F.lds + HY_WX + F.wave * HY_WXB;
    LAS unsigned char* kf0 = F.lds + HY_KF; LAS unsigned char* kfch = kf0 + grp * HY_KFCH;
    LAS float* red = (LAS float*)(F.lds + HY_RED);
    float* tap2 = (float*)(F.ws + WS_R6) + (size_t)F.bx * 2 * 4 * SEQ;
    hy_filter_gen4(F, l, c0, kf0, tap2, red + 8 * F.wave);
    VM_WAIT(); LDS_WAIT(); __syncthreads();
#pragma unroll 1
    for (int rnd = 0; rnd < 2; ++rnd) {
        const int c = c0 + F.G * (2 * rnd + grp);
        if (rnd == 1) {
            const int t_ = F.wave * 64 + cur_lane();
#pragma unroll
            for (int i = 0; i < 8; ++i) { const int q = t_ + 512 * i;
                const v4u v = *(const GAS v4u*)(tap2 + 4 * (size_t)q); *(LAS v4u*)(kf0 + (q >> 11) * HY_KFCH + 16 * (q & 2047)) = v; }
            LDS_WAIT(); __syncthreads();
        }
        Stage2 pre;
        if (ws == 0) hy_filter_fft(F, l, c, kfch, red + 2 * (2 * rnd + grp), (LAS float*)wxb);
        hy_load2(pre, (const bf16*)(F.ws + WS_R1) + (size_t)c * M + (size_t)(2 * ws) * SEQ, F.lane);
        LDS_WAIT(); __syncthreads();
        hy_wave_main(F, l, c, ws, wxb, kfch, pre);
        LDS_WAIT(); __syncthreads();
    }
}

__device__ __forceinline__ void transpose_pass(Frame& F) {
    const bf16* src = (const bf16*)(F.ws + WS_R1); bf16* dst = (bf16*)(F.ws + WS_R2);
    LAS unsigned char* tile = F.lds + F.wave * 18432; const int lane = F.lane;
    const int gw = F.bx * NWAVES + F.wave, NGW = F.G * NWAVES;
    constexpr int NTC = HYW / 64, NTT = M / 64;
    for (int it0 = 2 * gw; it0 < NTC * NTT; it0 += 2 * NGW) {
        v4u ld[2][8];
#pragma unroll
        for (int u = 0; u < 2; ++u) { const int it = it0 + u, c0 = (it % NTC) * 64, t0 = (it / NTC) * 64;
#pragma unroll
            for (int i = 0; i < 8; ++i) { const int q = lane + 64 * i, cr = q >> 3, ch = q & 7; ld[u][i] = *(const GAS v4u*)(src + (size_t)(c0 + cr) * M + t0 + 8 * ch); } }
#pragma unroll
        for (int u = 0; u < 2; ++u)
#pragma unroll
            for (int i = 0; i < 8; ++i) { const int q = lane + 64 * i, cr = q >> 3, ch = q & 7; *(LAS v4u*)(tile + u * 9216 + cr * 144 + 16 * ch) = ld[u][i]; }
        LDS_WAIT(); asm volatile("" ::: "memory");
#pragma unroll
        for (int u = 0; u < 2; ++u) { const int it = it0 + u, c0 = (it % NTC) * 64, t0 = (it / NTC) * 64;
#pragma unroll
            for (int i = 0; i < 8; ++i) { const int q = lane + 64 * i, tr = q >> 3, ch = q & 7;
                unsigned short e[8];
#pragma unroll
                for (int kk = 0; kk < 8; ++kk) e[kk] = *(const LAS unsigned short*)(tile + u * 9216 + (8 * ch + kk) * 144 + 2 * tr);
                v4u o; o.x = e[0] | ((unsigned)e[1] << 16); o.y = e[2] | ((unsigned)e[3] << 16); o.z = e[4] | ((unsigned)e[5] << 16); o.w = e[6] | ((unsigned)e[7] << 16);
                *(GAS v4u*)(dst + (size_t)(t0 + tr) * HYW + c0 + 8 * ch) = o; } }
        LDS_WAIT(); asm volatile("" ::: "memory");
    }
}
__device__ __forceinline__ void final_norm(Frame& F) {
    const int gw = F.bx * NWAVES + F.wave, NGW = F.G * NWAVES, lane = F.lane; const GAS f32x4* wv = (const GAS f32x4*)F.inp(26) + lane;
    f32x4 w[4];
#pragma unroll
    for (int j = 0; j < 4; ++j) w[j] = wv[64 * j];
    for (int m0 = 2 * gw; m0 < M; m0 += 2 * NGW) { f32x4 v[2][4];
#pragma unroll
        for (int r = 0; r < 2; ++r) { const GAS f32x4* xr = (const GAS f32x4*)(F.out + (size_t)(m0 + r) * D) + lane;
#pragma unroll
            for (int j = 0; j < 4; ++j) v[r][j] = xr[64 * j]; }
#pragma unroll
        for (int r = 0; r < 2; ++r) { float s = 0.f; GAS f32x4* xo = (GAS f32x4*)(F.out + (size_t)(m0 + r) * D) + lane;
#pragma unroll
            for (int j = 0; j < 4; ++j) s += (v[r][j].x * v[r][j].x + v[r][j].y * v[r][j].y) + (v[r][j].z * v[r][j].z + v[r][j].w * v[r][j].w);
            const float rs = 1.0f / sqrtf(wave_sum(s) * (1.0f / D) + 1e-6f);
#pragma unroll
            for (int j = 0; j < 4; ++j) xo[64 * j] = v[r][j] * rs * w[j]; } }
}

struct Args { const float* in[27]; float* out; unsigned char* ws; int ph_lo, ph_hi; };
__global__ void __launch_bounds__(NTHREADS, 2) mk_fwd(Args args) {
    extern __shared__ __attribute__((aligned(16))) unsigned char lds[];
    Frame F; F.lds = (LAS unsigned char*)lds; F.wave = __builtin_amdgcn_readfirstlane(threadIdx.x >> 6); F.tid = 0; F.lane = 0; F.G = gridDim.x; F.bx = blockIdx.x;
    F.out = args.out; F.ws = args.ws;
    volatile LAS unsigned* MISC = (volatile LAS unsigned*)(F.lds + LDSCTL_OFF);
    if (threadIdx.x < 64) MISC[threadIdx.x] = 0u;
    if (threadIdx.x == 64) { LAS unsigned long long* tab = (LAS unsigned long long*)(F.lds + LDSCTL_OFF + 256);
#pragma unroll
        for (int i = 0; i < 27; ++i) tab[i] = (unsigned long long)args.in[i]; }
    __syncthreads();
    XcdBarrier bar; bar.bar = (unsigned*)(F.ws + WS_CTL) + 1024; bar.x = 0; bar.st = nullptr;
    if (!MK_PER_PHASE) bar = xcd_barrier_post((unsigned*)(F.ws + WS_CTL) + 1024, MISC + 8, threadIdx.x == 0);
    const int lo = args.ph_lo, hi = args.ph_hi;
#define IN(k) (lo <= (k) && (k) < hi)
#if defined(MK_TIMING)
    unsigned long long* TS = (unsigned long long*)(F.ws + WS_CTL + 32768);
#define STAMP(k) do { if (blockIdx.x == 0 && threadIdx.x == 0) __hip_atomic_store(&TS[k], (unsigned long long)__builtin_amdgcn_s_memrealtime(), __ATOMIC_RELAXED, __HIP_MEMORY_SCOPE_AGENT); } while (0)
#else
#define STAMP(k) do { } while (0)
#endif
#define SEAM(k) do { if (IN(k) && IN((k) + 1)) xcd_barrier(bar, F.wave); STAMP((k) + 1); } while (0)
    LAS unsigned char* ring = F.lds;
    STAMP(0);
#ifndef MK_ONLY
#define MK_ONLY -1
#endif
#define ON(k) (MK_ONLY < 0 || MK_ONLY == (k))
#define FRAME_P0(Fp) Frame Fp = F; { int l_ = cur_lane(); asm volatile("" : "+v"(l_)); Fp.lane = l_; Fp.tid = F.wave * 64 + l_; Fp.ws = wsl; }
#ifndef MK_REP0
#define MK_REP0 1
#endif
#pragma unroll 1
    for (int rep0 = 0; rep0 < MK_REP0; ++rep0)
    if (ON(0) && IN(0)) { unsigned char* wsl = F.ws; FRAME_P0(Fp); p0_prologue(Fp); }
    SEAM(0);
#pragma unroll 1
    for (int l = 0; l < DEPTH; ++l) {
        const int pb = 1 + 5 * l;
        unsigned char* wsl = F.ws; asm volatile("" : "+s"(wsl));
#define WSL(off) (wsl + (off))
#define OPQ(p) asm volatile("" : "+s"(p))
#define FRAME_P(Fp) Frame Fp = F; { int l_ = cur_lane(); asm volatile("" : "+v"(l_)); Fp.lane = l_; Fp.tid = F.wave * 64 + l_; Fp.ws = wsl; }
        bf16* wl = (bf16*)WSL(WS_W + (size_t)l * W_LAYER);
        bf16* X = (bf16*)WSL(WS_X); float* ssq = (float*)WSL(WS_SSQ);
        bf16 *R1 = (bf16*)WSL(WS_R1), *R2 = (bf16*)WSL(WS_R2), *R3 = (bf16*)WSL(WS_R3), *R5 = (bf16*)WSL(WS_R5), *R6 = (bf16*)WSL(WS_R6);
#ifndef MK_REP1
#define MK_REP1 1
#define MK_REP12 1
#define MK_REP3 1
#define MK_REP4 1
#endif
#pragma unroll 1
        for (int rep12 = 0; rep12 < MK_REP12; ++rep12) {
#pragma unroll 1
        for (int rep1 = 0; rep1 < MK_REP1; ++rep1)
        if (ON(1) && IN(pb)) {
            { pg8::Gemm g{wl + W_IN / 2, X, 4096, M, D, D, D}; pg8::StaticOrder S; S.init(4096, M, F.G, F.bx); pg8::EpiHT E{R1, M, ssq};
              pg8::gemm_phase<pg8::EpiHT, pg8::StaticOrder, true, true, 1024, 1024, 1024>(ring, g, S, E, F.wave); }
            OPQ(X); OPQ(wl);
            { pg8::Gemm g{X, wl + W_IN / 2 + (size_t)4096 * D, M, 1024, D, D, D}; pg8::StaticOrder S; S.init(M, 1024, F.G, F.bx); pg8::EpiRow<0> E{R5, 1024, ssq};
              pg8::gemm_phase<pg8::EpiRow<0>, pg8::StaticOrder, true, true, 1024, 1024, 1024>(ring, g, S, E, F.wave); }
        }
        SEAM(pb);
        if (IN(pb + 1)) {
#if defined(MK_S5DRY)
            if (ON(2)) { FRAME_P(Fq); for (int it = F.bx; it < BATCH * S5G; it += F.G) s5_item(Fq, l, it / S5G, it % S5G, true); }
#endif
            if (ON(2)) { FRAME_P(Fp); for (int it = F.bx; it < BATCH * S5G; it += F.G) s5_item(Fp, l, it / S5G, it % S5G); }
            if (ON(3)) { FRAME_P(Fp); if (4 * F.G == HYW) hy_quad(Fp, l, F.bx); }
        }
        if (rep12 + 1 < MK_REP12) xcd_barrier(bar, F.wave);
        }
        SEAM(pb + 1);
#pragma unroll 1
        for (int rep3 = 0; rep3 < MK_REP3; ++rep3)
        if (ON(4) && IN(pb + 2)) {
            { pg8::Gemm g{X, wl + W_IN / 2 + (size_t)5120 * D, M, 2048, D, D, D}; pg8::StaticOrder S; S.init(M, 2048, F.G, F.bx); pg8::EpiRow<1> E{R3, 2048, ssq};
              pg8::gemm_phase<pg8::EpiRow<1>, pg8::StaticOrder, true, true, 1024, 1024, 1024>(ring, g, S, E, F.wave); }
            OPQ(R5); OPQ(wl);
            { pg8::Gemm g{R5, wl + W_GLU / 2, M, S5W, S5W, 1024, S5W}; pg8::StaticOrder S; S.init(M, S5W, F.G, F.bx); pg8::EpiGLU E{R6, S5W, R5, 1024, F.inp(12) + l * S5W};
              pg8::gemm_phase<pg8::EpiGLU, pg8::StaticOrder, true, true, 512, 1024, 512>(ring, g, S, E, F.wave); }
            __syncthreads();
            { FRAME_P(Fp); transpose_pass(Fp); }
            __syncthreads();
        }
        SEAM(pb + 2);
#pragma unroll 1
        for (int rep4 = 0; rep4 < MK_REP4; ++rep4)
        if (ON(5) && IN(pb + 3)) {
            { pg8::Gemm g{R6, wl + W_BS5 / 2, M, D, S5W, S5W, S5W}; pg8::StaticOrder S; S.init(M, D, F.G, F.bx); pg8::EpiMerge<0> E{R1, D, R3, 2048, 0};
              pg8::gemm_phase<pg8::EpiMerge<0>, pg8::StaticOrder, true, true, 512, 512, 512>(ring, g, S, E, F.wave); }
            VM_WAIT(); __syncthreads();
            OPQ(R2); OPQ(wl);
            { pg8::Gemm g{R2, wl + W_BHY / 2, M, D, HYW, HYW, HYW}; pg8::StaticOrder S; S.init(M, D, F.G, F.bx); pg8::EpiMerge<1> E{R1, D, R3, 2048, 1024};
              pg8::gemm_phase<pg8::EpiMerge<1>, pg8::StaticOrder, true, true, 1024, 1024, 1024>(ring, g, S, E, F.wave); }
        }
        SEAM(pb + 3);
        if (ON(6) && IN(pb + 4)) {
            pg8::Gemm g{R1, wl + W_OUT / 2, M, D, D, D, D}; pg8::StaticOrder S; S.init(M, D, F.G, F.bx); pg8::EpiOut E{l == 0 ? F.inp(0) : (const float*)F.out, F.out, X, ssq, l == DEPTH - 1};
            pg8::gemm_phase<pg8::EpiOut, pg8::StaticOrder, true, true, 1024, 1024, 1024>(ring, g, S, E, F.wave);
        }
        SEAM(pb + 4);
    }
    if (ON(7) && IN(11)) { unsigned char* wsl = F.ws; FRAME_P0(Fp); final_norm(Fp); }
#if defined(MK_TIMING)
    xcd_barrier(bar, F.wave); STAMP(12); xcd_barrier(bar, F.wave);
    { const unsigned long long a0 = __hip_atomic_load(&TS[MK_TA0], __ATOMIC_RELAXED, __HIP_MEMORY_SCOPE_AGENT), a1 = __hip_atomic_load(&TS[MK_TA1], __ATOMIC_RELAXED, __HIP_MEMORY_SCOPE_AGENT);
      const unsigned long long b0 = __hip_atomic_load(&TS[MK_TB0], __ATOMIC_RELAXED, __HIP_MEMORY_SCOPE_AGENT), b1 = __hip_atomic_load(&TS[MK_TB1], __ATOMIC_RELAXED, __HIP_MEMORY_SCOPE_AGENT);
      const float ta = (float)(a1 - a0) * 0.01f, tb = (float)(b1 - b0) * 0.01f;
      const float c = sqrtf(ta * 0.1f);
      for (size_t i = (size_t)blockIdx.x * NTHREADS + threadIdx.x; i < (size_t)M * D; i += (size_t)gridDim.x * NTHREADS) F.out[i] = (i == 0) ? tb : c; }
#endif
#undef IN
#undef SEAM
}

#if defined(MK_DEBUG_HASH)
extern "C" void kernel_launch_dbg(void* const* d_in, void* d_out, void* d_ws, hipStream_t stream, int grid);
#endif
extern "C" void kernel_launch(void* const* d_in, const int* in_sizes, int n_in, void* d_out, int out_size, void* d_ws, size_t ws_size, hipStream_t stream) {
    static int grid = 0;
    if (grid == 0) {
        if (n_in != 27 || out_size != M * D || ws_size < WS_END) { fprintf(stderr, "kernel_launch: unexpected shapes (n_in %d out %d ws %zu)\n", n_in, out_size, ws_size); grid = -1; return; }
        int dev = 0, cus = 0, per_cu = 0;
        if (hipGetDevice(&dev) != hipSuccess || hipDeviceGetAttribute(&cus, hipDeviceAttributeMultiprocessorCount, dev) != hipSuccess) { grid = -1; return; }
        if (hipFuncSetAttribute((const void*)mk_fwd, hipFuncAttributeMaxDynamicSharedMemorySize, LDS_BYTES) != hipSuccess) { fprintf(stderr, "kernel_launch: hipFuncSetAttribute failed\n"); grid = -1; return; }
        if (hipOccupancyMaxActiveBlocksPerMultiprocessor(&per_cu, (const void*)mk_fwd, NTHREADS, LDS_BYTES) != hipSuccess || per_cu < 1) fprintf(stderr, "kernel_launch: occupancy query says %d\n", per_cu);
        (void)hipGetLastError();
        grid = cus;
    }
    if (grid < 0) return;
    (void)hipMemsetAsync((char*)d_ws + WS_CTL, 0, CTL_ZERO_BYTES, stream);
    Args a{};
    for (int i = 0; i < 27; ++i) a.in[i] = (const float*)d_in[i];
    a.out = (float*)d_out; a.ws = (unsigned char*)d_ws;
#if defined(MK_DEBUG_HASH)
    kernel_launch_dbg(d_in, d_out, d_ws, stream, grid);
#elif MK_PER_PHASE
    for (int p = 0; p < NPHASE; ++p) { a.ph_lo = p; a.ph_hi = p + 1; hipLaunchKernelGGL(mk_fwd, dim3(grid), dim3(NTHREADS), LDS_BYTES, stream, a); }
#else
    a.ph_lo = 0; a.ph_hi = NPHASE; hipLaunchKernelGGL(mk_fwd, dim3(grid), dim3(NTHREADS), LDS_BYTES, stream, a);
#endif
}

#if defined(MK_DEBUG_HASH)
__global__ void dbg_hash(const unsigned* p, size_t nwords, unsigned long long* out) {
    unsigned long long s = 0; for (size_t i = (size_t)blockIdx.x * blockDim.x + threadIdx.x; i < nwords; i += (size_t)gridDim.x * blockDim.x) s += p[i];
    atomicAdd(out, s);
}
__global__ void dbg_report(const unsigned long long* h, float* out, size_t n) {
    int first = -1; for (int p = 0; p < NPHASE && first < 0; ++p) for (int r = 0; r < 4; ++r) if (h[p * 4 + r] != h[NPHASE * 4 + p * 4 + r]) { first = p; break; }
    const float c = first < 0 ? 0.f : sqrtf((float)(first + 1));
    for (size_t i = (size_t)blockIdx.x * blockDim.x + threadIdx.x; i < n; i += (size_t)gridDim.x * blockDim.x) out[i] = c;
}
extern "C" void kernel_launch_dbg(void* const* d_in, void* d_out, void* d_ws, hipStream_t stream, int grid) {
    Args a{}; for (int i = 0; i < 27; ++i) a.in[i] = (const float*)d_in[i];
    a.out = (float*)d_out; a.ws = (unsigned char*)d_ws;
    unsigned long long* H = (unsigned long long*)((char*)d_ws + 253 * MiB);
    (void)hipMemsetAsync(H, 0, 2 * NPHASE * 4 * 8, stream);
    struct Reg { size_t off, len; bool out; };
    auto regs_of = [&](int p, Reg (&r)[4]) { for (int i = 0; i < 4; ++i) r[i] = Reg{0, 0, false};
        if (p == 0) { r[0] = Reg{1 * MiB, 1 * MiB, false}; r[1] = Reg{2 * MiB, 1 * MiB + 64 * 1024, false}; r[2] = Reg{4 * MiB, 39 * MiB, false}; r[3] = Reg{43 * MiB, 33 * MiB, false}; return; }
        if (p == 11) { r[0] = Reg{0, (size_t)M * D * 4, true}; return; }
        const int q = (p - 1) % 5;
        if (q == 0) { r[0] = Reg{WS_R1, 128 * MiB, false}; r[1] = Reg{WS_R5, 32 * MiB, false}; }
        if (q == 1) { r[0] = Reg{WS_R1, 32 * MiB, false}; r[1] = Reg{WS_R5, 32 * MiB, false}; }
        if (q == 2) { r[0] = Reg{WS_R3, 64 * MiB, false}; r[1] = Reg{WS_R6, 16 * MiB, false}; r[2] = Reg{WS_R2, 32 * MiB, false}; }
        if (q == 3) { r[0] = Reg{WS_R1, 32 * MiB, false}; }
        if (q == 4) { r[0] = Reg{0, (size_t)M * D * 4, true}; r[1] = Reg{WS_X, 32 * MiB, false}; r[2] = Reg{WS_SSQ, 1 * MiB, false}; } };
    for (int run = 0; run < 2; ++run) {
        if (run == 0) (void)hipMemsetAsync((char*)d_ws + 1 * MiB, 0xAA, 251 * MiB, stream);
        (void)hipMemsetAsync((char*)d_ws + WS_CTL, 0, CTL_ZERO_BYTES, stream);
        for (int p = 0; p < NPHASE; ++p) { a.ph_lo = p; a.ph_hi = p + 1; hipLaunchKernelGGL(mk_fwd, dim3(grid), dim3(NTHREADS), LDS_BYTES, stream, a);
            Reg r[4]; regs_of(p, r);
            for (int i = 0; i < 4; ++i) if (r[i].len) hipLaunchKernelGGL(dbg_hash, dim3(1024), dim3(256), 0, stream, (const unsigned*)((r[i].out ? (char*)d_out : (char*)d_ws) + r[i].off), r[i].len / 4, H + (run * NPHASE + p) * 4 + i); }
    }
    hipLaunchKernelGGL(dbg_report, dim3(1024), dim3(256), 0, stream, H, (float*)d_out, (size_t)M * D);
}
#endif
```

```cpp
#include <hip/hip_runtime.h>
#include <cstdio>
#include <cstdint>
#include <cmath>
#include <utility>
namespace pg8 {
#define PG8_LAS __attribute__((address_space(3)))
typedef unsigned short bf16_t;
typedef short bf16x8 __attribute__((ext_vector_type(8)));
typedef float f32x4 __attribute__((ext_vector_type(4)));
typedef unsigned u32x4 __attribute__((ext_vector_type(4)));
constexpr int BM = 256, BK = 64, HALF = 128, HTB = HALF * BK * 2  , STAGE_BYTES = 8 * HTB, NXCD = 8, WGM = 8;

__host__ __device__ __forceinline__ int lds_byte(int r, int c) { const int st = (r >> 4) * 2 + (c >> 5), rr = r & 15, cc = c & 31, ob = rr * 64 + cc * 2; return st * 1024 + (ob ^ (((ob >> 9) & 1) << 5)); }
__host__ __device__ __forceinline__ void stage_rc(int b, int& R, int& C) { const int st = b / 1024, sb = b % 1024, swz = sb ^ (((sb >> 9) & 1) << 5); R = (st >> 1) * 16 + swz / 64; C = (st & 1) * 32 + (swz % 64) / 2; }
__host__ __device__ __forceinline__ int perm32(int rho) { const int n = rho >> 4, i = rho & 15; return 8 * (i >> 2) + 4 * n + (i & 3); }

struct Unit { int pm, pn; };
struct Gemm { const bf16_t* A; const bf16_t* Bt; int M, N, K, lda, ldb; };

struct StaticOrder {
    int nM, nN, nwg, G, c;
    __host__ __device__ void init(int M, int N, int G_, int c_) { nM = M / BM; nN = N / BM; nwg = nM * nN; G = G_; c = c_; }
    __host__ __device__ bool next(int i, Unit& u) const {
        const long L = (long)i * G + c; if (L >= nwg) return false;
        int wgid = (int)L; { const int q = nwg / NXCD, r = nwg % NXCD, xcd = wgid % NXCD, off = wgid / NXCD; wgid = (xcd < r ? xcd * (q + 1) : r * (q + 1) + (xcd - r) * q) + off; }
        const int nig = WGM * nN, gid = wgid / nig, fm = gid * WGM, gsz = (nM - fm) < WGM ? (nM - fm) : WGM;
        u.pm = fm + ((wgid % nig) % gsz); u.pn = (wgid % nig) / gsz; return true;
    }
    __device__ __forceinline__ void a_ready(const Unit&) const {}
    __device__ __forceinline__ void done(const Unit&) const {}
};

typedef unsigned u32x2 __attribute__((ext_vector_type(2)));

typedef __bf16 bf16x2_t __attribute__((ext_vector_type(2)));
typedef float f32x2_t __attribute__((ext_vector_type(2)));
__device__ __forceinline__ unsigned cvt_pk_bf16(float lo, float hi) { const f32x2_t v = {lo, hi}; const bf16x2_t b = __builtin_convertvector(v, bf16x2_t); return __builtin_bit_cast(unsigned, b); }
__device__ __forceinline__ float bf_lo(unsigned w) { return __uint_as_float(w << 16); }
__device__ __forceinline__ float bf_hi(unsigned w) { return __uint_as_float(w & 0xffff0000u); }
__device__ __forceinline__ float fast_sigmoid(float x) { return __builtin_amdgcn_rcpf(1.0f + __builtin_amdgcn_exp2f(-1.4426950408889634f * x)); }
constexpr float RMS_EPS = 1e-6f;
#define GAS_ __attribute__((address_space(1)))
__device__ __forceinline__ float rs_of(const float* ssq, int tok) {
    const GAS_ f32x4* p = (const GAS_ f32x4*)(ssq + (size_t)tok * 16); const f32x4 a = p[0], b = p[1], c = p[2], d = p[3];
    const float s = ((a[0] + a[1]) + (a[2] + a[3])) + ((b[0] + b[1]) + (b[2] + b[3])) + ((c[0] + c[1]) + (c[2] + c[3])) + ((d[0] + d[1]) + (d[2] + d[3]));
    return 1.0f / sqrtf(s * (1.0f / 1024.0f) + RMS_EPS);
}
struct EpiHT {
    static constexpr bool PERM = true, AFTER_DRAIN = false;
    bf16_t* O; int ldc; const float* ssq;
    __device__ __forceinline__ void operator()(const f32x4 (&acc)[2][2][4][2], const Unit& u, int wr, int wc, int fr, int fq) const {
        const int lane = (fq << 4) | fr;
        const int ctile = u.pn * BM + wc * 32 + 8 * fq;
        const float mine = rs_of(ssq, ctile + 128 * (fr >> 3) + (fr & 7));
        const int row0 = u.pm * BM + wr * 64 + fr;
#pragma unroll
        for (int bj = 0; bj < 2; ++bj) { float rsv[8];
#pragma unroll
            for (int i = 0; i < 8; ++i) rsv[i] = __shfl(mine, (lane & 48) | (8 * bj + i));
#pragma unroll
            for (int ai = 0; ai < 2; ++ai)
#pragma unroll
                for (int m = 0; m < 4; ++m) { bf16_t* rowp = O + (size_t)(row0 + ai * HALF + m * 16) * ldc + ctile + bj * HALF;
                    const f32x4 v0 = acc[ai][bj][m][0], v1 = acc[ai][bj][m][1]; u32x4 w;
                    w.x = cvt_pk_bf16(v0[0] * rsv[0], v0[1] * rsv[1]); w.y = cvt_pk_bf16(v0[2] * rsv[2], v0[3] * rsv[3]);
                    w.z = cvt_pk_bf16(v1[0] * rsv[4], v1[1] * rsv[5]); w.w = cvt_pk_bf16(v1[2] * rsv[6], v1[3] * rsv[7]);
                    *(GAS_ u32x4*)rowp = w; }
            asm volatile("" ::: "memory"); }
    }
};
template <int SIG> struct EpiRow {
    static constexpr bool PERM = true, AFTER_DRAIN = false;
    bf16_t* O; int ldc; const float* ssq;
    __device__ __forceinline__ void operator()(const f32x4 (&acc)[2][2][4][2], const Unit& u, int wr, int wc, int fr, int fq) const {
        const int lane = (fq << 4) | fr;
        const int row0 = u.pm * BM + wr * 64 + fr;
        float mine[2];
#pragma unroll
        for (int i = 0; i < 2; ++i) { const int q = 2 * fq + i; mine[i] = rs_of(ssq, row0 + (q >> 2) * HALF + (q & 3) * 16); }
        const int col0 = u.pn * BM + wc * 32 + 8 * fq;
#pragma unroll
        for (int ai = 0; ai < 2; ++ai)
#pragma unroll
            for (int m = 0; m < 4; ++m) { const int q = ai * 4 + m; const float rs = __shfl(mine[q & 1], ((q >> 1) << 4) | (lane & 15));
                bf16_t* rowp = O + (size_t)(row0 + ai * HALF + m * 16) * ldc + col0;
#pragma unroll
                for (int bj = 0; bj < 2; ++bj) { f32x4 v0 = acc[ai][bj][m][0] * rs, v1 = acc[ai][bj][m][1] * rs;
                    if (SIG) {
#pragma unroll
                        for (int e = 0; e < 4; ++e) { v0[e] = fast_sigmoid(v0[e]); v1[e] = fast_sigmoid(v1[e]); } }
                    u32x4 w; w.x = cvt_pk_bf16(v0[0], v0[1]); w.y = cvt_pk_bf16(v0[2], v0[3]); w.z = cvt_pk_bf16(v1[0], v1[1]); w.w = cvt_pk_bf16(v1[2], v1[3]);
                    *(GAS_ u32x4*)(rowp + bj * HALF) = w; }
                asm volatile("" ::: "memory"); }
    }
};
struct EpiGLU {
    static constexpr bool PERM = true, AFTER_DRAIN = false;
    bf16_t* O; int ldc; const bf16_t* YG; int ldy; const float* bglu;
    __device__ __forceinline__ void operator()(const f32x4 (&acc)[2][2][4][2], const Unit& u, int wr, int wc, int fr, int fq) const {
        const int row0 = u.pm * BM + wr * 64 + fr, col0 = u.pn * BM + wc * 32 + 8 * fq;
        f32x4 bv[2][2];
#pragma unroll
        for (int bj = 0; bj < 2; ++bj)
#pragma unroll
            for (int n = 0; n < 2; ++n) bv[bj][n] = *(const GAS_ f32x4*)(bglu + col0 + bj * HALF + 4 * n);
#pragma unroll
        for (int ai = 0; ai < 2; ++ai)
#pragma unroll
            for (int m = 0; m < 4; ++m) { const size_t r = (size_t)(row0 + ai * HALF + m * 16);
#pragma unroll
                for (int bj = 0; bj < 2; ++bj) { const int c = col0 + bj * HALF;
                    const u32x4 yv = *(const GAS_ u32x4*)(YG + r * ldy + c), gv = *(const GAS_ u32x4*)(YG + r * ldy + 512 + c);
                    const f32x4 a0 = acc[ai][bj][m][0] + bv[bj][0], a1 = acc[ai][bj][m][1] + bv[bj][1];
                    float o[8]; const unsigned yw[4] = {yv.x, yv.y, yv.z, yv.w}, gw[4] = {gv.x, gv.y, gv.z, gv.w};
#pragma unroll
                    for (int e = 0; e < 8; ++e) { const float a = e < 4 ? a0[e & 3] : a1[e & 3]; const float y = (e & 1) ? bf_hi(yw[e >> 1]) : bf_lo(yw[e >> 1]);
                        const float g = (e & 1) ? bf_hi(gw[e >> 1]) : bf_lo(gw[e >> 1]); o[e] = y * fast_sigmoid(a) * (g * fast_sigmoid(g)); }
                    u32x4 w; w.x = cvt_pk_bf16(o[0], o[1]); w.y = cvt_pk_bf16(o[2], o[3]); w.z = cvt_pk_bf16(o[4], o[5]); w.w = cvt_pk_bf16(o[6], o[7]);
                    *(GAS_ u32x4*)(O + r * ldc + c) = w; asm volatile("" ::: "memory"); } }
    }
};
template <int ADD> struct EpiMerge {
    static constexpr bool PERM = true, AFTER_DRAIN = false;
    bf16_t* O; int ldc; const bf16_t* G; int ldg; int goff;
    __device__ __forceinline__ void operator()(const f32x4 (&acc)[2][2][4][2], const Unit& u, int wr, int wc, int fr, int fq) const {
        const int row0 = u.pm * BM + wr * 64 + fr, col0 = u.pn * BM + wc * 32 + 8 * fq;
#pragma unroll
        for (int ai = 0; ai < 2; ++ai)
#pragma unroll
            for (int m = 0; m < 4; ++m) { const size_t r = (size_t)(row0 + ai * HALF + m * 16);
#pragma unroll
                for (int bj = 0; bj < 2; ++bj) { const int c = col0 + bj * HALF;
                    const u32x4 gv = *(const GAS_ u32x4*)(G + r * ldg + goff + c); u32x4 tv = {0u, 0u, 0u, 0u}; if (ADD) tv = *(const GAS_ u32x4*)(O + r * ldc + c);
                    const f32x4 a0 = acc[ai][bj][m][0], a1 = acc[ai][bj][m][1];
                    float o[8]; const unsigned gw[4] = {gv.x, gv.y, gv.z, gv.w}, tw[4] = {tv.x, tv.y, tv.z, tv.w};
#pragma unroll
                    for (int e = 0; e < 8; ++e) { const float a = e < 4 ? a0[e & 3] : a1[e & 3]; const float g = (e & 1) ? bf_hi(gw[e >> 1]) : bf_lo(gw[e >> 1]);
                        const float t = (e & 1) ? bf_hi(tw[e >> 1]) : bf_lo(tw[e >> 1]); o[e] = (ADD ? t : 0.f) + g * a; }
                    u32x4 w; w.x = cvt_pk_bf16(o[0], o[1]); w.y = cvt_pk_bf16(o[2], o[3]); w.z = cvt_pk_bf16(o[4], o[5]); w.w = cvt_pk_bf16(o[6], o[7]);
                    *(GAS_ u32x4*)(O + r * ldc + c) = w; asm volatile("" ::: "memory"); } }
    }
};
struct EpiOut {
    static constexpr bool PERM = false, AFTER_DRAIN = false;
    const float* base; float* H; bf16_t* XN; float* ssq; int last;
    __device__ __forceinline__ void operator()(const f32x4 (&acc)[2][2][4][2], const Unit& u, int wr, int wc, int fr, int fq) const {
        const int row0 = u.pm * BM + wr * 64 + fr, col0 = u.pn * BM + wc * 32 + 4 * fq;
#pragma unroll
        for (int ai = 0; ai < 2; ++ai)
#pragma unroll
            for (int m = 0; m < 4; ++m) { const size_t r = (size_t)(row0 + ai * HALF + m * 16); float s = 0.f;
#pragma unroll
                for (int bj = 0; bj < 2; ++bj)
#pragma unroll
                    for (int n = 0; n < 2; ++n) { const size_t off = r * 1024 + col0 + bj * HALF + n * 16;
                        const f32x4 h = *(const GAS_ f32x4*)(base + off) + acc[ai][bj][m][n]; *(GAS_ f32x4*)(H + off) = h;
                        s += (h[0] * h[0] + h[1] * h[1]) + (h[2] * h[2] + h[3] * h[3]);
                        if (!last) { u32x2 w; w.x = cvt_pk_bf16(h[0], h[1]); w.y = cvt_pk_bf16(h[2], h[3]); *(GAS_ u32x2*)(XN + off) = w; } }
                s += __shfl_xor(s, 16); s += __shfl_xor(s, 32);
                if (fq == 0 && !last) ((GAS_ float*)ssq)[r * 16 + u.pn * 4 + wc] = s; }
    }
};
template <class Epi, class Sched, bool ALIGN_EPI, bool SP2, int KK, int LDA, int LDB>
__device__ __forceinline__ void gemm_phase(PG8_LAS unsigned char* lds, const Gemm g, const Sched& S, const Epi& E, int wave_id  ) {
    int lane_; asm volatile("v_mbcnt_lo_u32_b32 %0, -1, 0\n\tv_mbcnt_hi_u32_b32 %0, -1, %0" : "=&v"(lane_)); const int tid_ = wave_id * 64 + lane_;
    const int tid = tid_, wid = __builtin_amdgcn_readfirstlane(tid >> 6), lane = tid & 63, wr = wid >> 2, wc = wid & 3, fr = lane & 15, fq = lane >> 4;
    constexpr int K = KK, nt = K / BK;
    unsigned voffA[2], voffB[2];
#pragma unroll
    for (int i = 0; i < 2; ++i) { int R, C; stage_rc(tid * 16 + i * 8192, R, C); const int Rb = Epi::PERM ? ((R & ~31) + perm32(R & 31)) : R;
        voffA[i] = (unsigned)(R * LDA + C) * 2u; voffB[i] = (unsigned)(Rb * LDB + C) * 2u; }
    constexpr size_t kstep = (size_t)(BK * 2);
    constexpr size_t hstepA = (size_t)HALF * LDA * 2, hstepB = (size_t)HALF * LDB * 2;
    constexpr size_t tstepA = 2 * hstepA, tstepB = 2 * hstepB;
    const unsigned ldsw = (unsigned)wid * 1024u;
    const int aoff = lds_byte(wr * 64 + fr, fq * 8), boff = lds_byte(wc * 32 + fr, fq * 8);
#define PG8_SA(b, h) (((b) * 2 + (h)) * HTB)
#define PG8_SB(b, h) ((4 + (b) * 2 + (h)) * HTB)
#define PG8_STAGE(bufoff, gbase, voff) do { _Pragma("unroll") for (int _i = 0; _i < 2; ++_i) \
        __builtin_amdgcn_global_load_lds((const unsigned*)((const char*)(gbase) + (voff)[_i]), (PG8_LAS unsigned*)(lds + (bufoff) + ldsw + _i * 8192), 16, 0, 0); } while (0)
#define PG8_LDA(dst, b, h) do { _Pragma("unroll") for (int m = 0; m < 4; ++m) _Pragma("unroll") for (int k = 0; k < 2; ++k) dst[m][k] = *(const PG8_LAS bf16x8*)(lds + PG8_SA(b, h) + aoff + m * 2048 + k * 1024); } while (0)
#define PG8_LDB(dst, b, h) do { _Pragma("unroll") for (int n = 0; n < 2; ++n) _Pragma("unroll") for (int k = 0; k < 2; ++k) dst[n][k] = *(const PG8_LAS bf16x8*)(lds + PG8_SB(b, h) + boff + n * 2048 + k * 1024); } while (0)
#define PG8_MMA(ai, bj, At, Bt) do { __builtin_amdgcn_s_setprio(1); _Pragma("unroll") for (int m = 0; m < 4; ++m) _Pragma("unroll") for (int n = 0; n < 2; ++n) _Pragma("unroll") for (int k = 0; k < 2; ++k) \
        acc[ai][bj][m][n] = __builtin_amdgcn_mfma_f32_16x16x32_bf16(Bt[n][k], At[m][k], acc[ai][bj][m][n], 0, 0, 0); __builtin_amdgcn_s_setprio(0); } while (0)
#define PG8_WAIT_V(n) asm volatile("s_waitcnt vmcnt(" #n ")" ::: "memory")
#define PG8_WAIT_L(n) asm volatile("s_waitcnt lgkmcnt(" #n ")" ::: "memory")
#define PG8_BAR __builtin_amdgcn_s_barrier()
#define PG8_SCHED __builtin_amdgcn_sched_barrier(0)
    Unit cur, nxt; int ui = 0;
    if (!S.next(0, cur)) return;
    f32x4 acc[2][2][4][2];
#pragma unroll
    for (int a = 0; a < 2; ++a)
#pragma unroll
        for (int b = 0; b < 2; ++b)
#pragma unroll
            for (int m = 0; m < 4; ++m)
#pragma unroll
                for (int n = 0; n < 2; ++n) acc[a][b][m][n] = (f32x4){0.f, 0.f, 0.f, 0.f};
    bf16x8 At[4][2], B0[2][2], B1[2][2];
    const char* cA = (const char*)g.A + (size_t)cur.pm * tstepA; const char* cB = (const char*)g.Bt + (size_t)cur.pn * tstepB;
    S.a_ready(cur);
    if constexpr (SP2) {
        PG8_STAGE(PG8_SB(0, 0), cB, voffB); PG8_STAGE(PG8_SB(0, 1), cB + hstepB, voffB); PG8_STAGE(PG8_SA(0, 0), cA, voffA); PG8_STAGE(PG8_SA(0, 1), cA + hstepA, voffA);
        if (wr == 1) PG8_BAR;
        PG8_WAIT_V(2); PG8_BAR;
        PG8_STAGE(PG8_SB(1, 0), cB + kstep, voffB); PG8_STAGE(PG8_SA(1, 0), cA + kstep, voffA); PG8_STAGE(PG8_SB(1, 1), cB + hstepB + kstep, voffB);
        PG8_WAIT_V(6); PG8_BAR;
    } else {
        PG8_STAGE(PG8_SB(0, 0), cB, voffB); PG8_STAGE(PG8_SA(0, 0), cA, voffA); PG8_STAGE(PG8_SB(0, 1), cB + hstepB, voffB); PG8_STAGE(PG8_SA(0, 1), cA + hstepA, voffA);
        if (wr == 1) PG8_BAR;
        PG8_WAIT_V(4); PG8_BAR;
        PG8_STAGE(PG8_SB(1, 0), cB + kstep, voffB); PG8_STAGE(PG8_SA(1, 0), cA + kstep, voffA); PG8_STAGE(PG8_SB(1, 1), cB + hstepB + kstep, voffB);
        PG8_WAIT_V(6); PG8_BAR;
    }
    for (;;) {
        const bool has_next = S.next(ui + 1, nxt);
        const char* nA = has_next ? (const char*)g.A + (size_t)nxt.pm * tstepA : cA; const char* nB = has_next ? (const char*)g.Bt + (size_t)nxt.pn * tstepB : cB;
        for (int t = 0; t < nt; t += 2) {
            const bool last = (t == nt - 2);
            const char* a1 = cA + (size_t)(t + 1) * kstep;
            const char* a2 = last ? nA : cA + (size_t)(t + 2) * kstep; const char* b2 = last ? nB : cB + (size_t)(t + 2) * kstep;
            const char* a3 = a2 + kstep; const char* b3 = b2 + kstep;
            if (last && has_next) S.a_ready(nxt);
            if constexpr (SP2) {
            PG8_LDB(B0, 0, 0); PG8_LDB(B1, 0, 1); PG8_SCHED; PG8_LDA(At, 0, 0); PG8_STAGE(PG8_SA(1, 1), a1 + hstepA, voffA);
            PG8_WAIT_V(8); PG8_WAIT_L(0); PG8_BAR; PG8_MMA(0, 0, At, B0); PG8_MMA(0, 1, At, B1); PG8_BAR; PG8_SCHED;
            PG8_LDA(At, 0, 1); PG8_STAGE(PG8_SB(0, 0), b2, voffB); PG8_STAGE(PG8_SB(0, 1), b2 + hstepB, voffB); PG8_STAGE(PG8_SA(0, 0), a2, voffA);
            PG8_WAIT_V(8); PG8_WAIT_L(0); PG8_BAR; PG8_MMA(1, 0, At, B0); PG8_MMA(1, 1, At, B1); PG8_BAR; PG8_SCHED;
            PG8_LDB(B0, 1, 0); PG8_LDB(B1, 1, 1); PG8_SCHED; PG8_LDA(At, 1, 0); PG8_STAGE(PG8_SA(0, 1), a2 + hstepA, voffA);
            PG8_WAIT_V(8); PG8_WAIT_L(0); PG8_BAR; PG8_MMA(0, 0, At, B0); PG8_MMA(0, 1, At, B1); PG8_BAR; PG8_SCHED;
            PG8_LDA(At, 1, 1); PG8_STAGE(PG8_SB(1, 0), b3, voffB); PG8_STAGE(PG8_SB(1, 1), b3 + hstepB, voffB); PG8_STAGE(PG8_SA(1, 0), a3, voffA);
            PG8_WAIT_V(8); PG8_WAIT_L(0); PG8_BAR; PG8_MMA(1, 0, At, B0); PG8_MMA(1, 1, At, B1); PG8_BAR; PG8_SCHED;
            } else {
            PG8_LDB(B0, 0, 0); PG8_SCHED; PG8_LDA(At, 0, 0); PG8_STAGE(PG8_SA(1, 1), a1 + hstepA, voffA);
            PG8_WAIT_L(8); PG8_BAR; PG8_WAIT_L(0); PG8_MMA(0, 0, At, B0); PG8_BAR; PG8_SCHED;
            PG8_LDB(B1, 0, 1); PG8_STAGE(PG8_SB(0, 0), b2, voffB);
            PG8_BAR; PG8_WAIT_L(0); PG8_MMA(0, 1, At, B1); PG8_BAR;
            PG8_LDA(At, 0, 1); PG8_STAGE(PG8_SA(0, 0), a2, voffA);
            PG8_BAR; PG8_WAIT_L(0); PG8_MMA(1, 0, At, B0); PG8_BAR; PG8_SCHED;
            PG8_STAGE(PG8_SB(0, 1), b2 + hstepB, voffB);
            PG8_WAIT_V(6); PG8_BAR; PG8_MMA(1, 1, At, B1); PG8_BAR;
            PG8_LDB(B0, 1, 0); PG8_SCHED; PG8_LDA(At, 1, 0); PG8_STAGE(PG8_SA(0, 1), a2 + hstepA, voffA);
            PG8_WAIT_L(8); PG8_BAR; PG8_WAIT_L(0); PG8_MMA(0, 0, At, B0); PG8_BAR; PG8_SCHED;
            PG8_LDB(B1, 1, 1); PG8_STAGE(PG8_SB(1, 0), b3, voffB);
            PG8_BAR; PG8_WAIT_L(0); PG8_MMA(0, 1, At, B1); PG8_BAR;
            PG8_LDA(At, 1, 1); PG8_STAGE(PG8_SA(1, 0), a3, voffA);
            PG8_BAR; PG8_WAIT_L(0); PG8_MMA(1, 0, At, B0); PG8_BAR; PG8_SCHED;
            PG8_STAGE(PG8_SB(1, 1), b3 + hstepB, voffB);
            PG8_WAIT_V(6); PG8_BAR; PG8_MMA(1, 1, At, B1); PG8_BAR;
            }
        }
        if constexpr (ALIGN_EPI) { if (wr == 0) PG8_BAR; }
        if constexpr (!Epi::AFTER_DRAIN) { E(acc, cur, wr, wc, fr, fq); S.done(cur); }
        if (!has_next) break;
#pragma unroll
        for (int a = 0; a < 2; ++a)
#pragma unroll
            for (int b = 0; b < 2; ++b)
#pragma unroll
                for (int m = 0; m < 4; ++m)
#pragma unroll
                    for (int n = 0; n < 2; ++n) acc[a][b][m][n] = (f32x4){0.f, 0.f, 0.f, 0.f};
        cur = nxt; cA = nA; cB = nB; ++ui;
        if constexpr (ALIGN_EPI) { if (wr == 1) PG8_BAR; }
    }
    PG8_WAIT_V(0);
    if constexpr (!ALIGN_EPI) { if (wr == 0) PG8_BAR; }
    PG8_BAR;
    if constexpr (Epi::AFTER_DRAIN) { E.fused(acc, cur, wr, wc, fr, fq, lds, wid, lane); S.done(cur); }
#undef PG8_SA
#undef PG8_SB
#undef PG8_STAGE
#undef PG8_LDA
#undef PG8_LDB
#undef PG8_MMA
#undef PG8_WAIT_V
#undef PG8_WAIT_L
#undef PG8_BAR
#undef PG8_SCHED
}
}

constexpr int NWAVES = 8, NTHREADS = 512;
#ifndef MK_PER_PHASE
#define MK_PER_PHASE 0
#endif
constexpr int D = 1024, BATCH = 8, SEQ = 2048, M = BATCH * SEQ, DEPTH = 2;
constexpr int S5W = 512, S5H = 16, S5G = 32, S5P = 64;
constexpr int HYW = 1024, HYF = 4096, HYE = 33, HYN = 64;
constexpr int INC = 7168;
constexpr int NPHASE = 12;

constexpr size_t MiB = 1u << 20;
constexpr size_t WS_CTL = 0, CTL_ZERO_BYTES = 64 * 1024;
constexpr size_t WS_H2 = 1 * MiB;
constexpr size_t WS_LBAR = 2 * MiB;
constexpr size_t WS_BBT = 2 * MiB + 64 * 1024;
constexpr size_t WS_CT = WS_BBT + 512 * 1024;
constexpr size_t WS_W = 4 * MiB;
constexpr size_t W_IN = 0, W_GLU = 14 * MiB, W_BS5 = W_GLU + 512 * 1024, W_BHY = W_BS5 + 1 * MiB, W_OUT = W_BHY + 2 * MiB, W_LAYER = W_OUT + 2 * MiB;
constexpr size_t WS_SSQ = 43 * MiB;
constexpr size_t WS_X = 44 * MiB;
constexpr size_t WS_R1 = 76 * MiB, WS_R2 = 108 * MiB, WS_R3 = 140 * MiB, WS_R4 = 172 * MiB, WS_R5 = 204 * MiB, WS_R6 = 236 * MiB, WS_W3T = 252 * MiB  , WS_END = 254 * MiB;
static_assert(WS_W + 2 * W_LAYER <= WS_SSQ, "weights");
constexpr int LDS_BYTES = 163840 - 256;
constexpr int LDSCTL_OFF = LDS_BYTES - 512;

#define GAS __attribute__((address_space(1)))
#define LAS __attribute__((address_space(3)))
typedef unsigned short bf16;
typedef unsigned v4u __attribute__((ext_vector_type(4)));
typedef unsigned v2u __attribute__((ext_vector_type(2)));
typedef float f32x4 __attribute__((ext_vector_type(4)));
typedef float f32x2 __attribute__((ext_vector_type(2)));
typedef short bf16x8 __attribute__((ext_vector_type(8)));
typedef GAS unsigned gu32;
#define RLX_AGENT __ATOMIC_RELAXED, __HIP_MEMORY_SCOPE_AGENT
#define LDS_WAIT() asm volatile("s_waitcnt lgkmcnt(0)" ::: "memory")
#define VM_WAIT() asm volatile("s_waitcnt vmcnt(0)" ::: "memory")
__device__ __forceinline__ unsigned f2bf(float f) { unsigned u = __builtin_bit_cast(unsigned, f); return (u + 0x7fffu + ((u >> 16) & 1u)) >> 16; }
__device__ __forceinline__ unsigned pk2(float lo, float hi) { return f2bf(lo) | (f2bf(hi) << 16); }
__device__ __forceinline__ float bf2f(unsigned short h) { return __uint_as_float((unsigned)h << 16); }
using pg8::bf_lo; using pg8::bf_hi; using pg8::fast_sigmoid;

#define XB_TMO      128
#define XB_XCNT(j)  (256  + 64 * (j))
#define XB_XSUB(j)  (1280 + 64 * (j))
#define XB_XGEN(j)  (2304 + 64 * (j))
#define XB_TOP      3328
#define XB_TOPGEN   3392
#define XCD_BAR_WORDS 3456
#define XB_SPIN_CAP (1u << 18)
__device__ __forceinline__ unsigned xb_ld(unsigned* p)              { return __hip_atomic_load(p, __ATOMIC_RELAXED, __HIP_MEMORY_SCOPE_AGENT); }
__device__ __forceinline__ unsigned xb_add(unsigned* p, unsigned v) { return __hip_atomic_fetch_add(p, v, __ATOMIC_RELAXED, __HIP_MEMORY_SCOPE_AGENT); }
__device__ __forceinline__ unsigned xb_xcc_id() { return (unsigned)__builtin_amdgcn_s_getreg((3 << 11) | 20) & 0xFu; }
#define XB_SPIN(cond, bar) do { unsigned _sp = 0; while (cond) { __builtin_amdgcn_s_sleep(1); \
    if ((++_sp & 255u) == 0u) { if (xb_ld(&(bar)[XB_TMO])) break; if (_sp > XB_SPIN_CAP) { atomicAdd(&(bar)[XB_TMO], 1u); break; } } } } while (0)
struct XcdBarrier { unsigned* bar; unsigned x; volatile LAS unsigned* st; };
__device__ __forceinline__ int cur_lane() { int l; asm volatile("v_mbcnt_lo_u32_b32 %0, -1, 0\n\tv_mbcnt_hi_u32_b32 %0, -1, %0" : "=&v"(l)); return l; }
__device__ __forceinline__ XcdBarrier xcd_barrier_post(unsigned* bar, volatile LAS unsigned* st, bool leader) {
    XcdBarrier b; b.bar = bar; b.x = xb_xcc_id(); b.st = st;
    if (leader) (void)xb_add(&bar[XB_XCNT(b.x)], 1u);
    return b;
}
__device__ __forceinline__ void xcd_barrier_complete(unsigned* bar, unsigned x, unsigned& nloc, unsigned& nx) {
    const unsigned G = gridDim.x * gridDim.y * gridDim.z;
    unsigned sum, cnt, mine, sp = 0u;
    for (;;) {
        sum = 0u; cnt = 0u; mine = 0u;
#pragma unroll
        for (unsigned j = 0; j < 16; ++j) { const unsigned c = xb_ld(&bar[XB_XCNT(j)]); sum += c; cnt += (c > 0u) ? 1u : 0u; mine = (j == x) ? c : mine; }
        if (sum == G) break;
        __builtin_amdgcn_s_sleep(1);
        if ((++sp & 255u) == 0u) { if (xb_ld(&bar[XB_TMO])) break; if (sp > XB_SPIN_CAP) { atomicAdd(&bar[XB_TMO], 1u); break; } }
    }
    nloc = mine > 0u ? mine : 1u; nx = cnt > 0u ? cnt : 1u;
}
__device__ __forceinline__ void xcd_barrier(const XcdBarrier& b, int wave_id) {
    asm volatile("s_waitcnt vmcnt(0)" ::: "memory");
    __syncthreads();
    if (wave_id == 0 && cur_lane() == 0) {
        unsigned* bar = b.bar; asm volatile("" : "+s"(bar));
        __builtin_amdgcn_s_waitcnt(0);
        unsigned nloc = b.st[0], nx = b.st[1];
        if (nloc == 0u) { xcd_barrier_complete(bar, b.x, nloc, nx); b.st[0] = nloc; b.st[1] = nx; }
        const unsigned old = xb_add(&bar[XB_XSUB(b.x)], 1u);
        const unsigned gen = old / nloc;
        if (old + 1u == (gen + 1u) * nloc) {
            __builtin_amdgcn_fence(__ATOMIC_RELEASE, "agent");
            asm volatile("s_waitcnt vmcnt(0)" ::: "memory");
            const unsigned og = xb_add(&bar[XB_TOP], 1u);
            const unsigned tg = og / nx;
            if (og + 1u == (tg + 1u) * nx) xb_add(&bar[XB_TOPGEN], 1u);
            else XB_SPIN(xb_ld(&bar[XB_TOPGEN]) == tg, bar);
            __builtin_amdgcn_fence(__ATOMIC_ACQUIRE, "agent");
            xb_add(&bar[XB_XGEN(b.x)], 1u);
            asm volatile("s_waitcnt vmcnt(0)" ::: "memory");
        } else {
            XB_SPIN(xb_ld(&bar[XB_XGEN(b.x)]) == gen, bar);
            __builtin_amdgcn_fence(__ATOMIC_ACQUIRE, "agent");
            asm volatile("s_waitcnt vmcnt(0)" ::: "memory");
        }
    }
    __syncthreads();
}

struct Frame {
    LAS unsigned char* lds;
    int tid, lane, wave, G, bx;
    float* out; unsigned char* ws;
    __device__ __forceinline__ const float* inp(int i) const {
        const LAS unsigned* t = (const LAS unsigned*)(lds + LDSCTL_OFF + 256) + 2 * i;
        const unsigned lo = __builtin_amdgcn_readfirstlane(t[0]), hi = __builtin_amdgcn_readfirstlane(t[1]);
        return (const float*)(((unsigned long long)hi << 32) | lo);
    }
};
__device__ __forceinline__ float wave_sum(float v) {
#pragma unroll
    for (int o = 1; o < 64; o <<= 1) v += __shfl_xor(v, o);
    return v;
}

__device__ __forceinline__ void p0_transpose_item(const float* W, int K, int N, bf16* WT, int k0, int n0, int drow, const float* kscale, LAS float* scr, int lane, bf16* WTlo = nullptr) {
    const int lr = lane >> 4, lc = (lane & 15) * 4;
    f32x4 v[16];
#pragma unroll
    for (int i = 0; i < 16; ++i) v[i] = *(const GAS f32x4*)(W + (size_t)(k0 + 4 * i + lr) * N + n0 + lc);
#pragma unroll
    for (int i = 0; i < 16; ++i) { const int kk = 4 * i + lr; f32x4 x = v[i]; if (kscale) x = x * kscale[k0 + kk];
        LAS float* d = scr + kk * 65 + lc; d[0] = x[0]; d[1] = x[1]; d[2] = x[2]; d[3] = x[3]; }
    LDS_WAIT(); asm volatile("" ::: "memory");
    const int c = lane & 7;
#pragma unroll
    for (int j = 0; j < 8; ++j) { const int n = (lane >> 3) + 8 * j; const LAS float* s = scr + (8 * c) * 65 + n;
        v4u o; o.x = pk2(s[0 * 65], s[1 * 65]); o.y = pk2(s[2 * 65], s[3 * 65]); o.z = pk2(s[4 * 65], s[5 * 65]); o.w = pk2(s[6 * 65], s[7 * 65]);
        *(GAS v4u*)(WT + (size_t)(drow + n) * K + k0 + 8 * c) = o;
        if (WTlo) { v4u q;
#define P0_LO2(a, b, hw) pk2((a) - __uint_as_float((hw) << 16), (b) - __uint_as_float((hw) & 0xffff0000u))
            q.x = P0_LO2(s[0 * 65], s[1 * 65], o.x); q.y = P0_LO2(s[2 * 65], s[3 * 65], o.y); q.z = P0_LO2(s[4 * 65], s[5 * 65], o.z); q.w = P0_LO2(s[6 * 65], s[7 * 65], o.w);
#undef P0_LO2
            *(GAS v4u*)(WTlo + (size_t)(drow + n) * K + k0 + 8 * c) = q; } }
    LDS_WAIT(); asm volatile("" ::: "memory");
}
__device__ __forceinline__ void p0_prologue(Frame& F) {
    LAS float* scr = (LAS float*)(F.lds + F.wave * 17408);
    const int gw = F.bx * NWAVES + F.wave, NGW = F.G * NWAVES, lane = F.lane;
    constexpr int I_IN = (D / 64) * (INC / 64), I_GLU = (S5W / 64) * (S5W / 64), I_BS5 = (S5W / 64) * (D / 64), I_BHY = (HYW / 64) * (D / 64), I_OUT = (D / 64) * (D / 64);
    constexpr int I_LAYER = I_IN + I_GLU + I_BS5 + I_BHY + I_OUT;
    for (int it = gw; it < DEPTH * I_LAYER; it += NGW) {
        const int l = it / I_LAYER; int r = it % I_LAYER; bf16* wl = (bf16*)(F.ws + WS_W + (size_t)l * W_LAYER);
        if (r < I_IN) { const int nblk = INC / 64, kb = r / nblk, nb = r % nblk, n0 = nb * 64;
            const int drow = (n0 >= 1024 && n0 < 5120) ? n0 - 1024 : (n0 < 1024 ? n0 + 4096 : n0);
            p0_transpose_item(F.inp(2) + (size_t)l * D * INC, D, INC, wl + W_IN / 2, kb * 64, n0, drow, F.inp(1) + l * D, scr, lane); continue; } r -= I_IN;
        if (r < I_GLU) { const int nblk = S5W / 64; p0_transpose_item(F.inp(11) + (size_t)l * S5W * S5W, S5W, S5W, wl + W_GLU / 2, (r / nblk) * 64, (r % nblk) * 64, (r % nblk) * 64, nullptr, scr, lane); continue; } r -= I_GLU;
        if (r < I_BS5) { const int nblk = D / 64; p0_transpose_item(F.inp(23) + (size_t)l * S5W * D, S5W, D, wl + W_BS5 / 2, (r / nblk) * 64, (r % nblk) * 64, (r % nblk) * 64, nullptr, scr, lane); continue; } r -= I_BS5;
        if (r < I_BHY) { const int nblk = D / 64; p0_transpose_item(F.inp(24) + (size_t)l * HYW * D, HYW, D, wl + W_BHY / 2, (r / nblk) * 64, (r % nblk) * 64, (r % nblk) * 64, nullptr, scr, lane); continue; } r -= I_BHY;
        { const int nblk = D / 64; p0_transpose_item(F.inp(25) + (size_t)l * D * D, D, D, wl + W_OUT / 2, (r / nblk) * 64, (r % nblk) * 64, (r % nblk) * 64, nullptr, scr, lane); }
    }
    for (int it = gw; it < DEPTH * (HYF / 64); it += NGW) { const int l = it / (HYF / 64), nb = it % (HYF / 64); bf16* hi = (bf16*)(F.ws + WS_W3T + (size_t)l * MiB);
        p0_transpose_item(F.inp(20) + (size_t)l * HYN * HYF, HYN, HYF, hi, 0, nb * 64, nb * 64, nullptr, scr, lane, hi + (size_t)HYF * HYN); }
    { bf16* X = (bf16*)(F.ws + WS_X); float* ssq = (float*)(F.ws + WS_SSQ);
      for (int m0 = 2 * gw; m0 < M; m0 += 2 * NGW) { f32x4 v[2][4]; float s[2];
#pragma unroll
        for (int r = 0; r < 2; ++r) { const GAS f32x4* xr = (const GAS f32x4*)(F.inp(0) + (size_t)(m0 + r) * D) + lane;
#pragma unroll
            for (int j = 0; j < 4; ++j) v[r][j] = xr[64 * j]; }
#pragma unroll
        for (int r = 0; r < 2; ++r) { float a = 0.f;
#pragma unroll
            for (int j = 0; j < 4; ++j) a += (v[r][j].x * v[r][j].x + v[r][j].y * v[r][j].y) + (v[r][j].z * v[r][j].z + v[r][j].w * v[r][j].w);
            s[r] = wave_sum(a);
            GAS unsigned long long* o8 = (GAS unsigned long long*)(X + (size_t)(m0 + r) * D) + lane;
#pragma unroll
            for (int j = 0; j < 4; ++j) o8[64 * j] = (unsigned long long)pk2(v[r][j].x, v[r][j].y) | ((unsigned long long)pk2(v[r][j].z, v[r][j].w) << 32);
            if (lane < 16) ssq[(size_t)(m0 + r) * 16 + lane] = lane == 0 ? s[r] : 0.f; } } }
    {
      for (int it = gw; it < DEPTH * SEQ; it += NGW) { const int l = it / SEQ, t = it % SEQ, j = lane;
        const float* w1 = F.inp(15) + (size_t)l * HYE * HYN; const float* b1 = F.inp(16) + l * HYN; const float* fr = F.inp(17) + l * HYN; const float* w2 = F.inp(18) + (size_t)l * HYN * HYN; const float* b2 = F.inp(19) + l * HYN;
        float f = 0.f;
        if (j == 0) f = (float)t / (float)(SEQ - 1);
        else if (j < 33) { const int bi = (j - 1) & 15; const float band = 1e-4f + (float)bi * ((15.f - 1e-4f) / 15.f); const float ang = band * (float)t * (float)(2.0 * 3.14159265358979323846 / SEQ); f = j < 17 ? cosf(ang) : -sinf(ang); }
        float a = b1[j];
        for (int i = 0; i < HYE; ++i) a += __shfl(f, i) * w1[i * HYN + j];
        const float h1 = sinf(fr[j] * a);
        float c = b2[j];
        for (int i = 0; i < HYN; ++i) c += __shfl(h1, i) * w2[i * HYN + j];
        const float hv = sinf(fr[j] * c); const unsigned hh = f2bf(hv);
        bf16* H2H = (bf16*)(F.ws + WS_H2 + (size_t)l * 512 * 1024);
        H2H[(size_t)t * HYN + j] = (bf16)hh; H2H[(size_t)SEQ * HYN + (size_t)t * HYN + j] = (bf16)f2bf(hv - __uint_as_float(hh << 16)); } }
    { float* LB = (float*)(F.ws + WS_LBAR); bf16* BBT = (bf16*)(F.ws + WS_BBT); bf16* CT = (bf16*)(F.ws + WS_CT);
      for (int q = gw; q < DEPTH * 2 * S5G; q += NGW) { const int p = lane; const int i = q * S5P + p;
        const float dt = expf(F.inp(5)[q]); const float lr = F.inp(3)[i], li = F.inp(4)[i]; const float mag = expf(lr * dt), ang = li * dt;
        const float br = mag * cosf(ang), bi = mag * sinf(ang); LB[2 * i] = br; LB[2 * i + 1] = bi;
        const float nr = br - 1.f, ni = bi, den = lr * lr + li * li; const float kr = (nr * lr + ni * li) / den, ki = (ni * lr - nr * li) / den;
        const float* bre = F.inp(6) + (size_t)i * S5H; const float* bim = F.inp(7) + (size_t)i * S5H;
        bf16* rowr = BBT + ((size_t)q * 128 + 2 * p) * 16; bf16* rowi = rowr + 16;
        for (int h = 0; h < S5H; ++h) { const float xr = bre[h], xi = bim[h]; rowr[h] = (bf16)f2bf(kr * xr - ki * xi); rowi[h] = (bf16)f2bf(kr * xi + ki * xr); }
        const float* cre = F.inp(8) + (size_t)q * S5H * S5P; const float* cim = F.inp(9) + (size_t)q * S5H * S5P;
        for (int h = 0; h < S5H; ++h) { *(unsigned*)(CT + ((size_t)q * 16 + h) * 128 + 2 * p) = pk2(cre[h * S5P + p], -cim[h * S5P + p]); } } }
}

constexpr int S5_YB = 0, S5_CH = 65536, S5_CHB = 8448, S5_SEND = S5_CH + 8 * S5_CHB;
__device__ __forceinline__ float gelu_tanh_fast(float x) {
    const float z = 0.7978845608028654f * (x + 0.044715f * x * x * x);
    const float e = __builtin_amdgcn_exp2f(2.0f * 1.4426950408889634f * z);
    const float th = 1.0f - 2.0f * __builtin_amdgcn_rcpf(e + 1.0f);
    return 0.5f * x * (1.0f + th);
}
template <int DIR, bool EMIT>
__device__ __forceinline__ void s5_pass(Frame& F, const bf16* Ub  , int tlo  , float ar, float ai, float& sr, float& si,
                                        const bf16x8 (&bbf)[8], const bf16x8 (&ctf)[4], const bf16x8& ddf, LAS unsigned char* ch, LAS unsigned char* yb, bf16* YGb) {
    const int lane = F.lane, fr = lane & 15, fq = lane >> 4;
    auto load_u = [&](int tc0) -> bf16x8 { bf16x8 z = {0, 0, 0, 0, 0, 0, 0, 0}; int row = tc0 + fr; asm volatile("" : "+v"(row));
        if (fq < 2) z = *(const GAS bf16x8*)(Ub + (size_t)row * 1024 + 8 * fq); return z; };
    bf16x8 ufr[4];
#pragma unroll
    for (int i = 0; i < 4; ++i) ufr[i] = load_u(DIR ? tlo + 16 * (15 - i) : tlo + 16 * i);
#pragma unroll 1
    for (int cb = 0; cb < 4; ++cb)
#pragma unroll
    for (int ci4 = 0; ci4 < 4; ++ci4) { const int ci = 4 * cb + ci4;
        const int tc0 = DIR ? tlo + 16 * (15 - ci) : tlo + 16 * ci;
        const bf16x8 uf = ufr[ci4];
#pragma unroll
        for (int j = 0; j < 8; ++j) { f32x4 a = {0.f, 0.f, 0.f, 0.f}; a = __builtin_amdgcn_mfma_f32_16x16x32_bf16(bbf[j], uf, a, 0, 0, 0);
            v2u w; w.x = pg8::cvt_pk_bf16(a[0], a[1]); w.y = pg8::cvt_pk_bf16(a[2], a[3]); *(LAS v2u*)(ch + fr * 264 + (16 * j + 4 * fq) * 2) = w; }
        LDS_WAIT();
        f32x2 x[16];
#pragma unroll
        for (int tt = 0; tt < 16; ++tt) { const unsigned w = *(const LAS unsigned*)(ch + tt * 264 + 4 * lane); x[tt] = (f32x2){bf_lo(w), bf_hi(w)}; }
        LDS_WAIT();
        unsigned spk[16];
#pragma unroll
        for (int i = 0; i < 16; ++i) { const int tt = DIR ? 15 - i : i;
            const float nr = ar * sr - ai * si + x[tt].x, ni = ar * si + ai * sr + x[tt].y; sr = nr; si = ni;
            if (EMIT) spk[tt] = pg8::cvt_pk_bf16(nr, ni); }
        if (EMIT) {
            LAS unsigned* sb = (LAS unsigned*)ch;
#pragma unroll
            for (int tt = 0; tt < 16; ++tt) sb[tt * 68 + lane] = spk[tt];
            LDS_WAIT();
            f32x4 y = {0.f, 0.f, 0.f, 0.f};
#pragma unroll
            for (int ks = 0; ks < 4; ++ks) { const bf16x8 sf = *(const LAS bf16x8*)(ch + fr * 272 + ks * 64 + fq * 16); y = __builtin_amdgcn_mfma_f32_16x16x32_bf16(ctf[ks], sf, y, 0, 0, 0); }
            LDS_WAIT();
            LAS v2u* ybp = (LAS v2u*)(yb + (size_t)(tc0 + fr) * 32 + 8 * fq);
            if (DIR == 0) { v2u w; w.x = pg8::cvt_pk_bf16(y[0], y[1]); w.y = pg8::cvt_pk_bf16(y[2], y[3]); *ybp = w; }
            else { y = __builtin_amdgcn_mfma_f32_16x16x32_bf16(ddf, uf, y, 0, 0, 0);
                const v2u f = *ybp; const float o0 = gelu_tanh_fast(y[0] + bf_lo(f.x)), o1 = gelu_tanh_fast(y[1] + bf_hi(f.x)), o2 = gelu_tanh_fast(y[2] + bf_lo(f.y)), o3 = gelu_tanh_fast(y[3] + bf_hi(f.y));
                v2u w; w.x = pg8::cvt_pk_bf16(o0, o1); w.y = pg8::cvt_pk_bf16(o2, o3);
                *(GAS v2u*)(YGb + (size_t)(tc0 + fr) * 1024 + 4 * fq) = w; }
        }
        if (ci + 4 < 16) ufr[ci4] = load_u(DIR ? tlo + 16 * (15 - (ci + 4)) : tlo + 16 * (ci + 4));
        __builtin_amdgcn_sched_barrier(0);
    }
}
__device__ __forceinline__ void s5_item(Frame& F, int l, int b, int g, bool dry = false) {
    const int lane = F.lane, fr = lane & 15, fq = lane >> 4, seg = F.wave;
    bf16* U = (bf16*)(F.ws + WS_R5) + (size_t)b * SEQ * 1024 + g * 16;
    LAS unsigned char* ch = F.lds + S5_CH + seg * S5_CHB; LAS unsigned char* yb = F.lds + S5_YB;
    LAS f32x2* send = (LAS f32x2*)(F.lds + S5_SEND);
#pragma unroll 1
    for (int dir = 0; dir < 2; ++dir) {
        const int q = (l * 2 + dir) * S5G + g;
        const float ar = ((const GAS float*)(F.ws + WS_LBAR))[(size_t)(q * S5P + lane) * 2], ai = ((const GAS float*)(F.ws + WS_LBAR))[(size_t)(q * S5P + lane) * 2 + 1];
        bf16x8 bbf[8], ctf[4], ddf; const bf16x8 zero8 = {0, 0, 0, 0, 0, 0, 0, 0};
        const bf16* BBT = (const bf16*)(F.ws + WS_BBT) + (size_t)q * 128 * 16; const bf16* CT = (const bf16*)(F.ws + WS_CT) + (size_t)q * 16 * 128;
#pragma unroll
        for (int j = 0; j < 8; ++j) bbf[j] = fq < 2 ? *(const GAS bf16x8*)(BBT + (16 * j + fr) * 16 + 8 * fq) : zero8;
#pragma unroll
        for (int ks = 0; ks < 4; ++ks) ctf[ks] = *(const GAS bf16x8*)(CT + fr * 128 + 32 * ks + 8 * fq);
        { const short dv = (short)f2bf(F.inp(10)[l * S5W + g * 16 + fr]); ddf = zero8;
#pragma unroll
          for (int jj = 0; jj < 8; ++jj) if (8 * fq + jj == fr) ddf[jj] = dv; }
        const int tlo = dir ? SEQ - 256 * (seg + 1) : 256 * seg;
        float sr = 0.f, si = 0.f;
#ifndef MK_S5DRY_MODE
#define MK_S5DRY_MODE 0
#endif
        if (!(dry && MK_S5DRY_MODE == 2)) { if (dir == 0) s5_pass<0, false>(F, U, tlo, ar, ai, sr, si, bbf, ctf, ddf, ch, yb, U); else s5_pass<1, false>(F, U, tlo, ar, ai, sr, si, bbf, ctf, ddf, ch, yb, U); }
        send[seg * 64 + lane] = (f32x2){sr, si};
        LDS_WAIT(); __syncthreads();
        float pr = ar, pi = ai;
#pragma unroll
        for (int k = 0; k < 8; ++k) { const float nr = pr * pr - pi * pi, ni = 2.f * pr * pi; pr = nr; pi = ni; }
        sr = 0.f; si = 0.f;
        for (int k = 0; k < seg; ++k) { const f32x2 e = send[k * 64 + lane]; const float nr = pr * sr - pi * si + e.x, ni = pr * si + pi * sr + e.y; sr = nr; si = ni; }
        bf16* YGo = dry ? (bf16*)(F.ws + WS_R6) + (size_t)(b & 1) * SEQ * 1024 + g * 16 : U;
        if (!(dry && MK_S5DRY_MODE == 1)) { if (dir == 0) s5_pass<0, true>(F, U, tlo, ar, ai, sr, si, bbf, ctf, ddf, ch, yb, YGo); else s5_pass<1, true>(F, U, tlo, ar, ai, sr, si, bbf, ctf, ddf, ch, yb, YGo); }
        LDS_WAIT(); __syncthreads();
    }
}

constexpr int HY_WX = 0, HY_WXB = 8704, HY_KF = 8 * HY_WXB, HY_KFO = 33 * 64 * 8, HY_KFCH = 2 * HY_KFO, HY_RED = HY_KF + 2 * HY_KFCH, HY_RAWROW = 4128;
static_assert(HY_RED + 256 <= LDSCTL_OFF && 4 * 2048 * 4 <= HY_KFCH && 2 * HY_RAWROW <= HY_WXB, "hyena LDS map");
#define C64_LIST 1.000000000e+00f, 9.951847267e-01f, 9.807852804e-01f, 9.569403357e-01f, 9.238795325e-01f, 8.819212643e-01f, 8.314696123e-01f, 7.730104534e-01f, 7.071067812e-01f, 6.343932842e-01f, 5.555702330e-01f, 4.713967368e-01f, 3.826834324e-01f, 2.902846773e-01f, 1.950903220e-01f, 9.801714033e-02f, 0.0f, -9.801714033e-02f, -1.950903220e-01f, -2.902846773e-01f, -3.826834324e-01f, -4.713967368e-01f, -5.555702330e-01f, -6.343932842e-01f, -7.071067812e-01f, -7.730104534e-01f, -8.314696123e-01f, -8.819212643e-01f, -9.238795325e-01f, -9.569403357e-01f, -9.807852804e-01f, -9.951847267e-01f, -1.000000000e+00f, -9.951847267e-01f, -9.807852804e-01f, -9.569403357e-01f, -9.238795325e-01f, -8.819212643e-01f, -8.314696123e-01f, -7.730104534e-01f, -7.071067812e-01f, -6.343932842e-01f, -5.555702330e-01f, -4.713967368e-01f, -3.826834324e-01f, -2.902846773e-01f, -1.950903220e-01f, -9.801714033e-02f, 0.0f, 9.801714033e-02f, 1.950903220e-01f, 2.902846773e-01f, 3.826834324e-01f, 4.713967368e-01f, 5.555702330e-01f, 6.343932842e-01f, 7.071067812e-01f, 7.730104534e-01f, 8.314696123e-01f, 8.819212643e-01f, 9.238795325e-01f, 9.569403357e-01f, 9.807852804e-01f, 9.951847267e-01f
__host__ __device__ constexpr int rev6(int s) { return ((s >> 4) & 3) | (s & 12) | ((s & 3) << 4); }

template <bool INV> __device__ __forceinline__ void r4(float& x0r, float& x0i, float& x1r, float& x1i, float& x2r, float& x2i, float& x3r, float& x3i) {
    const float t0r = x0r + x2r, t0i = x0i + x2i, t1r = x0r - x2r, t1i = x0i - x2i, t2r = x1r + x3r, t2i = x1i + x3i, t3r = x1r - x3r, t3i = x1i - x3i;
    x0r = t0r + t2r; x0i = t0i + t2i; x2r = t0r - t2r; x2i = t0i - t2i;
    if (!INV) { x1r = t1r + t3i; x1i = t1i - t3r; x3r = t1r - t3i; x3i = t1i + t3r; }
    else      { x1r = t1r - t3i; x1i = t1i + t3r; x3r = t1r + t3i; x3i = t1i - t3r; }
}
constexpr float C64T[64] = { C64_LIST };
template <int... Is, class Fn> __device__ __forceinline__ void static_for_impl(std::integer_sequence<int, Is...>, Fn&& f) { (f(std::integral_constant<int, Is>{}), ...); }
template <int N, class Fn> __device__ __forceinline__ void static_for(Fn&& f) { static_for_impl(std::make_integer_sequence<int, N>{}, f); }
template <bool INV, int E> __device__ __forceinline__ void twc(float& xr, float& xi) {
    constexpr int e = E & 63;
    if constexpr (e == 0) { return; }
    else if constexpr (e == 16) { const float tr = xr, ti = xi; if (!INV) { xr = ti; xi = -tr; } else { xr = -ti; xi = tr; } }
    else if constexpr (e == 32) { xr = -xr; xi = -xi; }
    else if constexpr (e == 48) { const float tr = xr, ti = xi; if (!INV) { xr = -ti; xi = tr; } else { xr = ti; xi = -tr; } }
    else {
        constexpr float c = C64T[e], sn = C64T[(e + 48) & 63], wi = INV ? sn : -sn;
        constexpr unsigned cb = __builtin_bit_cast(unsigned, c), wb = __builtin_bit_cast(unsigned, wi), nwb = wb ^ 0x80000000u;
        const float tr = xr, ti = xi; float a, b;
        asm("v_mul_f32 %0, %1, %2" : "=v"(a) : "i"(cb), "v"(tr));
        asm("v_fmac_f32 %0, %1, %2" : "+v"(a) : "i"(nwb), "v"(ti));
        asm("v_mul_f32 %0, %1, %2" : "=v"(b) : "i"(wb), "v"(tr));
        asm("v_fmac_f32 %0, %1, %2" : "+v"(b) : "i"(cb), "v"(ti));
        xr = a; xi = b;
    }
}
#define SFOR(N, I, ...) static_for<N>([&](auto I##_) __attribute__((always_inline)) { constexpr int I = decltype(I##_)::value; __VA_ARGS__ })
template <bool INV> __device__ __forceinline__ void dft64(float (&re)[64], float (&im)[64]) {
    if constexpr (!INV) {
        SFOR(16, bc, r4<false>(re[bc], im[bc], re[bc + 16], im[bc + 16], re[bc + 32], im[bc + 32], re[bc + 48], im[bc + 48]););
        SFOR(48, i, constexpr int p = 1 + i / 16; constexpr int bc = i % 16; twc<false, bc * p>(re[16 * p + bc], im[16 * p + bc]););
        __builtin_amdgcn_sched_barrier(0);
        SFOR(16, i, constexpr int s = 16 * (i / 4) + (i % 4); r4<false>(re[s], im[s], re[s + 4], im[s + 4], re[s + 8], im[s + 8], re[s + 12], im[s + 12]););
        SFOR(64, i, constexpr int q = (i >> 2) & 3; constexpr int c = i & 3; twc<false, 4 * c * q>(re[i], im[i]););
        __builtin_amdgcn_sched_barrier(0);
        SFOR(16, pq, constexpr int s = 4 * pq; r4<false>(re[s], im[s], re[s + 1], im[s + 1], re[s + 2], im[s + 2], re[s + 3], im[s + 3]););
    } else {
        SFOR(16, pq, constexpr int s = 4 * pq; r4<true>(re[s], im[s], re[s + 1], im[s + 1], re[s + 2], im[s + 2], re[s + 3], im[s + 3]););
        SFOR(64, i, constexpr int q = (i >> 2) & 3; constexpr int c = i & 3; twc<true, 4 * c * q>(re[i], im[i]););
        __builtin_amdgcn_sched_barrier(0);
        SFOR(16, i, constexpr int s = 16 * (i / 4) + (i % 4); r4<true>(re[s], im[s], re[s + 4], im[s + 4], re[s + 8], im[s + 8], re[s + 12], im[s + 12]););
        SFOR(48, i, constexpr int p = 1 + i / 16; constexpr int bc = i % 16; twc<true, bc * p>(re[16 * p + bc], im[16 * p + bc]););
        __builtin_amdgcn_sched_barrier(0);
        SFOR(16, bc, r4<true>(re[bc], im[bc], re[bc + 16], im[bc + 16], re[bc + 32], im[bc + 32], re[bc + 48], im[bc + 48]););
    }
    __builtin_amdgcn_sched_barrier(0);
}
__device__ __forceinline__ void wtrans(float (&v)[64], LAS float* wx, int lane) {
#pragma unroll
    for (int i = 0; i < 32; ++i) { const auto r = __builtin_amdgcn_permlane32_swap(__float_as_uint(v[i]), __float_as_uint(v[32 + i]), false, false); v[i] = __uint_as_float(r[0]); v[32 + i] = __uint_as_float(r[1]); }
    __builtin_amdgcn_sched_barrier(0);
    const int rd = (lane & 31) * 68 + (lane >> 5) * 32;
#pragma unroll
    for (int step = 0; step < 2; ++step) {
        asm volatile("" ::: "memory");
#pragma unroll
        for (int i = 0; i < 32; ++i) wx[i * 68 + lane] = v[32 * step + i];
        asm volatile("" ::: "memory");
#pragma unroll
        for (int i4 = 0; i4 < 8; ++i4) { const f32x4 q = *(const LAS f32x4*)(wx + rd + 4 * i4);
#pragma unroll
            for (int e = 0; e < 4; ++e) v[32 * step + 4 * i4 + e] = q[e]; }
        asm volatile("" ::: "memory");
    }
}
__device__ __forceinline__ void wfft_fwd(float (&re)[64], float (&im)[64], LAS float* wx, int lane) {
    dft64<false>(re, im);
    { float f = (float)lane * (1.0f / 4096.0f); asm volatile("" : "+v"(f));
#pragma unroll
      for (int s = 1; s < 64; ++s) { const float a = (float)rev6(s) * f; const float c = __builtin_amdgcn_cosf(a), sn = __builtin_amdgcn_sinf(a);
          const float tr = re[s] * c + im[s] * sn, ti = im[s] * c - re[s] * sn; re[s] = tr; im[s] = ti; if ((s & 7) == 7) __builtin_amdgcn_sched_barrier(0); } }
    __builtin_amdgcn_sched_barrier(0);
    wtrans(re, wx, lane); wtrans(im, wx, lane);
    __builtin_amdgcn_sched_barrier(0);
    dft64<false>(re, im);
}
__device__ __forceinline__ void wfft_inv(float (&re)[64], float (&im)[64], LAS float* wx, int lane) {
    dft64<true>(re, im);
    { float f = (float)rev6(lane) * (1.0f / 4096.0f); asm volatile("" : "+v"(f));
#pragma unroll
      for (int s = 1; s < 64; ++s) { const float a = (float)s * f; const float c = __builtin_amdgcn_cosf(a), sn = __builtin_amdgcn_sinf(a);
          const float tr = re[s] * c - im[s] * sn, ti = im[s] * c + re[s] * sn; re[s] = tr; im[s] = ti; if ((s & 7) == 7) __builtin_amdgcn_sched_barrier(0); } }
    __builtin_amdgcn_sched_barrier(0);
    wtrans(re, wx, lane); wtrans(im, wx, lane);
    __builtin_amdgcn_sched_barrier(0);
    dft64<true>(re, im);
}
struct Stage2 { v4u a[4], b[4]; };
__device__ __forceinline__ void hy_load2a(Stage2& S, const bf16* row0, int lane) {
#pragma unroll
    for (int i = 0; i < 4; ++i) { const int q = lane + 64 * i; S.a[i] = *(const GAS v4u*)(row0 + 8 * q); }
}
__device__ __forceinline__ void hy_load2b(Stage2& S, const bf16* row0, int lane) {
#pragma unroll
    for (int i = 0; i < 4; ++i) { const int q = lane + 64 * i; S.b[i] = *(const GAS v4u*)(row0 + SEQ + 8 * q); }
}
__device__ __forceinline__ void hy_load2(Stage2& S, const bf16* row0, int lane) { hy_load2a(S, row0, lane); hy_load2b(S, row0, lane); }
__device__ __forceinline__ void hy_commit2(const Stage2& S, LAS unsigned char* wxb, int lane) {
    asm volatile("" ::: "memory");
#pragma unroll
    for (int i = 0; i < 4; ++i) { const int q = lane + 64 * i; *(LAS v4u*)(wxb + 16 + 16 * q) = S.a[i]; *(LAS v4u*)(wxb + HY_RAWROW + 16 + 16 * q) = S.b[i]; }
    if (lane < 4) { LAS unsigned short* row = (LAS unsigned short*)(wxb + (lane >> 1) * HY_RAWROW); row[(lane & 1) ? 8 + SEQ : 7] = 0; }
    asm volatile("" ::: "memory");
}
__device__ __forceinline__ float raw2(LAS unsigned char* wxb, int r, int t) { return bf2f(*(const LAS unsigned short*)(wxb + r * HY_RAWROW + 16 + 2 * t)); }
__device__ __forceinline__ unsigned hilo_pack(float x0, float x1, unsigned& lo) {
    const unsigned h0 = f2bf(x0), h1 = f2bf(x1); lo = f2bf(x0 - __uint_as_float(h0 << 16)) | (f2bf(x1 - __uint_as_float(h1 << 16)) << 16); return h0 | (h1 << 16);
}
__device__ __forceinline__ void hy_filter_gen4(Frame& F, int l, int c0, LAS unsigned char* kf0, float* tap2, LAS float* red) {
    int lane_ = F.lane; asm volatile("" : "+v"(lane_)); const int lane = lane_; const int fr = lane & 15, fq = lane >> 4, w = F.wave;
    const float* dec = F.inp(21) + (size_t)l * HYF;
    const bf16* H2H = (const bf16*)(F.ws + WS_H2 + (size_t)l * 512 * 1024); const bf16* H2L = H2H + SEQ * HYN;
    bf16x8 ah[2], al[2];
    { const int ch = c0 + (F.G) * (fr >> 2), f4 = fr & 3, col = (f4 >> 1) * 2 * HYW + (f4 & 1) * HYW + ch;
      const bf16* whi = (const bf16*)(F.ws + WS_W3T + (size_t)l * MiB) + (size_t)col * HYN; const bf16* wlo = whi + (size_t)HYF * HYN;
#pragma unroll
      for (int ks = 0; ks < 2; ++ks) { ah[ks] = *(const GAS bf16x8*)(whi + 32 * ks + 8 * fq); al[ks] = *(const GAS bf16x8*)(wlo + 32 * ks + 8 * fq); } }
    float dk[4];
#pragma unroll
    for (int r = 0; r < 4; ++r) dk[r] = fabsf(((const GAS float*)dec)[(r >> 1) * 2 * HYW + (r & 1) * HYW + c0 + F.G * fq]);
    LAS float* stg = (LAS float*)(kf0 + (fq & 1) * HY_KFCH); float* tg = tap2 + (size_t)(fq & 1) * 4 * SEQ;
    float ss0 = 0.f, ss1 = 0.f;
#pragma unroll 1
    for (int tb = 0; tb < 2; ++tb) {
        bf16x8 bh[8][2], bl[8][2];
#pragma unroll
        for (int u = 0; u < 8; ++u)
#pragma unroll
            for (int ks = 0; ks < 2; ++ks) { const size_t off = (size_t)(256 * w + 128 * tb + 16 * u + fr) * HYN + 32 * ks + 8 * fq; bh[u][ks] = *(const GAS bf16x8*)(H2H + off); bl[u][ks] = *(const GAS bf16x8*)(H2L + off); }
#pragma unroll
        for (int u = 0; u < 8; ++u) { const int t = 256 * w + 128 * tb + 16 * u + fr; f32x4 acc = {0.f, 0.f, 0.f, 0.f};
#pragma unroll
            for (int ks = 0; ks < 2; ++ks) { acc = __builtin_amdgcn_mfma_f32_16x16x32_bf16(ah[ks], bh[u][ks], acc, 0, 0, 0); acc = __builtin_amdgcn_mfma_f32_16x16x32_bf16(ah[ks], bl[u][ks], acc, 0, 0, 0); acc = __builtin_amdgcn_mfma_f32_16x16x32_bf16(al[ks], bh[u][ks], acc, 0, 0, 0); }
            const float tn = (float)t * (1.0f / (float)(SEQ - 1));
#pragma unroll
            for (int r = 0; r < 4; ++r) { const float v = acc[r] * (__expf(-tn * dk[r]) + 0.05f);
                if (fq < 2) stg[r * SEQ + t] = v; else ((GAS float*)tg)[(size_t)r * SEQ + t] = v;
                const float sq = ((r & 1) && t == 0) ? 0.f : v * v; if (r < 2) ss0 += sq; else ss1 += sq; } }
    }
#pragma unroll
    for (int o = 1; o < 16; o <<= 1) { ss0 += __shfl_xor(ss0, o); ss1 += __shfl_xor(ss1, o); }
    if (fr == 0) { red[2 * fq] = ss0; red[2 * fq + 1] = ss1; }
}
__device__ __forceinline__ void hy_filter_fft(Frame& F, int l, int c, LAS unsigned char* kfch, const LAS float* red4, LAS float* wx) {
    int lane_ = F.lane; asm volatile("" : "+v"(lane_)); const int lane = lane_; const LAS float* stg = (const LAS float*)kfch;
    float re[64], im[64];
#pragma unroll
    for (int n1 = 0; n1 < 32; ++n1) { re[n1] = stg[64 * n1 + lane]; im[n1] = stg[2 * SEQ + 64 * n1 + lane]; }
#pragma unroll
    for (int n1 = 32; n1 < 64; ++n1) { const int t = 64 * (64 - n1) - lane; float a = stg[SEQ + t], b = stg[3 * SEQ + t]; if (n1 == 32 && lane == 0) { a = 0.f; b = 0.f; } re[n1] = a; im[n1] = b; }
    float s0 = 0.f, s1 = 0.f;
#pragma unroll
    for (int w = 0; w < 8; ++w) { s0 += red4[8 * w]; s1 += red4[8 * w + 1]; }
    const float sc = 1.0f / 4096.0f; const float n0 = 0.5f * sc / sqrtf(s0 + 1e-6f), n1s = 0.5f * sc / sqrtf(s1 + 1e-6f);
    const float d0 = F.inp(22)[(size_t)l * 2 * HYW + c] * sc, d1 = F.inp(22)[(size_t)l * 2 * HYW + HYW + c] * sc;
    asm volatile("s_waitcnt lgkmcnt(0)" ::: "memory");
    wfft_fwd(re, im, wx, lane);
    const int k1 = rev6(lane), lc = rev6((64 - k1) & 63);
    LAS f32x2* kf0 = (LAS f32x2*)kfch + k1; LAS f32x2* kf1 = (LAS f32x2*)(kfch + HY_KFO) + k1;
#pragma unroll
    for (int k0 = 0; k0 <= 32; ++k0) { const int s = rev6(k0), sm = rev6(63 - k0), sz = rev6((64 - k0) & 63);
        float pr = __shfl(re[sm], lc), pi = __shfl(im[sm], lc); if (lane == 0) { pr = re[sz]; pi = im[sz]; }
        const float zr = re[s], zi = im[s];
        kf0[k0 * 64] = (f32x2){(zr + pr) * n0 + d0, (zi - pi) * n0};
        kf1[k0 * 64] = (f32x2){(zi + pi) * n1s + d1, -(zr - pr) * n1s}; if ((k0 & 3) == 3) __builtin_amdgcn_sched_barrier(0); }
}
__device__ __forceinline__ void hy_wave_main(Frame& F, int l, int c, int ws, LAS unsigned char* wxb, LAS unsigned char* kfch, Stage2& pre, bool dry = false) {
    int lane_ = F.lane; asm volatile("" : "+v"(lane_)); const int lane = lane_; LAS float* wx = (LAS float*)wxb;
    const size_t rowoff = (size_t)c * M + (size_t)(2 * ws) * SEQ;
    const bf16* PV = (const bf16*)(F.ws + WS_R1) + rowoff; const bf16* PX1 = (const bf16*)(F.ws + WS_R2) + rowoff; const bf16* PX2 = (const bf16*)(F.ws + WS_R3) + rowoff;
    const bf16* GH = (const bf16*)(F.ws + WS_R4) + rowoff; bf16* OUT = (bf16*)(F.ws + WS_R1) + rowoff;
    const float* cw = F.inp(13) + (size_t)l * 3 * 3 * HYW; const float* cb = F.inp(14) + (size_t)l * 3 * HYW;
    float re[64], im[64];
    hy_commit2(pre, wxb, lane);
    hy_load2a(pre, PX1, lane);
    { const float w0 = cw[c], w1 = cw[3 * HYW + c], w2 = cw[6 * HYW + c], b = cb[c];
#pragma unroll
      for (int n1 = 0; n1 < 32; ++n1) { const int t = 64 * n1 + lane;
          re[n1] = b + w0 * raw2(wxb, 0, t - 1) + w1 * raw2(wxb, 0, t) + w2 * raw2(wxb, 0, t + 1);
          im[n1] = b + w0 * raw2(wxb, 1, t - 1) + w1 * raw2(wxb, 1, t) + w2 * raw2(wxb, 1, t + 1); if ((n1 & 3) == 3) __builtin_amdgcn_sched_barrier(0); } }
#pragma unroll 1
    for (int o = 0; o < 2; ++o) {
        int lane_o = F.lane; asm volatile("" : "+v"(lane_o));
        const int lane = lane_o; const int k1 = rev6(lane);
#pragma unroll
        for (int n1 = 32; n1 < 64; ++n1) { re[n1] = 0.f; im[n1] = 0.f; }
        asm volatile("s_waitcnt lgkmcnt(0)" ::: "memory");
        wfft_fwd(re, im, wx, lane);
        { const LAS unsigned char* bd = kfch + o * HY_KFO + k1 * 8; const LAS unsigned char* bm = kfch + o * HY_KFO + ((k1 ? 0 : 64) + ((64 - k1) & 63)) * 8;
#pragma unroll
          for (int s = 0; s < 64; ++s) { const int k0 = rev6(s);
              if (k0 < 32) { const f32x2 kv = *(const LAS f32x2*)(bd + k0 * 512); const float tr = re[s] * kv.x - im[s] * kv.y, ti = re[s] * kv.y + im[s] * kv.x; re[s] = tr; im[s] = ti; }
              else { const f32x2 kv = *(const LAS f32x2*)(bm + (63 - k0) * 512); const float tr = re[s] * kv.x + im[s] * kv.y, ti = im[s] * kv.x - re[s] * kv.y; re[s] = tr; im[s] = ti; }
              if ((s & 7) == 7) __builtin_amdgcn_sched_barrier(0); } }
        __builtin_amdgcn_sched_barrier(0);
        wfft_inv(re, im, wx, lane);
        hy_load2b(pre, o == 0 ? PX1 : PX2, lane); hy_commit2(pre, wxb, lane);
        { const int xo = (o + 1) * HYW + c; const float w0 = cw[xo], w1 = cw[3 * HYW + xo], w2 = cw[6 * HYW + xo], b = cb[xo];
#pragma unroll
          for (int n1 = 0; n1 < 32; ++n1) { const int t = 64 * n1 + lane;
              const float g0 = b + w0 * raw2(wxb, 0, t - 1) + w1 * raw2(wxb, 0, t) + w2 * raw2(wxb, 0, t + 1);
              const float g1 = b + w0 * raw2(wxb, 1, t - 1) + w1 * raw2(wxb, 1, t) + w2 * raw2(wxb, 1, t + 1);
              re[n1] *= g0; im[n1] *= g1; if ((n1 & 3) == 3) __builtin_amdgcn_sched_barrier(0); } }
        hy_load2a(pre, o == 0 ? PX2 : GH, lane);
    }
    int lane_g = F.lane; asm volatile("" : "+v"(lane_g));
    hy_load2b(pre, GH, lane_g); hy_commit2(pre, wxb, lane_g);
    if (!dry)
#pragma unroll
    for (int n1 = 0; n1 < 32; ++n1) { const int t = 64 * n1 + lane_g; const float g0 = raw2(wxb, 0, t), g1 = raw2(wxb, 1, t);
        ((GAS bf16*)OUT)[t] = (bf16)f2bf(re[n1] * g0 * fast_sigmoid(g0)); ((GAS bf16*)OUT)[SEQ + t] = (bf16)f2bf(im[n1] * g1 * fast_sigmoid(g1)); if ((n1 & 3) == 3) __builtin_amdgcn_sched_barrier(0); }
    asm volatile("s_waitcnt lgkmcnt(0)" ::: "memory");
}
__device__ __forceinline__ void hy_quad(Frame& F, int l, int c0) {
    const int grp = F.wave >> 2, ws = F.wave & 3;
    LAS unsigned char* wxb = F.lds + HY_WX + F.wave * HY_WXB;
    LAS unsigned char* kf0 = F.lds + HY_KF; LAS unsigned char* kfch = kf0 + grp * HY_KFCH;
    LAS float* red = (LAS float*)(F.lds + HY_RED);
    float* tap2 = (float*)(F.ws + WS_R6) + (size_t)F.bx * 2 * 4 * SEQ;
    hy_filter_gen4(F, l, c0, kf0, tap2, red + 8 * F.wave);
    VM_WAIT(); LDS_WAIT(); __syncthreads();
#pragma unroll 1
    for (int rnd = 0; rnd < 2; ++rnd) {
        const int c = c0 + F.G * (2 * rnd + grp);
        if (rnd == 1) {
            const int t_ = F.wave * 64 + cur_lane();
#pragma unroll
            for (int i = 0; i < 8; ++i) { const int q = t_ + 512 * i;
                const v4u v = *(const GAS v4u*)(tap2 + 4 * (size_t)q); *(LAS v4u*)(kf0 + (q >> 11) * HY_KFCH + 16 * (q & 2047)) = v; }
            LDS_WAIT(); __syncthreads();
        }
        Stage2 pre;
        if (ws == 0) hy_filter_fft(F, l, c, kfch, red + 2 * (2 * rnd + grp), (LAS float*)wxb);
        hy_load2(pre, (const bf16*)(F.ws + WS_R1) + (size_t)c * M + (size_t)(2 * ws) * SEQ, F.lane);
        LDS_WAIT(); __syncthreads();
        hy_wave_main(F, l, c, ws, wxb, kfch, pre);
        LDS_WAIT(); __syncthreads();
    }
}

__device__ __forceinline__ void transpose_pass(Frame& F) {
    const bf16* src = (const bf16*)(F.ws + WS_R1); bf16* dst = (bf16*)(F.ws + WS_R2);
    LAS unsigned char* tile = F.lds + F.wave * 18432; const int lane = F.lane;
    const int gw = F.bx * NWAVES + F.wave, NGW = F.G * NWAVES;
    constexpr int NTC = HYW / 64, NTT = M / 64;
    for (int it0 = 2 * gw; it0 < NTC * NTT; it0 += 2 * NGW) {
        v4u ld[2][8];
#pragma unroll
        for (int u = 0; u < 2; ++u) { const int it = it0 + u, c0 = (it % NTC) * 64, t0 = (it / NTC) * 64;
#pragma unroll
            for (int i = 0; i < 8; ++i) { const int q = lane + 64 * i, cr = q >> 3, ch = q & 7; ld[u][i] = *(const GAS v4u*)(src + (size_t)(c0 + cr) * M + t0 + 8 * ch); } }
#pragma unroll
        for (int u = 0; u < 2; ++u)
#pragma unroll
            for (int i = 0; i < 8; ++i) { const int q = lane + 64 * i, cr = q >> 3, ch = q & 7; *(LAS v4u*)(tile + u * 9216 + cr * 144 + 16 * ch) = ld[u][i]; }
        LDS_WAIT(); asm volatile("" ::: "memory");
#pragma unroll
        for (int u = 0; u < 2; ++u) { const int it = it0 + u, c0 = (it % NTC) * 64, t0 = (it / NTC) * 64;
#pragma unroll
            for (int i = 0; i < 8; ++i) { const int q = lane + 64 * i, tr = q >> 3, ch = q & 7;
                unsigned short e[8];
#pragma unroll
                for (int kk = 0; kk < 8; ++kk) e[kk] = *(const LAS unsigned short*)(tile + u * 9216 + (8 * ch + kk) * 144 + 2 * tr);
                v4u o; o.x = e[0] | ((unsigned)e[1] << 16); o.y = e[2] | ((unsigned)e[3] << 16); o.z = e[4] | ((unsigned)e[5] << 16); o.w = e[6] | ((unsigned)e[7] << 16);
                *(GAS v4u*)(dst + (size_t)(t0 + tr) * HYW + c0 + 8 * ch) = o; } }
        LDS_WAIT(); asm volatile("" ::: "memory");
    }
}
__device__ __forceinline__ void final_norm(Frame& F) {
    const int gw = F.bx * NWAVES + F.wave, NGW = F.G * NWAVES, lane = F.lane; const GAS f32x4* wv = (const GAS f32x4*)F.inp(26) + lane;
    f32x4 w[4];
#pragma unroll
    for (int j = 0; j < 4; ++j) w[j] = wv[64 * j];
    for (int m0 = 2 * gw; m0 < M; m0 += 2 * NGW) { f32x4 v[2][4];
#pragma unroll
        for (int r = 0; r < 2; ++r) { const GAS f32x4* xr = (const GAS f32x4*)(F.out + (size_t)(m0 + r) * D) + lane;
#pragma unroll
            for (int j = 0; j < 4; ++j) v[r][j] = xr[64 * j]; }
#pragma unroll
        for (int r = 0; r < 2; ++r) { float s = 0.f; GAS f32x4* xo = (GAS f32x4*)(F.out + (size_t)(m0 + r) * D) + lane;
#pragma unroll
            for (int j = 0; j < 4; ++j) s += (v[r][j].x * v[r][j].x + v[r][j].y * v[r][j].y) + (v[r][j].z * v[r][j].z + v[r][j].w * v[r][j].w);
            const float rs = 1.0f / sqrtf(wave_sum(s) * (1.0f / D) + 1e-6f);
#pragma unroll
            for (int j = 0; j < 4; ++j) xo[64 * j] = v[r][j] * rs * w[j]; } }
}

struct EpiOutNormB {
    static constexpr bool PERM = false, AFTER_DRAIN = false;
    const float* base; float* out; const float* nw; float* ssq; const XcdBarrier* bar; int wave;
    __device__ __forceinline__ void operator()(pg8::f32x4 (&acc)[2][2][4][2], const pg8::Unit& u, int wr, int wc, int fr, int fq) const {
        using pg8::f32x4; constexpr int HALF = pg8::HALF, BM = pg8::BM;
        const int lane = (fq << 4) | fr, row0 = u.pm * BM + wr * 64 + fr, col0 = u.pn * BM + wc * 32 + 4 * fq;
#pragma unroll
        for (int ai = 0; ai < 2; ++ai)
#pragma unroll
            for (int m = 0; m < 4; ++m) { const size_t r = (size_t)(row0 + ai * HALF + m * 16); float s = 0.f;
#pragma unroll
                for (int bj = 0; bj < 2; ++bj)
#pragma unroll
                    for (int n = 0; n < 2; ++n) { const f32x4 h = *(const GAS f32x4*)(base + r * 1024 + col0 + bj * HALF + n * 16) + acc[ai][bj][m][n]; acc[ai][bj][m][n] = h;
                        s += (h[0] * h[0] + h[1] * h[1]) + (h[2] * h[2] + h[3] * h[3]); }
                s += __shfl_xor(s, 16); s += __shfl_xor(s, 32);
                if (fq == 0) ((GAS float*)ssq)[r * 16 + u.pn * 4 + wc] = s;
                asm volatile("" ::: "memory"); }
        xcd_barrier(*bar, wave);
        float mine[2];
#pragma unroll
        for (int i = 0; i < 2; ++i) { const int q = 2 * fq + i; mine[i] = pg8::rs_of(ssq, row0 + (q >> 2) * HALF + (q & 3) * 16); }
        f32x4 wv[2][2];
#pragma unroll
        for (int bj = 0; bj < 2; ++bj)
#pragma unroll
            for (int n = 0; n < 2; ++n) wv[bj][n] = *(const GAS f32x4*)(nw + col0 + bj * HALF + n * 16);
#pragma unroll
        for (int ai = 0; ai < 2; ++ai)
#pragma unroll
            for (int m = 0; m < 4; ++m) { const int q = ai * 4 + m; const float rs = __shfl(mine[q & 1], ((q >> 1) << 4) | (lane & 15)); const size_t r = (size_t)(row0 + ai * HALF + m * 16);
#pragma unroll
                for (int bj = 0; bj < 2; ++bj)
#pragma unroll
                    for (int n = 0; n < 2; ++n) *(GAS f32x4*)(out + r * 1024 + col0 + bj * HALF + n * 16) = acc[ai][bj][m][n] * rs * wv[bj][n]; }
    }
};

struct Args { const float* in[27]; float* out; unsigned char* ws; int ph_lo, ph_hi; };
__global__ void __launch_bounds__(NTHREADS, 2) mk_fwd(Args args) {
    extern __shared__ __attribute__((aligned(16))) unsigned char lds[];
    Frame F; F.lds = (LAS unsigned char*)lds; F.wave = __builtin_amdgcn_readfirstlane(threadIdx.x >> 6); F.tid = 0; F.lane = 0; F.G = gridDim.x; F.bx = blockIdx.x;
    F.out = args.out; F.ws = args.ws;
    volatile LAS unsigned* MISC = (volatile LAS unsigned*)(F.lds + LDSCTL_OFF);
    if (threadIdx.x < 64) MISC[threadIdx.x] = 0u;
    if (threadIdx.x == 64) { LAS unsigned long long* tab = (LAS unsigned long long*)(F.lds + LDSCTL_OFF + 256);
#pragma unroll
        for (int i = 0; i < 27; ++i) tab[i] = (unsigned long long)args.in[i]; }
    __syncthreads();
    XcdBarrier bar; bar.bar = (unsigned*)(F.ws + WS_CTL) + 1024; bar.x = 0; bar.st = nullptr;
    if (!MK_PER_PHASE) bar = xcd_barrier_post((unsigned*)(F.ws + WS_CTL) + 1024, MISC + 8, threadIdx.x == 0);
    const int lo = args.ph_lo, hi = args.ph_hi;
#define IN(k) (lo <= (k) && (k) < hi)
#if defined(MK_TIMING)
    unsigned long long* TS = (unsigned long long*)(F.ws + WS_CTL + 32768);
#define STAMP(k) do { if (blockIdx.x == 0 && threadIdx.x == 0) __hip_atomic_store(&TS[k], (unsigned long long)__builtin_amdgcn_s_memrealtime(), __ATOMIC_RELAXED, __HIP_MEMORY_SCOPE_AGENT); } while (0)
#else
#define STAMP(k) do { } while (0)
#endif
#define SEAM(k) do { if (IN(k) && IN((k) + 1)) xcd_barrier(bar, F.wave); STAMP((k) + 1); } while (0)
    LAS unsigned char* ring = F.lds;
    STAMP(0);
#ifndef MK_ONLY
#define MK_ONLY -1
#endif
#define ON(k) (MK_ONLY < 0 || MK_ONLY == (k))
#define FRAME_P0(Fp) Frame Fp = F; { int l_ = cur_lane(); asm volatile("" : "+v"(l_)); Fp.lane = l_; Fp.tid = F.wave * 64 + l_; Fp.ws = wsl; }
#ifndef MK_REP0
#define MK_REP0 1
#endif
#pragma unroll 1
    for (int rep0 = 0; rep0 < MK_REP0; ++rep0)
    if (ON(0) && IN(0)) { unsigned char* wsl = F.ws; FRAME_P0(Fp); p0_prologue(Fp); }
    SEAM(0);
    bool fused_final = false;
#pragma unroll 1
    for (int l = 0; l < DEPTH; ++l) {
        const int pb = 1 + 5 * l;
        unsigned char* wsl = F.ws; asm volatile("" : "+s"(wsl));
#define WSL(off) (wsl + (off))
#define OPQ(p) asm volatile("" : "+s"(p))
#define FRAME_P(Fp) Frame Fp = F; { int l_ = cur_lane(); asm volatile("" : "+v"(l_)); Fp.lane = l_; Fp.tid = F.wave * 64 + l_; Fp.ws = wsl; }
        bf16* wl = (bf16*)WSL(WS_W + (size_t)l * W_LAYER);
        bf16* X = (bf16*)WSL(WS_X); float* ssq = (float*)WSL(WS_SSQ);
        bf16 *R1 = (bf16*)WSL(WS_R1), *R2 = (bf16*)WSL(WS_R2), *R3 = (bf16*)WSL(WS_R3), *R5 = (bf16*)WSL(WS_R5), *R6 = (bf16*)WSL(WS_R6);
#ifndef MK_REP1
#define MK_REP1 1
#define MK_REP12 1
#define MK_REP3 1
#define MK_REP4 1
#endif
#pragma unroll 1
        for (int rep12 = 0; rep12 < MK_REP12; ++rep12) {
#pragma unroll 1
        for (int rep1 = 0; rep1 < MK_REP1; ++rep1)
        if (ON(1) && IN(pb)) {
            { pg8::Gemm g{wl + W_IN / 2, X, 4096, M, D, D, D}; pg8::StaticOrder S; S.init(4096, M, F.G, F.bx); pg8::EpiHT E{R1, M, ssq};
              pg8::gemm_phase<pg8::EpiHT, pg8::StaticOrder, true, true, 1024, 1024, 1024>(ring, g, S, E, F.wave); }
            OPQ(X); OPQ(wl);
            { pg8::Gemm g{X, wl + W_IN / 2 + (size_t)4096 * D, M, 1024, D, D, D}; pg8::StaticOrder S; S.init(M, 1024, F.G, F.bx); pg8::EpiRow<0> E{R5, 1024, ssq};
              pg8::gemm_phase<pg8::EpiRow<0>, pg8::StaticOrder, true, true, 1024, 1024, 1024>(ring, g, S, E, F.wave); }
        }
        SEAM(pb);
        if (IN(pb + 1)) {
#if defined(MK_S5DRY)
            if (ON(2)) { FRAME_P(Fq); for (int it = F.bx; it < BATCH * S5G; it += F.G) s5_item(Fq, l, it / S5G, it % S5G, true); }
#endif
            if (ON(2)) { FRAME_P(Fp); for (int it = F.bx; it < BATCH * S5G; it += F.G) s5_item(Fp, l, it / S5G, it % S5G); }
            if (ON(3)) { FRAME_P(Fp); if (4 * F.G == HYW) hy_quad(Fp, l, F.bx); }
        }
        if (rep12 + 1 < MK_REP12) xcd_barrier(bar, F.wave);
        }
        SEAM(pb + 1);
#pragma unroll 1
        for (int rep3 = 0; rep3 < MK_REP3; ++rep3)
        if (ON(4) && IN(pb + 2)) {
            { pg8::Gemm g{X, wl + W_IN / 2 + (size_t)5120 * D, M, 2048, D, D, D}; pg8::StaticOrder S; S.init(M, 2048, F.G, F.bx); pg8::EpiRow<1> E{R3, 2048, ssq};
              pg8::gemm_phase<pg8::EpiRow<1>, pg8::StaticOrder, true, true, 1024, 1024, 1024>(ring, g, S, E, F.wave); }
            OPQ(R5); OPQ(wl);
            { pg8::Gemm g{R5, wl + W_GLU / 2, M, S5W, S5W, 1024, S5W}; pg8::StaticOrder S; S.init(M, S5W, F.G, F.bx); pg8::EpiGLU E{R6, S5W, R5, 1024, F.inp(12) + l * S5W};
              pg8::gemm_phase<pg8::EpiGLU, pg8::StaticOrder, true, true, 512, 1024, 512>(ring, g, S, E, F.wave); }
            __syncthreads();
            { FRAME_P(Fp); transpose_pass(Fp); }
            __syncthreads();
        }
        SEAM(pb + 2);
#pragma unroll 1
        for (int rep4 = 0; rep4 < MK_REP4; ++rep4)
        if (ON(5) && IN(pb + 3)) {
            { pg8::Gemm g{R6, wl + W_BS5 / 2, M, D, S5W, S5W, S5W}; pg8::StaticOrder S; S.init(M, D, F.G, F.bx); pg8::EpiMerge<0> E{R1, D, R3, 2048, 0};
              pg8::gemm_phase<pg8::EpiMerge<0>, pg8::StaticOrder, true, true, 512, 512, 512>(ring, g, S, E, F.wave); }
            VM_WAIT(); __syncthreads();
            OPQ(R2); OPQ(wl);
            { pg8::Gemm g{R2, wl + W_BHY / 2, M, D, HYW, HYW, HYW}; pg8::StaticOrder S; S.init(M, D, F.G, F.bx); pg8::EpiMerge<1> E{R1, D, R3, 2048, 1024};
              pg8::gemm_phase<pg8::EpiMerge<1>, pg8::StaticOrder, true, true, 1024, 1024, 1024>(ring, g, S, E, F.wave); }
        }
        SEAM(pb + 3);
        if (ON(6) && IN(pb + 4)) {
            pg8::Gemm g{R1, wl + W_OUT / 2, M, D, D, D, D}; pg8::StaticOrder S; S.init(M, D, F.G, F.bx);
            if (l < DEPTH - 1 || MK_PER_PHASE || F.G * 256 != (M / 256) * D) { pg8::EpiOut E{l == 0 ? F.inp(0) : (const float*)F.out, F.out, X, ssq, l == DEPTH - 1};
                pg8::gemm_phase<pg8::EpiOut, pg8::StaticOrder, true, true, 1024, 1024, 1024>(ring, g, S, E, F.wave); }
            else { EpiOutNormB E{(const float*)F.out, F.out, F.inp(26), ssq, &bar, F.wave};
                pg8::gemm_phase<EpiOutNormB, pg8::StaticOrder, true, true, 1024, 1024, 1024>(ring, g, S, E, F.wave); fused_final = true; }
        }
        if (!fused_final) SEAM(pb + 4);
    }
    if (ON(7) && IN(11) && !fused_final) { unsigned char* wsl = F.ws; FRAME_P0(Fp); final_norm(Fp); }
#if defined(MK_TIMING)
    xcd_barrier(bar, F.wave); STAMP(12); xcd_barrier(bar, F.wave);
    { const unsigned long long a0 = __hip_atomic_load(&TS[MK_TA0], __ATOMIC_RELAXED, __HIP_MEMORY_SCOPE_AGENT), a1 = __hip_atomic_load(&TS[MK_TA1], __ATOMIC_RELAXED, __HIP_MEMORY_SCOPE_AGENT);
      const unsigned long long b0 = __hip_atomic_load(&TS[MK_TB0], __ATOMIC_RELAXED, __HIP_MEMORY_SCOPE_AGENT), b1 = __hip_atomic_load(&TS[MK_TB1], __ATOMIC_RELAXED, __HIP_MEMORY_SCOPE_AGENT);
      const float ta = (float)(a1 - a0) * 0.01f, tb = (float)(b1 - b0) * 0.01f;
      const float c = sqrtf(ta * 0.1f);
      for (size_t i = (size_t)blockIdx.x * NTHREADS + threadIdx.x; i < (size_t)M * D; i += (size_t)gridDim.x * NTHREADS) F.out[i] = (i == 0) ? tb : c; }
#endif
#undef IN
#undef SEAM
}

#if defined(MK_DEBUG_HASH)
extern "C" void kernel_launch_dbg(void* const* d_in, void* d_out, void* d_ws, hipStream_t stream, int grid);
#endif
extern "C" void kernel_launch(void* const* d_in, const int* in_sizes, int n_in, void* d_out, int out_size, void* d_ws, size_t ws_size, hipStream_t stream) {
    static int grid = 0;
    if (grid == 0) {
        if (n_in != 27 || out_size != M * D || ws_size < WS_END) { fprintf(stderr, "kernel_launch: unexpected shapes (n_in %d out %d ws %zu)\n", n_in, out_size, ws_size); grid = -1; return; }
        int dev = 0, cus = 0, per_cu = 0;
        if (hipGetDevice(&dev) != hipSuccess || hipDeviceGetAttribute(&cus, hipDeviceAttributeMultiprocessorCount, dev) != hipSuccess) { grid = -1; return; }
        if (hipFuncSetAttribute((const void*)mk_fwd, hipFuncAttributeMaxDynamicSharedMemorySize, LDS_BYTES) != hipSuccess) { fprintf(stderr, "kernel_launch: hipFuncSetAttribute failed\n"); grid = -1; return; }
        if (hipOccupancyMaxActiveBlocksPerMultiprocessor(&per_cu, (const void*)mk_fwd, NTHREADS, LDS_BYTES) != hipSuccess || per_cu < 1) fprintf(stderr, "kernel_launch: occupancy query says %d\n", per_cu);
        (void)hipGetLastError();
        grid = cus;
    }
    if (grid < 0) return;
    (void)hipMemsetAsync((char*)d_ws + WS_CTL, 0, CTL_ZERO_BYTES, stream);
    Args a{};
    for (int i = 0; i < 27; ++i) a.in[i] = (const float*)d_in[i];
    a.out = (float*)d_out; a.ws = (unsigned char*)d_ws;
#if defined(MK_DEBUG_HASH)
    kernel_launch_dbg(d_in, d_out, d_ws, stream, grid);
#elif MK_PER_PHASE
    for (int p = 0; p < NPHASE; ++p) { a.ph_lo = p; a.ph_hi = p + 1; hipLaunchKernelGGL(mk_fwd, dim3(grid), dim3(NTHREADS), LDS_BYTES, stream, a); }
#else
    a.ph_lo = 0; a.ph_hi = NPHASE; hipLaunchKernelGGL(mk_fwd, dim3(grid), dim3(NTHREADS), LDS_BYTES, stream, a);
#endif
}

#if defined(MK_DEBUG_HASH)
__global__ void dbg_hash(const unsigned* p, size_t nwords, unsigned long long* out) {
    unsigned long long s = 0; for (size_t i = (size_t)blockIdx.x * blockDim.x + threadIdx.x; i < nwords; i += (size_t)gridDim.x * blockDim.x) s += p[i];
    atomicAdd(out, s);
}
__global__ void dbg_report(const unsigned long long* h, float* out, size_t n) {
    int first = -1; for (int p = 0; p < NPHASE && first < 0; ++p) for (int r = 0; r < 4; ++r) if (h[p * 4 + r] != h[NPHASE * 4 + p * 4 + r]) { first = p; break; }
    const float c = first < 0 ? 0.f : sqrtf((float)(first + 1));
    for (size_t i = (size_t)blockIdx.x * blockDim.x + threadIdx.x; i < n; i += (size_t)gridDim.x * blockDim.x) out[i] = c;
}
extern "C" void kernel_launch_dbg(void* const* d_in, void* d_out, void* d_ws, hipStream_t stream, int grid) {
    Args a{}; for (int i = 0; i < 27; ++i) a.in[i] = (const float*)d_in[i];
    a.out = (float*)d_out; a.ws = (unsigned char*)d_ws;
    unsigned long long* H = (unsigned long long*)((char*)d_ws + 253 * MiB);
    (void)hipMemsetAsync(H, 0, 2 * NPHASE * 4 * 8, stream);
    struct Reg { size_t off, len; bool out; };
    auto regs_of = [&](int p, Reg (&r)[4]) { for (int i = 0; i < 4; ++i) r[i] = Reg{0, 0, false};
        if (p == 0) { r[0] = Reg{1 * MiB, 1 * MiB, false}; r[1] = Reg{2 * MiB, 1 * MiB + 64 * 1024, false}; r[2] = Reg{4 * MiB, 39 * MiB, false}; r[3] = Reg{43 * MiB, 33 * MiB, false}; return; }
        if (p == 11) { r[0] = Reg{0, (size_t)M * D * 4, true}; return; }
        const int q = (p - 1) % 5;
        if (q == 0) { r[0] = Reg{WS_R1, 128 * MiB, false}; r[1] = Reg{WS_R5, 32 * MiB, false}; }
        if (q == 1) { r[0] = Reg{WS_R1, 32 * MiB, false}; r[1] = Reg{WS_R5, 32 * MiB, false}; }
        if (q == 2) { r[0] = Reg{WS_R3, 64 * MiB, false}; r[1] = Reg{WS_R6, 16 * MiB, false}; r[2] = Reg{WS_R2, 32 * MiB, false}; }
        if (q == 3) { r[0] = Reg{WS_R1, 32 * MiB, false}; }
        if (q == 4) { r[0] = Reg{0, (size_t)M * D * 4, true}; r[1] = Reg{WS_X, 32 * MiB, false}; r[2] = Reg{WS_SSQ, 1 * MiB, false}; } };
    for (int run = 0; run < 2; ++run) {
        if (run == 0) (void)hipMemsetAsync((char*)d_ws + 1 * MiB, 0xAA, 251 * MiB, stream);
        (void)hipMemsetAsync((char*)d_ws + WS_CTL, 0, CTL_ZERO_BYTES, stream);
        for (int p = 0; p < NPHASE; ++p) { a.ph_lo = p; a.ph_hi = p + 1; hipLaunchKernelGGL(mk_fwd, dim3(grid), dim3(NTHREADS), LDS_BYTES, stream, a);
            Reg r[4]; regs_of(p, r);
            for (int i = 0; i < 4; ++i) if (r[i].len) hipLaunchKernelGGL(dbg_hash, dim3(1024), dim3(256), 0, stream, (const unsigned*)((r[i].out ? (char*)d_out : (char*)d_ws) + r[i].off), r[i].len / 4, H + (run * NPHASE + p) * 4 + i); }
    }
    hipLaunchKernelGGL(dbg_report, dim3(1024), dim3(256), 0, stream, H, (float*)d_out, (size_t)M * D);
}
#endif
```

```cpp
#include <hip/hip_runtime.h>
#include <cstdio>
#include <cstdint>
#include <cmath>
#include <utility>
#if defined(MK_SW_ID)
#ifndef MK_SW_BLOCK
#define MK_SW_BLOCK 37
#endif
#ifndef MK_SW_WAVE
#define MK_SW_WAVE 2
#endif
#ifndef MK_SW_REAL
#define MK_SW_REAL 0
#endif
__device__ __forceinline__ unsigned long long sw_stamp() { unsigned long long t; __builtin_amdgcn_sched_barrier(0);
    if (MK_SW_REAL) asm volatile("s_memrealtime %0\n\ts_waitcnt lgkmcnt(0)" : "=s"(t) :: "memory"); else asm volatile("s_memtime %0\n\ts_waitcnt lgkmcnt(0)" : "=s"(t) :: "memory");
    __builtin_amdgcn_sched_barrier(0); return t; }
#define SW_ON(bx, wave) ((bx) == MK_SW_BLOCK && (wave) == MK_SW_WAVE)
#define SW_BEGIN(id, on) unsigned long long sw_b_##id = 0; if ((id) == MK_SW_ID) sw_b_##id = sw_stamp();
#define SW_END(id, on, wsp) do { if ((id) == MK_SW_ID && (on)) { const unsigned long long d_ = sw_stamp() - sw_b_##id; int l_; asm volatile("v_mbcnt_lo_u32_b32 %0, -1, 0\n\tv_mbcnt_hi_u32_b32 %0, -1, %0" : "=&v"(l_)); \
    if (l_ == 0) atomicAdd((unsigned long long*)((wsp) + 48 * 1024), d_); } } while (0)
#define SW_ENDA(id, on, acc) do { if ((id) == MK_SW_ID) (acc) += (sw_stamp() - sw_b_##id) & ((on) ? ~0ull : 0ull); } while (0)
#define SW_FLUSH(on, wsp, acc) do { if (on) { int l_; asm volatile("v_mbcnt_lo_u32_b32 %0, -1, 0\n\tv_mbcnt_hi_u32_b32 %0, -1, %0" : "=&v"(l_)); if (l_ == 0) atomicAdd((unsigned long long*)((wsp) + 48 * 1024), (acc)); (acc) = 0; } } while (0)
#define SW_WSSLOT (163584 - 512 + 480)
#define SW_BEGIN_N(nm, idx) unsigned long long sw_n_##nm = 0; if ((idx) == MK_SW_ID) sw_n_##nm = sw_stamp();
#define SW_END_N(nm, idx, on, wsp) do { if ((idx) == MK_SW_ID && (on)) { const unsigned long long d_ = sw_stamp() - sw_n_##nm; int l_; asm volatile("v_mbcnt_lo_u32_b32 %0, -1, 0\n\tv_mbcnt_hi_u32_b32 %0, -1, %0" : "=&v"(l_)); if (l_ == 0) atomicAdd((unsigned long long*)((wsp) + 48 * 1024), d_); } } while (0)
#else
#define SW_ON(bx, wave) false
#define SW_BEGIN(id, on)
#define SW_END(id, on, wsp) do { } while (0)
#define SW_ENDA(id, on, acc) do { } while (0)
#define SW_FLUSH(on, wsp, acc) do { } while (0)
#define SW_BEGIN_N(nm, idx)
#define SW_END_N(nm, idx, on, wsp) do { } while (0)
#endif
namespace pg8 {
#define PG8_LAS __attribute__((address_space(3)))
typedef unsigned short bf16_t;
typedef short bf16x8 __attribute__((ext_vector_type(8)));
typedef float f32x4 __attribute__((ext_vector_type(4)));
typedef unsigned u32x4 __attribute__((ext_vector_type(4)));
constexpr int BM = 256, BK = 64, HALF = 128, HTB = HALF * BK * 2  , STAGE_BYTES = 8 * HTB, NXCD = 8, WGM = 8;

__host__ __device__ __forceinline__ int lds_byte(int r, int c) { const int st = (r >> 4) * 2 + (c >> 5), rr = r & 15, cc = c & 31, ob = rr * 64 + cc * 2; return st * 1024 + (ob ^ (((ob >> 9) & 1) << 5)); }
__host__ __device__ __forceinline__ void stage_rc(int b, int& R, int& C) { const int st = b / 1024, sb = b % 1024, swz = sb ^ (((sb >> 9) & 1) << 5); R = (st >> 1) * 16 + swz / 64; C = (st & 1) * 32 + (swz % 64) / 2; }
__host__ __device__ __forceinline__ int perm32(int rho) { const int n = rho >> 4, i = rho & 15; return 8 * (i >> 2) + 4 * n + (i & 3); }

struct Unit { int pm, pn; };
struct Gemm { const bf16_t* A; const bf16_t* Bt; int M, N, K, lda, ldb; };

struct StaticOrder {
    int nM, nN, nwg, G, c;
    __host__ __device__ void init(int M, int N, int G_, int c_) { nM = M / BM; nN = N / BM; nwg = nM * nN; G = G_; c = c_; }
    __host__ __device__ bool next(int i, Unit& u) const {
        const long L = (long)i * G + c; if (L >= nwg) return false;
        int wgid = (int)L; { const int q = nwg / NXCD, r = nwg % NXCD, xcd = wgid % NXCD, off = wgid / NXCD; wgid = (xcd < r ? xcd * (q + 1) : r * (q + 1) + (xcd - r) * q) + off; }
        const int nig = WGM * nN, gid = wgid / nig, fm = gid * WGM, gsz = (nM - fm) < WGM ? (nM - fm) : WGM;
        u.pm = fm + ((wgid % nig) % gsz); u.pn = (wgid % nig) / gsz; return true;
    }
    __device__ __forceinline__ void a_ready(const Unit&) const {}
    __device__ __forceinline__ void done(const Unit&) const {}
};

typedef unsigned u32x2 __attribute__((ext_vector_type(2)));

typedef __bf16 bf16x2_t __attribute__((ext_vector_type(2)));
typedef float f32x2_t __attribute__((ext_vector_type(2)));
__device__ __forceinline__ unsigned cvt_pk_bf16(float lo, float hi) { const f32x2_t v = {lo, hi}; const bf16x2_t b = __builtin_convertvector(v, bf16x2_t); return __builtin_bit_cast(unsigned, b); }
__device__ __forceinline__ float bf_lo(unsigned w) { return __uint_as_float(w << 16); }
__device__ __forceinline__ float bf_hi(unsigned w) { return __uint_as_float(w & 0xffff0000u); }
__device__ __forceinline__ float fast_sigmoid(float x) { return __builtin_amdgcn_rcpf(1.0f + __builtin_amdgcn_exp2f(-1.4426950408889634f * x)); }
constexpr float RMS_EPS = 1e-6f;
#define GAS_ __attribute__((address_space(1)))
__device__ __forceinline__ float rs_of(const float* ssq, int tok) {
    const GAS_ f32x4* p = (const GAS_ f32x4*)(ssq + (size_t)tok * 16); const f32x4 a = p[0], b = p[1], c = p[2], d = p[3];
    const float s = ((a[0] + a[1]) + (a[2] + a[3])) + ((b[0] + b[1]) + (b[2] + b[3])) + ((c[0] + c[1]) + (c[2] + c[3])) + ((d[0] + d[1]) + (d[2] + d[3]));
    return 1.0f / sqrtf(s * (1.0f / 1024.0f) + RMS_EPS);
}
struct EpiHT {
    static constexpr bool PERM = true, AFTER_DRAIN = false; static constexpr int SWID = 0;
    bf16_t* O; int ldc; const float* ssq;
    __device__ __forceinline__ void operator()(const f32x4 (&acc)[2][2][4][2], const Unit& u, int wr, int wc, int fr, int fq) const {
        const int lane = (fq << 4) | fr;
        const int ctile = u.pn * BM + wc * 32 + 8 * fq;
        const float mine = rs_of(ssq, ctile + 128 * (fr >> 3) + (fr & 7));
        const int row0 = u.pm * BM + wr * 64 + fr;
#pragma unroll
        for (int bj = 0; bj < 2; ++bj) { float rsv[8];
#pragma unroll
            for (int i = 0; i < 8; ++i) rsv[i] = __shfl(mine, (lane & 48) | (8 * bj + i));
#pragma unroll
            for (int ai = 0; ai < 2; ++ai)
#pragma unroll
                for (int m = 0; m < 4; ++m) { bf16_t* rowp = O + (size_t)(row0 + ai * HALF + m * 16) * ldc + ctile + bj * HALF;
                    const f32x4 v0 = acc[ai][bj][m][0], v1 = acc[ai][bj][m][1]; u32x4 w;
                    w.x = cvt_pk_bf16(v0[0] * rsv[0], v0[1] * rsv[1]); w.y = cvt_pk_bf16(v0[2] * rsv[2], v0[3] * rsv[3]);
                    w.z = cvt_pk_bf16(v1[0] * rsv[4], v1[1] * rsv[5]); w.w = cvt_pk_bf16(v1[2] * rsv[6], v1[3] * rsv[7]);
                    *(GAS_ u32x4*)rowp = w; }
            asm volatile("" ::: "memory"); }
    }
};
template <int SIG> struct EpiRow {
    static constexpr bool PERM = true, AFTER_DRAIN = false; static constexpr int SWID = 1;
    bf16_t* O; int ldc; const float* ssq;
    __device__ __forceinline__ void operator()(const f32x4 (&acc)[2][2][4][2], const Unit& u, int wr, int wc, int fr, int fq) const {
        const int lane = (fq << 4) | fr;
        const int row0 = u.pm * BM + wr * 64 + fr;
        float mine[2];
#pragma unroll
        for (int i = 0; i < 2; ++i) { const int q = 2 * fq + i; mine[i] = rs_of(ssq, row0 + (q >> 2) * HALF + (q & 3) * 16); }
        const int col0 = u.pn * BM + wc * 32 + 8 * fq;
#pragma unroll
        for (int ai = 0; ai < 2; ++ai)
#pragma unroll
            for (int m = 0; m < 4; ++m) { const int q = ai * 4 + m; const float rs = __shfl(mine[q & 1], ((q >> 1) << 4) | (lane & 15));
                bf16_t* rowp = O + (size_t)(row0 + ai * HALF + m * 16) * ldc + col0;
#pragma unroll
                for (int bj = 0; bj < 2; ++bj) { f32x4 v0 = acc[ai][bj][m][0] * rs, v1 = acc[ai][bj][m][1] * rs;
                    if (SIG) {
#pragma unroll
                        for (int e = 0; e < 4; ++e) { v0[e] = fast_sigmoid(v0[e]); v1[e] = fast_sigmoid(v1[e]); } }
                    u32x4 w; w.x = cvt_pk_bf16(v0[0], v0[1]); w.y = cvt_pk_bf16(v0[2], v0[3]); w.z = cvt_pk_bf16(v1[0], v1[1]); w.w = cvt_pk_bf16(v1[2], v1[3]);
                    *(GAS_ u32x4*)(rowp + bj * HALF) = w; }
                asm volatile("" ::: "memory"); }
    }
};
struct EpiGLU {
    static constexpr bool PERM = true, AFTER_DRAIN = false; static constexpr int SWID = 2;
    bf16_t* O; int ldc; const bf16_t* YG; int ldy; const float* bglu;
    __device__ __forceinline__ void operator()(const f32x4 (&acc)[2][2][4][2], const Unit& u, int wr, int wc, int fr, int fq) const {
        const int row0 = u.pm * BM + wr * 64 + fr, col0 = u.pn * BM + wc * 32 + 8 * fq;
        f32x4 bv[2][2];
#pragma unroll
        for (int bj = 0; bj < 2; ++bj)
#pragma unroll
            for (int n = 0; n < 2; ++n) bv[bj][n] = *(const GAS_ f32x4*)(bglu + col0 + bj * HALF + 4 * n);
#pragma unroll
        for (int ai = 0; ai < 2; ++ai)
#pragma unroll
            for (int m = 0; m < 4; ++m) { const size_t r = (size_t)(row0 + ai * HALF + m * 16);
#pragma unroll
                for (int bj = 0; bj < 2; ++bj) { const int c = col0 + bj * HALF;
                    const u32x4 yv = *(const GAS_ u32x4*)(YG + r * ldy + c), gv = *(const GAS_ u32x4*)(YG + r * ldy + 512 + c);
                    const f32x4 a0 = acc[ai][bj][m][0] + bv[bj][0], a1 = acc[ai][bj][m][1] + bv[bj][1];
                    float o[8]; const unsigned yw[4] = {yv.x, yv.y, yv.z, yv.w}, gw[4] = {gv.x, gv.y, gv.z, gv.w};
#pragma unroll
                    for (int e = 0; e < 8; ++e) { const float a = e < 4 ? a0[e & 3] : a1[e & 3]; const float y = (e & 1) ? bf_hi(yw[e >> 1]) : bf_lo(yw[e >> 1]);
                        const float g = (e & 1) ? bf_hi(gw[e >> 1]) : bf_lo(gw[e >> 1]); o[e] = y * fast_sigmoid(a) * (g * fast_sigmoid(g)); }
                    u32x4 w; w.x = cvt_pk_bf16(o[0], o[1]); w.y = cvt_pk_bf16(o[2], o[3]); w.z = cvt_pk_bf16(o[4], o[5]); w.w = cvt_pk_bf16(o[6], o[7]);
                    *(GAS_ u32x4*)(O + r * ldc + c) = w; asm volatile("" ::: "memory"); } }
    }
};
template <int ADD> struct EpiMerge {
    static constexpr bool PERM = true, AFTER_DRAIN = false; static constexpr int SWID = 3;
    bf16_t* O; int ldc; const bf16_t* G; int ldg; int goff;
    __device__ __forceinline__ void operator()(const f32x4 (&acc)[2][2][4][2], const Unit& u, int wr, int wc, int fr, int fq) const {
        const int row0 = u.pm * BM + wr * 64 + fr, col0 = u.pn * BM + wc * 32 + 8 * fq;
#pragma unroll
        for (int ai = 0; ai < 2; ++ai)
#pragma unroll
            for (int mp = 0; mp < 2; ++mp) {
                u32x4 gv[2][2], tv[2][2];
#pragma unroll
                for (int mm = 0; mm < 2; ++mm)
#pragma unroll
                    for (int bj = 0; bj < 2; ++bj) { const size_t r = (size_t)(row0 + ai * HALF + (2 * mp + mm) * 16); const int c = col0 + bj * HALF;
                        gv[mm][bj] = *(const GAS_ u32x4*)(G + r * ldg + goff + c); tv[mm][bj] = (u32x4){0u, 0u, 0u, 0u}; if (ADD) tv[mm][bj] = *(const GAS_ u32x4*)(O + r * ldc + c); }
#pragma unroll
                for (int mm = 0; mm < 2; ++mm)
#pragma unroll
                    for (int bj = 0; bj < 2; ++bj) { const int m = 2 * mp + mm; const size_t r = (size_t)(row0 + ai * HALF + m * 16); const int c = col0 + bj * HALF;
                        const f32x4 a0 = acc[ai][bj][m][0], a1 = acc[ai][bj][m][1];
                        float o[8]; const unsigned gw[4] = {gv[mm][bj].x, gv[mm][bj].y, gv[mm][bj].z, gv[mm][bj].w}, tw[4] = {tv[mm][bj].x, tv[mm][bj].y, tv[mm][bj].z, tv[mm][bj].w};
#pragma unroll
                        for (int e = 0; e < 8; ++e) { const float a = e < 4 ? a0[e & 3] : a1[e & 3]; const float g = (e & 1) ? bf_hi(gw[e >> 1]) : bf_lo(gw[e >> 1]);
                            const float t = (e & 1) ? bf_hi(tw[e >> 1]) : bf_lo(tw[e >> 1]); o[e] = (ADD ? t : 0.f) + g * a; }
                        u32x4 w; w.x = cvt_pk_bf16(o[0], o[1]); w.y = cvt_pk_bf16(o[2], o[3]); w.z = cvt_pk_bf16(o[4], o[5]); w.w = cvt_pk_bf16(o[6], o[7]);
                        *(GAS_ u32x4*)(O + r * ldc + c) = w; }
                asm volatile("" ::: "memory"); }
    }
};
template <bool F32IN, bool LAST>
struct EpiOut {
    static constexpr bool PERM = false, AFTER_DRAIN = false; static constexpr int SWID = 4;
    const float* base; const bf16_t* baseb; float* H; bf16_t* XN; float* ssq;
    __device__ __forceinline__ void operator()(const f32x4 (&acc)[2][2][4][2], const Unit& u, int wr, int wc, int fr, int fq) const {
        const int row0 = u.pm * BM + wr * 64 + fr, col0 = u.pn * BM + wc * 32 + 4 * fq;
#pragma unroll
        for (int ai = 0; ai < 2; ++ai)
#pragma unroll
            for (int m = 0; m < 4; ++m) { const size_t r = (size_t)(row0 + ai * HALF + m * 16); float s = 0.f;
                f32x4 h[2][2];
#pragma unroll
                for (int bj = 0; bj < 2; ++bj)
#pragma unroll
                    for (int n = 0; n < 2; ++n) { const size_t off = r * 1024 + col0 + bj * HALF + n * 16;
                        if constexpr (F32IN) h[bj][n] = *(const GAS_ f32x4*)(base + off);
                        else { const u32x2 w = *(const GAS_ u32x2*)(baseb + off); h[bj][n][0] = __uint_as_float(w.x << 16); h[bj][n][1] = __uint_as_float(w.x & 0xffff0000u); h[bj][n][2] = __uint_as_float(w.y << 16); h[bj][n][3] = __uint_as_float(w.y & 0xffff0000u); } }
#pragma unroll
                for (int bj = 0; bj < 2; ++bj)
#pragma unroll
                    for (int n = 0; n < 2; ++n) { const size_t off = r * 1024 + col0 + bj * HALF + n * 16; const f32x4 v = h[bj][n] + acc[ai][bj][m][n];
                        s += (v[0] * v[0] + v[1] * v[1]) + (v[2] * v[2] + v[3] * v[3]);
                        if constexpr (!LAST) { u32x2 w; w.x = cvt_pk_bf16(v[0], v[1]); w.y = cvt_pk_bf16(v[2], v[3]); *(GAS_ u32x2*)(XN + off) = w; }
                        else *(GAS_ f32x4*)(H + off) = v; }
                if constexpr (!LAST) { s += __shfl_xor(s, 16); s += __shfl_xor(s, 32);
                    if (fq == 0) ((GAS_ float*)ssq)[r * 16 + u.pn * 4 + wc] = s; } }
    }
};
template <class Epi, class Sched, bool ALIGN_EPI, bool SP2, int KK, int LDA, int LDB>
__device__ __forceinline__ void gemm_phase(PG8_LAS unsigned char* lds, const Gemm g, const Sched& S, const Epi& E, int wave_id  ) {
    int lane_; asm volatile("v_mbcnt_lo_u32_b32 %0, -1, 0\n\tv_mbcnt_hi_u32_b32 %0, -1, %0" : "=&v"(lane_)); const int tid_ = wave_id * 64 + lane_;
    const int tid = tid_, wid = __builtin_amdgcn_readfirstlane(tid >> 6), lane = tid & 63, wr = wid >> 2, wc = wid & 3, fr = lane & 15, fq = lane >> 4;
    constexpr int K = KK, nt = K / BK;
    unsigned voffA[2], voffB[2];
#pragma unroll
    for (int i = 0; i < 2; ++i) { int R, C; stage_rc(tid * 16 + i * 8192, R, C); const int Rb = Epi::PERM ? ((R & ~31) + perm32(R & 31)) : R;
        voffA[i] = (unsigned)(R * LDA + C) * 2u; voffB[i] = (unsigned)(Rb * LDB + C) * 2u; }
    constexpr size_t kstep = (size_t)(BK * 2);
    constexpr size_t hstepA = (size_t)HALF * LDA * 2, hstepB = (size_t)HALF * LDB * 2;
    constexpr size_t tstepA = 2 * hstepA, tstepB = 2 * hstepB;
    const unsigned ldsw = (unsigned)wid * 1024u;
    const int aoff = lds_byte(wr * 64 + fr, fq * 8), boff = lds_byte(wc * 32 + fr, fq * 8);
#define PG8_SA(b, h) (((b) * 2 + (h)) * HTB)
#define PG8_SB(b, h) ((4 + (b) * 2 + (h)) * HTB)
#define PG8_STAGE(bufoff, gbase, voff) do { _Pragma("unroll") for (int _i = 0; _i < 2; ++_i) \
        __builtin_amdgcn_global_load_lds((const unsigned*)((const char*)(gbase) + (voff)[_i]), (PG8_LAS unsigned*)(lds + (bufoff) + ldsw + _i * 8192), 16, 0, 0); } while (0)
#define PG8_LDA(dst, b, h) do { _Pragma("unroll") for (int m = 0; m < 4; ++m) _Pragma("unroll") for (int k = 0; k < 2; ++k) dst[m][k] = *(const PG8_LAS bf16x8*)(lds + PG8_SA(b, h) + aoff + m * 2048 + k * 1024); } while (0)
#define PG8_LDB(dst, b, h) do { _Pragma("unroll") for (int n = 0; n < 2; ++n) _Pragma("unroll") for (int k = 0; k < 2; ++k) dst[n][k] = *(const PG8_LAS bf16x8*)(lds + PG8_SB(b, h) + boff + n * 2048 + k * 1024); } while (0)
#define PG8_MMA(ai, bj, At, Bt) do { __builtin_amdgcn_s_setprio(1); _Pragma("unroll") for (int m = 0; m < 4; ++m) _Pragma("unroll") for (int n = 0; n < 2; ++n) _Pragma("unroll") for (int k = 0; k < 2; ++k) \
        acc[ai][bj][m][n] = __builtin_amdgcn_mfma_f32_16x16x32_bf16(Bt[n][k], At[m][k], acc[ai][bj][m][n], 0, 0, 0); __builtin_amdgcn_s_setprio(0); } while (0)
#define PG8_WAIT_V(n) asm volatile("s_waitcnt vmcnt(" #n ")" ::: "memory")
#define PG8_WAIT_L(n) asm volatile("s_waitcnt lgkmcnt(" #n ")" ::: "memory")
#define PG8_BAR __builtin_amdgcn_s_barrier()
#define PG8_SCHED __builtin_amdgcn_sched_barrier(0)
    Unit cur, nxt; int ui = 0;
    if (!S.next(0, cur)) return;
    f32x4 acc[2][2][4][2];
#pragma unroll
    for (int a = 0; a < 2; ++a)
#pragma unroll
        for (int b = 0; b < 2; ++b)
#pragma unroll
            for (int m = 0; m < 4; ++m)
#pragma unroll
                for (int n = 0; n < 2; ++n) acc[a][b][m][n] = (f32x4){0.f, 0.f, 0.f, 0.f};
    bf16x8 At[4][2], B0[2][2], B1[2][2];
    const char* cA = (const char*)g.A + (size_t)cur.pm * tstepA; const char* cB = (const char*)g.Bt + (size_t)cur.pn * tstepB;
    S.a_ready(cur);
    if constexpr (SP2) {
        PG8_STAGE(PG8_SB(0, 0), cB, voffB); PG8_STAGE(PG8_SB(0, 1), cB + hstepB, voffB); PG8_STAGE(PG8_SA(0, 0), cA, voffA); PG8_STAGE(PG8_SA(0, 1), cA + hstepA, voffA);
        if (wr == 1) PG8_BAR;
        PG8_WAIT_V(2); PG8_BAR;
        PG8_STAGE(PG8_SB(1, 0), cB + kstep, voffB); PG8_STAGE(PG8_SA(1, 0), cA + kstep, voffA); PG8_STAGE(PG8_SB(1, 1), cB + hstepB + kstep, voffB);
        PG8_WAIT_V(6); PG8_BAR;
    } else {
        PG8_STAGE(PG8_SB(0, 0), cB, voffB); PG8_STAGE(PG8_SA(0, 0), cA, voffA); PG8_STAGE(PG8_SB(0, 1), cB + hstepB, voffB); PG8_STAGE(PG8_SA(0, 1), cA + hstepA, voffA);
        if (wr == 1) PG8_BAR;
        PG8_WAIT_V(4); PG8_BAR;
        PG8_STAGE(PG8_SB(1, 0), cB + kstep, voffB); PG8_STAGE(PG8_SA(1, 0), cA + kstep, voffA); PG8_STAGE(PG8_SB(1, 1), cB + hstepB + kstep, voffB);
        PG8_WAIT_V(6); PG8_BAR;
    }
#if defined(MK_SW_ID)
    unsigned char* sw_ws = (unsigned char*)(*(const PG8_LAS unsigned long long*)(lds + SW_WSSLOT)); const bool sw_on = SW_ON((int)blockIdx.x, wid);
#endif
    for (;;) {
        const bool has_next = S.next(ui + 1, nxt);
        SW_BEGIN_N(kl, 100 + Epi::SWID)
        const char* nA = has_next ? (const char*)g.A + (size_t)nxt.pm * tstepA : cA; const char* nB = has_next ? (const char*)g.Bt + (size_t)nxt.pn * tstepB : cB;
        for (int t = 0; t < nt; t += 2) {
            const bool last = (t == nt - 2);
            const char* a1 = cA + (size_t)(t + 1) * kstep;
            const char* a2 = last ? nA : cA + (size_t)(t + 2) * kstep; const char* b2 = last ? nB : cB + (size_t)(t + 2) * kstep;
            const char* a3 = a2 + kstep; const char* b3 = b2 + kstep;
            if (last && has_next) S.a_ready(nxt);
            if constexpr (SP2) {
            PG8_LDB(B0, 0, 0); PG8_LDB(B1, 0, 1); PG8_SCHED; PG8_LDA(At, 0, 0); PG8_STAGE(PG8_SA(1, 1), a1 + hstepA, voffA);
            PG8_WAIT_V(8); PG8_WAIT_L(0); PG8_BAR; PG8_MMA(0, 0, At, B0); PG8_MMA(0, 1, At, B1); PG8_BAR; PG8_SCHED;
            PG8_LDA(At, 0, 1); PG8_STAGE(PG8_SB(0, 0), b2, voffB); PG8_STAGE(PG8_SB(0, 1), b2 + hstepB, voffB); PG8_STAGE(PG8_SA(0, 0), a2, voffA);
            PG8_WAIT_V(8); PG8_WAIT_L(0); PG8_BAR; PG8_MMA(1, 0, At, B0); PG8_MMA(1, 1, At, B1); PG8_BAR; PG8_SCHED;
            PG8_LDB(B0, 1, 0); PG8_LDB(B1, 1, 1); PG8_SCHED; PG8_LDA(At, 1, 0); PG8_STAGE(PG8_SA(0, 1), a2 + hstepA, voffA);
            PG8_WAIT_V(8); PG8_WAIT_L(0); PG8_BAR; PG8_MMA(0, 0, At, B0); PG8_MMA(0, 1, At, B1); PG8_BAR; PG8_SCHED;
            PG8_LDA(At, 1, 1); PG8_STAGE(PG8_SB(1, 0), b3, voffB); PG8_STAGE(PG8_SB(1, 1), b3 + hstepB, voffB); PG8_STAGE(PG8_SA(1, 0), a3, voffA);
            PG8_WAIT_V(8); PG8_WAIT_L(0); PG8_BAR; PG8_MMA(1, 0, At, B0); PG8_MMA(1, 1, At, B1); PG8_BAR; PG8_SCHED;
            } else {
            PG8_LDB(B0, 0, 0); PG8_SCHED; PG8_LDA(At, 0, 0); PG8_STAGE(PG8_SA(1, 1), a1 + hstepA, voffA);
            PG8_WAIT_L(8); PG8_BAR; PG8_WAIT_L(0); PG8_MMA(0, 0, At, B0); PG8_BAR; PG8_SCHED;
            PG8_LDB(B1, 0, 1); PG8_STAGE(PG8_SB(0, 0), b2, voffB);
            PG8_BAR; PG8_WAIT_L(0); PG8_MMA(0, 1, At, B1); PG8_BAR;
            PG8_LDA(At, 0, 1); PG8_STAGE(PG8_SA(0, 0), a2, voffA);
            PG8_BAR; PG8_WAIT_L(0); PG8_MMA(1, 0, At, B0); PG8_BAR; PG8_SCHED;
            PG8_STAGE(PG8_SB(0, 1), b2 + hstepB, voffB);
            PG8_WAIT_V(6); PG8_BAR; PG8_MMA(1, 1, At, B1); PG8_BAR;
            PG8_LDB(B0, 1, 0); PG8_SCHED; PG8_LDA(At, 1, 0); PG8_STAGE(PG8_SA(0, 1), a2 + hstepA, voffA);
            PG8_WAIT_L(8); PG8_BAR; PG8_WAIT_L(0); PG8_MMA(0, 0, At, B0); PG8_BAR; PG8_SCHED;
            PG8_LDB(B1, 1, 1); PG8_STAGE(PG8_SB(1, 0), b3, voffB);
            PG8_BAR; PG8_WAIT_L(0); PG8_MMA(0, 1, At, B1); PG8_BAR;
            PG8_LDA(At, 1, 1); PG8_STAGE(PG8_SA(1, 0), a3, voffA);
            PG8_BAR; PG8_WAIT_L(0); PG8_MMA(1, 0, At, B0); PG8_BAR; PG8_SCHED;
            PG8_STAGE(PG8_SB(1, 1), b3 + hstepB, voffB);
            PG8_WAIT_V(6); PG8_BAR; PG8_MMA(1, 1, At, B1); PG8_BAR;
            }
        }
        SW_END_N(kl, 100 + Epi::SWID, sw_on, sw_ws);
        SW_BEGIN_N(ep, 110 + Epi::SWID)
        if constexpr (ALIGN_EPI) { if (wr == 0) PG8_BAR; }
        if constexpr (!Epi::AFTER_DRAIN) { E(acc, cur, wr, wc, fr, fq); S.done(cur); }
        SW_END_N(ep, 110 + Epi::SWID, sw_on, sw_ws);
        if (!has_next) break;
#pragma unroll
        for (int a = 0; a < 2; ++a)
#pragma unroll
            for (int b = 0; b < 2; ++b)
#pragma unroll
                for (int m = 0; m < 4; ++m)
#pragma unroll
                    for (int n = 0; n < 2; ++n) acc[a][b][m][n] = (f32x4){0.f, 0.f, 0.f, 0.f};
        cur = nxt; cA = nA; cB = nB; ++ui;
        if constexpr (ALIGN_EPI) { if (wr == 1) PG8_BAR; }
    }
    PG8_WAIT_V(0);
    if constexpr (!ALIGN_EPI) { if (wr == 0) PG8_BAR; }
    PG8_BAR;
    if constexpr (Epi::AFTER_DRAIN) { E.fused(acc, cur, wr, wc, fr, fq, lds, wid, lane); S.done(cur); }
#undef PG8_SA
#undef PG8_SB
#undef PG8_STAGE
#undef PG8_LDA
#undef PG8_LDB
#undef PG8_MMA
#undef PG8_WAIT_V
#undef PG8_WAIT_L
#undef PG8_BAR
#undef PG8_SCHED
}
}

constexpr int NWAVES = 8, NTHREADS = 512;
#ifndef MK_PER_PHASE
#define MK_PER_PHASE 0
#endif
constexpr int D = 1024, BATCH = 8, SEQ = 2048, M = BATCH * SEQ, DEPTH = 2;
constexpr int S5W = 512, S5H = 16, S5G = 32, S5P = 64;
constexpr int HYW = 1024, HYF = 4096, HYE = 33, HYN = 64;
constexpr int INC = 7168;
constexpr int NPHASE = 12;

constexpr size_t MiB = 1u << 20;
constexpr size_t WS_CTL = 0, CTL_ZERO_BYTES = 64 * 1024;
constexpr size_t WS_H2 = 1 * MiB;
constexpr size_t WS_LBAR = 2 * MiB;
constexpr size_t WS_BBT = 2 * MiB + 64 * 1024;
constexpr size_t WS_CT = WS_BBT + 512 * 1024;
constexpr size_t WS_W = 4 * MiB;
constexpr size_t W_IN = 0, W_GLU = 14 * MiB, W_BS5 = W_GLU + 512 * 1024, W_BHY = W_BS5 + 1 * MiB, W_OUT = W_BHY + 2 * MiB, W_LAYER = W_OUT + 2 * MiB;
constexpr size_t WS_SSQ = 43 * MiB;
constexpr size_t WS_X = 44 * MiB;
constexpr size_t WS_R1 = 76 * MiB, WS_R2 = 108 * MiB, WS_R3 = 140 * MiB, WS_R4 = 172 * MiB, WS_R5 = 204 * MiB, WS_R6 = 236 * MiB, WS_W3T = 252 * MiB  , WS_END = 254 * MiB;
static_assert(WS_W + 2 * W_LAYER <= WS_SSQ, "weights");
constexpr int LDS_BYTES = 163840 - 256;
constexpr int LDSCTL_OFF = LDS_BYTES - 512;

#define GAS __attribute__((address_space(1)))
#define LAS __attribute__((address_space(3)))
typedef unsigned short bf16;
typedef unsigned v4u __attribute__((ext_vector_type(4)));
typedef unsigned v2u __attribute__((ext_vector_type(2)));
typedef float f32x4 __attribute__((ext_vector_type(4)));
typedef float f32x2 __attribute__((ext_vector_type(2)));
typedef short bf16x8 __attribute__((ext_vector_type(8)));
typedef GAS unsigned gu32;
#define RLX_AGENT __ATOMIC_RELAXED, __HIP_MEMORY_SCOPE_AGENT
#define LDS_WAIT() asm volatile("s_waitcnt lgkmcnt(0)" ::: "memory")
#define VM_WAIT() asm volatile("s_waitcnt vmcnt(0)" ::: "memory")
__device__ __forceinline__ unsigned f2bf(float f) { unsigned u = __builtin_bit_cast(unsigned, f); return (u + 0x7fffu + ((u >> 16) & 1u)) >> 16; }
__device__ __forceinline__ unsigned pk2(float lo, float hi) { return f2bf(lo) | (f2bf(hi) << 16); }
__device__ __forceinline__ float bf2f(unsigned short h) { return __uint_as_float((unsigned)h << 16); }
using pg8::bf_lo; using pg8::bf_hi; using pg8::fast_sigmoid;

#define XB_TMO      128
#define XB_XCNT(j)  (256  + 64 * (j))
#define XB_XSUB(j)  (1280 + 64 * (j))
#define XB_XGEN(j)  (2304 + 64 * (j))
#define XB_TOP      3328
#define XB_TOPGEN   3392
#define XCD_BAR_WORDS 3456
#define XB_SPIN_CAP (1u << 18)
__device__ __forceinline__ unsigned xb_ld(unsigned* p)              { return __hip_atomic_load(p, __ATOMIC_RELAXED, __HIP_MEMORY_SCOPE_AGENT); }
__device__ __forceinline__ unsigned xb_add(unsigned* p, unsigned v) { return __hip_atomic_fetch_add(p, v, __ATOMIC_RELAXED, __HIP_MEMORY_SCOPE_AGENT); }
__device__ __forceinline__ unsigned xb_xcc_id() { return (unsigned)__builtin_amdgcn_s_getreg((3 << 11) | 20) & 0xFu; }
#define XB_SPIN(cond, bar) do { unsigned _sp = 0; while (cond) { __builtin_amdgcn_s_sleep(1); \
    if ((++_sp & 255u) == 0u) { if (xb_ld(&(bar)[XB_TMO])) break; if (_sp > XB_SPIN_CAP) { atomicAdd(&(bar)[XB_TMO], 1u); break; } } } } while (0)
struct XcdBarrier { unsigned* bar; unsigned x; volatile LAS unsigned* st; };
__device__ __forceinline__ int cur_lane() { int l; asm volatile("v_mbcnt_lo_u32_b32 %0, -1, 0\n\tv_mbcnt_hi_u32_b32 %0, -1, %0" : "=&v"(l)); return l; }
__device__ __forceinline__ XcdBarrier xcd_barrier_post(unsigned* bar, volatile LAS unsigned* st, bool leader) {
    XcdBarrier b; b.bar = bar; b.x = xb_xcc_id(); b.st = st;
    if (leader) (void)xb_add(&bar[XB_XCNT(b.x)], 1u);
    return b;
}
__device__ __forceinline__ void xcd_barrier_complete(unsigned* bar, unsigned x, unsigned& nloc, unsigned& nx) {
    const unsigned G = gridDim.x * gridDim.y * gridDim.z;
    unsigned sum, cnt, mine, sp = 0u;
    for (;;) {
        sum = 0u; cnt = 0u; mine = 0u;
#pragma unroll
        for (unsigned j = 0; j < 16; ++j) { const unsigned c = xb_ld(&bar[XB_XCNT(j)]); sum += c; cnt += (c > 0u) ? 1u : 0u; mine = (j == x) ? c : mine; }
        if (sum == G) break;
        __builtin_amdgcn_s_sleep(1);
        if ((++sp & 255u) == 0u) { if (xb_ld(&bar[XB_TMO])) break; if (sp > XB_SPIN_CAP) { atomicAdd(&bar[XB_TMO], 1u); break; } }
    }
    nloc = mine > 0u ? mine : 1u; nx = cnt > 0u ? cnt : 1u;
}
__device__ __forceinline__ void xcd_barrier(const XcdBarrier& b, int wave_id) {
    asm volatile("s_waitcnt vmcnt(0)" ::: "memory");
    __syncthreads();
    if (wave_id == 0 && cur_lane() == 0) {
        unsigned* bar = b.bar; asm volatile("" : "+s"(bar));
        __builtin_amdgcn_s_waitcnt(0);
        unsigned nloc = b.st[0], nx = b.st[1];
        if (nloc == 0u) { xcd_barrier_complete(bar, b.x, nloc, nx); b.st[0] = nloc; b.st[1] = nx; }
        const unsigned old = xb_add(&bar[XB_XSUB(b.x)], 1u);
        const unsigned gen = old / nloc;
        if (old + 1u == (gen + 1u) * nloc) {
            __builtin_amdgcn_fence(__ATOMIC_RELEASE, "agent");
            asm volatile("s_waitcnt vmcnt(0)" ::: "memory");
            const unsigned og = xb_add(&bar[XB_TOP], 1u);
            const unsigned tg = og / nx;
            if (og + 1u == (tg + 1u) * nx) xb_add(&bar[XB_TOPGEN], 1u);
            else XB_SPIN(xb_ld(&bar[XB_TOPGEN]) == tg, bar);
            __builtin_amdgcn_fence(__ATOMIC_ACQUIRE, "agent");
            xb_add(&bar[XB_XGEN(b.x)], 1u);
            asm volatile("s_waitcnt vmcnt(0)" ::: "memory");
        } else {
            XB_SPIN(xb_ld(&bar[XB_XGEN(b.x)]) == gen, bar);
            __builtin_amdgcn_fence(__ATOMIC_ACQUIRE, "agent");
            asm volatile("s_waitcnt vmcnt(0)" ::: "memory");
        }
    }
    __syncthreads();
}

struct Frame {
    LAS unsigned char* lds;
    int tid, lane, wave, G, bx;
    float* out; unsigned char* ws; unsigned long long swacc = 0;
    __device__ __forceinline__ const float* inp(int i) const {
        const LAS unsigned* t = (const LAS unsigned*)(lds + LDSCTL_OFF + 256) + 2 * i;
        const unsigned lo = __builtin_amdgcn_readfirstlane(t[0]), hi = __builtin_amdgcn_readfirstlane(t[1]);
        return (const float*)(((unsigned long long)hi << 32) | lo);
    }
};
__device__ __forceinline__ float wave_sum(float v) {
#pragma unroll
    for (int o = 1; o < 64; o <<= 1) v += __shfl_xor(v, o);
    return v;
}

__device__ __forceinline__ void p0_transpose_item(const float* W, int K, int N, bf16* WT, int k0, int n0, int drow, const float* kscale, LAS float* scr, int lane, bf16* WTlo = nullptr) {
    const int lr = lane >> 4, lc = (lane & 15) * 4;
    f32x4 v[16];
#pragma unroll
    for (int i = 0; i < 16; ++i) v[i] = *(const GAS f32x4*)(W + (size_t)(k0 + 4 * i + lr) * N + n0 + lc);
#pragma unroll
    for (int i = 0; i < 16; ++i) { const int kk = 4 * i + lr; f32x4 x = v[i]; if (kscale) x = x * kscale[k0 + kk];
        LAS float* d = scr + kk * 65 + lc; d[0] = x[0]; d[1] = x[1]; d[2] = x[2]; d[3] = x[3]; }
    LDS_WAIT(); asm volatile("" ::: "memory");
    const int c = lane & 7;
#pragma unroll
    for (int j = 0; j < 8; ++j) { const int n = (lane >> 3) + 8 * j; const LAS float* s = scr + (8 * c) * 65 + n;
        v4u o; o.x = pk2(s[0 * 65], s[1 * 65]); o.y = pk2(s[2 * 65], s[3 * 65]); o.z = pk2(s[4 * 65], s[5 * 65]); o.w = pk2(s[6 * 65], s[7 * 65]);
        *(GAS v4u*)(WT + (size_t)(drow + n) * K + k0 + 8 * c) = o;
        if (WTlo) { v4u q;
#define P0_LO2(a, b, hw) pk2((a) - __uint_as_float((hw) << 16), (b) - __uint_as_float((hw) & 0xffff0000u))
            q.x = P0_LO2(s[0 * 65], s[1 * 65], o.x); q.y = P0_LO2(s[2 * 65], s[3 * 65], o.y); q.z = P0_LO2(s[4 * 65], s[5 * 65], o.z); q.w = P0_LO2(s[6 * 65], s[7 * 65], o.w);
#undef P0_LO2
            *(GAS v4u*)(WTlo + (size_t)(drow + n) * K + k0 + 8 * c) = q; } }
    LDS_WAIT(); asm volatile("" ::: "memory");
}
__device__ __forceinline__ void p0_prologue(Frame& F) {
    LAS float* scr = (LAS float*)(F.lds + F.wave * 17408);
    const int gw = F.bx * NWAVES + F.wave, NGW = F.G * NWAVES, lane = F.lane;
    constexpr int I_IN = (D / 64) * (INC / 64), I_GLU = (S5W / 64) * (S5W / 64), I_BS5 = (S5W / 64) * (D / 64), I_BHY = (HYW / 64) * (D / 64), I_OUT = (D / 64) * (D / 64);
    constexpr int I_LAYER = I_IN + I_GLU + I_BS5 + I_BHY + I_OUT;
    for (int it = gw; it < DEPTH * I_LAYER; it += NGW) {
        const int l = it / I_LAYER; int r = it % I_LAYER; bf16* wl = (bf16*)(F.ws + WS_W + (size_t)l * W_LAYER);
        if (r < I_IN) { const int nblk = INC / 64, kb = r / nblk, nb = r % nblk, n0 = nb * 64;
            const int drow = (n0 >= 1024 && n0 < 5120) ? n0 - 1024 : (n0 < 1024 ? n0 + 4096 : n0);
            p0_transpose_item(F.inp(2) + (size_t)l * D * INC, D, INC, wl + W_IN / 2, kb * 64, n0, drow, F.inp(1) + l * D, scr, lane); continue; } r -= I_IN;
        if (r < I_GLU) { const int nblk = S5W / 64; p0_transpose_item(F.inp(11) + (size_t)l * S5W * S5W, S5W, S5W, wl + W_GLU / 2, (r / nblk) * 64, (r % nblk) * 64, (r % nblk) * 64, nullptr, scr, lane); continue; } r -= I_GLU;
        if (r < I_BS5) { const int nblk = D / 64; p0_transpose_item(F.inp(23) + (size_t)l * S5W * D, S5W, D, wl + W_BS5 / 2, (r / nblk) * 64, (r % nblk) * 64, (r % nblk) * 64, nullptr, scr, lane); continue; } r -= I_BS5;
        if (r < I_BHY) { const int nblk = D / 64; p0_transpose_item(F.inp(24) + (size_t)l * HYW * D, HYW, D, wl + W_BHY / 2, (r / nblk) * 64, (r % nblk) * 64, (r % nblk) * 64, nullptr, scr, lane); continue; } r -= I_BHY;
        { const int nblk = D / 64; p0_transpose_item(F.inp(25) + (size_t)l * D * D, D, D, wl + W_OUT / 2, (r / nblk) * 64, (r % nblk) * 64, (r % nblk) * 64, nullptr, scr, lane); }
    }
    for (int it = gw; it < DEPTH * (HYF / 64); it += NGW) { const int l = it / (HYF / 64), nb = it % (HYF / 64); bf16* hi = (bf16*)(F.ws + WS_W3T + (size_t)l * MiB);
        p0_transpose_item(F.inp(20) + (size_t)l * HYN * HYF, HYN, HYF, hi, 0, nb * 64, nb * 64, nullptr, scr, lane, hi + (size_t)HYF * HYN); }
    { bf16* X = (bf16*)(F.ws + WS_X); float* ssq = (float*)(F.ws + WS_SSQ);
      for (int m0 = 2 * gw; m0 < M; m0 += 2 * NGW) { f32x4 v[2][4]; float s[2];
#pragma unroll
        for (int r = 0; r < 2; ++r) { const GAS f32x4* xr = (const GAS f32x4*)(F.inp(0) + (size_t)(m0 + r) * D) + lane;
#pragma unroll
            for (int j = 0; j < 4; ++j) v[r][j] = xr[64 * j]; }
#pragma unroll
        for (int r = 0; r < 2; ++r) { float a = 0.f;
#pragma unroll
            for (int j = 0; j < 4; ++j) a += (v[r][j].x * v[r][j].x + v[r][j].y * v[r][j].y) + (v[r][j].z * v[r][j].z + v[r][j].w * v[r][j].w);
            s[r] = wave_sum(a);
            GAS unsigned long long* o8 = (GAS unsigned long long*)(X + (size_t)(m0 + r) * D) + lane;
#pragma unroll
            for (int j = 0; j < 4; ++j) o8[64 * j] = (unsigned long long)pk2(v[r][j].x, v[r][j].y) | ((unsigned long long)pk2(v[r][j].z, v[r][j].w) << 32);
            if (lane < 16) ssq[(size_t)(m0 + r) * 16 + lane] = lane == 0 ? s[r] : 0.f; } } }
    {
      for (int it = gw; it < DEPTH * SEQ; it += NGW) { const int l = it / SEQ, t = it % SEQ, j = lane;
        const float* w1 = F.inp(15) + (size_t)l * HYE * HYN; const float* b1 = F.inp(16) + l * HYN; const float* fr = F.inp(17) + l * HYN; const float* w2 = F.inp(18) + (size_t)l * HYN * HYN; const float* b2 = F.inp(19) + l * HYN;
        float f = 0.f;
        if (j == 0) f = (float)t / (float)(SEQ - 1);
        else if (j < 33) { const int bi = (j - 1) & 15; const float band = 1e-4f + (float)bi * ((15.f - 1e-4f) / 15.f); const float ang = band * (float)t * (float)(2.0 * 3.14159265358979323846 / SEQ); f = j < 17 ? cosf(ang) : -sinf(ang); }
        float a = b1[j];
        for (int i = 0; i < HYE; ++i) a += __shfl(f, i) * w1[i * HYN + j];
        const float h1 = sinf(fr[j] * a);
        float c = b2[j];
        for (int i = 0; i < HYN; ++i) c += __shfl(h1, i) * w2[i * HYN + j];
        const float hv = sinf(fr[j] * c); const unsigned hh = f2bf(hv);
        bf16* H2H = (bf16*)(F.ws + WS_H2 + (size_t)l * 512 * 1024);
        H2H[(size_t)t * HYN + j] = (bf16)hh; H2H[(size_t)SEQ * HYN + (size_t)t * HYN + j] = (bf16)f2bf(hv - __uint_as_float(hh << 16)); } }
    { float* LB = (float*)(F.ws + WS_LBAR); bf16* BBT = (bf16*)(F.ws + WS_BBT); bf16* CT = (bf16*)(F.ws + WS_CT);
      for (int q = gw; q < DEPTH * 2 * S5G; q += NGW) { const int p = lane; const int i = q * S5P + p;
        const float dt = expf(F.inp(5)[q]); const float lr = F.inp(3)[i], li = F.inp(4)[i]; const float mag = expf(lr * dt), ang = li * dt;
        const float br = mag * cosf(ang), bi = mag * sinf(ang); LB[2 * i] = br; LB[2 * i + 1] = bi;
        const float nr = br - 1.f, ni = bi, den = lr * lr + li * li; const float kr = (nr * lr + ni * li) / den, ki = (ni * lr - nr * li) / den;
        const float* bre = F.inp(6) + (size_t)i * S5H; const float* bim = F.inp(7) + (size_t)i * S5H;
        bf16* rowr = BBT + ((size_t)q * 128 + 2 * p) * 16; bf16* rowi = rowr + 16;
        for (int h = 0; h < S5H; ++h) { const float xr = bre[h], xi = bim[h]; rowr[h] = (bf16)f2bf(kr * xr - ki * xi); rowi[h] = (bf16)f2bf(kr * xi + ki * xr); }
        const float* cre = F.inp(8) + (size_t)q * S5H * S5P; const float* cim = F.inp(9) + (size_t)q * S5H * S5P;
        for (int h = 0; h < S5H; ++h) { *(unsigned*)(CT + ((size_t)q * 16 + h) * 128 + 2 * p) = pk2(cre[h * S5P + p], -cim[h * S5P + p]); } } }
}


constexpr int S5_YB = 0, S5_CH = 65536, S5_CHB = 8704, S5_SEND = S5_CH + 8 * S5_CHB;
__device__ __forceinline__ float gelu_tanh_fast(float x) {
    const float z = 0.7978845608028654f * (x + 0.044715f * x * x * x);
    const float e = __builtin_amdgcn_exp2f(2.0f * 1.4426950408889634f * z);
    const float th = 1.0f - 2.0f * __builtin_amdgcn_rcpf(e + 1.0f);
    return 0.5f * x * (1.0f + th);
}
template <int DIR, bool EMIT>
__device__ __forceinline__ void s5_pass(Frame& F, const bf16* Ub  , int tlo  , float ar, float ai, float& sr, float& si,
                                        const bf16x8 (&bbf)[8], const bf16x8 (&ctf)[4], const bf16x8& ddf, LAS unsigned char* ch, LAS unsigned char* yb, bf16* YGb) {
    const int lane = F.lane, fr = lane & 15, fq = lane >> 4; const bool swon = SW_ON(F.bx, F.wave);
    auto load_u = [&](int tc0) -> bf16x8 { bf16x8 z = {0, 0, 0, 0, 0, 0, 0, 0}; int row = tc0 + fr; asm volatile("" : "+v"(row));
        if (fq < 2) z = *(const GAS bf16x8*)(Ub + (size_t)row * 1024 + 8 * fq); return z; };
    auto tcb_of = [&](int ci) -> int { return DIR ? tlo + 32 * (7 - ci) : tlo + 32 * ci; };
    bf16x8 ufr[2][2];
#pragma unroll
    for (int i = 0; i < 2; ++i)
#pragma unroll
        for (int k = 0; k < 2; ++k) ufr[i][k] = load_u(tcb_of(i) + 16 * k);
#pragma unroll 1
    for (int cb = 0; cb < 4; ++cb)
#pragma unroll
    for (int ci2 = 0; ci2 < 2; ++ci2) { const int ci = 2 * cb + ci2; const int tcb = tcb_of(ci);
        bf16x8 uf[2];
#pragma unroll
        for (int k = 0; k < 2; ++k) uf[k] = ufr[ci2][k];
        SW_BEGIN(10, swon)
#pragma unroll
        for (int k = 0; k < 2; ++k)
#pragma unroll
            for (int j = 0; j < 8; ++j) { f32x4 a = {0.f, 0.f, 0.f, 0.f}; a = __builtin_amdgcn_mfma_f32_16x16x32_bf16(bbf[j], uf[k], a, 0, 0, 0);
                v2u w; w.x = pg8::cvt_pk_bf16(a[0], a[1]); w.y = pg8::cvt_pk_bf16(a[2], a[3]); *(LAS v2u*)(ch + (16 * k + fr) * 264 + (16 * j + 4 * fq) * 2) = w; }
        LDS_WAIT();
        SW_END(10, swon, F.ws);
        SW_BEGIN(11, swon)
        unsigned xw[32];
#pragma unroll
        for (int tt = 0; tt < 32; ++tt) xw[tt] = *(const LAS unsigned*)(ch + tt * 264 + 4 * lane);
        LDS_WAIT();
        SW_END(11, swon, F.ws);
        SW_BEGIN(12, swon)
        unsigned spk[32];
        {
            const f32x2 A1 = {ar, ar}, A2 = {-ai, ai}; f32x2 S = {sr, si};
#pragma unroll
            for (int i = 0; i < 32; ++i) { const int tt = DIR ? 31 - i : i;
                const f32x2 X = {bf_lo(xw[tt]), bf_hi(xw[tt])};
                const f32x2 T = __builtin_elementwise_fma(A1, S, X);
                S = __builtin_elementwise_fma(A2, __builtin_shufflevector(S, S, 1, 0), T);
                if (EMIT) spk[tt] = pg8::cvt_pk_bf16(S.x, S.y); }
            sr = S.x; si = S.y; }
        SW_END(12, swon, F.ws);
        if (EMIT) {
            SW_BEGIN(13, swon)
            LAS unsigned* sb = (LAS unsigned*)ch;
#pragma unroll
            for (int tt = 0; tt < 32; ++tt) sb[tt * 68 + lane] = spk[tt];
            LDS_WAIT();
            SW_END(13, swon, F.ws);
            SW_BEGIN(14, swon)
            f32x4 y[2];
#pragma unroll
            for (int k = 0; k < 2; ++k) { y[k] = (f32x4){0.f, 0.f, 0.f, 0.f};
#pragma unroll
                for (int ks = 0; ks < 4; ++ks) { const bf16x8 sf = *(const LAS bf16x8*)(ch + (16 * k + fr) * 272 + ks * 64 + fq * 16); y[k] = __builtin_amdgcn_mfma_f32_16x16x32_bf16(ctf[ks], sf, y[k], 0, 0, 0); } }
            LDS_WAIT();
            asm volatile("" :: "v"(y[0]), "v"(y[1]));
            SW_END(14, swon, F.ws);
            SW_BEGIN(15, swon)
#pragma unroll
            for (int k = 0; k < 2; ++k) {
                LAS v2u* ybp = (LAS v2u*)(yb + (size_t)(tcb + 16 * k + fr) * 32 + 8 * fq);
                if (DIR == 0) { v2u w; w.x = pg8::cvt_pk_bf16(y[k][0], y[k][1]); w.y = pg8::cvt_pk_bf16(y[k][2], y[k][3]); *ybp = w; }
                else { y[k] = __builtin_amdgcn_mfma_f32_16x16x32_bf16(ddf, uf[k], y[k], 0, 0, 0);
                    const v2u f = *ybp; const float o0 = gelu_tanh_fast(y[k][0] + bf_lo(f.x)), o1 = gelu_tanh_fast(y[k][1] + bf_hi(f.x)), o2 = gelu_tanh_fast(y[k][2] + bf_lo(f.y)), o3 = gelu_tanh_fast(y[k][3] + bf_hi(f.y));
                    v2u w; w.x = pg8::cvt_pk_bf16(o0, o1); w.y = pg8::cvt_pk_bf16(o2, o3);
                    *(GAS v2u*)(YGb + (size_t)(tcb + 16 * k + fr) * 1024 + 4 * fq) = w; } }
            SW_END(15, swon, F.ws);
        }
        if (ci + 2 < 8) {
#pragma unroll
            for (int k = 0; k < 2; ++k) ufr[ci2][k] = load_u(tcb_of(ci + 2) + 16 * k); }
        __builtin_amdgcn_sched_barrier(0);
    }
}
__device__ __forceinline__ void s5_item(Frame& F, int l, int b, int g, bool dry = false) {
    const int lane = F.lane, fr = lane & 15, fq = lane >> 4, seg = F.wave;
    bf16* U = (bf16*)(F.ws + WS_R5) + (size_t)b * SEQ * 1024 + g * 16;
    LAS unsigned char* ch = F.lds + S5_CH + seg * S5_CHB; LAS unsigned char* yb = F.lds + S5_YB;
    LAS f32x2* send = (LAS f32x2*)(F.lds + S5_SEND); const bool swon = SW_ON(F.bx, F.wave);
    SW_BEGIN(1, swon)
#pragma unroll 1
    for (int dir = 0; dir < 2; ++dir) {
        const int q = (l * 2 + dir) * S5G + g;
        const float ar = ((const GAS float*)(F.ws + WS_LBAR))[(size_t)(q * S5P + lane) * 2], ai = ((const GAS float*)(F.ws + WS_LBAR))[(size_t)(q * S5P + lane) * 2 + 1];
        bf16x8 bbf[8], ctf[4], ddf; const bf16x8 zero8 = {0, 0, 0, 0, 0, 0, 0, 0};
        const bf16* BBT = (const bf16*)(F.ws + WS_BBT) + (size_t)q * 128 * 16; const bf16* CT = (const bf16*)(F.ws + WS_CT) + (size_t)q * 16 * 128;
#pragma unroll
        for (int j = 0; j < 8; ++j) bbf[j] = fq < 2 ? *(const GAS bf16x8*)(BBT + (16 * j + fr) * 16 + 8 * fq) : zero8;
#pragma unroll
        for (int ks = 0; ks < 4; ++ks) ctf[ks] = *(const GAS bf16x8*)(CT + fr * 128 + 32 * ks + 8 * fq);
        { const short dv = (short)f2bf(((const GAS float*)F.inp(10))[l * S5W + g * 16 + fr]); ddf = zero8;
#pragma unroll
          for (int jj = 0; jj < 8; ++jj) if (8 * fq + jj == fr) ddf[jj] = dv; }
        const int tlo = dir ? SEQ - 256 * (seg + 1) : 256 * seg;
        float sr = 0.f, si = 0.f;
#ifndef MK_S5DRY_MODE
#define MK_S5DRY_MODE 0
#endif
        SW_BEGIN(2, swon)
        if (!(dry && MK_S5DRY_MODE == 2)) { if (dir == 0) s5_pass<0, false>(F, U, tlo, ar, ai, sr, si, bbf, ctf, ddf, ch, yb, U); else s5_pass<1, false>(F, U, tlo, ar, ai, sr, si, bbf, ctf, ddf, ch, yb, U); }
        SW_END(2, swon, F.ws);
        send[seg * 64 + lane] = (f32x2){sr, si};
        LDS_WAIT(); __syncthreads();
        float pr = ar, pi = ai;
#pragma unroll
        for (int k = 0; k < 8; ++k) { const float nr = pr * pr - pi * pi, ni = 2.f * pr * pi; pr = nr; pi = ni; }
        sr = 0.f; si = 0.f;
        for (int k = 0; k < seg; ++k) { const f32x2 e = send[k * 64 + lane]; const float nr = pr * sr - pi * si + e.x, ni = pr * si + pi * sr + e.y; sr = nr; si = ni; }
        bf16* YGo = dry ? (bf16*)(F.ws + WS_R6) + (size_t)(b & 1) * SEQ * 1024 + g * 16 : U;
        SW_BEGIN(3, swon)
        if (!(dry && MK_S5DRY_MODE == 1)) { if (dir == 0) s5_pass<0, true>(F, U, tlo, ar, ai, sr, si, bbf, ctf, ddf, ch, yb, YGo); else s5_pass<1, true>(F, U, tlo, ar, ai, sr, si, bbf, ctf, ddf, ch, yb, YGo); }
        SW_END(3, swon, F.ws);
        LDS_WAIT(); __syncthreads();
    }
    SW_END(1, swon, F.ws);
}

constexpr int HY_WX = 0, HY_WXB = 8704, HY_KF = 8 * HY_WXB, HY_KFO = 33 * 64 * 8, HY_KFCH = 2 * HY_KFO, HY_RED = HY_KF + 2 * HY_KFCH, HY_RAWROW = 4128;
static_assert(HY_RED + 256 <= LDSCTL_OFF && 4 * 2048 * 4 <= HY_KFCH && 2 * HY_RAWROW <= HY_WXB, "hyena LDS map");
#define C64_LIST 1.000000000e+00f, 9.951847267e-01f, 9.807852804e-01f, 9.569403357e-01f, 9.238795325e-01f, 8.819212643e-01f, 8.314696123e-01f, 7.730104534e-01f, 7.071067812e-01f, 6.343932842e-01f, 5.555702330e-01f, 4.713967368e-01f, 3.826834324e-01f, 2.902846773e-01f, 1.950903220e-01f, 9.801714033e-02f, 0.0f, -9.801714033e-02f, -1.950903220e-01f, -2.902846773e-01f, -3.826834324e-01f, -4.713967368e-01f, -5.555702330e-01f, -6.343932842e-01f, -7.071067812e-01f, -7.730104534e-01f, -8.314696123e-01f, -8.819212643e-01f, -9.238795325e-01f, -9.569403357e-01f, -9.807852804e-01f, -9.951847267e-01f, -1.000000000e+00f, -9.951847267e-01f, -9.807852804e-01f, -9.569403357e-01f, -9.238795325e-01f, -8.819212643e-01f, -8.314696123e-01f, -7.730104534e-01f, -7.071067812e-01f, -6.343932842e-01f, -5.555702330e-01f, -4.713967368e-01f, -3.826834324e-01f, -2.902846773e-01f, -1.950903220e-01f, -9.801714033e-02f, 0.0f, 9.801714033e-02f, 1.950903220e-01f, 2.902846773e-01f, 3.826834324e-01f, 4.713967368e-01f, 5.555702330e-01f, 6.343932842e-01f, 7.071067812e-01f, 7.730104534e-01f, 8.314696123e-01f, 8.819212643e-01f, 9.238795325e-01f, 9.569403357e-01f, 9.807852804e-01f, 9.951847267e-01f
__host__ __device__ constexpr int rev6(int s) { return ((s >> 4) & 3) | (s & 12) | ((s & 3) << 4); }

template <bool INV> __device__ __forceinline__ void r4(float& x0r, float& x0i, float& x1r, float& x1i, float& x2r, float& x2i, float& x3r, float& x3i) {
    const float t0r = x0r + x2r, t0i = x0i + x2i, t1r = x0r - x2r, t1i = x0i - x2i, t2r = x1r + x3r, t2i = x1i + x3i, t3r = x1r - x3r, t3i = x1i - x3i;
    x0r = t0r + t2r; x0i = t0i + t2i; x2r = t0r - t2r; x2i = t0i - t2i;
    if (!INV) { x1r = t1r + t3i; x1i = t1i - t3r; x3r = t1r - t3i; x3i = t1i + t3r; }
    else      { x1r = t1r - t3i; x1i = t1i + t3r; x3r = t1r + t3i; x3i = t1i - t3r; }
}
constexpr float C64T[64] = { C64_LIST };
template <int... Is, class Fn> __device__ __forceinline__ void static_for_impl(std::integer_sequence<int, Is...>, Fn&& f) { (f(std::integral_constant<int, Is>{}), ...); }
template <int N, class Fn> __device__ __forceinline__ void static_for(Fn&& f) { static_for_impl(std::make_integer_sequence<int, N>{}, f); }
template <bool INV, int E> __device__ __forceinline__ void twc(float& xr, float& xi) {
    constexpr int e = E & 63;
    if constexpr (e == 0) { return; }
    else if constexpr (e == 16) { const float tr = xr, ti = xi; if (!INV) { xr = ti; xi = -tr; } else { xr = -ti; xi = tr; } }
    else if constexpr (e == 32) { xr = -xr; xi = -xi; }
    else if constexpr (e == 48) { const float tr = xr, ti = xi; if (!INV) { xr = -ti; xi = tr; } else { xr = ti; xi = -tr; } }
    else {
        constexpr float c = C64T[e], sn = C64T[(e + 48) & 63], wi = INV ? sn : -sn;
        constexpr unsigned cb = __builtin_bit_cast(unsigned, c), wb = __builtin_bit_cast(unsigned, wi), nwb = wb ^ 0x80000000u;
        const float tr = xr, ti = xi; float a, b;
        asm("v_mul_f32 %0, %1, %2" : "=v"(a) : "i"(cb), "v"(tr));
        asm("v_fmac_f32 %0, %1, %2" : "+v"(a) : "i"(nwb), "v"(ti));
        asm("v_mul_f32 %0, %1, %2" : "=v"(b) : "i"(wb), "v"(tr));
        asm("v_fmac_f32 %0, %1, %2" : "+v"(b) : "i"(cb), "v"(ti));
        xr = a; xi = b;
    }
}
#define SFOR(N, I, ...) static_for<N>([&](auto I##_) __attribute__((always_inline)) { constexpr int I = decltype(I##_)::value; __VA_ARGS__ })
template <bool INV> __device__ __forceinline__ void dft64(float (&re)[64], float (&im)[64]) {
    if constexpr (!INV) {
        SFOR(16, bc, r4<false>(re[bc], im[bc], re[bc + 16], im[bc + 16], re[bc + 32], im[bc + 32], re[bc + 48], im[bc + 48]););
        SFOR(48, i, constexpr int p = 1 + i / 16; constexpr int bc = i % 16; twc<false, bc * p>(re[16 * p + bc], im[16 * p + bc]););
        __builtin_amdgcn_sched_barrier(0);
        SFOR(16, i, constexpr int s = 16 * (i / 4) + (i % 4); r4<false>(re[s], im[s], re[s + 4], im[s + 4], re[s + 8], im[s + 8], re[s + 12], im[s + 12]););
        SFOR(64, i, constexpr int q = (i >> 2) & 3; constexpr int c = i & 3; twc<false, 4 * c * q>(re[i], im[i]););
        __builtin_amdgcn_sched_barrier(0);
        SFOR(16, pq, constexpr int s = 4 * pq; r4<false>(re[s], im[s], re[s + 1], im[s + 1], re[s + 2], im[s + 2], re[s + 3], im[s + 3]););
    } else {
        SFOR(16, pq, constexpr int s = 4 * pq; r4<true>(re[s], im[s], re[s + 1], im[s + 1], re[s + 2], im[s + 2], re[s + 3], im[s + 3]););
        SFOR(64, i, constexpr int q = (i >> 2) & 3; constexpr int c = i & 3; twc<true, 4 * c * q>(re[i], im[i]););
        __builtin_amdgcn_sched_barrier(0);
        SFOR(16, i, constexpr int s = 16 * (i / 4) + (i % 4); r4<true>(re[s], im[s], re[s + 4], im[s + 4], re[s + 8], im[s + 8], re[s + 12], im[s + 12]););
        SFOR(48, i, constexpr int p = 1 + i / 16; constexpr int bc = i % 16; twc<true, bc * p>(re[16 * p + bc], im[16 * p + bc]););
        __builtin_amdgcn_sched_barrier(0);
        SFOR(16, bc, r4<true>(re[bc], im[bc], re[bc + 16], im[bc + 16], re[bc + 32], im[bc + 32], re[bc + 48], im[bc + 48]););
    }
    __builtin_amdgcn_sched_barrier(0);
}
__device__ __forceinline__ void wtrans(float (&v)[64], LAS float* wx, int lane, bool swon = false, unsigned long long* wsp = nullptr) {
    SW_BEGIN(40, swon)
#pragma unroll
    for (int i = 0; i < 32; ++i) { const auto r = __builtin_amdgcn_permlane32_swap(__float_as_uint(v[i]), __float_as_uint(v[32 + i]), false, false); v[i] = __uint_as_float(r[0]); v[32 + i] = __uint_as_float(r[1]); }
    __builtin_amdgcn_sched_barrier(0);
    SW_ENDA(40, swon, *wsp);
    const int rd = (lane & 31) * 68 + (lane >> 5) * 32;
#pragma unroll
    for (int step = 0; step < 2; ++step) {
        asm volatile("" ::: "memory");
        SW_BEGIN(41, swon)
#pragma unroll
        for (int i = 0; i < 32; ++i) wx[i * 68 + lane] = v[32 * step + i];
        asm volatile("s_waitcnt lgkmcnt(0)" ::: "memory");
        SW_ENDA(41, swon, *wsp);
        SW_BEGIN(42, swon)
#pragma unroll
        for (int i4 = 0; i4 < 8; ++i4) { const f32x4 q = *(const LAS f32x4*)(wx + rd + 4 * i4);
#pragma unroll
            for (int e = 0; e < 4; ++e) v[32 * step + 4 * i4 + e] = q[e]; }
        asm volatile("s_waitcnt lgkmcnt(0)" ::: "memory");
        SW_ENDA(42, swon, *wsp);
    }
}
__device__ __forceinline__ void wfft_fwd(float (&re)[64], float (&im)[64], LAS float* wx, int lane, bool swon = false, unsigned long long* wsp = nullptr) {
    SW_BEGIN(27, swon)
    dft64<false>(re, im);
    SW_ENDA(27, swon, *wsp);
    SW_BEGIN(28, swon)
    { float f = (float)lane * (1.0f / 4096.0f); asm volatile("" : "+v"(f));
#pragma unroll
      for (int s = 1; s < 64; ++s) { const float a = (float)rev6(s) * f; const float c = __builtin_amdgcn_cosf(a), sn = __builtin_amdgcn_sinf(a);
          const float tr = re[s] * c + im[s] * sn, ti = im[s] * c - re[s] * sn; re[s] = tr; im[s] = ti; if ((s & 7) == 7) __builtin_amdgcn_sched_barrier(0); } }
    __builtin_amdgcn_sched_barrier(0);
    SW_ENDA(28, swon, *wsp);
    SW_BEGIN(29, swon)
    wtrans(re, wx, lane, swon, wsp); wtrans(im, wx, lane, swon, wsp);
    __builtin_amdgcn_sched_barrier(0);
    SW_ENDA(29, swon, *wsp);
    dft64<false>(re, im);
}
template <class Mid> __device__ __forceinline__ void wfft_inv(float (&re)[64], float (&im)[64], LAS float* wx, int lane, Mid&& mid) {
    dft64<true>(re, im);
    { float f = (float)rev6(lane) * (1.0f / 4096.0f); asm volatile("" : "+v"(f));
#pragma unroll
      for (int s = 1; s < 64; ++s) { const float a = (float)s * f; const float c = __builtin_amdgcn_cosf(a), sn = __builtin_amdgcn_sinf(a);
          const float tr = re[s] * c - im[s] * sn, ti = im[s] * c + re[s] * sn; re[s] = tr; im[s] = ti; if ((s & 7) == 7) __builtin_amdgcn_sched_barrier(0); } }
    __builtin_amdgcn_sched_barrier(0);
    wtrans(re, wx, lane); wtrans(im, wx, lane);
    __builtin_amdgcn_sched_barrier(0);
    mid();
    __builtin_amdgcn_sched_barrier(0);
    dft64<true>(re, im);
}
struct Stage2 { v4u a[4], b[4]; };
__device__ __forceinline__ void hy_load2a(Stage2& S, const bf16* row0, int lane) {
#pragma unroll
    for (int i = 0; i < 4; ++i) { const int q = lane + 64 * i; S.a[i] = *(const GAS v4u*)(row0 + 8 * q); }
}
__device__ __forceinline__ void hy_load2b(Stage2& S, const bf16* row0, int lane) {
#pragma unroll
    for (int i = 0; i < 4; ++i) { const int q = lane + 64 * i; S.b[i] = *(const GAS v4u*)(row0 + SEQ + 8 * q); }
}
__device__ __forceinline__ void hy_load2(Stage2& S, const bf16* row0, int lane) { hy_load2a(S, row0, lane); hy_load2b(S, row0, lane); }
__device__ __forceinline__ void hy_commit2(const Stage2& S, LAS unsigned char* wxb, int lane) {
    asm volatile("" ::: "memory");
#pragma unroll
    for (int i = 0; i < 4; ++i) { const int q = lane + 64 * i; *(LAS v4u*)(wxb + 16 + 16 * q) = S.a[i]; *(LAS v4u*)(wxb + HY_RAWROW + 16 + 16 * q) = S.b[i]; }
    if (lane < 4) { LAS unsigned short* row = (LAS unsigned short*)(wxb + (lane >> 1) * HY_RAWROW); row[(lane & 1) ? 8 + SEQ : 7] = 0; }
    asm volatile("" ::: "memory");
}
__device__ __forceinline__ float raw2(LAS unsigned char* wxb, int r, int t) { return bf2f(*(const LAS unsigned short*)(wxb + r * HY_RAWROW + 16 + 2 * t)); }
template <class Fn> __device__ __forceinline__ void hy_sconv(LAS unsigned char* wxb, int lane, float w0, float w1, float w2, float b, Fn&& f) {
    const unsigned p = (unsigned)((lane & 1) ^ 1);
    const unsigned s0 = 0x01000c0cu + 0x02020000u * p, s1 = s0 + 0x02020000u, s2 = s1 + 0x02020000u;
    LAS unsigned char* base = wxb + 16 + 4 * ((lane - 1) >> 1);
#pragma unroll
    for (int blk = 0; blk < 4; ++blk) {
        unsigned d[8][2][2];
        const LAS unsigned* q0 = (const LAS unsigned*)(base + 1024 * blk); const LAS unsigned* q1 = (const LAS unsigned*)(base + HY_RAWROW + 1024 * blk);
#pragma unroll
        for (int i = 0; i < 8; ++i) { d[i][0][0] = q0[32 * i]; d[i][0][1] = q0[32 * i + 1]; d[i][1][0] = q1[32 * i]; d[i][1][1] = q1[32 * i + 1]; }
        asm volatile("s_waitcnt lgkmcnt(0)" ::: "memory");
        __builtin_amdgcn_sched_barrier(0);
#pragma unroll
        for (int i = 0; i < 8; ++i) { float c[2];
#pragma unroll
            for (int r = 0; r < 2; ++r) { const float xm = __uint_as_float(__builtin_amdgcn_perm(d[i][r][1], d[i][r][0], s0)), x0 = __uint_as_float(__builtin_amdgcn_perm(d[i][r][1], d[i][r][0], s1)),
                                                      xp = __uint_as_float(__builtin_amdgcn_perm(d[i][r][1], d[i][r][0], s2)); c[r] = b + w0 * xm + w1 * x0 + w2 * xp; }
            f(8 * blk + i, c[0], c[1]); }
        __builtin_amdgcn_sched_barrier(0);
    }
}
__device__ __forceinline__ unsigned hilo_pack(float x0, float x1, unsigned& lo) {
    const unsigned h0 = f2bf(x0), h1 = f2bf(x1); lo = f2bf(x0 - __uint_as_float(h0 << 16)) | (f2bf(x1 - __uint_as_float(h1 << 16)) << 16); return h0 | (h1 << 16);
}
__device__ __forceinline__ void hy_filter_gen4(Frame& F, int l, int c0, LAS unsigned char* kf0, float* tap2, LAS float* red) {
    int lane_ = F.lane; asm volatile("" : "+v"(lane_)); const int lane = lane_; const int fr = lane & 15, fq = lane >> 4, w = F.wave;
    const float* dec = F.inp(21) + (size_t)l * HYF;
    const bf16* H2H = (const bf16*)(F.ws + WS_H2 + (size_t)l * 512 * 1024); const bf16* H2L = H2H + SEQ * HYN;
    bf16x8 ah[2], al[2];
    { const int ch = c0 + (HYW / 4) * (fr >> 2), f4 = fr & 3, col = (f4 >> 1) * 2 * HYW + (f4 & 1) * HYW + ch;
      const bf16* whi = (const bf16*)(F.ws + WS_W3T + (size_t)l * MiB) + (size_t)col * HYN; const bf16* wlo = whi + (size_t)HYF * HYN;
#pragma unroll
      for (int ks = 0; ks < 2; ++ks) { ah[ks] = *(const GAS bf16x8*)(whi + 32 * ks + 8 * fq); al[ks] = *(const GAS bf16x8*)(wlo + 32 * ks + 8 * fq); } }
    float dk[4];
#pragma unroll
    for (int r = 0; r < 4; ++r) dk[r] = fabsf(((const GAS float*)dec)[(r >> 1) * 2 * HYW + (r & 1) * HYW + c0 + (HYW / 4) * fq]);
    LAS float* stg = (LAS float*)(kf0 + (fq & 1) * HY_KFCH); float* tg = tap2 + (size_t)(fq & 1) * 4 * SEQ;
    float ss0 = 0.f, ss1 = 0.f;
#pragma unroll 1
    for (int tb = 0; tb < 2; ++tb) {
        bf16x8 bh[8][2], bl[8][2];
#pragma unroll
        for (int u = 0; u < 8; ++u)
#pragma unroll
            for (int ks = 0; ks < 2; ++ks) { const size_t off = (size_t)(256 * w + 128 * tb + 16 * u + fr) * HYN + 32 * ks + 8 * fq; bh[u][ks] = *(const GAS bf16x8*)(H2H + off); bl[u][ks] = *(const GAS bf16x8*)(H2L + off); }
#pragma unroll
        for (int u = 0; u < 8; ++u) { const int t = 256 * w + 128 * tb + 16 * u + fr; f32x4 acc = {0.f, 0.f, 0.f, 0.f};
#pragma unroll
            for (int ks = 0; ks < 2; ++ks) { acc = __builtin_amdgcn_mfma_f32_16x16x32_bf16(ah[ks], bh[u][ks], acc, 0, 0, 0); acc = __builtin_amdgcn_mfma_f32_16x16x32_bf16(ah[ks], bl[u][ks], acc, 0, 0, 0); acc = __builtin_amdgcn_mfma_f32_16x16x32_bf16(al[ks], bh[u][ks], acc, 0, 0, 0); }
            const float tn = (float)t * (1.0f / (float)(SEQ - 1));
#pragma unroll
            for (int r = 0; r < 4; ++r) { const float v = acc[r] * (__expf(-tn * dk[r]) + 0.05f);
                if (fq < 2) stg[r * SEQ + t] = v; else ((GAS float*)tg)[(size_t)r * SEQ + t] = v;
                const float sq = ((r & 1) && t == 0) ? 0.f : v * v; if (r < 2) ss0 += sq; else ss1 += sq; } }
    }
#pragma unroll
    for (int o = 1; o < 16; o <<= 1) { ss0 += __shfl_xor(ss0, o); ss1 += __shfl_xor(ss1, o); }
    if (fr == 0) { red[2 * fq] = ss0; red[2 * fq + 1] = ss1; }
}
template <bool GLB> __device__ __forceinline__ void hy_filter_fft(Frame& F, int l, int c, LAS unsigned char* kfch, const float* tapg, float* kfg, const LAS float* red4, LAS float* wx) {
    int lane_ = F.lane; asm volatile("" : "+v"(lane_)); const int lane = lane_; const LAS float* stg = (const LAS float*)kfch;
    auto tap = [&](int idx) __attribute__((always_inline)) -> float { if constexpr (GLB) return ((const GAS float*)tapg)[idx]; else return stg[idx]; };
    float re[64], im[64];
#pragma unroll
    for (int n1 = 0; n1 < 32; ++n1) { re[n1] = tap(64 * n1 + lane); im[n1] = tap(2 * SEQ + 64 * n1 + lane); }
#pragma unroll
    for (int n1 = 32; n1 < 64; ++n1) { const int t = 64 * (64 - n1) - lane; float a = tap(SEQ + t), b = tap(3 * SEQ + t); if (n1 == 32 && lane == 0) { a = 0.f; b = 0.f; } re[n1] = a; im[n1] = b; }
    float s0 = 0.f, s1 = 0.f;
#pragma unroll
    for (int w = 0; w < 8; ++w) { s0 += red4[8 * w]; s1 += red4[8 * w + 1]; }
    const float sc = 1.0f / 4096.0f; const float n0 = 0.5f * sc / sqrtf(s0 + 1e-6f), n1s = 0.5f * sc / sqrtf(s1 + 1e-6f);
    const float d0 = ((const GAS float*)F.inp(22))[(size_t)l * 2 * HYW + c] * sc, d1 = ((const GAS float*)F.inp(22))[(size_t)l * 2 * HYW + HYW + c] * sc;
    asm volatile("s_waitcnt vmcnt(0) lgkmcnt(0)" ::: "memory");
    wfft_fwd(re, im, wx, lane);
    const int k1 = rev6(lane), lc = rev6((64 - k1) & 63);
    LAS f32x2* kf0 = (LAS f32x2*)kfch + k1; LAS f32x2* kf1 = (LAS f32x2*)(kfch + HY_KFO) + k1;
    GAS f32x2* kg0 = (GAS f32x2*)kfg + k1; GAS f32x2* kg1 = (GAS f32x2*)kfg + HY_KFO / 8 + k1;
#pragma unroll
    for (int kb = 0; kb < 4; ++kb) {
        const int klo = 8 * kb, kn = kb == 3 ? 9 : 8; float pr[9], pi[9];
#pragma unroll
        for (int j = 0; j < 9; ++j) if (j < kn) { const int sm = rev6(63 - (klo + j)); pr[j] = __shfl(re[sm], lc); pi[j] = __shfl(im[sm], lc); }
        asm volatile("s_waitcnt lgkmcnt(0)" ::: "memory");
        __builtin_amdgcn_sched_barrier(0);
#pragma unroll
        for (int j = 0; j < 9; ++j) if (j < kn) { const int k0 = klo + j, s = rev6(k0), sz = rev6((64 - k0) & 63);
            float qr = pr[j], qi = pi[j]; if (lane == 0) { qr = re[sz]; qi = im[sz]; }
            const float zr = re[s], zi = im[s];
            const f32x2 v0 = {(zr + qr) * n0 + d0, (zi - qi) * n0}, v1 = {(zi + qi) * n1s + d1, -(zr - qr) * n1s};
            if constexpr (GLB) { kg0[k0 * 64] = v0; kg1[k0 * 64] = v1; } else { kf0[k0 * 64] = v0; kf1[k0 * 64] = v1; } }
        __builtin_amdgcn_sched_barrier(0);
    }
}
__device__ __forceinline__ void hy_wave_main(Frame& F, int l, int c, int ws, LAS unsigned char* wxb, LAS unsigned char* kfch, Stage2& pre, bool dry = false) {
    int lane_ = F.lane; asm volatile("" : "+v"(lane_)); const int lane = lane_; LAS float* wx = (LAS float*)wxb;
    const size_t rowoff = (size_t)c * M + (size_t)(2 * ws) * SEQ;
    const bf16* PV = (const bf16*)(F.ws + WS_R1) + rowoff; const bf16* PX1 = (const bf16*)(F.ws + WS_R2) + rowoff; const bf16* PX2 = (const bf16*)(F.ws + WS_R3) + rowoff;
    const bf16* GH = (const bf16*)(F.ws + WS_R4) + rowoff; bf16* OUT = (bf16*)(F.ws + WS_R1) + rowoff;
    const float* cw = F.inp(13) + (size_t)l * 3 * 3 * HYW; const float* cb = F.inp(14) + (size_t)l * 3 * HYW;
    float re[64], im[64]; const bool swon = SW_ON(F.bx, F.wave);
    SW_BEGIN(25, swon)
    hy_commit2(pre, wxb, lane);
    hy_load2a(pre, PX1, lane);
    { const float w0 = ((const GAS float*)cw)[c], w1 = ((const GAS float*)cw)[3 * HYW + c], w2 = ((const GAS float*)cw)[6 * HYW + c], b = ((const GAS float*)cb)[c];
      hy_sconv(wxb, lane, w0, w1, w2, b, [&](int n1, float c0, float c1) __attribute__((always_inline)) { re[n1] = c0; im[n1] = c1; }); }
    SW_ENDA(25, swon, F.swacc);
#pragma unroll 1
    for (int o = 0; o < 2; ++o) {
        int lane_o = F.lane; asm volatile("" : "+v"(lane_o));
        const int lane = lane_o; const int k1 = rev6(lane);
#pragma unroll
        for (int n1 = 32; n1 < 64; ++n1) { re[n1] = 0.f; im[n1] = 0.f; }
        asm volatile("s_waitcnt lgkmcnt(0)" ::: "memory");
        SW_BEGIN(21, swon)
        wfft_fwd(re, im, wx, lane, swon, &F.swacc);
        SW_ENDA(21, swon, F.swacc);
        SW_BEGIN(22, swon)
        { const LAS unsigned char* bd = kfch + o * HY_KFO + k1 * 8; const LAS unsigned char* bm = kfch + o * HY_KFO + ((k1 ? 0 : 64) + ((64 - k1) & 63)) * 8;
#pragma unroll
          for (int s = 0; s < 64; ++s) { const int k0 = rev6(s);
              if (k0 < 32) { const f32x2 kv = *(const LAS f32x2*)(bd + k0 * 512); const float tr = re[s] * kv.x - im[s] * kv.y, ti = re[s] * kv.y + im[s] * kv.x; re[s] = tr; im[s] = ti; }
              else { const f32x2 kv = *(const LAS f32x2*)(bm + (63 - k0) * 512); const float tr = re[s] * kv.x + im[s] * kv.y, ti = im[s] * kv.x - re[s] * kv.y; re[s] = tr; im[s] = ti; }
              if ((s & 7) == 7) __builtin_amdgcn_sched_barrier(0); } }
        __builtin_amdgcn_sched_barrier(0);
        SW_ENDA(22, swon, F.swacc);
        SW_BEGIN(23, swon)
        wfft_inv(re, im, wx, lane, [&]() __attribute__((always_inline)) { hy_load2b(pre, o == 0 ? PX1 : PX2, lane); });
        SW_ENDA(23, swon, F.swacc);
        SW_BEGIN(24, swon)
        hy_commit2(pre, wxb, lane);
        asm volatile("s_waitcnt lgkmcnt(0)" ::: "memory");
        hy_load2a(pre, o == 0 ? PX2 : GH, lane); if (o == 1) hy_load2b(pre, GH, lane);
        { const int xo = (o + 1) * HYW + c; const float w0 = ((const GAS float*)cw)[xo], w1 = ((const GAS float*)cw)[3 * HYW + xo], w2 = ((const GAS float*)cw)[6 * HYW + xo], b = ((const GAS float*)cb)[xo];
          hy_sconv(wxb, lane, w0, w1, w2, b, [&](int n1, float g0, float g1) __attribute__((always_inline)) { re[n1] *= g0; im[n1] *= g1; }); }
        SW_ENDA(24, swon, F.swacc);
    }
    SW_BEGIN(26, swon)
    int lane_g = F.lane; asm volatile("" : "+v"(lane_g));
    hy_commit2(pre, wxb, lane_g);
    if (!dry)
#pragma unroll
    for (int blk = 0; blk < 2; ++blk) {
        unsigned gq[16][2];
#pragma unroll
        for (int i = 0; i < 16; ++i) { const int t = 64 * (16 * blk + i) + lane_g; gq[i][0] = *(const LAS unsigned short*)(wxb + 16 + 2 * t); gq[i][1] = *(const LAS unsigned short*)(wxb + HY_RAWROW + 16 + 2 * t); }
        asm volatile("s_waitcnt lgkmcnt(0)" ::: "memory");
        __builtin_amdgcn_sched_barrier(0);
#pragma unroll
        for (int i = 0; i < 16; ++i) { const int n1 = 16 * blk + i, t = 64 * n1 + lane_g; const float g0 = __uint_as_float(gq[i][0] << 16), g1 = __uint_as_float(gq[i][1] << 16);
            ((GAS bf16*)OUT)[t] = (bf16)f2bf(re[n1] * g0 * fast_sigmoid(g0)); ((GAS bf16*)OUT)[SEQ + t] = (bf16)f2bf(im[n1] * g1 * fast_sigmoid(g1)); }
        __builtin_amdgcn_sched_barrier(0);
    }
    asm volatile("s_waitcnt lgkmcnt(0)" ::: "memory");
    SW_ENDA(26, swon, F.swacc);
}
__device__ __forceinline__ void hy_quad(Frame& F, int l, int c0) {
    const int grp = F.wave >> 2, ws = F.wave & 3;
    LAS unsigned char* wxb = F.lds + HY_WX + F.wave * HY_WXB;
    LAS unsigned char* kf0 = F.lds + HY_KF; LAS unsigned char* kfch = kf0 + grp * HY_KFCH;
    LAS float* red = (LAS float*)(F.lds + HY_RED);
    float* tap2 = (float*)(F.ws + WS_R6) + (size_t)F.bx * 2 * 4 * SEQ;
    float* kf2 = F.out + (size_t)F.bx * (2 * HY_KFCH / 4);
    const bool swon = SW_ON(F.bx, F.wave);
    SW_BEGIN(33, swon)
    SW_BEGIN(30, swon)
    hy_filter_gen4(F, l, c0, kf0, tap2, red + 8 * F.wave);
    SW_ENDA(30, swon, F.swacc);
    SW_BEGIN(34, swon)
    VM_WAIT(); LDS_WAIT(); __syncthreads();
    SW_ENDA(34, swon, F.swacc);
    Stage2 pre;
    SW_BEGIN(35, swon)
    if (F.wave < 2) hy_filter_fft<false>(F, l, c0 + (HYW / 4) * F.wave, kf0 + F.wave * HY_KFCH, nullptr, nullptr, red + 2 * F.wave, (LAS float*)wxb);
    else if (F.wave < 4) hy_filter_fft<true>(F, l, c0 + (HYW / 4) * F.wave, kf0, tap2 + (size_t)(F.wave - 2) * 4 * SEQ, kf2 + (size_t)(F.wave - 2) * (HY_KFCH / 4), red + 2 * F.wave, (LAS float*)wxb);
    VM_WAIT();
    hy_load2(pre, (const bf16*)(F.ws + WS_R1) + (size_t)(c0 + (HYW / 4) * grp) * M + (size_t)(2 * ws) * SEQ, F.lane);
    LDS_WAIT(); __syncthreads();
    SW_ENDA(35, swon, F.swacc);
#pragma unroll 1
    for (int rnd = 0; rnd < 2; ++rnd) {
        const int c = c0 + (HYW / 4) * (2 * rnd + grp);
        SW_BEGIN(32, swon)
        if (rnd == 1) {
            const int t_ = F.wave * 64 + cur_lane();
            hy_load2(pre, (const bf16*)(F.ws + WS_R1) + (size_t)c * M + (size_t)(2 * ws) * SEQ, F.lane);
#pragma unroll
            for (int i = 0; i < 9; ++i) { const int q = t_ + 512 * i;
                if (q < 2 * HY_KFCH / 16) { const v4u v = *(const GAS v4u*)(kf2 + 4 * (size_t)q); *(LAS v4u*)(kf0 + 16 * q) = v; } }
            LDS_WAIT(); __syncthreads();
        }
        SW_ENDA(32, swon, F.swacc);
        SW_BEGIN(20, swon)
        hy_wave_main(F, l, c, ws, wxb, kfch, pre);
        SW_ENDA(20, swon, F.swacc);
        SW_BEGIN(36, swon)
        LDS_WAIT(); __syncthreads();
        SW_ENDA(36, swon, F.swacc);
    }
    SW_ENDA(33, swon, F.swacc);
}

__device__ __forceinline__ void transpose_pass(Frame& F) {
    const bf16* src = (const bf16*)(F.ws + WS_R1); bf16* dst = (bf16*)(F.ws + WS_R2);
    LAS unsigned char* tile = F.lds + F.wave * 18432; const int lane = F.lane;
    const int gw = F.bx * NWAVES + F.wave, NGW = F.G * NWAVES;
    constexpr int NTC = HYW / 64, NTT = M / 64;
    for (int it0 = 2 * gw; it0 < NTC * NTT; it0 += 2 * NGW) {
        v4u ld[2][8];
#pragma unroll
        for (int u = 0; u < 2; ++u) { const int it = it0 + u, c0 = (it % NTC) * 64, t0 = (it / NTC) * 64;
#pragma unroll
            for (int i = 0; i < 8; ++i) { const int q = lane + 64 * i, cr = q >> 3, ch = q & 7; ld[u][i] = *(const GAS v4u*)(src + (size_t)(c0 + cr) * M + t0 + 8 * ch); } }
#pragma unroll
        for (int u = 0; u < 2; ++u)
#pragma unroll
            for (int i = 0; i < 8; ++i) { const int q = lane + 64 * i, cr = q >> 3, ch = q & 7; *(LAS v4u*)(tile + u * 9216 + cr * 144 + 16 * ch) = ld[u][i]; }
        LDS_WAIT(); asm volatile("" ::: "memory");
#pragma unroll
        for (int u = 0; u < 2; ++u) { const int it = it0 + u, c0 = (it % NTC) * 64, t0 = (it / NTC) * 64;
#pragma unroll
            for (int i = 0; i < 8; ++i) { const int q = lane + 64 * i, tr = q >> 3, ch = q & 7;
                unsigned short e[8];
#pragma unroll
                for (int kk = 0; kk < 8; ++kk) e[kk] = *(const LAS unsigned short*)(tile + u * 9216 + (8 * ch + kk) * 144 + 2 * tr);
                v4u o; o.x = e[0] | ((unsigned)e[1] << 16); o.y = e[2] | ((unsigned)e[3] << 16); o.z = e[4] | ((unsigned)e[5] << 16); o.w = e[6] | ((unsigned)e[7] << 16);
                *(GAS v4u*)(dst + (size_t)(t0 + tr) * HYW + c0 + 8 * ch) = o; } }
        LDS_WAIT(); asm volatile("" ::: "memory");
    }
}
__device__ __forceinline__ void final_norm(Frame& F) {
    const int gw = F.bx * NWAVES + F.wave, NGW = F.G * NWAVES, lane = F.lane; const GAS f32x4* wv = (const GAS f32x4*)F.inp(26) + lane;
    f32x4 w[4];
#pragma unroll
    for (int j = 0; j < 4; ++j) w[j] = wv[64 * j];
    for (int m0 = 2 * gw; m0 < M; m0 += 2 * NGW) { f32x4 v[2][4];
#pragma unroll
        for (int r = 0; r < 2; ++r) { const GAS f32x4* xr = (const GAS f32x4*)(F.out + (size_t)(m0 + r) * D) + lane;
#pragma unroll
            for (int j = 0; j < 4; ++j) v[r][j] = xr[64 * j]; }
#pragma unroll
        for (int r = 0; r < 2; ++r) { float s = 0.f; GAS f32x4* xo = (GAS f32x4*)(F.out + (size_t)(m0 + r) * D) + lane;
#pragma unroll
            for (int j = 0; j < 4; ++j) s += (v[r][j].x * v[r][j].x + v[r][j].y * v[r][j].y) + (v[r][j].z * v[r][j].z + v[r][j].w * v[r][j].w);
            const float rs = 1.0f / sqrtf(wave_sum(s) * (1.0f / D) + 1e-6f);
#pragma unroll
            for (int j = 0; j < 4; ++j) xo[64 * j] = v[r][j] * rs * w[j]; } }
}

struct EpiOutNormB {
    static constexpr bool PERM = false, AFTER_DRAIN = false; static constexpr int SWID = 9;
    const bf16* xb; float* out; const float* nw; float* ssq; const XcdBarrier* bar; int wave; const unsigned char* swp;
    __device__ __forceinline__ void operator()(pg8::f32x4 (&acc)[2][2][4][2], const pg8::Unit& u, int wr, int wc, int fr, int fq) const {
        using pg8::f32x4; constexpr int HALF = pg8::HALF, BM = pg8::BM;
        const int lane = (fq << 4) | fr, row0 = u.pm * BM + wr * 64 + fr, col0 = u.pn * BM + wc * 32 + 4 * fq;
#pragma unroll
        for (int ai = 0; ai < 2; ++ai)
#pragma unroll
            for (int m = 0; m < 4; ++m) { const size_t r = (size_t)(row0 + ai * HALF + m * 16); float s = 0.f;
#pragma unroll
                for (int bj = 0; bj < 2; ++bj)
#pragma unroll
                    for (int n = 0; n < 2; ++n) { const v2u w = *(const GAS v2u*)(xb + r * 1024 + col0 + bj * HALF + n * 16);
                        f32x4 h = acc[ai][bj][m][n]; h[0] += __uint_as_float(w.x << 16); h[1] += __uint_as_float(w.x & 0xffff0000u); h[2] += __uint_as_float(w.y << 16); h[3] += __uint_as_float(w.y & 0xffff0000u); acc[ai][bj][m][n] = h;
                        s += (h[0] * h[0] + h[1] * h[1]) + (h[2] * h[2] + h[3] * h[3]); }
                s += __shfl_xor(s, 16); s += __shfl_xor(s, 32);
                if (fq == 0) ((GAS float*)ssq)[r * 16 + u.pn * 4 + wc] = s;
                asm volatile("" ::: "memory"); }
        xcd_barrier(*bar, wave);
        float swf = 1.0f;
#if defined(MK_SW_ID)
        { const unsigned long long cyc = __hip_atomic_load((unsigned long long*)swp, __ATOMIC_RELAXED, __HIP_MEMORY_SCOPE_AGENT); swf = 1.0f + sqrtf((float)cyc * (float)(MK_SW_SCALE)); }
#endif
        float mine[2];
#pragma unroll
        for (int i = 0; i < 2; ++i) { const int q = 2 * fq + i; mine[i] = pg8::rs_of(ssq, row0 + (q >> 2) * HALF + (q & 3) * 16); }
        f32x4 wv[2][2];
#pragma unroll
        for (int bj = 0; bj < 2; ++bj)
#pragma unroll
            for (int n = 0; n < 2; ++n) wv[bj][n] = *(const GAS f32x4*)(nw + col0 + bj * HALF + n * 16);
#pragma unroll
        for (int ai = 0; ai < 2; ++ai)
#pragma unroll
            for (int m = 0; m < 4; ++m) { const int q = ai * 4 + m; const float rs = swf * __shfl(mine[q & 1], ((q >> 1) << 4) | (lane & 15)); const size_t r = (size_t)(row0 + ai * HALF + m * 16);
#pragma unroll
                for (int bj = 0; bj < 2; ++bj)
#pragma unroll
                    for (int n = 0; n < 2; ++n) *(GAS f32x4*)(out + r * 1024 + col0 + bj * HALF + n * 16) = acc[ai][bj][m][n] * rs * wv[bj][n]; }
    }
};

struct Args { const float* in[27]; float* out; unsigned char* ws; int ph_lo, ph_hi; };
__global__ void __launch_bounds__(NTHREADS, 2) mk_fwd(Args args) {
    extern __shared__ __attribute__((aligned(16))) unsigned char lds[];
    Frame F; F.lds = (LAS unsigned char*)lds; F.wave = __builtin_amdgcn_readfirstlane(threadIdx.x >> 6); F.tid = 0; F.lane = 0; F.G = gridDim.x; F.bx = blockIdx.x;
    F.out = args.out; F.ws = args.ws;
    volatile LAS unsigned* MISC = (volatile LAS unsigned*)(F.lds + LDSCTL_OFF);
    if (threadIdx.x < 64) MISC[threadIdx.x] = 0u;
    if (threadIdx.x == 64) { LAS unsigned long long* tab = (LAS unsigned long long*)(F.lds + LDSCTL_OFF + 256);
#pragma unroll
        for (int i = 0; i < 27; ++i) tab[i] = (unsigned long long)args.in[i]; tab[28] = (unsigned long long)args.ws; }
    __syncthreads();
    XcdBarrier bar; bar.bar = (unsigned*)(F.ws + WS_CTL) + 1024; bar.x = 0; bar.st = nullptr;
    if (!MK_PER_PHASE) bar = xcd_barrier_post((unsigned*)(F.ws + WS_CTL) + 1024, MISC + 8, threadIdx.x == 0);
    const int lo = args.ph_lo, hi = args.ph_hi;
#define IN(k) (lo <= (k) && (k) < hi)
#if defined(MK_TIMING)
    unsigned long long* TS = (unsigned long long*)(F.ws + WS_CTL + 32768);
#define STAMP(k) do { if (blockIdx.x == 0 && threadIdx.x == 0) __hip_atomic_store(&TS[k], (unsigned long long)__builtin_amdgcn_s_memrealtime(), __ATOMIC_RELAXED, __HIP_MEMORY_SCOPE_AGENT); } while (0)
#else
#define STAMP(k) do { } while (0)
#endif
#define SEAM(k) do { if (IN(k) && IN((k) + 1)) xcd_barrier(bar, F.wave); STAMP((k) + 1); } while (0)
    LAS unsigned char* ring = F.lds;
    STAMP(0);
#ifndef MK_ONLY
#define MK_ONLY -1
#endif
#define ON(k) (MK_ONLY < 0 || MK_ONLY == (k))
#define FRAME_P0(Fp) Frame Fp = F; { int l_ = cur_lane(); asm volatile("" : "+v"(l_)); Fp.lane = l_; Fp.tid = F.wave * 64 + l_; Fp.ws = wsl; }
#ifndef MK_REP0
#define MK_REP0 1
#endif
    const bool swk = SW_ON(F.bx, F.wave);
    { SW_BEGIN(60, swk)
#pragma unroll 1
    for (int rep0 = 0; rep0 < MK_REP0; ++rep0)
    if (ON(0) && IN(0)) { unsigned char* wsl = F.ws; FRAME_P0(Fp); p0_prologue(Fp); }
    SW_END(60, swk, F.ws); }
    { SW_BEGIN(67, swk) SEAM(0); SW_END(67, swk, F.ws); }
    bool fused_final = false;
#pragma unroll 1
    for (int l = 0; l < DEPTH; ++l) {
        const int pb = 1 + 5 * l;
        unsigned char* wsl = F.ws; asm volatile("" : "+s"(wsl));
#define WSL(off) (wsl + (off))
#define OPQ(p) asm volatile("" : "+s"(p))
#define FRAME_P(Fp) Frame Fp = F; { int l_ = cur_lane(); asm volatile("" : "+v"(l_)); Fp.lane = l_; Fp.tid = F.wave * 64 + l_; Fp.ws = wsl; }
        bf16* wl = (bf16*)WSL(WS_W + (size_t)l * W_LAYER);
        bf16* X = (bf16*)WSL(WS_X); float* ssq = (float*)WSL(WS_SSQ);
        bf16 *R1 = (bf16*)WSL(WS_R1), *R2 = (bf16*)WSL(WS_R2), *R3 = (bf16*)WSL(WS_R3), *R5 = (bf16*)WSL(WS_R5), *R6 = (bf16*)WSL(WS_R6);
#ifndef MK_REP1
#define MK_REP1 1
#define MK_REP12 1
#define MK_REP3 1
#define MK_REP4 1
#endif
#pragma unroll 1
        for (int rep12 = 0; rep12 < MK_REP12; ++rep12) {
        { SW_BEGIN(61, swk)
#pragma unroll 1
        for (int rep1 = 0; rep1 < MK_REP1; ++rep1)
        if (ON(1) && IN(pb)) {
            { pg8::Gemm g{wl + W_IN / 2, X, 4096, M, D, D, D}; pg8::StaticOrder S; S.init(4096, M, F.G, F.bx); pg8::EpiHT E{R1, M, ssq};
              pg8::gemm_phase<pg8::EpiHT, pg8::StaticOrder, true, true, 1024, 1024, 1024>(ring, g, S, E, F.wave); }
            OPQ(X); OPQ(wl);
            { pg8::Gemm g{X, wl + W_IN / 2 + (size_t)4096 * D, M, 1024, D, D, D}; pg8::StaticOrder S; S.init(M, 1024, F.G, F.bx); pg8::EpiRow<0> E{R5, 1024, ssq};
              pg8::gemm_phase<pg8::EpiRow<0>, pg8::StaticOrder, true, true, 1024, 1024, 1024>(ring, g, S, E, F.wave); }
        }
        SW_END(61, swk, F.ws); }
        { SW_BEGIN(67, swk) SEAM(pb); SW_END(67, swk, F.ws); }
        if (IN(pb + 1)) {
#if defined(MK_S5DRY)
            if (ON(2)) { FRAME_P(Fq); for (int it = F.bx; it < BATCH * S5G; it += F.G) s5_item(Fq, l, it / S5G, it % S5G, true); }
#endif
            { SW_BEGIN(62, swk) if (ON(2)) { FRAME_P(Fp); for (int it = F.bx; it < BATCH * S5G; it += F.G) s5_item(Fp, l, it / S5G, it % S5G); } SW_END(62, swk, F.ws); }
            { SW_BEGIN(63, swk) if (ON(3)) { FRAME_P(Fp); for (int c0 = F.bx; c0 < HYW / 4; c0 += F.G) hy_quad(Fp, l, c0); SW_FLUSH(SW_ON(Fp.bx, Fp.wave), Fp.ws, Fp.swacc); } SW_END(63, swk, F.ws); }
        }
        if (rep12 + 1 < MK_REP12) xcd_barrier(bar, F.wave);
        }
        { SW_BEGIN(67, swk) SEAM(pb + 1); SW_END(67, swk, F.ws); }
        { SW_BEGIN(64, swk)
#pragma unroll 1
        for (int rep3 = 0; rep3 < MK_REP3; ++rep3)
        if (ON(4) && IN(pb + 2)) {
            { pg8::Gemm g{X, wl + W_IN / 2 + (size_t)5120 * D, M, 2048, D, D, D}; pg8::StaticOrder S; S.init(M, 2048, F.G, F.bx); pg8::EpiRow<1> E{R3, 2048, ssq};
              pg8::gemm_phase<pg8::EpiRow<1>, pg8::StaticOrder, true, true, 1024, 1024, 1024>(ring, g, S, E, F.wave); }
            OPQ(R5); OPQ(wl);
            { pg8::Gemm g{R5, wl + W_GLU / 2, M, S5W, S5W, 1024, S5W}; pg8::StaticOrder S; S.init(M, S5W, F.G, F.bx); pg8::EpiGLU E{R6, S5W, R5, 1024, F.inp(12) + l * S5W};
              pg8::gemm_phase<pg8::EpiGLU, pg8::StaticOrder, true, true, 512, 1024, 512>(ring, g, S, E, F.wave); }
            __syncthreads();
            { SW_BEGIN(68, swk) { FRAME_P(Fp); transpose_pass(Fp); } SW_END(68, swk, F.ws); }
            __syncthreads();
        }
        SW_END(64, swk, F.ws); }
        { SW_BEGIN(67, swk) SEAM(pb + 2); SW_END(67, swk, F.ws); }
        { SW_BEGIN(65, swk)
#pragma unroll 1
        for (int rep4 = 0; rep4 < MK_REP4; ++rep4)
        if (ON(5) && IN(pb + 3)) {
            { pg8::Gemm g{R6, wl + W_BS5 / 2, M, D, S5W, S5W, S5W}; pg8::StaticOrder S; S.init(M, D, F.G, F.bx); pg8::EpiMerge<0> E{R1, D, R3, 2048, 0};
              pg8::gemm_phase<pg8::EpiMerge<0>, pg8::StaticOrder, true, true, 512, 512, 512>(ring, g, S, E, F.wave); }
            VM_WAIT(); __syncthreads();
            OPQ(R2); OPQ(wl);
            { pg8::Gemm g{R2, wl + W_BHY / 2, M, D, HYW, HYW, HYW}; pg8::StaticOrder S; S.init(M, D, F.G, F.bx); pg8::EpiMerge<1> E{R1, D, R3, 2048, 1024};
              pg8::gemm_phase<pg8::EpiMerge<1>, pg8::StaticOrder, true, true, 1024, 1024, 1024>(ring, g, S, E, F.wave); }
        }
        SW_END(65, swk, F.ws); }
        { SW_BEGIN(67, swk) SEAM(pb + 3); SW_END(67, swk, F.ws); }
        { SW_BEGIN(66, swk)
        if (ON(6) && IN(pb + 4)) {
            pg8::Gemm g{R1, wl + W_OUT / 2, M, D, D, D, D}; pg8::StaticOrder S; S.init(M, D, F.G, F.bx);
            if (l == 0 && DEPTH > 1) { pg8::EpiOut<true, false> E{F.inp(0), X, F.out, X, ssq};
                pg8::gemm_phase<pg8::EpiOut<true, false>, pg8::StaticOrder, true, true, 1024, 1024, 1024>(ring, g, S, E, F.wave); }
            else if (l < DEPTH - 1) { pg8::EpiOut<false, false> E{nullptr, X, F.out, X, ssq};
                pg8::gemm_phase<pg8::EpiOut<false, false>, pg8::StaticOrder, true, true, 1024, 1024, 1024>(ring, g, S, E, F.wave); }
            else if (MK_PER_PHASE || F.G * 256 != (M / 256) * D) { pg8::EpiOut<false, true> E{nullptr, X, F.out, X, ssq};
                pg8::gemm_phase<pg8::EpiOut<false, true>, pg8::StaticOrder, true, true, 1024, 1024, 1024>(ring, g, S, E, F.wave); }
            else { EpiOutNormB E{X, F.out, F.inp(26), ssq, &bar, F.wave, wsl + WS_CTL + 48 * 1024};
                pg8::gemm_phase<EpiOutNormB, pg8::StaticOrder, true, true, 1024, 1024, 1024>(ring, g, S, E, F.wave); fused_final = true; }
        }
        if (l == 0) SW_END(66, swk, F.ws); }
        if (!fused_final) { SW_BEGIN(67, swk) SEAM(pb + 4); SW_END(67, swk, F.ws); }
    }
    if (ON(7) && IN(11) && !fused_final) { unsigned char* wsl = F.ws; FRAME_P0(Fp); final_norm(Fp); }
#if defined(MK_TIMING)
    xcd_barrier(bar, F.wave); STAMP(12); xcd_barrier(bar, F.wave);
    { const unsigned long long a0 = __hip_atomic_load(&TS[MK_TA0], __ATOMIC_RELAXED, __HIP_MEMORY_SCOPE_AGENT), a1 = __hip_atomic_load(&TS[MK_TA1], __ATOMIC_RELAXED, __HIP_MEMORY_SCOPE_AGENT);
      const unsigned long long b0 = __hip_atomic_load(&TS[MK_TB0], __ATOMIC_RELAXED, __HIP_MEMORY_SCOPE_AGENT), b1 = __hip_atomic_load(&TS[MK_TB1], __ATOMIC_RELAXED, __HIP_MEMORY_SCOPE_AGENT);
      const float ta = (float)(a1 - a0) * 0.01f, tb = (float)(b1 - b0) * 0.01f;
      const float c = sqrtf(ta * 0.1f);
      for (size_t i = (size_t)blockIdx.x * NTHREADS + threadIdx.x; i < (size_t)M * D; i += (size_t)gridDim.x * NTHREADS) F.out[i] = (i == 0) ? tb : c; }
#endif
#undef IN
#undef SEAM
}

#if defined(MK_DEBUG_HASH)
extern "C" void kernel_launch_dbg(void* const* d_in, void* d_out, void* d_ws, hipStream_t stream, int grid);
#endif
extern "C" void kernel_launch(void* const* d_in, const int* in_sizes, int n_in, void* d_out, int out_size, void* d_ws, size_t ws_size, hipStream_t stream) {
    static int grid = 0;
    if (grid == 0) {
        if (n_in != 27 || out_size != M * D || ws_size < WS_END) { fprintf(stderr, "kernel_launch: unexpected shapes (n_in %d out %d ws %zu)\n", n_in, out_size, ws_size); grid = -1; return; }
        int dev = 0, cus = 0, per_cu = 0;
        if (hipGetDevice(&dev) != hipSuccess || hipDeviceGetAttribute(&cus, hipDeviceAttributeMultiprocessorCount, dev) != hipSuccess) { grid = -1; return; }
        if (hipFuncSetAttribute((const void*)mk_fwd, hipFuncAttributeMaxDynamicSharedMemorySize, LDS_BYTES) != hipSuccess) { fprintf(stderr, "kernel_launch: hipFuncSetAttribute failed\n"); grid = -1; return; }
        if (hipOccupancyMaxActiveBlocksPerMultiprocessor(&per_cu, (const void*)mk_fwd, NTHREADS, LDS_BYTES) != hipSuccess || per_cu < 1) fprintf(stderr, "kernel_launch: occupancy query says %d\n", per_cu);
        (void)hipGetLastError();
        grid = cus;
    }
    if (grid < 0) return;
    (void)hipMemsetAsync((char*)d_ws + WS_CTL, 0, CTL_ZERO_BYTES, stream);
    Args a{};
    for (int i = 0; i < 27; ++i) a.in[i] = (const float*)d_in[i];
    a.out = (float*)d_out; a.ws = (unsigned char*)d_ws;
#if defined(MK_DEBUG_HASH)
    kernel_launch_dbg(d_in, d_out, d_ws, stream, grid);
#elif MK_PER_PHASE
    for (int p = 0; p < NPHASE; ++p) { a.ph_lo = p; a.ph_hi = p + 1; hipLaunchKernelGGL(mk_fwd, dim3(grid), dim3(NTHREADS), LDS_BYTES, stream, a); }
#else
    a.ph_lo = 0; a.ph_hi = NPHASE; hipLaunchKernelGGL(mk_fwd, dim3(grid), dim3(NTHREADS), LDS_BYTES, stream, a);
#endif
}

#if defined(MK_DEBUG_HASH)
__global__ void dbg_hash(const unsigned* p, size_t nwords, unsigned long long* out) {
    unsigned long long s = 0; for (size_t i = (size_t)blockIdx.x * blockDim.x + threadIdx.x; i < nwords; i += (size_t)gridDim.x * blockDim.x) s += p[i];
    atomicAdd(out, s);
}
__global__ void dbg_report(const unsigned long long* h, float* out, size_t n) {
    int first = -1; for (int p = 0; p < NPHASE && first < 0; ++p) for (int r = 0; r < 4; ++r) if (h[p * 4 + r] != h[NPHASE * 4 + p * 4 + r]) { first = p; break; }
    const float c = first < 0 ? 0.f : sqrtf((float)(first + 1));
    for (size_t i = (size_t)blockIdx.x * blockDim.x + threadIdx.x; i < n; i += (size_t)gridDim.x * blockDim.x) out[i] = c;
}
extern "C" void kernel_launch_dbg(void* const* d_in, void* d_out, void* d_ws, hipStream_t stream, int grid) {
    Args a{}; for (int i = 0; i < 27; ++i) a.in[i] = (const float*)d_in[i];
    a.out = (float*)d_out; a.ws = (unsigned char*)d_ws;
    unsigned long long* H = (unsigned long long*)((char*)d_ws + 253 * MiB);
    (void)hipMemsetAsync(H, 0, 2 * NPHASE * 4 * 8, stream);
    struct Reg { size_t off, len; bool out; };
    auto regs_of = [&](int p, Reg (&r)[4]) { for (int i = 0; i < 4; ++i) r[i] = Reg{0, 0, false};
        if (p == 0) { r[0] = Reg{1 * MiB, 1 * MiB, false}; r[1] = Reg{2 * MiB, 1 * MiB + 64 * 1024, false}; r[2] = Reg{4 * MiB, 39 * MiB, false}; r[3] = Reg{43 * MiB, 33 * MiB, false}; return; }
        if (p == 11) { r[0] = Reg{0, (size_t)M * D * 4, true}; return; }
        const int q = (p - 1) % 5;
        if (q == 0) { r[0] = Reg{WS_R1, 128 * MiB, false}; r[1] = Reg{WS_R5, 32 * MiB, false}; }
        if (q == 1) { r[0] = Reg{WS_R1, 32 * MiB, false}; r[1] = Reg{WS_R5, 32 * MiB, false}; }
        if (q == 2) { r[0] = Reg{WS_R3, 64 * MiB, false}; r[1] = Reg{WS_R6, 16 * MiB, false}; r[2] = Reg{WS_R2, 32 * MiB, false}; }
        if (q == 3) { r[0] = Reg{WS_R1, 32 * MiB, false}; }
        if (q == 4) { r[0] = Reg{0, (size_t)M * D * 4, true}; r[1] = Reg{WS_X, 32 * MiB, false}; r[2] = Reg{WS_SSQ, 1 * MiB, false}; } };
    for (int run = 0; run < 2; ++run) {
        if (run == 0) (void)hipMemsetAsync((char*)d_ws + 1 * MiB, 0xAA, 251 * MiB, stream);
        (void)hipMemsetAsync((char*)d_ws + WS_CTL, 0, CTL_ZERO_BYTES, stream);
        for (int p = 0; p < NPHASE; ++p) { a.ph_lo = p; a.ph_hi = p + 1; hipLaunchKernelGGL(mk_fwd, dim3(grid), dim3(NTHREADS), LDS_BYTES, stream, a);
            Reg r[4]; regs_of(p, r);
            for (int i = 0; i < 4; ++i) if (r[i].len) hipLaunchKernelGGL(dbg_hash, dim3(1024), dim3(256), 0, stream, (const unsigned*)((r[i].out ? (char*)d_out : (char*)d_ws) + r[i].off), r[i].len / 4, H + (run * NPHASE + p) * 4 + i); }
    }
    hipLaunchKernelGGL(dbg_report, dim3(1024), dim3(256), 0, stream, H, (float*)d_out, (size_t)M * D);
}
#endif
```

```cpp
#include <hip/hip_runtime.h>
#include <cstdio>
#include <cstdint>
#include <cmath>
#include <utility>
#if defined(MK_SW_ID)
#ifndef MK_SW_BLOCK
#define MK_SW_BLOCK 37
#endif
#ifndef MK_SW_WAVE
#define MK_SW_WAVE 2
#endif
#ifndef MK_SW_LAYER
#define MK_SW_LAYER -1
#endif
#ifndef MK_SW_REAL
#define MK_SW_REAL 0
#endif
__device__ __forceinline__ unsigned long long sw_stamp() { unsigned long long t; __builtin_amdgcn_sched_barrier(0);
    if (MK_SW_REAL) asm volatile("s_memrealtime %0\n\ts_waitcnt lgkmcnt(0)" : "=s"(t) :: "memory"); else asm volatile("s_memtime %0\n\ts_waitcnt lgkmcnt(0)" : "=s"(t) :: "memory");
    __builtin_amdgcn_sched_barrier(0); return t; }
#define SW_ON(bx, wave) ((bx) == MK_SW_BLOCK && (wave) == MK_SW_WAVE)
#define SW_BEGIN(id, on) unsigned long long sw_b_##id = 0; if ((id) == MK_SW_ID) sw_b_##id = sw_stamp();
#define SW_END(id, on, wsp) do { if ((id) == MK_SW_ID && (on)) { const unsigned long long d_ = sw_stamp() - sw_b_##id; int l_; asm volatile("v_mbcnt_lo_u32_b32 %0, -1, 0\n\tv_mbcnt_hi_u32_b32 %0, -1, %0" : "=&v"(l_)); \
    if (l_ == 0) atomicAdd((unsigned long long*)((wsp) + 48 * 1024), d_); } } while (0)
#define SW_ENDA(id, on, acc) do { if ((id) == MK_SW_ID) (acc) += (sw_stamp() - sw_b_##id) & ((on) ? ~0ull : 0ull); } while (0)
#define SW_FLUSH(on, wsp, acc) do { if (on) { int l_; asm volatile("v_mbcnt_lo_u32_b32 %0, -1, 0\n\tv_mbcnt_hi_u32_b32 %0, -1, %0" : "=&v"(l_)); if (l_ == 0) atomicAdd((unsigned long long*)((wsp) + 48 * 1024), (acc)); (acc) = 0; } } while (0)
#define SW_WSSLOT (163584 - 512 + 480)
#define SW_BEGIN_N(nm, idx) unsigned long long sw_n_##nm = 0; if ((idx) == MK_SW_ID) sw_n_##nm = sw_stamp();
#define SW_END_N(nm, idx, on, wsp) do { if ((idx) == MK_SW_ID && (on)) { const unsigned long long d_ = sw_stamp() - sw_n_##nm; int l_; asm volatile("v_mbcnt_lo_u32_b32 %0, -1, 0\n\tv_mbcnt_hi_u32_b32 %0, -1, %0" : "=&v"(l_)); if (l_ == 0) atomicAdd((unsigned long long*)((wsp) + 48 * 1024), d_); } } while (0)
#else
#define MK_SW_LAYER -1
#define SW_ON(bx, wave) false
#define SW_BEGIN(id, on)
#define SW_END(id, on, wsp) do { } while (0)
#define SW_ENDA(id, on, acc) do { } while (0)
#define SW_FLUSH(on, wsp, acc) do { } while (0)
#define SW_BEGIN_N(nm, idx)
#define SW_END_N(nm, idx, on, wsp) do { } while (0)
#endif
namespace pg8 {
#define PG8_LAS __attribute__((address_space(3)))
typedef unsigned short bf16_t;
typedef short bf16x8 __attribute__((ext_vector_type(8)));
typedef float f32x4 __attribute__((ext_vector_type(4)));
typedef unsigned u32x4 __attribute__((ext_vector_type(4)));
constexpr int BM = 256, BK = 64, HALF = 128, HTB = HALF * BK * 2  , STAGE_BYTES = 8 * HTB, NXCD = 8, WGM = 8;

__host__ __device__ __forceinline__ int lds_byte(int r, int c) { const int st = (r >> 4) * 2 + (c >> 5), rr = r & 15, cc = c & 31, ob = rr * 64 + cc * 2; return st * 1024 + (ob ^ (((ob >> 9) & 1) << 5)); }
__host__ __device__ __forceinline__ void stage_rc(int b, int& R, int& C) { const int st = b / 1024, sb = b % 1024, swz = sb ^ (((sb >> 9) & 1) << 5); R = (st >> 1) * 16 + swz / 64; C = (st & 1) * 32 + (swz % 64) / 2; }
__host__ __device__ __forceinline__ int perm32(int rho) { const int n = rho >> 4, i = rho & 15; return 8 * (i >> 2) + 4 * n + (i & 3); }

struct Unit { int pm, pn; };
struct Gemm { const bf16_t* A; const bf16_t* Bt; int M, N, K, lda, ldb; };

struct StaticOrder {
    int nM, nN, nwg, G, c;
    __host__ __device__ void init(int M, int N, int G_, int c_) { nM = M / BM; nN = N / BM; nwg = nM * nN; G = G_; c = c_; }
    __host__ __device__ bool next(int i, Unit& u) const {
        const long L = (long)i * G + c; if (L >= nwg) return false;
        int wgid = (int)L; { const int q = nwg / NXCD, r = nwg % NXCD, xcd = wgid % NXCD, off = wgid / NXCD; wgid = (xcd < r ? xcd * (q + 1) : r * (q + 1) + (xcd - r) * q) + off; }
        const int nig = WGM * nN, gid = wgid / nig, fm = gid * WGM, gsz = (nM - fm) < WGM ? (nM - fm) : WGM;
        u.pm = fm + ((wgid % nig) % gsz); u.pn = (wgid % nig) / gsz; return true;
    }
    __device__ __forceinline__ void a_ready(const Unit&) const {}
    __device__ __forceinline__ void done(const Unit&) const {}
};

typedef unsigned u32x2 __attribute__((ext_vector_type(2)));

typedef __bf16 bf16x2_t __attribute__((ext_vector_type(2)));
typedef float f32x2_t __attribute__((ext_vector_type(2)));
__device__ __forceinline__ unsigned cvt_pk_bf16(float lo, float hi) { const f32x2_t v = {lo, hi}; const bf16x2_t b = __builtin_convertvector(v, bf16x2_t); return __builtin_bit_cast(unsigned, b); }
__device__ __forceinline__ float bf_lo(unsigned w) { return __uint_as_float(w << 16); }
__device__ __forceinline__ float bf_hi(unsigned w) { return __uint_as_float(w & 0xffff0000u); }
__device__ __forceinline__ float fast_sigmoid(float x) { return __builtin_amdgcn_rcpf(1.0f + __builtin_amdgcn_exp2f(-1.4426950408889634f * x)); }
constexpr float RMS_EPS = 1e-6f;
#define GAS_ __attribute__((address_space(1)))
__device__ __forceinline__ float rs_of(const float* ssq, int tok) {
    const GAS_ f32x4* p = (const GAS_ f32x4*)(ssq + (size_t)tok * 16); const f32x4 a = p[0], b = p[1], c = p[2], d = p[3];
    const float s = ((a[0] + a[1]) + (a[2] + a[3])) + ((b[0] + b[1]) + (b[2] + b[3])) + ((c[0] + c[1]) + (c[2] + c[3])) + ((d[0] + d[1]) + (d[2] + d[3]));
    return 1.0f / sqrtf(s * (1.0f / 1024.0f) + RMS_EPS);
}
struct EpiHT {
    static constexpr bool PERM = true, AFTER_DRAIN = false; static constexpr int SWID = 0;
    bf16_t* O; int ldc; const float* ssq;
    __device__ __forceinline__ void operator()(const f32x4 (&acc)[2][2][4][2], const Unit& u, int wr, int wc, int fr, int fq) const {
        const int lane = (fq << 4) | fr;
        const int ctile = u.pn * BM + wc * 32 + 8 * fq;
        const float mine = rs_of(ssq, ctile + 128 * (fr >> 3) + (fr & 7));
        const int row0 = u.pm * BM + wr * 64 + fr;
#pragma unroll
        for (int bj = 0; bj < 2; ++bj) { float rsv[8];
#pragma unroll
            for (int i = 0; i < 8; ++i) rsv[i] = __shfl(mine, (lane & 48) | (8 * bj + i));
#pragma unroll
            for (int ai = 0; ai < 2; ++ai)
#pragma unroll
                for (int m = 0; m < 4; ++m) { bf16_t* rowp = O + (size_t)(row0 + ai * HALF + m * 16) * ldc + ctile + bj * HALF;
                    const f32x4 v0 = acc[ai][bj][m][0], v1 = acc[ai][bj][m][1]; u32x4 w;
                    w.x = cvt_pk_bf16(v0[0] * rsv[0], v0[1] * rsv[1]); w.y = cvt_pk_bf16(v0[2] * rsv[2], v0[3] * rsv[3]);
                    w.z = cvt_pk_bf16(v1[0] * rsv[4], v1[1] * rsv[5]); w.w = cvt_pk_bf16(v1[2] * rsv[6], v1[3] * rsv[7]);
                    *(GAS_ u32x4*)rowp = w; }
            asm volatile("" ::: "memory"); }
    }
};
template <int SIG> struct EpiRow {
    static constexpr bool PERM = true, AFTER_DRAIN = false; static constexpr int SWID = 1;
    bf16_t* O; int ldc; const float* ssq;
    __device__ __forceinline__ void operator()(const f32x4 (&acc)[2][2][4][2], const Unit& u, int wr, int wc, int fr, int fq) const {
        const int lane = (fq << 4) | fr;
        const int row0 = u.pm * BM + wr * 64 + fr;
        float mine[2];
#pragma unroll
        for (int i = 0; i < 2; ++i) { const int q = 2 * fq + i; mine[i] = rs_of(ssq, row0 + (q >> 2) * HALF + (q & 3) * 16); }
        const int col0 = u.pn * BM + wc * 32 + 8 * fq;
#pragma unroll
        for (int ai = 0; ai < 2; ++ai)
#pragma unroll
            for (int m = 0; m < 4; ++m) { const int q = ai * 4 + m; const float rs = __shfl(mine[q & 1], ((q >> 1) << 4) | (lane & 15));
                bf16_t* rowp = O + (size_t)(row0 + ai * HALF + m * 16) * ldc + col0;
#pragma unroll
                for (int bj = 0; bj < 2; ++bj) { f32x4 v0 = acc[ai][bj][m][0] * rs, v1 = acc[ai][bj][m][1] * rs;
                    if (SIG) {
#pragma unroll
                        for (int e = 0; e < 4; ++e) { v0[e] = fast_sigmoid(v0[e]); v1[e] = fast_sigmoid(v1[e]); } }
                    u32x4 w; w.x = cvt_pk_bf16(v0[0], v0[1]); w.y = cvt_pk_bf16(v0[2], v0[3]); w.z = cvt_pk_bf16(v1[0], v1[1]); w.w = cvt_pk_bf16(v1[2], v1[3]);
                    *(GAS_ u32x4*)(rowp + bj * HALF) = w; }
                asm volatile("" ::: "memory"); }
    }
};
struct EpiGLU {
    static constexpr bool PERM = true, AFTER_DRAIN = false; static constexpr int SWID = 2;
    bf16_t* O; int ldc; const bf16_t* YG; int ldy; const float* bglu;
    __device__ __forceinline__ void operator()(const f32x4 (&acc)[2][2][4][2], const Unit& u, int wr, int wc, int fr, int fq) const {
        const int row0 = u.pm * BM + wr * 64 + fr, col0 = u.pn * BM + wc * 32 + 8 * fq;
        f32x4 bv[2][2];
#pragma unroll
        for (int bj = 0; bj < 2; ++bj)
#pragma unroll
            for (int n = 0; n < 2; ++n) bv[bj][n] = *(const GAS_ f32x4*)(bglu + col0 + bj * HALF + 4 * n);
#pragma unroll
        for (int ai = 0; ai < 2; ++ai)
#pragma unroll
            for (int mp = 0; mp < 2; ++mp) {
                u32x4 yv[2][2], gv[2][2];
#pragma unroll
                for (int mm = 0; mm < 2; ++mm)
#pragma unroll
                    for (int bj = 0; bj < 2; ++bj) { const size_t r = (size_t)(row0 + ai * HALF + (2 * mp + mm) * 16); const int c = col0 + bj * HALF;
                        yv[mm][bj] = *(const GAS_ u32x4*)(YG + r * ldy + c); gv[mm][bj] = *(const GAS_ u32x4*)(YG + r * ldy + 512 + c); }
#pragma unroll
                for (int mm = 0; mm < 2; ++mm)
#pragma unroll
                    for (int bj = 0; bj < 2; ++bj) { const int m = 2 * mp + mm; const size_t r = (size_t)(row0 + ai * HALF + m * 16); const int c = col0 + bj * HALF;
                        const f32x4 a0 = acc[ai][bj][m][0] + bv[bj][0], a1 = acc[ai][bj][m][1] + bv[bj][1];
                        const u32x4 yq = yv[mm][bj], gq = gv[mm][bj];
                        float o[8]; const unsigned yw[4] = {yq.x, yq.y, yq.z, yq.w}, gw[4] = {gq.x, gq.y, gq.z, gq.w};
#pragma unroll
                        for (int e = 0; e < 8; ++e) { const float a = e < 4 ? a0[e & 3] : a1[e & 3]; const float y = (e & 1) ? bf_hi(yw[e >> 1]) : bf_lo(yw[e >> 1]);
                            const float g = (e & 1) ? bf_hi(gw[e >> 1]) : bf_lo(gw[e >> 1]); o[e] = y * fast_sigmoid(a) * (g * fast_sigmoid(g)); }
                        u32x4 w; w.x = cvt_pk_bf16(o[0], o[1]); w.y = cvt_pk_bf16(o[2], o[3]); w.z = cvt_pk_bf16(o[4], o[5]); w.w = cvt_pk_bf16(o[6], o[7]);
                        *(GAS_ u32x4*)(O + r * ldc + c) = w; }
                asm volatile("" ::: "memory"); }
    }
};
template <int ADD> struct EpiMerge {
    static constexpr bool PERM = true, AFTER_DRAIN = false; static constexpr int SWID = 3;
    bf16_t* O; int ldc; const bf16_t* G; int ldg; int goff;
    __device__ __forceinline__ void operator()(const f32x4 (&acc)[2][2][4][2], const Unit& u, int wr, int wc, int fr, int fq) const {
        const int row0 = u.pm * BM + wr * 64 + fr, col0 = u.pn * BM + wc * 32 + 8 * fq;
#pragma unroll
        for (int ai = 0; ai < 2; ++ai)
#pragma unroll
            for (int mp = 0; mp < 2; ++mp) {
                u32x4 gv[2][2], tv[2][2];
#pragma unroll
                for (int mm = 0; mm < 2; ++mm)
#pragma unroll
                    for (int bj = 0; bj < 2; ++bj) { const size_t r = (size_t)(row0 + ai * HALF + (2 * mp + mm) * 16); const int c = col0 + bj * HALF;
                        gv[mm][bj] = *(const GAS_ u32x4*)(G + r * ldg + goff + c); tv[mm][bj] = (u32x4){0u, 0u, 0u, 0u}; if (ADD) tv[mm][bj] = *(const GAS_ u32x4*)(O + r * ldc + c); }
#pragma unroll
                for (int mm = 0; mm < 2; ++mm)
#pragma unroll
                    for (int bj = 0; bj < 2; ++bj) { const int m = 2 * mp + mm; const size_t r = (size_t)(row0 + ai * HALF + m * 16); const int c = col0 + bj * HALF;
                        const f32x4 a0 = acc[ai][bj][m][0], a1 = acc[ai][bj][m][1];
                        float o[8]; const unsigned gw[4] = {gv[mm][bj].x, gv[mm][bj].y, gv[mm][bj].z, gv[mm][bj].w}, tw[4] = {tv[mm][bj].x, tv[mm][bj].y, tv[mm][bj].z, tv[mm][bj].w};
#pragma unroll
                        for (int e = 0; e < 8; ++e) { const float a = e < 4 ? a0[e & 3] : a1[e & 3]; const float g = (e & 1) ? bf_hi(gw[e >> 1]) : bf_lo(gw[e >> 1]);
                            const float t = (e & 1) ? bf_hi(tw[e >> 1]) : bf_lo(tw[e >> 1]); o[e] = (ADD ? t : 0.f) + g * a; }
                        u32x4 w; w.x = cvt_pk_bf16(o[0], o[1]); w.y = cvt_pk_bf16(o[2], o[3]); w.z = cvt_pk_bf16(o[4], o[5]); w.w = cvt_pk_bf16(o[6], o[7]);
                        *(GAS_ u32x4*)(O + r * ldc + c) = w; }
                asm volatile("" ::: "memory"); }
    }
};
template <bool F32IN, bool LAST>
struct EpiOut {
    static constexpr bool PERM = false, AFTER_DRAIN = false; static constexpr int SWID = 4;
    const float* base; const bf16_t* baseb; float* H; bf16_t* XN; float* ssq;
    __device__ __forceinline__ void operator()(const f32x4 (&acc)[2][2][4][2], const Unit& u, int wr, int wc, int fr, int fq) const {
        const int row0 = u.pm * BM + wr * 64 + fr, col0 = u.pn * BM + wc * 32 + 4 * fq;
#pragma unroll
        for (int ai = 0; ai < 2; ++ai)
#pragma unroll
            for (int m = 0; m < 4; ++m) { const size_t r = (size_t)(row0 + ai * HALF + m * 16); float s = 0.f;
                f32x4 h[2][2];
#pragma unroll
                for (int bj = 0; bj < 2; ++bj)
#pragma unroll
                    for (int n = 0; n < 2; ++n) { const size_t off = r * 1024 + col0 + bj * HALF + n * 16;
                        if constexpr (F32IN) h[bj][n] = *(const GAS_ f32x4*)(base + off);
                        else { const u32x2 w = *(const GAS_ u32x2*)(baseb + off); h[bj][n][0] = __uint_as_float(w.x << 16); h[bj][n][1] = __uint_as_float(w.x & 0xffff0000u); h[bj][n][2] = __uint_as_float(w.y << 16); h[bj][n][3] = __uint_as_float(w.y & 0xffff0000u); } }
#pragma unroll
                for (int bj = 0; bj < 2; ++bj)
#pragma unroll
                    for (int n = 0; n < 2; ++n) { const size_t off = r * 1024 + col0 + bj * HALF + n * 16; const f32x4 v = h[bj][n] + acc[ai][bj][m][n];
                        s += (v[0] * v[0] + v[1] * v[1]) + (v[2] * v[2] + v[3] * v[3]);
                        if constexpr (!LAST) { u32x2 w; w.x = cvt_pk_bf16(v[0], v[1]); w.y = cvt_pk_bf16(v[2], v[3]); *(GAS_ u32x2*)(XN + off) = w; }
                        else *(GAS_ f32x4*)(H + off) = v; }
                if constexpr (!LAST) { s += __shfl_xor(s, 16); s += __shfl_xor(s, 32);
                    if (fq == 0) ((GAS_ float*)ssq)[r * 16 + u.pn * 4 + wc] = s; } }
    }
};
template <class Epi, class Sched, bool ALIGN_EPI, bool SP2, int KK, int LDA, int LDB>
__device__ __forceinline__ void gemm_phase(PG8_LAS unsigned char* lds, const Gemm g, const Sched& S, const Epi& E, int wave_id  ) {
    int lane_; asm volatile("v_mbcnt_lo_u32_b32 %0, -1, 0\n\tv_mbcnt_hi_u32_b32 %0, -1, %0" : "=&v"(lane_)); const int tid_ = wave_id * 64 + lane_;
    const int tid = tid_, wid = __builtin_amdgcn_readfirstlane(tid >> 6), lane = tid & 63, wr = wid >> 2, wc = wid & 3, fr = lane & 15, fq = lane >> 4;
    constexpr int K = KK, nt = K / BK;
    unsigned voffA[2], voffB[2];
#pragma unroll
    for (int i = 0; i < 2; ++i) { int R, C; stage_rc(tid * 16 + i * 8192, R, C); const int Rb = Epi::PERM ? ((R & ~31) + perm32(R & 31)) : R;
        voffA[i] = (unsigned)(R * LDA + C) * 2u; voffB[i] = (unsigned)(Rb * LDB + C) * 2u; }
    constexpr size_t kstep = (size_t)(BK * 2);
    constexpr size_t hstepA = (size_t)HALF * LDA * 2, hstepB = (size_t)HALF * LDB * 2;
    constexpr size_t tstepA = 2 * hstepA, tstepB = 2 * hstepB;
    const unsigned ldsw = (unsigned)wid * 1024u;
    const int aoff = lds_byte(wr * 64 + fr, fq * 8), boff = lds_byte(wc * 32 + fr, fq * 8);
#define PG8_SA(b, h) (((b) * 2 + (h)) * HTB)
#define PG8_SB(b, h) ((4 + (b) * 2 + (h)) * HTB)
#define PG8_STAGE(bufoff, gbase, voff) do { _Pragma("unroll") for (int _i = 0; _i < 2; ++_i) \
        __builtin_amdgcn_global_load_lds((const unsigned*)((const char*)(gbase) + (voff)[_i]), (PG8_LAS unsigned*)(lds + (bufoff) + ldsw + _i * 8192), 16, 0, 0); } while (0)
#define PG8_LDA(dst, b, h) do { _Pragma("unroll") for (int m = 0; m < 4; ++m) _Pragma("unroll") for (int k = 0; k < 2; ++k) dst[m][k] = *(const PG8_LAS bf16x8*)(lds + PG8_SA(b, h) + aoff + m * 2048 + k * 1024); } while (0)
#define PG8_LDB(dst, b, h) do { _Pragma("unroll") for (int n = 0; n < 2; ++n) _Pragma("unroll") for (int k = 0; k < 2; ++k) dst[n][k] = *(const PG8_LAS bf16x8*)(lds + PG8_SB(b, h) + boff + n * 2048 + k * 1024); } while (0)
#define PG8_MMA(ai, bj, At, Bt) do { __builtin_amdgcn_s_setprio(1); _Pragma("unroll") for (int m = 0; m < 4; ++m) _Pragma("unroll") for (int n = 0; n < 2; ++n) _Pragma("unroll") for (int k = 0; k < 2; ++k) \
        acc[ai][bj][m][n] = __builtin_amdgcn_mfma_f32_16x16x32_bf16(Bt[n][k], At[m][k], acc[ai][bj][m][n], 0, 0, 0); __builtin_amdgcn_s_setprio(0); } while (0)
#define PG8_WAIT_V(n) asm volatile("s_waitcnt vmcnt(" #n ")" ::: "memory")
#define PG8_WAIT_L(n) asm volatile("s_waitcnt lgkmcnt(" #n ")" ::: "memory")
#define PG8_BAR __builtin_amdgcn_s_barrier()
#define PG8_SCHED __builtin_amdgcn_sched_barrier(0)
    Unit cur, nxt; int ui = 0;
    if (!S.next(0, cur)) return;
    SW_BEGIN_N(pr, 120 + Epi::SWID)
    f32x4 acc[2][2][4][2];
#pragma unroll
    for (int a = 0; a < 2; ++a)
#pragma unroll
        for (int b = 0; b < 2; ++b)
#pragma unroll
            for (int m = 0; m < 4; ++m)
#pragma unroll
                for (int n = 0; n < 2; ++n) acc[a][b][m][n] = (f32x4){0.f, 0.f, 0.f, 0.f};
    bf16x8 At[4][2], B0[2][2], B1[2][2];
    const char* cA = (const char*)g.A + (size_t)cur.pm * tstepA; const char* cB = (const char*)g.Bt + (size_t)cur.pn * tstepB;
    S.a_ready(cur);
    if constexpr (SP2) {
        PG8_STAGE(PG8_SB(0, 0), cB, voffB); PG8_STAGE(PG8_SB(0, 1), cB + hstepB, voffB); PG8_STAGE(PG8_SA(0, 0), cA, voffA); PG8_STAGE(PG8_SA(0, 1), cA + hstepA, voffA);
        if (wr == 1) PG8_BAR;
        PG8_WAIT_V(2); PG8_BAR;
        PG8_STAGE(PG8_SB(1, 0), cB + kstep, voffB); PG8_STAGE(PG8_SA(1, 0), cA + kstep, voffA); PG8_STAGE(PG8_SB(1, 1), cB + hstepB + kstep, voffB);
        PG8_WAIT_V(6); PG8_BAR;
    } else {
        PG8_STAGE(PG8_SB(0, 0), cB, voffB); PG8_STAGE(PG8_SA(0, 0), cA, voffA); PG8_STAGE(PG8_SB(0, 1), cB + hstepB, voffB); PG8_STAGE(PG8_SA(0, 1), cA + hstepA, voffA);
        if (wr == 1) PG8_BAR;
        PG8_WAIT_V(4); PG8_BAR;
        PG8_STAGE(PG8_SB(1, 0), cB + kstep, voffB); PG8_STAGE(PG8_SA(1, 0), cA + kstep, voffA); PG8_STAGE(PG8_SB(1, 1), cB + hstepB + kstep, voffB);
        PG8_WAIT_V(6); PG8_BAR;
    }
#if defined(MK_SW_ID)
    unsigned char* sw_ws = (unsigned char*)(*(const PG8_LAS unsigned long long*)(lds + SW_WSSLOT)); const bool sw_on = SW_ON((int)blockIdx.x, wid);
#endif
    SW_END_N(pr, 120 + Epi::SWID, sw_on, sw_ws);
    for (;;) {
        const bool has_next = S.next(ui + 1, nxt);
        SW_BEGIN_N(kl, 100 + Epi::SWID)
        const char* nA = has_next ? (const char*)g.A + (size_t)nxt.pm * tstepA : cA; const char* nB = has_next ? (const char*)g.Bt + (size_t)nxt.pn * tstepB : cB;
        for (int t = 0; t < nt; t += 2) {
            const bool last = (t == nt - 2);
            const char* a1 = cA + (size_t)(t + 1) * kstep;
            const char* a2 = last ? nA : cA + (size_t)(t + 2) * kstep; const char* b2 = last ? nB : cB + (size_t)(t + 2) * kstep;
            const char* a3 = a2 + kstep; const char* b3 = b2 + kstep;
            if (last && has_next) S.a_ready(nxt);
            if constexpr (SP2) {
            PG8_LDB(B0, 0, 0); PG8_LDB(B1, 0, 1); PG8_SCHED; PG8_LDA(At, 0, 0); PG8_STAGE(PG8_SA(1, 1), a1 + hstepA, voffA);
            PG8_WAIT_V(8); PG8_WAIT_L(0); PG8_BAR; PG8_MMA(0, 0, At, B0); PG8_MMA(0, 1, At, B1); PG8_BAR; PG8_SCHED;
            PG8_LDA(At, 0, 1); PG8_STAGE(PG8_SB(0, 0), b2, voffB); PG8_STAGE(PG8_SB(0, 1), b2 + hstepB, voffB); PG8_STAGE(PG8_SA(0, 0), a2, voffA);
            PG8_WAIT_V(8); PG8_WAIT_L(0); PG8_BAR; PG8_MMA(1, 0, At, B0); PG8_MMA(1, 1, At, B1); PG8_BAR; PG8_SCHED;
            PG8_LDB(B0, 1, 0); PG8_LDB(B1, 1, 1); PG8_SCHED; PG8_LDA(At, 1, 0); PG8_STAGE(PG8_SA(0, 1), a2 + hstepA, voffA);
            PG8_WAIT_V(8); PG8_WAIT_L(0); PG8_BAR; PG8_MMA(0, 0, At, B0); PG8_MMA(0, 1, At, B1); PG8_BAR; PG8_SCHED;
            PG8_LDA(At, 1, 1); PG8_STAGE(PG8_SB(1, 0), b3, voffB); PG8_STAGE(PG8_SB(1, 1), b3 + hstepB, voffB); PG8_STAGE(PG8_SA(1, 0), a3, voffA);
            PG8_WAIT_V(8); PG8_WAIT_L(0); PG8_BAR; PG8_MMA(1, 0, At, B0); PG8_MMA(1, 1, At, B1); PG8_BAR; PG8_SCHED;
            } else {
            PG8_LDB(B0, 0, 0); PG8_SCHED; PG8_LDA(At, 0, 0); PG8_STAGE(PG8_SA(1, 1), a1 + hstepA, voffA);
            PG8_WAIT_L(8); PG8_BAR; PG8_WAIT_L(0); PG8_MMA(0, 0, At, B0); PG8_BAR; PG8_SCHED;
            PG8_LDB(B1, 0, 1); PG8_STAGE(PG8_SB(0, 0), b2, voffB);
            PG8_BAR; PG8_WAIT_L(0); PG8_MMA(0, 1, At, B1); PG8_BAR;
            PG8_LDA(At, 0, 1); PG8_STAGE(PG8_SA(0, 0), a2, voffA);
            PG8_BAR; PG8_WAIT_L(0); PG8_MMA(1, 0, At, B0); PG8_BAR; PG8_SCHED;
            PG8_STAGE(PG8_SB(0, 1), b2 + hstepB, voffB);
            PG8_WAIT_V(6); PG8_BAR; PG8_MMA(1, 1, At, B1); PG8_BAR;
            PG8_LDB(B0, 1, 0); PG8_SCHED; PG8_LDA(At, 1, 0); PG8_STAGE(PG8_SA(0, 1), a2 + hstepA, voffA);
            PG8_WAIT_L(8); PG8_BAR; PG8_WAIT_L(0); PG8_MMA(0, 0, At, B0); PG8_BAR; PG8_SCHED;
            PG8_LDB(B1, 1, 1); PG8_STAGE(PG8_SB(1, 0), b3, voffB);
            PG8_BAR; PG8_WAIT_L(0); PG8_MMA(0, 1, At, B1); PG8_BAR;
            PG8_LDA(At, 1, 1); PG8_STAGE(PG8_SA(1, 0), a3, voffA);
            PG8_BAR; PG8_WAIT_L(0); PG8_MMA(1, 0, At, B0); PG8_BAR; PG8_SCHED;
            PG8_STAGE(PG8_SB(1, 1), b3 + hstepB, voffB);
            PG8_WAIT_V(6); PG8_BAR; PG8_MMA(1, 1, At, B1); PG8_BAR;
            }
        }
        SW_END_N(kl, 100 + Epi::SWID, sw_on, sw_ws);
        SW_BEGIN_N(ep, 110 + Epi::SWID)
        if constexpr (ALIGN_EPI) { if (wr == 0) PG8_BAR; }
        if constexpr (!Epi::AFTER_DRAIN) { E(acc, cur, wr, wc, fr, fq); S.done(cur); }
        SW_END_N(ep, 110 + Epi::SWID, sw_on, sw_ws);
        if (!has_next) break;
#pragma unroll
        for (int a = 0; a < 2; ++a)
#pragma unroll
            for (int b = 0; b < 2; ++b)
#pragma unroll
                for (int m = 0; m < 4; ++m)
#pragma unroll
                    for (int n = 0; n < 2; ++n) acc[a][b][m][n] = (f32x4){0.f, 0.f, 0.f, 0.f};
        cur = nxt; cA = nA; cB = nB; ++ui;
        if constexpr (ALIGN_EPI) { if (wr == 1) PG8_BAR; }
    }
    SW_BEGIN_N(dr, 130 + Epi::SWID)
    PG8_WAIT_V(0);
    if constexpr (!ALIGN_EPI) { if (wr == 0) PG8_BAR; }
    PG8_BAR;
    if constexpr (Epi::AFTER_DRAIN) { E.fused(acc, cur, wr, wc, fr, fq, lds, wid, lane); S.done(cur); }
    SW_END_N(dr, 130 + Epi::SWID, sw_on, sw_ws);
#undef PG8_SA
#undef PG8_SB
#undef PG8_STAGE
#undef PG8_LDA
#undef PG8_LDB
#undef PG8_MMA
#undef PG8_WAIT_V
#undef PG8_WAIT_L
#undef PG8_BAR
#undef PG8_SCHED
}
}

constexpr int NWAVES = 8, NTHREADS = 512;
#ifndef MK_PER_PHASE
#define MK_PER_PHASE 0
#endif
constexpr int D = 1024, BATCH = 8, SEQ = 2048, M = BATCH * SEQ, DEPTH = 2;
constexpr int S5W = 512, S5H = 16, S5G = 32, S5P = 64;
constexpr int HYW = 1024, HYF = 4096, HYE = 33, HYN = 64;
constexpr int INC = 7168;
constexpr int NPHASE = 12;

constexpr size_t MiB = 1u << 20;
constexpr size_t WS_CTL = 0, CTL_ZERO_BYTES = 64 * 1024;
constexpr size_t WS_H2 = 1 * MiB;
constexpr size_t WS_LBAR = 2 * MiB;
constexpr size_t WS_BBT = 2 * MiB + 64 * 1024;
constexpr size_t WS_CT = WS_BBT + 512 * 1024;
constexpr size_t WS_W = 4 * MiB;
constexpr size_t W_IN = 0, W_GLU = 14 * MiB, W_BS5 = W_GLU + 512 * 1024, W_BHY = W_BS5 + 1 * MiB, W_OUT = W_BHY + 2 * MiB, W_LAYER = W_OUT + 2 * MiB;
constexpr size_t WS_SSQ = 43 * MiB;
constexpr size_t WS_X = 44 * MiB;
constexpr size_t WS_R1 = 76 * MiB, WS_R2 = 108 * MiB, WS_R3 = 140 * MiB, WS_R4 = 172 * MiB, WS_R5 = 204 * MiB, WS_R6 = 236 * MiB, WS_W3T = 252 * MiB  , WS_END = 254 * MiB;
static_assert(WS_W + 2 * W_LAYER <= WS_SSQ, "weights");
constexpr int LDS_BYTES = 163840 - 256;
constexpr int LDSCTL_OFF = LDS_BYTES - 512;

#define GAS __attribute__((address_space(1)))
#define LAS __attribute__((address_space(3)))
typedef unsigned short bf16;
typedef unsigned v4u __attribute__((ext_vector_type(4)));
typedef unsigned v2u __attribute__((ext_vector_type(2)));
typedef float f32x4 __attribute__((ext_vector_type(4)));
typedef float f32x2 __attribute__((ext_vector_type(2)));
typedef short bf16x8 __attribute__((ext_vector_type(8)));
typedef GAS unsigned gu32;
#define RLX_AGENT __ATOMIC_RELAXED, __HIP_MEMORY_SCOPE_AGENT
#define LDS_WAIT() asm volatile("s_waitcnt lgkmcnt(0)" ::: "memory")
#define VM_WAIT() asm volatile("s_waitcnt vmcnt(0)" ::: "memory")
__device__ __forceinline__ unsigned f2bf(float f) { unsigned u = __builtin_bit_cast(unsigned, f); return (u + 0x7fffu + ((u >> 16) & 1u)) >> 16; }
__device__ __forceinline__ unsigned pk2(float lo, float hi) { return f2bf(lo) | (f2bf(hi) << 16); }
__device__ __forceinline__ float bf2f(unsigned short h) { return __uint_as_float((unsigned)h << 16); }
using pg8::bf_lo; using pg8::bf_hi; using pg8::fast_sigmoid;

#define XB_TMO      128
#define XB_XCNT(j)  (256  + 64 * (j))
#define XB_XSUB(j)  (1280 + 64 * (j))
#define XB_XGEN(j)  (2304 + 64 * (j))
#define XB_TOP      3328
#define XB_TOPGEN   3392
#define XCD_BAR_WORDS 3456
#define XB_SPIN_CAP (1u << 18)
__device__ __forceinline__ unsigned xb_ld(unsigned* p)              { return __hip_atomic_load(p, __ATOMIC_RELAXED, __HIP_MEMORY_SCOPE_AGENT); }
__device__ __forceinline__ unsigned xb_add(unsigned* p, unsigned v) { return __hip_atomic_fetch_add(p, v, __ATOMIC_RELAXED, __HIP_MEMORY_SCOPE_AGENT); }
__device__ __forceinline__ unsigned xb_xcc_id() { return (unsigned)__builtin_amdgcn_s_getreg((3 << 11) | 20) & 0xFu; }
#define XB_SPIN(cond, bar) do { unsigned _sp = 0; while (cond) { __builtin_amdgcn_s_sleep(1); \
    if ((++_sp & 255u) == 0u) { if (xb_ld(&(bar)[XB_TMO])) break; if (_sp > XB_SPIN_CAP) { atomicAdd(&(bar)[XB_TMO], 1u); break; } } } } while (0)
struct XcdBarrier { unsigned* bar; unsigned x; volatile LAS unsigned* st; };
__device__ __forceinline__ int cur_lane() { int l; asm volatile("v_mbcnt_lo_u32_b32 %0, -1, 0\n\tv_mbcnt_hi_u32_b32 %0, -1, %0" : "=&v"(l)); return l; }
__device__ __forceinline__ XcdBarrier xcd_barrier_post(unsigned* bar, volatile LAS unsigned* st, bool leader) {
    XcdBarrier b; b.bar = bar; b.x = xb_xcc_id(); b.st = st;
    if (leader) (void)xb_add(&bar[XB_XCNT(b.x)], 1u);
    return b;
}
__device__ __forceinline__ void xcd_barrier_complete(unsigned* bar, unsigned x, unsigned& nloc, unsigned& nx) {
    const unsigned G = gridDim.x * gridDim.y * gridDim.z;
    unsigned sum, cnt, mine, sp = 0u;
    for (;;) {
        sum = 0u; cnt = 0u; mine = 0u;
#pragma unroll
        for (unsigned j = 0; j < 16; ++j) { const unsigned c = xb_ld(&bar[XB_XCNT(j)]); sum += c; cnt += (c > 0u) ? 1u : 0u; mine = (j == x) ? c : mine; }
        if (sum == G) break;
        __builtin_amdgcn_s_sleep(1);
        if ((++sp & 255u) == 0u) { if (xb_ld(&bar[XB_TMO])) break; if (sp > XB_SPIN_CAP) { atomicAdd(&bar[XB_TMO], 1u); break; } }
    }
    nloc = mine > 0u ? mine : 1u; nx = cnt > 0u ? cnt : 1u;
}
__device__ __forceinline__ void xcd_barrier(const XcdBarrier& b, int wave_id) {
    asm volatile("s_waitcnt vmcnt(0)" ::: "memory");
    __syncthreads();
    if (wave_id == 0 && cur_lane() == 0) {
        unsigned* bar = b.bar; asm volatile("" : "+s"(bar));
        __builtin_amdgcn_s_waitcnt(0);
        unsigned nloc = b.st[0], nx = b.st[1];
        if (nloc == 0u) { xcd_barrier_complete(bar, b.x, nloc, nx); b.st[0] = nloc; b.st[1] = nx; }
        const unsigned old = xb_add(&bar[XB_XSUB(b.x)], 1u);
        const unsigned gen = old / nloc;
        if (old + 1u == (gen + 1u) * nloc) {
            __builtin_amdgcn_fence(__ATOMIC_RELEASE, "agent");
            asm volatile("s_waitcnt vmcnt(0)" ::: "memory");
            const unsigned og = xb_add(&bar[XB_TOP], 1u);
            const unsigned tg = og / nx;
            if (og + 1u == (tg + 1u) * nx) xb_add(&bar[XB_TOPGEN], 1u);
            else XB_SPIN(xb_ld(&bar[XB_TOPGEN]) == tg, bar);
            __builtin_amdgcn_fence(__ATOMIC_ACQUIRE, "agent");
            xb_add(&bar[XB_XGEN(b.x)], 1u);
            asm volatile("s_waitcnt vmcnt(0)" ::: "memory");
        } else {
            XB_SPIN(xb_ld(&bar[XB_XGEN(b.x)]) == gen, bar);
            __builtin_amdgcn_fence(__ATOMIC_ACQUIRE, "agent");
            asm volatile("s_waitcnt vmcnt(0)" ::: "memory");
        }
    }
    __syncthreads();
}

struct Frame {
    LAS unsigned char* lds;
    int tid, lane, wave, G, bx;
    float* out; unsigned char* ws; unsigned long long swacc = 0;
    __device__ __forceinline__ const float* inp(int i) const {
        const LAS unsigned* t = (const LAS unsigned*)(lds + LDSCTL_OFF + 256) + 2 * i;
        const unsigned lo = __builtin_amdgcn_readfirstlane(t[0]), hi = __builtin_amdgcn_readfirstlane(t[1]);
        return (const float*)(((unsigned long long)hi << 32) | lo);
    }
};
__device__ __forceinline__ float wave_sum(float v) {
#pragma unroll
    for (int o = 1; o < 64; o <<= 1) v += __shfl_xor(v, o);
    return v;
}

__device__ __forceinline__ void p0_transpose_item(const float* W, int K, int N, bf16* WT, int k0, int n0, int drow, const float* kscale, LAS float* scr, int lane, bf16* WTlo = nullptr) {
    const int lr = lane >> 4, lc = (lane & 15) * 4;
    f32x4 v[16];
#pragma unroll
    for (int i = 0; i < 16; ++i) v[i] = *(const GAS f32x4*)(W + (size_t)(k0 + 4 * i + lr) * N + n0 + lc);
#pragma unroll
    for (int i = 0; i < 16; ++i) { const int kk = 4 * i + lr; f32x4 x = v[i]; if (kscale) x = x * kscale[k0 + kk];
        LAS float* d = scr + kk * 65 + lc; d[0] = x[0]; d[1] = x[1]; d[2] = x[2]; d[3] = x[3]; }
    LDS_WAIT(); asm volatile("" ::: "memory");
    const int c = lane & 7;
#pragma unroll
    for (int j = 0; j < 8; ++j) { const int n = (lane >> 3) + 8 * j; const LAS float* s = scr + (8 * c) * 65 + n;
        v4u o; o.x = pk2(s[0 * 65], s[1 * 65]); o.y = pk2(s[2 * 65], s[3 * 65]); o.z = pk2(s[4 * 65], s[5 * 65]); o.w = pk2(s[6 * 65], s[7 * 65]);
        *(GAS v4u*)(WT + (size_t)(drow + n) * K + k0 + 8 * c) = o;
        if (WTlo) { v4u q;
#define P0_LO2(a, b, hw) pk2((a) - __uint_as_float((hw) << 16), (b) - __uint_as_float((hw) & 0xffff0000u))
            q.x = P0_LO2(s[0 * 65], s[1 * 65], o.x); q.y = P0_LO2(s[2 * 65], s[3 * 65], o.y); q.z = P0_LO2(s[4 * 65], s[5 * 65], o.z); q.w = P0_LO2(s[6 * 65], s[7 * 65], o.w);
#undef P0_LO2
            *(GAS v4u*)(WTlo + (size_t)(drow + n) * K + k0 + 8 * c) = q; } }
    LDS_WAIT(); asm volatile("" ::: "memory");
}
__device__ __forceinline__ void p0_prologue(Frame& F) {
    LAS float* scr = (LAS float*)(F.lds + F.wave * 17408);
    const int gw = F.bx * NWAVES + F.wave, NGW = F.G * NWAVES, lane = F.lane;
    constexpr int I_IN = (D / 64) * (INC / 64), I_GLU = (S5W / 64) * (S5W / 64), I_BS5 = (S5W / 64) * (D / 64), I_BHY = (HYW / 64) * (D / 64), I_OUT = (D / 64) * (D / 64);
    constexpr int I_LAYER = I_IN + I_GLU + I_BS5 + I_BHY + I_OUT;
    const bool swon = SW_ON(F.bx, F.wave);
    SW_BEGIN(70, swon)
    for (int it = gw; it < DEPTH * I_LAYER; it += NGW) {
        const int l = it / I_LAYER; int r = it % I_LAYER; bf16* wl = (bf16*)(F.ws + WS_W + (size_t)l * W_LAYER);
        if (r < I_IN) { const int nblk = INC / 64, kb = r / nblk, nb = r % nblk, n0 = nb * 64;
            const int drow = (n0 >= 1024 && n0 < 5120) ? n0 - 1024 : (n0 < 1024 ? n0 + 4096 : n0);
            p0_transpose_item(F.inp(2) + (size_t)l * D * INC, D, INC, wl + W_IN / 2, kb * 64, n0, drow, F.inp(1) + l * D, scr, lane); continue; } r -= I_IN;
        if (r < I_GLU) { const int nblk = S5W / 64; p0_transpose_item(F.inp(11) + (size_t)l * S5W * S5W, S5W, S5W, wl + W_GLU / 2, (r / nblk) * 64, (r % nblk) * 64, (r % nblk) * 64, nullptr, scr, lane); continue; } r -= I_GLU;
        if (r < I_BS5) { const int nblk = D / 64; p0_transpose_item(F.inp(23) + (size_t)l * S5W * D, S5W, D, wl + W_BS5 / 2, (r / nblk) * 64, (r % nblk) * 64, (r % nblk) * 64, nullptr, scr, lane); continue; } r -= I_BS5;
        if (r < I_BHY) { const int nblk = D / 64; p0_transpose_item(F.inp(24) + (size_t)l * HYW * D, HYW, D, wl + W_BHY / 2, (r / nblk) * 64, (r % nblk) * 64, (r % nblk) * 64, nullptr, scr, lane); continue; } r -= I_BHY;
        { const int nblk = D / 64; p0_transpose_item(F.inp(25) + (size_t)l * D * D, D, D, wl + W_OUT / 2, (r / nblk) * 64, (r % nblk) * 64, (r % nblk) * 64, nullptr, scr, lane); }
    }
    SW_ENDA(70, swon, F.swacc);
    SW_BEGIN(71, swon)
    const int w3_first = NGW >= 1024 ? NGW - 640 : 0, tb_first = NGW >= 1024 ? NGW - 512 : 0;
    for (int it = gw - w3_first + (gw < w3_first ? NGW : 0); it < DEPTH * (HYF / 64); it += NGW) { const int l = it / (HYF / 64), nb = it % (HYF / 64); bf16* hi = (bf16*)(F.ws + WS_W3T + (size_t)l * MiB);
        p0_transpose_item(F.inp(20) + (size_t)l * HYN * HYF, HYN, HYF, hi, 0, nb * 64, nb * 64, nullptr, scr, lane); }
    SW_ENDA(71, swon, F.swacc);
    SW_BEGIN(72, swon)
    { bf16* X = (bf16*)(F.ws + WS_X); float* ssq = (float*)(F.ws + WS_SSQ);
      for (int m0 = 4 * gw; m0 < M; m0 += 4 * NGW) { f32x4 v[4][4]; float s[4];
#pragma unroll
        for (int r = 0; r < 4; ++r) { const GAS f32x4* xr = (const GAS f32x4*)(F.inp(0) + (size_t)(m0 + r) * D) + lane;
#pragma unroll
            for (int j = 0; j < 4; ++j) v[r][j] = xr[64 * j]; }
#pragma unroll
        for (int r = 0; r < 4; ++r) { float a = 0.f;
#pragma unroll
            for (int j = 0; j < 4; ++j) a += (v[r][j].x * v[r][j].x + v[r][j].y * v[r][j].y) + (v[r][j].z * v[r][j].z + v[r][j].w * v[r][j].w);
            s[r] = wave_sum(a);
            GAS unsigned long long* o8 = (GAS unsigned long long*)(X + (size_t)(m0 + r) * D) + lane;
#pragma unroll
            for (int j = 0; j < 4; ++j) o8[64 * j] = (unsigned long long)pk2(v[r][j].x, v[r][j].y) | ((unsigned long long)pk2(v[r][j].z, v[r][j].w) << 32);
            if (lane < 16) ssq[(size_t)(m0 + r) * 16 + lane] = lane == 0 ? s[r] : 0.f; } } }
    SW_ENDA(72, swon, F.swacc);
    SW_BEGIN(73, swon)
    {
      auto fsin = [](float x) __attribute__((always_inline)) { return __builtin_amdgcn_sinf(__builtin_amdgcn_fractf(x * 0.15915494309189535f)); };
      auto fcos = [](float x) __attribute__((always_inline)) { return __builtin_amdgcn_cosf(__builtin_amdgcn_fractf(x * 0.15915494309189535f)); };
      for (int it = gw; it < DEPTH * SEQ; it += NGW) { const int l = it / SEQ, t = it % SEQ, j = lane;
        const GAS float* w1 = (const GAS float*)(F.inp(15) + (size_t)l * HYE * HYN); const GAS float* b1 = (const GAS float*)(F.inp(16) + l * HYN); const GAS float* fr = (const GAS float*)(F.inp(17) + l * HYN);
        const GAS float* w2 = (const GAS float*)(F.inp(18) + (size_t)l * HYN * HYN); const GAS float* b2 = (const GAS float*)(F.inp(19) + l * HYN);
        float f = 0.f;
        if (j == 0) f = (float)t / (float)(SEQ - 1);
        else if (j < 33) { const int bi = (j - 1) & 15; const float band = 1e-4f + (float)bi * ((15.f - 1e-4f) / 15.f); const float ang = band * (float)t * (float)(2.0 * 3.14159265358979323846 / SEQ); f = j < 17 ? fcos(ang) : -fsin(ang); }
        float a = b1[j]; const float frj = fr[j];
        { float wv[HYE];
#pragma unroll
          for (int i = 0; i < HYE; ++i) wv[i] = w1[i * HYN + j];
#pragma unroll
          for (int i = 0; i < HYE; ++i) a += __int_as_float(__builtin_amdgcn_readlane(__float_as_int(f), i)) * wv[i]; }
        const float h1 = fsin(frj * a);
        float c = b2[j];
        { float wv[HYN];
#pragma unroll
          for (int i = 0; i < HYN; ++i) wv[i] = w2[i * HYN + j];
#pragma unroll
          for (int i = 0; i < HYN; ++i) c += __int_as_float(__builtin_amdgcn_readlane(__float_as_int(h1), i)) * wv[i]; }
        const float hv = fsin(frj * c); const unsigned hh = f2bf(hv);
        bf16* H2H = (bf16*)(F.ws + WS_H2 + (size_t)l * 512 * 1024);
        H2H[(size_t)t * HYN + j] = (bf16)hh; } }
    SW_ENDA(73, swon, F.swacc);
    SW_BEGIN(74, swon)
    { float* LB = (float*)(F.ws + WS_LBAR); bf16* BBT = (bf16*)(F.ws + WS_BBT); bf16* CT = (bf16*)(F.ws + WS_CT);
      for (int qi = gw - tb_first + (gw < tb_first ? NGW : 0); qi < DEPTH * 2 * S5G * 4; qi += NGW) { const int q = qi >> 2, h0 = (qi & 3) * 4, p = lane; const int i = q * S5P + p;
        const float dt = expf(((const GAS float*)F.inp(5))[q]); const float lr = ((const GAS float*)F.inp(3))[i], li = ((const GAS float*)F.inp(4))[i]; const float mag = expf(lr * dt), ang = li * dt;
        const float br = mag * cosf(ang), bi = mag * sinf(ang); if (h0 == 0) { LB[2 * i] = br; LB[2 * i + 1] = bi; }
        const float nr = br - 1.f, ni = bi, den = lr * lr + li * li; const float kr = (nr * lr + ni * li) / den, ki = (ni * lr - nr * li) / den;
        const f32x4 xr4 = *(const GAS f32x4*)(F.inp(6) + (size_t)i * S5H + h0), xi4 = *(const GAS f32x4*)(F.inp(7) + (size_t)i * S5H + h0);
        bf16* rowr = BBT + ((size_t)q * 128 + 2 * p) * 16; bf16* rowi = rowr + 16;
        v2u wr2, wi2; wr2.x = pk2(kr * xr4[0] - ki * xi4[0], kr * xr4[1] - ki * xi4[1]); wr2.y = pk2(kr * xr4[2] - ki * xi4[2], kr * xr4[3] - ki * xi4[3]);
        wi2.x = pk2(kr * xi4[0] + ki * xr4[0], kr * xi4[1] + ki * xr4[1]); wi2.y = pk2(kr * xi4[2] + ki * xr4[2], kr * xi4[3] + ki * xr4[3]);
        *(GAS v2u*)(rowr + h0) = wr2; *(GAS v2u*)(rowi + h0) = wi2;
        const float* cre = F.inp(8) + (size_t)q * S5H * S5P; const float* cim = F.inp(9) + (size_t)q * S5H * S5P;
        float cr[4], ci[4];
#pragma unroll
        for (int hh = 0; hh < 4; ++hh) { cr[hh] = ((const GAS float*)cre)[(h0 + hh) * S5P + p]; ci[hh] = ((const GAS float*)cim)[(h0 + hh) * S5P + p]; }
#pragma unroll
        for (int hh = 0; hh < 4; ++hh) *(GAS unsigned*)(CT + ((size_t)q * 16 + h0 + hh) * 128 + 2 * p) = pk2(cr[hh], -ci[hh]); } }
    SW_ENDA(74, swon, F.swacc);
    SW_FLUSH(swon, F.ws, F.swacc);
}


constexpr int S5_YB = 0, S5_CH = 65536, S5_CHB = 8704, S5_SEND = S5_CH + 8 * S5_CHB;
__device__ __forceinline__ float gelu_tanh_fast(float x) {
    const float z = 0.7978845608028654f * (x + 0.044715f * x * x * x);
    const float e = __builtin_amdgcn_exp2f(2.0f * 1.4426950408889634f * z);
    const float th = 1.0f - 2.0f * __builtin_amdgcn_rcpf(e + 1.0f);
    return 0.5f * x * (1.0f + th);
}
template <int DIR, bool EMIT>
__device__ __forceinline__ void s5_pass(Frame& F, const bf16* Ub  , int tlo  , float ar, float ai, float& sr, float& si,
                                        const bf16x8 (&bbf)[8], const bf16x8 (&ctf)[4], const bf16x8& ddf, LAS unsigned char* ch, LAS unsigned char* yb, bf16* YGb) {
    const int lane = F.lane, fr = lane & 15, fq = lane >> 4; const bool swon = SW_ON(F.bx, F.wave);
    auto load_u = [&](int tc0) -> bf16x8 { int row = tc0 + fr; asm volatile("" : "+v"(row));
        return *(const GAS bf16x8*)(Ub + (size_t)row * 1024 + 8 * (fq & 1)); };
    auto tcb_of = [&](int ci) -> int { return DIR ? tlo + 32 * (7 - ci) : tlo + 32 * ci; };
    bf16x8 ufr[2][2];
#pragma unroll
    for (int i = 0; i < 2; ++i)
#pragma unroll
        for (int k = 0; k < 2; ++k) ufr[i][k] = load_u(tcb_of(i) + 16 * k);
#pragma unroll 1
    for (int cb = 0; cb < 4; ++cb)
#pragma unroll
    for (int ci2 = 0; ci2 < 2; ++ci2) { const int ci = 2 * cb + ci2; const int tcb = tcb_of(ci);
        bf16x8 uf[2];
#pragma unroll
        for (int k = 0; k < 2; ++k) uf[k] = ufr[ci2][k];
        if (ci + 2 < 8) {
#pragma unroll
            for (int k = 0; k < 2; ++k) ufr[ci2][k] = load_u(tcb_of(ci + 2) + 16 * k); }
        SW_BEGIN(10, swon)
#pragma unroll
        for (int k = 0; k < 2; ++k)
#pragma unroll
            for (int j = 0; j < 8; ++j) { f32x4 a = {0.f, 0.f, 0.f, 0.f}; a = __builtin_amdgcn_mfma_f32_16x16x32_bf16(bbf[j], uf[k], a, 0, 0, 0);
                v2u w; w.x = pg8::cvt_pk_bf16(a[0], a[1]); w.y = pg8::cvt_pk_bf16(a[2], a[3]); *(LAS v2u*)(ch + (16 * k + fr) * 264 + (16 * j + 4 * fq) * 2) = w; }
        LDS_WAIT();
        SW_END(10, swon, F.ws);
        SW_BEGIN(11, swon)
        unsigned xw[32];
#pragma unroll
        for (int tt = 0; tt < 32; ++tt) xw[tt] = *(const LAS unsigned*)(ch + tt * 264 + 4 * lane);
        LDS_WAIT();
        SW_END(11, swon, F.ws);
        SW_BEGIN(12, swon)
        unsigned spk[32];
        {
            const f32x2 A1 = {ar, ar}, A2 = {-ai, ai}; f32x2 S = {sr, si};
#pragma unroll
            for (int i = 0; i < 32; ++i) { const int tt = DIR ? 31 - i : i;
                const f32x2 X = {bf_lo(xw[tt]), bf_hi(xw[tt])};
                const f32x2 T = __builtin_elementwise_fma(A1, S, X);
                S = __builtin_elementwise_fma(A2, __builtin_shufflevector(S, S, 1, 0), T);
                if (EMIT) spk[tt] = pg8::cvt_pk_bf16(S.x, S.y); }
            sr = S.x; si = S.y; }
        SW_END(12, swon, F.ws);
        if (EMIT) {
            SW_BEGIN(13, swon)
            LAS unsigned* sb = (LAS unsigned*)ch;
#pragma unroll
            for (int tt = 0; tt < 32; ++tt) sb[tt * 68 + lane] = spk[tt];
            LDS_WAIT();
            SW_END(13, swon, F.ws);
            SW_BEGIN(14, swon)
            f32x4 y[2];
#pragma unroll
            for (int k = 0; k < 2; ++k) { y[k] = (f32x4){0.f, 0.f, 0.f, 0.f};
#pragma unroll
                for (int ks = 0; ks < 4; ++ks) { const bf16x8 sf = *(const LAS bf16x8*)(ch + (16 * k + fr) * 272 + ks * 64 + fq * 16); y[k] = __builtin_amdgcn_mfma_f32_16x16x32_bf16(ctf[ks], sf, y[k], 0, 0, 0); } }
            LDS_WAIT();
            asm volatile("" :: "v"(y[0]), "v"(y[1]));
            SW_END(14, swon, F.ws);
            SW_BEGIN(15, swon)
#pragma unroll
            for (int k = 0; k < 2; ++k) {
                LAS v2u* ybp = (LAS v2u*)(yb + (size_t)(tcb + 16 * k + fr) * 32 + 8 * fq);
                if (DIR == 0) { v2u w; w.x = pg8::cvt_pk_bf16(y[k][0], y[k][1]); w.y = pg8::cvt_pk_bf16(y[k][2], y[k][3]); *ybp = w; }
                else { y[k] = __builtin_amdgcn_mfma_f32_16x16x32_bf16(ddf, uf[k], y[k], 0, 0, 0);
                    const v2u f = *ybp; const float o0 = gelu_tanh_fast(y[k][0] + bf_lo(f.x)), o1 = gelu_tanh_fast(y[k][1] + bf_hi(f.x)), o2 = gelu_tanh_fast(y[k][2] + bf_lo(f.y)), o3 = gelu_tanh_fast(y[k][3] + bf_hi(f.y));
                    v2u w; w.x = pg8::cvt_pk_bf16(o0, o1); w.y = pg8::cvt_pk_bf16(o2, o3);
                    *(GAS v2u*)(YGb + (size_t)(tcb + 16 * k + fr) * 1024 + 4 * fq) = w; } }
            SW_END(15, swon, F.ws);
        }
        __builtin_amdgcn_sched_barrier(0);
    }
}
__device__ __forceinline__ void s5_item(Frame& F, int l, int b, int g, bool dry = false) {
    const int lane = F.lane, fr = lane & 15, fq = lane >> 4, seg = F.wave;
    bf16* U = (bf16*)(F.ws + WS_R5) + (size_t)b * SEQ * 1024 + g * 16;
    LAS unsigned char* ch = F.lds + S5_CH + seg * S5_CHB; LAS unsigned char* yb = F.lds + S5_YB;
    LAS f32x2* send = (LAS f32x2*)(F.lds + S5_SEND); const bool swon = SW_ON(F.bx, F.wave);
    SW_BEGIN(1, swon)
#pragma unroll 1
    for (int dir = 0; dir < 2; ++dir) {
        SW_BEGIN(4, swon)
        const int q = (l * 2 + dir) * S5G + g;
        const float ar = ((const GAS float*)(F.ws + WS_LBAR))[(size_t)(q * S5P + lane) * 2], ai = ((const GAS float*)(F.ws + WS_LBAR))[(size_t)(q * S5P + lane) * 2 + 1];
        bf16x8 bbf[8], ctf[4], ddf; const bf16x8 zero8 = {0, 0, 0, 0, 0, 0, 0, 0};
        const bf16* BBT = (const bf16*)(F.ws + WS_BBT) + (size_t)q * 128 * 16; const bf16* CT = (const bf16*)(F.ws + WS_CT) + (size_t)q * 16 * 128;
#pragma unroll
        for (int j = 0; j < 8; ++j) bbf[j] = fq < 2 ? *(const GAS bf16x8*)(BBT + (16 * j + fr) * 16 + 8 * fq) : zero8;
#pragma unroll
        for (int ks = 0; ks < 4; ++ks) ctf[ks] = *(const GAS bf16x8*)(CT + fr * 128 + 32 * ks + 8 * fq);
        { const short dv = (short)f2bf(((const GAS float*)F.inp(10))[l * S5W + g * 16 + fr]); ddf = zero8;
#pragma unroll
          for (int jj = 0; jj < 8; ++jj) if (8 * fq + jj == fr) ddf[jj] = dv; }
        const int tlo = dir ? SEQ - 256 * (seg + 1) : 256 * seg;
        float sr = 0.f, si = 0.f;
#ifndef MK_S5DRY_MODE
#define MK_S5DRY_MODE 0
#endif
        SW_END(4, swon, F.ws);
        SW_BEGIN(2, swon)
        if (!(dry && MK_S5DRY_MODE == 2)) { if (dir == 0) s5_pass<0, false>(F, U, tlo, ar, ai, sr, si, bbf, ctf, ddf, ch, yb, U); else s5_pass<1, false>(F, U, tlo, ar, ai, sr, si, bbf, ctf, ddf, ch, yb, U); }
        SW_END(2, swon, F.ws);
        SW_BEGIN(5, swon)
        send[seg * 64 + lane] = (f32x2){sr, si};
        LDS_WAIT(); __syncthreads();
        SW_END(5, swon, F.ws);
        SW_BEGIN(6, swon)
        float pr = ar, pi = ai;
#pragma unroll
        for (int k = 0; k < 8; ++k) { const float nr = pr * pr - pi * pi, ni = 2.f * pr * pi; pr = nr; pi = ni; }
        sr = 0.f; si = 0.f;
        for (int k = 0; k < seg; ++k) { const f32x2 e = send[k * 64 + lane]; const float nr = pr * sr - pi * si + e.x, ni = pr * si + pi * sr + e.y; sr = nr; si = ni; }
        bf16* YGo = dry ? (bf16*)(F.ws + WS_R6) + (size_t)(b & 1) * SEQ * 1024 + g * 16 : U;
        SW_END(6, swon, F.ws);
        SW_BEGIN(3, swon)
        if (!(dry && MK_S5DRY_MODE == 1)) { if (dir == 0) s5_pass<0, true>(F, U, tlo, ar, ai, sr, si, bbf, ctf, ddf, ch, yb, YGo); else s5_pass<1, true>(F, U, tlo, ar, ai, sr, si, bbf, ctf, ddf, ch, yb, YGo); }
        SW_END(3, swon, F.ws);
        SW_BEGIN(7, swon)
        LDS_WAIT(); __syncthreads();
        SW_END(7, swon, F.ws);
    }
    SW_END(1, swon, F.ws);
}

constexpr int HY_WX = 0, HY_WXB = 8704, HY_KF = 8 * HY_WXB, HY_KFO = 33 * 64 * 8, HY_KFCH = 2 * HY_KFO, HY_RED = HY_KF + 2 * HY_KFCH, HY_RAWROW = 4128;
static_assert(HY_RED + 256 <= LDSCTL_OFF && 4 * 2048 * 4 <= HY_KFCH && 2 * HY_RAWROW <= HY_WXB, "hyena LDS map");
#define C64_LIST 1.000000000e+00f, 9.951847267e-01f, 9.807852804e-01f, 9.569403357e-01f, 9.238795325e-01f, 8.819212643e-01f, 8.314696123e-01f, 7.730104534e-01f, 7.071067812e-01f, 6.343932842e-01f, 5.555702330e-01f, 4.713967368e-01f, 3.826834324e-01f, 2.902846773e-01f, 1.950903220e-01f, 9.801714033e-02f, 0.0f, -9.801714033e-02f, -1.950903220e-01f, -2.902846773e-01f, -3.826834324e-01f, -4.713967368e-01f, -5.555702330e-01f, -6.343932842e-01f, -7.071067812e-01f, -7.730104534e-01f, -8.314696123e-01f, -8.819212643e-01f, -9.238795325e-01f, -9.569403357e-01f, -9.807852804e-01f, -9.951847267e-01f, -1.000000000e+00f, -9.951847267e-01f, -9.807852804e-01f, -9.569403357e-01f, -9.238795325e-01f, -8.819212643e-01f, -8.314696123e-01f, -7.730104534e-01f, -7.071067812e-01f, -6.343932842e-01f, -5.555702330e-01f, -4.713967368e-01f, -3.826834324e-01f, -2.902846773e-01f, -1.950903220e-01f, -9.801714033e-02f, 0.0f, 9.801714033e-02f, 1.950903220e-01f, 2.902846773e-01f, 3.826834324e-01f, 4.713967368e-01f, 5.555702330e-01f, 6.343932842e-01f, 7.071067812e-01f, 7.730104534e-01f, 8.314696123e-01f, 8.819212643e-01f, 9.238795325e-01f, 9.569403357e-01f, 9.807852804e-01f, 9.951847267e-01f
__host__ __device__ constexpr int rev6(int s) { return ((s >> 4) & 3) | (s & 12) | ((s & 3) << 4); }

template <bool INV> __device__ __forceinline__ void r4(float& x0r, float& x0i, float& x1r, float& x1i, float& x2r, float& x2i, float& x3r, float& x3i) {
    const float t0r = x0r + x2r, t0i = x0i + x2i, t1r = x0r - x2r, t1i = x0i - x2i, t2r = x1r + x3r, t2i = x1i + x3i, t3r = x1r - x3r, t3i = x1i - x3i;
    x0r = t0r + t2r; x0i = t0i + t2i; x2r = t0r - t2r; x2i = t0i - t2i;
    if (!INV) { x1r = t1r + t3i; x1i = t1i - t3r; x3r = t1r - t3i; x3i = t1i + t3r; }
    else      { x1r = t1r - t3i; x1i = t1i + t3r; x3r = t1r + t3i; x3i = t1i - t3r; }
}
constexpr float C64T[64] = { C64_LIST };
template <int... Is, class Fn> __device__ __forceinline__ void static_for_impl(std::integer_sequence<int, Is...>, Fn&& f) { (f(std::integral_constant<int, Is>{}), ...); }
template <int N, class Fn> __device__ __forceinline__ void static_for(Fn&& f) { static_for_impl(std::make_integer_sequence<int, N>{}, f); }
template <bool INV, int E> __device__ __forceinline__ void twc(float& xr, float& xi) {
    constexpr int e = E & 63;
    if constexpr (e == 0) { return; }
    else if constexpr (e == 16) { const float tr = xr, ti = xi; if (!INV) { xr = ti; xi = -tr; } else { xr = -ti; xi = tr; } }
    else if constexpr (e == 32) { xr = -xr; xi = -xi; }
    else if constexpr (e == 48) { const float tr = xr, ti = xi; if (!INV) { xr = -ti; xi = tr; } else { xr = ti; xi = -tr; } }
    else {
        constexpr float c = C64T[e], sn = C64T[(e + 48) & 63], wi = INV ? sn : -sn;
        constexpr unsigned cb = __builtin_bit_cast(unsigned, c), wb = __builtin_bit_cast(unsigned, wi), nwb = wb ^ 0x80000000u;
        const float tr = xr, ti = xi; float a, b;
        asm("v_mul_f32 %0, %1, %2" : "=v"(a) : "i"(cb), "v"(tr));
        asm("v_fmac_f32 %0, %1, %2" : "+v"(a) : "i"(nwb), "v"(ti));
        asm("v_mul_f32 %0, %1, %2" : "=v"(b) : "i"(wb), "v"(tr));
        asm("v_fmac_f32 %0, %1, %2" : "+v"(b) : "i"(cb), "v"(ti));
        xr = a; xi = b;
    }
}
#define SFOR(N, I, ...) static_for<N>([&](auto I##_) __attribute__((always_inline)) { constexpr int I = decltype(I##_)::value; __VA_ARGS__ })
template <bool INV, bool ZH = false> __device__ __forceinline__ void dft64(float (&re)[64], float (&im)[64]) {
    if constexpr (!INV) {
        if constexpr (ZH) { SFOR(16, bc, const float ar = re[bc], ai = im[bc], br = re[bc + 16], bi = im[bc + 16];
                                 re[bc] = ar + br; im[bc] = ai + bi; re[bc + 32] = ar - br; im[bc + 32] = ai - bi; re[bc + 16] = ar + bi; im[bc + 16] = ai - br; re[bc + 48] = ar - bi; im[bc + 48] = ai + br;); }
        else SFOR(16, bc, r4<false>(re[bc], im[bc], re[bc + 16], im[bc + 16], re[bc + 32], im[bc + 32], re[bc + 48], im[bc + 48]););
        SFOR(48, i, constexpr int p = 1 + i / 16; constexpr int bc = i % 16; twc<false, bc * p>(re[16 * p + bc], im[16 * p + bc]););
        __builtin_amdgcn_sched_barrier(0);
        SFOR(16, i, constexpr int s = 16 * (i / 4) + (i % 4); r4<false>(re[s], im[s], re[s + 4], im[s + 4], re[s + 8], im[s + 8], re[s + 12], im[s + 12]););
        SFOR(64, i, constexpr int q = (i >> 2) & 3; constexpr int c = i & 3; twc<false, 4 * c * q>(re[i], im[i]););
        __builtin_amdgcn_sched_barrier(0);
        SFOR(16, pq, constexpr int s = 4 * pq; r4<false>(re[s], im[s], re[s + 1], im[s + 1], re[s + 2], im[s + 2], re[s + 3], im[s + 3]););
    } else {
        SFOR(16, pq, constexpr int s = 4 * pq; r4<true>(re[s], im[s], re[s + 1], im[s + 1], re[s + 2], im[s + 2], re[s + 3], im[s + 3]););
        SFOR(64, i, constexpr int q = (i >> 2) & 3; constexpr int c = i & 3; twc<true, 4 * c * q>(re[i], im[i]););
        __builtin_amdgcn_sched_barrier(0);
        SFOR(16, i, constexpr int s = 16 * (i / 4) + (i % 4); r4<true>(re[s], im[s], re[s + 4], im[s + 4], re[s + 8], im[s + 8], re[s + 12], im[s + 12]););
        SFOR(48, i, constexpr int p = 1 + i / 16; constexpr int bc = i % 16; twc<true, bc * p>(re[16 * p + bc], im[16 * p + bc]););
        __builtin_amdgcn_sched_barrier(0);
        SFOR(16, bc, r4<true>(re[bc], im[bc], re[bc + 16], im[bc + 16], re[bc + 32], im[bc + 32], re[bc + 48], im[bc + 48]););
    }
    __builtin_amdgcn_sched_barrier(0);
}
__device__ __forceinline__ void wtrans(float (&v)[64], LAS float* wx, int lane, bool swon = false, unsigned long long* wsp = nullptr) {
    SW_BEGIN(40, swon)
#pragma unroll
    for (int i = 0; i < 32; ++i) { const auto r = __builtin_amdgcn_permlane32_swap(__float_as_uint(v[i]), __float_as_uint(v[32 + i]), false, false); v[i] = __uint_as_float(r[0]); v[32 + i] = __uint_as_float(r[1]); }
    __builtin_amdgcn_sched_barrier(0);
    SW_ENDA(40, swon, *wsp);
    const int rd = (lane & 31) * 68 + (lane >> 5) * 32;
#pragma unroll
    for (int step = 0; step < 2; ++step) {
        asm volatile("" ::: "memory");
        SW_BEGIN(41, swon)
#pragma unroll
        for (int i = 0; i < 32; ++i) wx[i * 68 + lane] = v[32 * step + i];
        asm volatile("s_waitcnt lgkmcnt(0)" ::: "memory");
        SW_ENDA(41, swon, *wsp);
        SW_BEGIN(42, swon)
#pragma unroll
        for (int i4 = 0; i4 < 8; ++i4) { const f32x4 q = *(const LAS f32x4*)(wx + rd + 4 * i4);
#pragma unroll
            for (int e = 0; e < 4; ++e) v[32 * step + 4 * i4 + e] = q[e]; }
        asm volatile("s_waitcnt lgkmcnt(0)" ::: "memory");
        SW_ENDA(42, swon, *wsp);
    }
}
template <int K> __device__ __forceinline__ void hy_turn(int pw) {
    const int hi = (pw ^ K) & 1;
    asm volatile("s_setprio 0\n\ts_cmp_eq_u32 %0, 0\n\ts_cbranch_scc1 1f\n\ts_setprio 1\n1:" :: "s"(hi) : "scc");
}
template <bool ZH = false> __device__ __forceinline__ void wfft_fwd(float (&re)[64], float (&im)[64], LAS float* wx, int lane, bool swon = false, unsigned long long* wsp = nullptr, int pw = -1) {
    SW_BEGIN(27, swon)
    if (pw >= 0) hy_turn<0>(pw);
    dft64<false, ZH>(re, im);
    SW_ENDA(27, swon, *wsp);
    SW_BEGIN(28, swon)
    { float f = (float)lane * (1.0f / 4096.0f); asm volatile("" : "+v"(f));
#pragma unroll
      for (int s = 1; s < 64; ++s) { const float a = (float)rev6(s) * f; const float c = __builtin_amdgcn_cosf(a), sn = __builtin_amdgcn_sinf(a);
          const float tr = re[s] * c + im[s] * sn, ti = im[s] * c - re[s] * sn; re[s] = tr; im[s] = ti; if ((s & 7) == 7) __builtin_amdgcn_sched_barrier(0); } }
    __builtin_amdgcn_sched_barrier(0);
    SW_ENDA(28, swon, *wsp);
    SW_BEGIN(29, swon)
    if (pw >= 0) hy_turn<1>(pw);
    wtrans(re, wx, lane, swon, wsp); wtrans(im, wx, lane, swon, wsp);
    __builtin_amdgcn_sched_barrier(0);
    SW_ENDA(29, swon, *wsp);
    if (pw >= 0) hy_turn<0>(pw);
    dft64<false>(re, im);
}
template <class Mid> __device__ __forceinline__ void wfft_inv(float (&re)[64], float (&im)[64], LAS float* wx, int lane, Mid&& mid, int pw) {
    hy_turn<0>(pw);
    dft64<true>(re, im);
    { float f = (float)rev6(lane) * (1.0f / 4096.0f); asm volatile("" : "+v"(f));
#pragma unroll
      for (int s = 1; s < 64; ++s) { const float a = (float)s * f; const float c = __builtin_amdgcn_cosf(a), sn = __builtin_amdgcn_sinf(a);
          const float tr = re[s] * c - im[s] * sn, ti = im[s] * c + re[s] * sn; re[s] = tr; im[s] = ti; if ((s & 7) == 7) __builtin_amdgcn_sched_barrier(0); } }
    __builtin_amdgcn_sched_barrier(0);
    hy_turn<1>(pw);
    wtrans(re, wx, lane); wtrans(im, wx, lane);
    __builtin_amdgcn_sched_barrier(0);
    mid();
    __builtin_amdgcn_sched_barrier(0);
    hy_turn<0>(pw);
    dft64<true>(re, im);
}
struct Stage2 { v4u a[4], b[4]; };
__device__ __forceinline__ void hy_load2a(Stage2& S, const bf16* row0, int lane) {
#pragma unroll
    for (int i = 0; i < 4; ++i) { const int q = lane + 64 * i; S.a[i] = *(const GAS v4u*)(row0 + 8 * q); }
}
__device__ __forceinline__ void hy_load2b(Stage2& S, const bf16* row0, int lane) {
#pragma unroll
    for (int i = 0; i < 4; ++i) { const int q = lane + 64 * i; S.b[i] = *(const GAS v4u*)(row0 + SEQ + 8 * q); }
}
__device__ __forceinline__ void hy_load2(Stage2& S, const bf16* row0, int lane) { hy_load2a(S, row0, lane); hy_load2b(S, row0, lane); }
__device__ __forceinline__ void hy_commit2(const Stage2& S, LAS unsigned char* wxb, int lane) {
    asm volatile("" ::: "memory");
#pragma unroll
    for (int i = 0; i < 4; ++i) { const int q = lane + 64 * i; *(LAS v4u*)(wxb + 16 + 16 * q) = S.a[i]; *(LAS v4u*)(wxb + HY_RAWROW + 16 + 16 * q) = S.b[i]; }
    if (lane < 4) { LAS unsigned short* row = (LAS unsigned short*)(wxb + (lane >> 1) * HY_RAWROW); row[(lane & 1) ? 8 + SEQ : 7] = 0; }
    asm volatile("" ::: "memory");
}
__device__ __forceinline__ float raw2(LAS unsigned char* wxb, int r, int t) { return bf2f(*(const LAS unsigned short*)(wxb + r * HY_RAWROW + 16 + 2 * t)); }
template <class Fn> __device__ __forceinline__ void hy_sconv(LAS unsigned char* wxb, int lane, float w0, float w1, float w2, float b, Fn&& f) {
    const unsigned p = (unsigned)((lane & 1) ^ 1);
    const unsigned s0 = 0x01000c0cu + 0x02020000u * p, s1 = s0 + 0x02020000u, s2 = s1 + 0x02020000u;
    LAS unsigned char* base = wxb + 16 + 4 * ((lane - 1) >> 1);
#pragma unroll
    for (int blk = 0; blk < 4; ++blk) {
        unsigned d[8][2][2];
        const LAS unsigned* q0 = (const LAS unsigned*)(base + 1024 * blk); const LAS unsigned* q1 = (const LAS unsigned*)(base + HY_RAWROW + 1024 * blk);
#pragma unroll
        for (int i = 0; i < 8; ++i) { d[i][0][0] = q0[32 * i]; d[i][0][1] = q0[32 * i + 1]; d[i][1][0] = q1[32 * i]; d[i][1][1] = q1[32 * i + 1]; }
        asm volatile("s_waitcnt lgkmcnt(0)" ::: "memory");
        __builtin_amdgcn_sched_barrier(0);
#pragma unroll
        for (int i = 0; i < 8; ++i) { float c[2];
#pragma unroll
            for (int r = 0; r < 2; ++r) { const float xm = __uint_as_float(__builtin_amdgcn_perm(d[i][r][1], d[i][r][0], s0)), x0 = __uint_as_float(__builtin_amdgcn_perm(d[i][r][1], d[i][r][0], s1)),
                                                      xp = __uint_as_float(__builtin_amdgcn_perm(d[i][r][1], d[i][r][0], s2)); c[r] = b + w0 * xm + w1 * x0 + w2 * xp; }
            f(8 * blk + i, c[0], c[1]); }
        __builtin_amdgcn_sched_barrier(0);
    }
}
__device__ __forceinline__ unsigned hilo_pack(float x0, float x1, unsigned& lo) {
    const unsigned h0 = f2bf(x0), h1 = f2bf(x1); lo = f2bf(x0 - __uint_as_float(h0 << 16)) | (f2bf(x1 - __uint_as_float(h1 << 16)) << 16); return h0 | (h1 << 16);
}
__device__ __forceinline__ void hy_filter_gen4(Frame& F, int l, int c0, LAS unsigned char* kf0, LAS float* red) {
    const bool swon0 = SW_ON(F.bx, F.wave) && (MK_SW_LAYER < 0 || l == MK_SW_LAYER);
    SW_BEGIN(45, swon0)
    int lane_ = F.lane; asm volatile("" : "+v"(lane_)); const int lane = lane_; const int fr = lane & 15, fq = lane >> 4, w = F.wave;
    const float* dec = F.inp(21) + (size_t)l * HYF;
    const bf16* H2H = (const bf16*)(F.ws + WS_H2 + (size_t)l * 512 * 1024);
    bf16x8 ah[2];
    { const int ch = c0 + (HYW / 4) * (fr >> 2), f4 = fr & 3, col = (f4 >> 1) * 2 * HYW + (f4 & 1) * HYW + ch;
      const bf16* whi = (const bf16*)(F.ws + WS_W3T + (size_t)l * MiB) + (size_t)col * HYN;
#pragma unroll
      for (int ks = 0; ks < 2; ++ks) ah[ks] = *(const GAS bf16x8*)(whi + 32 * ks + 8 * fq); }
    float dk[4];
#pragma unroll
    for (int r = 0; r < 4; ++r) dk[r] = fabsf(((const GAS float*)dec)[(r >> 1) * 2 * HYW + (r & 1) * HYW + c0 + (HYW / 4) * fq]);
    LAS unsigned short* stg = (LAS unsigned short*)kf0 + (size_t)fq * 4 * SEQ;
    float ss0 = 0.f, ss1 = 0.f;
    bf16x8 bh[16][2];
#pragma unroll
    for (int u = 0; u < 16; ++u)
#pragma unroll
        for (int ks = 0; ks < 2; ++ks) bh[u][ks] = *(const GAS bf16x8*)(H2H + (size_t)(256 * w + 16 * u + fr) * HYN + 32 * ks + 8 * fq);
    const bool swon = SW_ON(F.bx, F.wave);
    SW_ENDA(45, swon0, F.swacc);
    SW_BEGIN(31, swon)
    asm volatile("s_waitcnt vmcnt(0)" ::: "memory");
    SW_ENDA(31, swon, F.swacc);
    SW_BEGIN(43, swon)
#pragma unroll
    for (int u = 0; u < 16; ++u) { const int t = 256 * w + 16 * u + fr; f32x4 acc = {0.f, 0.f, 0.f, 0.f};
#pragma unroll
        for (int ks = 0; ks < 2; ++ks) acc = __builtin_amdgcn_mfma_f32_16x16x32_bf16(ah[ks], bh[u][ks], acc, 0, 0, 0);
        const float tn = (float)t * (1.0f / (float)(SEQ - 1));
#pragma unroll
        for (int r = 0; r < 4; ++r) { const unsigned hb = f2bf(acc[r] * (__expf(-tn * dk[r]) + 0.05f)); const float v = __uint_as_float(hb << 16);
            stg[r * SEQ + t] = (unsigned short)hb;
            const float sq = ((r & 1) && t == 0) ? 0.f : v * v; if (r < 2) ss0 += sq; else ss1 += sq; } }
    SW_ENDA(43, swon, F.swacc);
    SW_BEGIN(44, swon)
#pragma unroll
    for (int o = 1; o < 16; o <<= 1) { ss0 += __shfl_xor(ss0, o); ss1 += __shfl_xor(ss1, o); }
    if (fr == 0) { red[2 * fq] = ss0; red[2 * fq + 1] = ss1; }
    SW_ENDA(44, swon, F.swacc);
}
template <bool GLB> __device__ __forceinline__ void hy_filter_fft(Frame& F, float dpar0, float dpar1, LAS unsigned char* kfch, const LAS unsigned short* tp, float* kfg, const LAS float* red4, LAS float* wx, volatile LAS unsigned* cnt, unsigned cnt_want) {
    int lane_ = F.lane; asm volatile("" : "+v"(lane_)); const int lane = lane_;
    auto tap = [&](int idx) __attribute__((always_inline)) -> float { return __uint_as_float((unsigned)tp[idx] << 16); };
    float re[64], im[64]; const bool swon = SW_ON(F.bx, F.wave);
    SW_BEGIN(37, swon)
#pragma unroll
    for (int n1 = 0; n1 < 32; ++n1) { re[n1] = tap(64 * n1 + lane); im[n1] = tap(2 * SEQ + 64 * n1 + lane); }
#pragma unroll
    for (int n1 = 32; n1 < 64; ++n1) { const int t = 64 * (64 - n1) - lane; float a = tap(SEQ + t), b = tap(3 * SEQ + t); if (n1 == 32 && lane == 0) { a = 0.f; b = 0.f; } re[n1] = a; im[n1] = b; }
    float s0 = 0.f, s1 = 0.f;
#pragma unroll
    for (int w = 0; w < 8; ++w) { s0 += red4[8 * w]; s1 += red4[8 * w + 1]; }
    const float sc = 1.0f / 4096.0f; const float n0 = 0.5f * sc / sqrtf(s0 + 1e-6f), n1s = 0.5f * sc / sqrtf(s1 + 1e-6f);
    const float d0 = dpar0 * sc, d1 = dpar1 * sc;
    asm volatile("s_waitcnt vmcnt(0) lgkmcnt(0)" ::: "memory");
    if (lane == 0) __hip_atomic_fetch_add((LAS unsigned*)cnt, 1u, __ATOMIC_RELAXED, __HIP_MEMORY_SCOPE_WORKGROUP);
    SW_ENDA(37, swon, F.swacc);
    SW_BEGIN(38, swon)
    wfft_fwd(re, im, wx, lane);
    SW_ENDA(38, swon, F.swacc);
    SW_BEGIN(39, swon)
    if constexpr (!GLB) { while (*cnt < cnt_want) __builtin_amdgcn_s_sleep(2); }
    const int k1 = rev6(lane), lc = rev6((64 - k1) & 63);
    LAS f32x2* kf0 = (LAS f32x2*)kfch + k1; LAS f32x2* kf1 = (LAS f32x2*)(kfch + HY_KFO) + k1;
    GAS f32x2* kg0 = (GAS f32x2*)kfg + k1; GAS f32x2* kg1 = (GAS f32x2*)kfg + HY_KFO / 8 + k1;
#pragma unroll
    for (int kb = 0; kb < 4; ++kb) {
        const int klo = 8 * kb, kn = kb == 3 ? 9 : 8; float pr[9], pi[9];
#pragma unroll
        for (int j = 0; j < 9; ++j) if (j < kn) { const int sm = rev6(63 - (klo + j)); pr[j] = __shfl(re[sm], lc); pi[j] = __shfl(im[sm], lc); }
        asm volatile("s_waitcnt lgkmcnt(0)" ::: "memory");
        __builtin_amdgcn_sched_barrier(0);
#pragma unroll
        for (int j = 0; j < 9; ++j) if (j < kn) { const int k0 = klo + j, s = rev6(k0), sz = rev6((64 - k0) & 63);
            float qr = pr[j], qi = pi[j]; if (lane == 0) { qr = re[sz]; qi = im[sz]; }
            const float zr = re[s], zi = im[s];
            const f32x2 v0 = {(zr + qr) * n0 + d0, (zi - qi) * n0}, v1 = {(zi + qi) * n1s + d1, -(zr - qr) * n1s};
            if constexpr (GLB) { kg0[k0 * 64] = v0; kg1[k0 * 64] = v1; } else { kf0[k0 * 64] = v0; kf1[k0 * 64] = v1; } }
        __builtin_amdgcn_sched_barrier(0);
    }
    SW_ENDA(39, swon, F.swacc);
}
__device__ __forceinline__ unsigned hy_token(int l) { unsigned w_; asm volatile("s_add_u32 %0, %1, 1" : "=s"(w_) : "s"(l) : "scc"); return w_; }
__device__ __forceinline__ void hy_wave_main(Frame& F, int l, int c, int ws, LAS unsigned char* wxb, LAS unsigned char* kfch, Stage2& pre, const volatile LAS unsigned* kfflag, unsigned want, bool dry = false) {
    int lane_ = F.lane; asm volatile("" : "+v"(lane_)); const int lane = lane_; LAS float* wx = (LAS float*)wxb;
    const size_t rowoff = (size_t)c * M + (size_t)(2 * ws) * SEQ;
    const bf16* PV = (const bf16*)(F.ws + WS_R1) + rowoff; const bf16* PX1 = (const bf16*)(F.ws + WS_R2) + rowoff; const bf16* PX2 = (const bf16*)(F.ws + WS_R3) + rowoff;
    const bf16* GH = (const bf16*)(F.ws + WS_R4) + rowoff; bf16* OUT = (bf16*)(F.ws + WS_R1) + rowoff;
    const float* cw = F.inp(13) + (size_t)l * 3 * 3 * HYW; const float* cb = F.inp(14) + (size_t)l * 3 * HYW;
    float re[64], im[64]; const bool swon = SW_ON(F.bx, F.wave);
    SW_BEGIN(25, swon)
    hy_commit2(pre, wxb, lane);
    hy_load2a(pre, PX1, lane);
    { const float w0 = ((const GAS float*)cw)[c], w1 = ((const GAS float*)cw)[3 * HYW + c], w2 = ((const GAS float*)cw)[6 * HYW + c], b = ((const GAS float*)cb)[c];
      hy_sconv(wxb, lane, w0, w1, w2, b, [&](int n1, float c0, float c1) __attribute__((always_inline)) { re[n1] = c0; im[n1] = c1; }); }
    SW_ENDA(25, swon, F.swacc);
#pragma unroll 1
    for (int o = 0; o < 2; ++o) {
        int lane_o = F.lane; asm volatile("" : "+v"(lane_o));
        const int lane = lane_o; const int k1 = rev6(lane);
        asm volatile("s_waitcnt lgkmcnt(0)" ::: "memory");
        SW_BEGIN(21, swon)
        wfft_fwd<true>(re, im, wx, lane, swon, &F.swacc, F.wave >> 2);
        hy_turn<1>(F.wave >> 2);
        SW_ENDA(21, swon, F.swacc);
        { unsigned tmp_; const unsigned fa_ = (unsigned)(size_t)kfflag;
          asm volatile("1:\n\tds_read_b32 %0, %1\n\ts_waitcnt lgkmcnt(0)\n\tv_cmp_ne_u32_e32 vcc, %2, %0\n\ts_cbranch_vccz 2f\n\ts_sleep 2\n\ts_branch 1b\n2:"
                       : "=&v"(tmp_) : "v"(fa_), "s"(hy_token(l)) : "vcc", "memory"); }
        SW_BEGIN(22, swon)
        { const LAS unsigned char* bd = kfch + o * HY_KFO + k1 * 8; const LAS unsigned char* bm = kfch + o * HY_KFO + ((k1 ? 0 : 64) + ((64 - k1) & 63)) * 8;
#pragma unroll
          for (int sb = 0; sb < 64; sb += 16) {
              f32x2 kv[16];
#pragma unroll
              for (int j = 0; j < 16; ++j) { const int k0 = rev6(sb + j); kv[j] = k0 < 32 ? *(const LAS f32x2*)(bd + k0 * 512) : *(const LAS f32x2*)(bm + (63 - k0) * 512); }
              asm volatile("s_waitcnt lgkmcnt(0)" ::: "memory");
              __builtin_amdgcn_sched_barrier(0);
#pragma unroll
              for (int j = 0; j < 16; ++j) { const int s = sb + j, k0 = rev6(s);
                  if (k0 < 32) { const float tr = re[s] * kv[j].x - im[s] * kv[j].y, ti = re[s] * kv[j].y + im[s] * kv[j].x; re[s] = tr; im[s] = ti; }
                  else { const float tr = re[s] * kv[j].x + im[s] * kv[j].y, ti = im[s] * kv[j].x - re[s] * kv[j].y; re[s] = tr; im[s] = ti; } }
              __builtin_amdgcn_sched_barrier(0); } }
        __builtin_amdgcn_sched_barrier(0);
        SW_ENDA(22, swon, F.swacc);
        SW_BEGIN(23, swon)
        wfft_inv(re, im, wx, lane, [&]() __attribute__((always_inline)) { hy_load2b(pre, o == 0 ? PX1 : PX2, lane); }, F.wave >> 2);
        hy_turn<1>(F.wave >> 2);
        SW_ENDA(23, swon, F.swacc);
        SW_BEGIN(24, swon)
        hy_commit2(pre, wxb, lane);
        asm volatile("s_waitcnt lgkmcnt(0)" ::: "memory");
        hy_load2a(pre, o == 0 ? PX2 : GH, lane); if (o == 1) hy_load2b(pre, GH, lane);
        { const int xo = (o + 1) * HYW + c; const float w0 = ((const GAS float*)cw)[xo], w1 = ((const GAS float*)cw)[3 * HYW + xo], w2 = ((const GAS float*)cw)[6 * HYW + xo], b = ((const GAS float*)cb)[xo];
          hy_sconv(wxb, lane, w0, w1, w2, b, [&](int n1, float g0, float g1) __attribute__((always_inline)) { re[n1] *= g0; im[n1] *= g1; }); }
        SW_ENDA(24, swon, F.swacc);
    }
    SW_BEGIN(26, swon)
    int lane_g = F.lane; asm volatile("" : "+v"(lane_g));
    hy_commit2(pre, wxb, lane_g);
    if (!dry)
#pragma unroll
    for (int blk = 0; blk < 2; ++blk) {
        unsigned gq[16][2];
#pragma unroll
        for (int i = 0; i < 16; ++i) { const int t = 64 * (16 * blk + i) + lane_g; gq[i][0] = *(const LAS unsigned short*)(wxb + 16 + 2 * t); gq[i][1] = *(const LAS unsigned short*)(wxb + HY_RAWROW + 16 + 2 * t); }
        asm volatile("s_waitcnt lgkmcnt(0)" ::: "memory");
        __builtin_amdgcn_sched_barrier(0);
#pragma unroll
        for (int i = 0; i < 16; ++i) { const int n1 = 16 * blk + i, t = 64 * n1 + lane_g; const float g0 = __uint_as_float(gq[i][0] << 16), g1 = __uint_as_float(gq[i][1] << 16);
            ((GAS bf16*)OUT)[t] = (bf16)f2bf(re[n1] * g0 * fast_sigmoid(g0)); ((GAS bf16*)OUT)[SEQ + t] = (bf16)f2bf(im[n1] * g1 * fast_sigmoid(g1)); }
        __builtin_amdgcn_sched_barrier(0);
    }
    asm volatile("s_waitcnt lgkmcnt(0)" ::: "memory");
    __builtin_amdgcn_s_setprio(0);
    SW_ENDA(26, swon, F.swacc);
}
__device__ __forceinline__ void hy_quad(Frame& F, int l, int c0) {
    const int grp = F.wave >> 2, ws = F.wave & 3;
    LAS unsigned char* wxb = F.lds + HY_WX + F.wave * HY_WXB;
    LAS unsigned char* kf0 = F.lds + HY_KF; LAS unsigned char* kfch = kf0 + grp * HY_KFCH;
    LAS float* red = (LAS float*)(F.lds + HY_RED);
    float* kf2 = F.out + (size_t)F.bx * (2 * HY_KFCH / 4);
    const bool swon = SW_ON(F.bx, F.wave);
    SW_BEGIN(33, swon)
    float dpar0 = 0.f, dpar1 = 0.f;
    if (F.wave < 4) { const GAS float* dp = (const GAS float*)F.inp(22) + (size_t)l * 2 * HYW + c0 + (HYW / 4) * F.wave; dpar0 = dp[0]; dpar1 = dp[HYW]; }
    SW_BEGIN(30, swon)
    hy_filter_gen4(F, l, c0, kf0, red + 8 * F.wave);
    SW_ENDA(30, swon, F.swacc);
    SW_BEGIN(34, swon)
    LDS_WAIT(); __syncthreads();
    SW_ENDA(34, swon, F.swacc);
    Stage2 pre;
    SW_BEGIN(35, swon)
    volatile LAS unsigned* kfl = (volatile LAS unsigned*)(F.lds + LDSCTL_OFF) + 48;
    if (F.wave < 2) hy_filter_fft<false>(F, dpar0, dpar1, kf0 + F.wave * HY_KFCH, (const LAS unsigned short*)kf0 + (size_t)F.wave * 4 * SEQ, nullptr, red + 2 * F.wave, (LAS float*)wxb, kfl + 4, 4u * hy_token(l));
    else if (F.wave < 4) hy_filter_fft<true>(F, dpar0, dpar1, kf0, (const LAS unsigned short*)kf0 + (size_t)F.wave * 4 * SEQ, kf2 + (size_t)(F.wave - 2) * (HY_KFCH / 4), red + 2 * F.wave, (LAS float*)wxb, kfl + 4, 0u);
    if (F.wave < 4) { VM_WAIT(); LDS_WAIT(); kfl[F.wave] = hy_token(l); }
    hy_load2(pre, (const bf16*)(F.ws + WS_R1) + (size_t)(c0 + (HYW / 4) * grp) * M + (size_t)(2 * ws) * SEQ, cur_lane());
    SW_ENDA(35, swon, F.swacc);
#pragma unroll 1
    for (int rnd = 0; rnd < 2; ++rnd) {
        const int c = c0 + (HYW / 4) * (2 * rnd + grp);
        SW_BEGIN(20, swon)
        hy_wave_main(F, l, c, ws, wxb, kfch, pre, kfl + grp, 0u);
        SW_ENDA(20, swon, F.swacc);
        SW_BEGIN(36, swon)
        if (rnd == 0) {
            const int t_ = F.wave * 64 + cur_lane();
            { const unsigned w_ = hy_token(l); while (kfl[2] != w_ || kfl[3] != w_) __builtin_amdgcn_s_sleep(2); }
            v4u kv[9];
#pragma unroll
            for (int i = 0; i < 9; ++i) { const int q = t_ + 512 * i; kv[i] = (v4u){0u, 0u, 0u, 0u}; if (i < 8 || q < 2 * HY_KFCH / 16) kv[i] = *(const GAS v4u*)(kf2 + 4 * (size_t)q); }
            hy_load2(pre, (const bf16*)(F.ws + WS_R1) + (size_t)(c + 2 * (HYW / 4)) * M + (size_t)(2 * ws) * SEQ, t_ & 63);
            LDS_WAIT(); __syncthreads();
#pragma unroll
            for (int i = 0; i < 9; ++i) { const int q = t_ + 512 * i; if (i < 8 || q < 2 * HY_KFCH / 16) *(LAS v4u*)(kf0 + 16 * q) = kv[i]; }
        }
        LDS_WAIT(); __syncthreads();
        SW_ENDA(36, swon, F.swacc);
    }
    SW_ENDA(33, swon, F.swacc);
}

__device__ __forceinline__ void transpose_pass(Frame& F) {
    const bf16* src = (const bf16*)(F.ws + WS_R1); bf16* dst = (bf16*)(F.ws + WS_R2);
    LAS unsigned char* tile = F.lds + F.wave * 18432; const int lane = F.lane;
    constexpr int NGLU = (M / 256) * (S5W / 256);
    const bool split = F.G >= 2 * NGLU; if (split && F.bx < NGLU) return;
    const int gw = (split ? F.bx - NGLU : F.bx) * NWAVES + F.wave, NGW = (split ? F.G - NGLU : F.G) * NWAVES;
    constexpr int NTC = HYW / 64, NTT = M / 64;
    for (int it0 = 2 * gw; it0 < NTC * NTT; it0 += 2 * NGW) {
        v4u ld[2][8];
#pragma unroll
        for (int u = 0; u < 2; ++u) { const int it = it0 + u, c0 = (it % NTC) * 64, t0 = (it / NTC) * 64;
#pragma unroll
            for (int i = 0; i < 8; ++i) { const int q = lane + 64 * i, cr = q >> 3, ch = q & 7; ld[u][i] = *(const GAS v4u*)(src + (size_t)(c0 + cr) * M + t0 + 8 * ch); } }
#pragma unroll
        for (int u = 0; u < 2; ++u)
#pragma unroll
            for (int i = 0; i < 8; ++i) { const int q = lane + 64 * i, cr = q >> 3, ch = q & 7; *(LAS v4u*)(tile + u * 9216 + cr * 144 + 16 * ch) = ld[u][i]; }
        LDS_WAIT(); asm volatile("" ::: "memory");
#pragma unroll
        for (int u = 0; u < 2; ++u) { const int it = it0 + u, c0 = (it % NTC) * 64, t0 = (it / NTC) * 64;
#pragma unroll
            for (int i = 0; i < 8; ++i) { const int q = lane + 64 * i, tr = q >> 3, ch = q & 7;
                unsigned short e[8];
#pragma unroll
                for (int kk = 0; kk < 8; ++kk) e[kk] = *(const LAS unsigned short*)(tile + u * 9216 + (8 * ch + kk) * 144 + 2 * tr);
                v4u o; o.x = e[0] | ((unsigned)e[1] << 16); o.y = e[2] | ((unsigned)e[3] << 16); o.z = e[4] | ((unsigned)e[5] << 16); o.w = e[6] | ((unsigned)e[7] << 16);
                *(GAS v4u*)(dst + (size_t)(t0 + tr) * HYW + c0 + 8 * ch) = o; } }
        LDS_WAIT(); asm volatile("" ::: "memory");
    }
}
__device__ __forceinline__ void final_norm(Frame& F) {
    const int gw = F.bx * NWAVES + F.wave, NGW = F.G * NWAVES, lane = F.lane; const GAS f32x4* wv = (const GAS f32x4*)F.inp(26) + lane;
    f32x4 w[4];
#pragma unroll
    for (int j = 0; j < 4; ++j) w[j] = wv[64 * j];
    for (int m0 = 2 * gw; m0 < M; m0 += 2 * NGW) { f32x4 v[2][4];
#pragma unroll
        for (int r = 0; r < 2; ++r) { const GAS f32x4* xr = (const GAS f32x4*)(F.out + (size_t)(m0 + r) * D) + lane;
#pragma unroll
            for (int j = 0; j < 4; ++j) v[r][j] = xr[64 * j]; }
#pragma unroll
        for (int r = 0; r < 2; ++r) { float s = 0.f; GAS f32x4* xo = (GAS f32x4*)(F.out + (size_t)(m0 + r) * D) + lane;
#pragma unroll
            for (int j = 0; j < 4; ++j) s += (v[r][j].x * v[r][j].x + v[r][j].y * v[r][j].y) + (v[r][j].z * v[r][j].z + v[r][j].w * v[r][j].w);
            const float rs = 1.0f / sqrtf(wave_sum(s) * (1.0f / D) + 1e-6f);
#pragma unroll
            for (int j = 0; j < 4; ++j) xo[64 * j] = v[r][j] * rs * w[j]; } }
}

struct EpiOutNormB {
    static constexpr bool PERM = false, AFTER_DRAIN = false; static constexpr int SWID = 9;
    const bf16* xb; float* out; const float* nw; float* ssq; const XcdBarrier* bar; int wave; const unsigned char* swp;
    __device__ __forceinline__ void operator()(pg8::f32x4 (&acc)[2][2][4][2], const pg8::Unit& u, int wr, int wc, int fr, int fq) const {
        using pg8::f32x4; constexpr int HALF = pg8::HALF, BM = pg8::BM;
        const int lane = (fq << 4) | fr, row0 = u.pm * BM + wr * 64 + fr, col0 = u.pn * BM + wc * 32 + 4 * fq;
#pragma unroll
        for (int ai = 0; ai < 2; ++ai)
#pragma unroll
            for (int m = 0; m < 4; ++m) { const size_t r = (size_t)(row0 + ai * HALF + m * 16); float s = 0.f;
#pragma unroll
                for (int bj = 0; bj < 2; ++bj)
#pragma unroll
                    for (int n = 0; n < 2; ++n) { const v2u w = *(const GAS v2u*)(xb + r * 1024 + col0 + bj * HALF + n * 16);
                        f32x4 h = acc[ai][bj][m][n]; h[0] += __uint_as_float(w.x << 16); h[1] += __uint_as_float(w.x & 0xffff0000u); h[2] += __uint_as_float(w.y << 16); h[3] += __uint_as_float(w.y & 0xffff0000u); acc[ai][bj][m][n] = h;
                        s += (h[0] * h[0] + h[1] * h[1]) + (h[2] * h[2] + h[3] * h[3]); }
                s += __shfl_xor(s, 16); s += __shfl_xor(s, 32);
                if (fq == 0) ((GAS float*)ssq)[r * 16 + u.pn * 4 + wc] = s;
                asm volatile("" ::: "memory"); }
        xcd_barrier(*bar, wave);
        float swf = 1.0f;
#if defined(MK_SW_ID)
        { const unsigned long long cyc = __hip_atomic_load((unsigned long long*)swp, __ATOMIC_RELAXED, __HIP_MEMORY_SCOPE_AGENT); swf = 1.0f + sqrtf((float)cyc * (float)(MK_SW_SCALE)); }
#endif
        float mine[2];
#pragma unroll
        for (int i = 0; i < 2; ++i) { const int q = 2 * fq + i; mine[i] = pg8::rs_of(ssq, row0 + (q >> 2) * HALF + (q & 3) * 16); }
        f32x4 wv[2][2];
#pragma unroll
        for (int bj = 0; bj < 2; ++bj)
#pragma unroll
            for (int n = 0; n < 2; ++n) wv[bj][n] = *(const GAS f32x4*)(nw + col0 + bj * HALF + n * 16);
#pragma unroll
        for (int ai = 0; ai < 2; ++ai)
#pragma unroll
            for (int m = 0; m < 4; ++m) { const int q = ai * 4 + m; const float rs = swf * __shfl(mine[q & 1], ((q >> 1) << 4) | (lane & 15)); const size_t r = (size_t)(row0 + ai * HALF + m * 16);
#pragma unroll
                for (int bj = 0; bj < 2; ++bj)
#pragma unroll
                    for (int n = 0; n < 2; ++n) *(GAS f32x4*)(out + r * 1024 + col0 + bj * HALF + n * 16) = acc[ai][bj][m][n] * rs * wv[bj][n]; }
    }
};

struct Args { const float* in[27]; float* out; unsigned char* ws; int ph_lo, ph_hi; };
__global__ void __launch_bounds__(NTHREADS, 2) mk_fwd(Args args) {
    extern __shared__ __attribute__((aligned(16))) unsigned char lds[];
    { unsigned long long pc_; asm volatile("s_getpc_b64 %0" : "=s"(pc_));
      const char* cbase = (const char*)pc_; unsigned acc_ = 0u;
      for (int i = threadIdx.x; i < 3600; i += NTHREADS) acc_ |= *(const GAS unsigned*)(cbase + 64 * (size_t)i);
      asm volatile("" :: "v"(acc_)); }
    Frame F; F.lds = (LAS unsigned char*)lds; F.wave = __builtin_amdgcn_readfirstlane(threadIdx.x >> 6); F.tid = 0; F.lane = 0; F.G = gridDim.x; F.bx = blockIdx.x;
    F.out = args.out; F.ws = args.ws;
    volatile LAS unsigned* MISC = (volatile LAS unsigned*)(F.lds + LDSCTL_OFF);
    if (threadIdx.x < 64) MISC[threadIdx.x] = 0u;
    if (threadIdx.x == 64) { LAS unsigned long long* tab = (LAS unsigned long long*)(F.lds + LDSCTL_OFF + 256);
#pragma unroll
        for (int i = 0; i < 27; ++i) tab[i] = (unsigned long long)args.in[i]; tab[28] = (unsigned long long)args.ws; }
    __syncthreads();
    XcdBarrier bar; bar.bar = (unsigned*)(F.ws + WS_CTL) + 1024; bar.x = 0; bar.st = nullptr;
    if (!MK_PER_PHASE) bar = xcd_barrier_post((unsigned*)(F.ws + WS_CTL) + 1024, MISC + 8, threadIdx.x == 0);
    const int lo = args.ph_lo, hi = args.ph_hi;
#define IN(k) (lo <= (k) && (k) < hi)
#if defined(MK_TIMING)
    unsigned long long* TS = (unsigned long long*)(F.ws + WS_CTL + 32768);
#define STAMP(k) do { if (blockIdx.x == 0 && threadIdx.x == 0) __hip_atomic_store(&TS[k], (unsigned long long)__builtin_amdgcn_s_memrealtime(), __ATOMIC_RELAXED, __HIP_MEMORY_SCOPE_AGENT); } while (0)
#else
#define STAMP(k) do { } while (0)
#endif
#define SEAM(k) do { if (IN(k) && IN((k) + 1)) xcd_barrier(bar, F.wave); STAMP((k) + 1); } while (0)
    LAS unsigned char* ring = F.lds;
    STAMP(0);
#ifndef MK_ONLY
#define MK_ONLY -1
#endif
#define ON(k) (MK_ONLY < 0 || MK_ONLY == (k))
#define FRAME_P0(Fp) Frame Fp = F; { int l_ = cur_lane(); asm volatile("" : "+v"(l_)); Fp.lane = l_; Fp.tid = F.wave * 64 + l_; Fp.ws = wsl; }
#ifndef MK_REP0
#define MK_REP0 1
#endif
    const bool swk = SW_ON(F.bx, F.wave);
    { SW_BEGIN(60, swk)
#pragma unroll 1
    for (int rep0 = 0; rep0 < MK_REP0; ++rep0)
    if (ON(0) && IN(0)) { unsigned char* wsl = F.ws; FRAME_P0(Fp); p0_prologue(Fp); }
    SW_END(60, swk, F.ws); }
    { SW_BEGIN(80, swk) SEAM(0); SW_END(80, swk, F.ws); }
    bool fused_final = false;
#pragma unroll 1
    for (int l = 0; l < DEPTH; ++l) {
        const int pb = 1 + 5 * l;
        unsigned char* wsl = F.ws; asm volatile("" : "+s"(wsl));
#define WSL(off) (wsl + (off))
#define OPQ(p) asm volatile("" : "+s"(p))
#define FRAME_P(Fp) Frame Fp = F; { int l_ = cur_lane(); asm volatile("" : "+v"(l_)); Fp.lane = l_; Fp.tid = F.wave * 64 + l_; Fp.ws = wsl; }
        bf16* wl = (bf16*)WSL(WS_W + (size_t)l * W_LAYER);
        bf16* X = (bf16*)WSL(WS_X); float* ssq = (float*)WSL(WS_SSQ);
        bf16 *R1 = (bf16*)WSL(WS_R1), *R2 = (bf16*)WSL(WS_R2), *R3 = (bf16*)WSL(WS_R3), *R5 = (bf16*)WSL(WS_R5), *R6 = (bf16*)WSL(WS_R6);
#ifndef MK_REP1
#define MK_REP1 1
#define MK_REP12 1
#define MK_REP3 1
#define MK_REP4 1
#endif
#pragma unroll 1
        for (int rep12 = 0; rep12 < MK_REP12; ++rep12) {
        { SW_BEGIN(61, swk)
#pragma unroll 1
        for (int rep1 = 0; rep1 < MK_REP1; ++rep1)
        if (ON(1) && IN(pb)) {
            { pg8::Gemm g{wl + W_IN / 2, X, 4096, M, D, D, D}; pg8::StaticOrder S; S.init(4096, M, F.G, F.bx); pg8::EpiHT E{R1, M, ssq};
              pg8::gemm_phase<pg8::EpiHT, pg8::StaticOrder, true, true, 1024, 1024, 1024>(ring, g, S, E, F.wave); }
            OPQ(X); OPQ(wl);
            { pg8::Gemm g{X, wl + W_IN / 2 + (size_t)4096 * D, M, 1024, D, D, D}; pg8::StaticOrder S; S.init(M, 1024, F.G, F.bx); pg8::EpiRow<0> E{R5, 1024, ssq};
              pg8::gemm_phase<pg8::EpiRow<0>, pg8::StaticOrder, true, true, 1024, 1024, 1024>(ring, g, S, E, F.wave); }
        }
        SW_END(61, swk, F.ws); }
        { SW_BEGIN(81, swk) SEAM(pb); SW_END(81, swk, F.ws); }
        if (IN(pb + 1)) {
#if defined(MK_S5DRY)
            if (ON(2)) { FRAME_P(Fq); for (int it = F.bx; it < BATCH * S5G; it += F.G) s5_item(Fq, l, it / S5G, it % S5G, true); }
#endif
            { SW_BEGIN(62, swk) if (ON(2)) { FRAME_P(Fp); for (int it = F.bx; it < BATCH * S5G; it += F.G) s5_item(Fp, l, it / S5G, it % S5G); } SW_END(62, swk, F.ws); }
            { SW_BEGIN(63, swk) if (ON(3)) { FRAME_P(Fp); for (int c0 = F.bx; c0 < HYW / 4; c0 += F.G) hy_quad(Fp, l, c0); SW_FLUSH(SW_ON(Fp.bx, Fp.wave), Fp.ws, Fp.swacc); } SW_END(63, swk, F.ws); }
        }
        if (rep12 + 1 < MK_REP12) xcd_barrier(bar, F.wave);
        }
        { SW_BEGIN(82, swk) SEAM(pb + 1); SW_END(82, swk, F.ws); }
        { SW_BEGIN(64, swk)
#pragma unroll 1
        for (int rep3 = 0; rep3 < MK_REP3; ++rep3)
        if (ON(4) && IN(pb + 2)) {
            { pg8::Gemm g{X, wl + W_IN / 2 + (size_t)5120 * D, M, 2048, D, D, D}; pg8::StaticOrder S; S.init(M, 2048, F.G, F.bx); pg8::EpiRow<1> E{R3, 2048, ssq};
              pg8::gemm_phase<pg8::EpiRow<1>, pg8::StaticOrder, true, true, 1024, 1024, 1024>(ring, g, S, E, F.wave); }
            OPQ(R5); OPQ(wl);
            { pg8::Gemm g{R5, wl + W_GLU / 2, M, S5W, S5W, 1024, S5W}; pg8::StaticOrder S; S.init(M, S5W, F.G, F.bx); pg8::EpiGLU E{R6, S5W, R5, 1024, F.inp(12) + l * S5W};
              pg8::gemm_phase<pg8::EpiGLU, pg8::StaticOrder, true, true, 512, 1024, 512>(ring, g, S, E, F.wave); }
            __syncthreads();
            { SW_BEGIN(68, swk) { FRAME_P(Fp); transpose_pass(Fp); } SW_END(68, swk, F.ws); }
            __syncthreads();
        }
        SW_END(64, swk, F.ws); }
        { SW_BEGIN(83, swk) SEAM(pb + 2); SW_END(83, swk, F.ws); }
        { SW_BEGIN(65, swk)
#pragma unroll 1
        for (int rep4 = 0; rep4 < MK_REP4; ++rep4)
        if (ON(5) && IN(pb + 3)) {
            { pg8::Gemm g{R6, wl + W_BS5 / 2, M, D, S5W, S5W, S5W}; pg8::StaticOrder S; S.init(M, D, F.G, F.bx); pg8::EpiMerge<0> E{R1, D, R3, 2048, 0};
              pg8::gemm_phase<pg8::EpiMerge<0>, pg8::StaticOrder, true, true, 512, 512, 512>(ring, g, S, E, F.wave); }
            VM_WAIT(); __syncthreads();
            OPQ(R2); OPQ(wl);
            { pg8::Gemm g{R2, wl + W_BHY / 2, M, D, HYW, HYW, HYW}; pg8::StaticOrder S; S.init(M, D, F.G, F.bx); pg8::EpiMerge<1> E{R1, D, R3, 2048, 1024};
              pg8::gemm_phase<pg8::EpiMerge<1>, pg8::StaticOrder, true, true, 1024, 1024, 1024>(ring, g, S, E, F.wave); }
        }
        SW_END(65, swk, F.ws); }
        { SW_BEGIN(84, swk) SEAM(pb + 3); SW_END(84, swk, F.ws); }
        { SW_BEGIN(66, swk)
        if (ON(6) && IN(pb + 4)) {
            pg8::Gemm g{R1, wl + W_OUT / 2, M, D, D, D, D}; pg8::StaticOrder S; S.init(M, D, F.G, F.bx);
            if (l < DEPTH - 1) { pg8::EpiOut<false, false> E{nullptr, X, F.out, X, ssq};
                pg8::gemm_phase<pg8::EpiOut<false, false>, pg8::StaticOrder, true, true, 1024, 1024, 1024>(ring, g, S, E, F.wave); }
            else if (MK_PER_PHASE || F.G * 256 != (M / 256) * D) { pg8::EpiOut<false, true> E{nullptr, X, F.out, X, ssq};
                pg8::gemm_phase<pg8::EpiOut<false, true>, pg8::StaticOrder, true, true, 1024, 1024, 1024>(ring, g, S, E, F.wave); }
            else { EpiOutNormB E{X, F.out, F.inp(26), ssq, &bar, F.wave, wsl + WS_CTL + 48 * 1024};
                pg8::gemm_phase<EpiOutNormB, pg8::StaticOrder, true, true, 1024, 1024, 1024>(ring, g, S, E, F.wave); fused_final = true; }
        }
        if (l == 0) SW_END(66, swk, F.ws); }
        if (!fused_final) { SW_BEGIN(85, swk) SEAM(pb + 4); SW_END(85, swk, F.ws); }
    }
    if (ON(7) && IN(11) && !fused_final) { unsigned char* wsl = F.ws; FRAME_P0(Fp); final_norm(Fp); }
#if defined(MK_TIMING)
    xcd_barrier(bar, F.wave); STAMP(12); xcd_barrier(bar, F.wave);
    { const unsigned long long a0 = __hip_atomic_load(&TS[MK_TA0], __ATOMIC_RELAXED, __HIP_MEMORY_SCOPE_AGENT), a1 = __hip_atomic_load(&TS[MK_TA1], __ATOMIC_RELAXED, __HIP_MEMORY_SCOPE_AGENT);
      const unsigned long long b0 = __hip_atomic_load(&TS[MK_TB0], __ATOMIC_RELAXED, __HIP_MEMORY_SCOPE_AGENT), b1 = __hip_atomic_load(&TS[MK_TB1], __ATOMIC_RELAXED, __HIP_MEMORY_SCOPE_AGENT);
      const float ta = (float)(a1 - a0) * 0.01f, tb = (float)(b1 - b0) * 0.01f;
      const float c = sqrtf(ta * 0.1f);
      for (size_t i = (size_t)blockIdx.x * NTHREADS + threadIdx.x; i < (size_t)M * D; i += (size_t)gridDim.x * NTHREADS) F.out[i] = (i == 0) ? tb : c; }
#endif
#undef IN
#undef SEAM
}

#if defined(MK_DEBUG_HASH)
extern "C" void kernel_launch_dbg(void* const* d_in, void* d_out, void* d_ws, hipStream_t stream, int grid);
#endif
extern "C" void kernel_launch(void* const* d_in, const int* in_sizes, int n_in, void* d_out, int out_size, void* d_ws, size_t ws_size, hipStream_t stream) {
    static int grid = 0;
    if (grid == 0) {
        if (n_in != 27 || out_size != M * D || ws_size < WS_END) { fprintf(stderr, "kernel_launch: unexpected shapes (n_in %d out %d ws %zu)\n", n_in, out_size, ws_size); grid = -1; return; }
        int dev = 0, cus = 0, per_cu = 0;
        if (hipGetDevice(&dev) != hipSuccess || hipDeviceGetAttribute(&cus, hipDeviceAttributeMultiprocessorCount, dev) != hipSuccess) { grid = -1; return; }
        if (hipFuncSetAttribute((const void*)mk_fwd, hipFuncAttributeMaxDynamicSharedMemorySize, LDS_BYTES) != hipSuccess) { fprintf(stderr, "kernel_launch: hipFuncSetAttribute failed\n"); grid = -1; return; }
        if (hipOccupancyMaxActiveBlocksPerMultiprocessor(&per_cu, (const void*)mk_fwd, NTHREADS, LDS_BYTES) != hipSuccess || per_cu < 1) fprintf(stderr, "kernel_launch: occupancy query says %d\n", per_cu);
        (void)hipGetLastError();
        grid = cus;
    }
    if (grid < 0) return;
    (void)hipMemsetAsync((char*)d_ws + WS_CTL, 0, CTL_ZERO_BYTES, stream);
    Args a{};
    for (int i = 0; i < 27; ++i) a.in[i] = (const float*)d_in[i];
    a.out = (float*)d_out; a.ws = (unsigned char*)d_ws;
#if defined(MK_DEBUG_HASH)
    kernel_launch_dbg(d_in, d_out, d_ws, stream, grid);
#elif MK_PER_PHASE
    for (int p = 0; p < NPHASE; ++p) { a.ph_lo = p; a.ph_hi = p + 1; hipLaunchKernelGGL(mk_fwd, dim3(grid), dim3(NTHREADS), LDS_BYTES, stream, a); }
#else
    a.ph_lo = 0; a.ph_hi = NPHASE; hipLaunchKernelGGL(mk_fwd, dim3(grid), dim3(NTHREADS), LDS_BYTES, stream, a);
#endif
}

#if defined(MK_DEBUG_HASH)
__global__ void dbg_hash(const unsigned* p, size_t nwords, unsigned long long* out) {
    unsigned long long s = 0; for (size_t i = (size_t)blockIdx.x * blockDim.x + threadIdx.x; i < nwords; i += (size_t)gridDim.x * blockDim.x) s += p[i];
    atomicAdd(out, s);
}
__global__ void dbg_report(const unsigned long long* h, float* out, size_t n) {
    int first = -1; for (int p = 0; p < NPHASE && first < 0; ++p) for (int r = 0; r < 4; ++r) if (h[p * 4 + r] != h[NPHASE * 4 + p * 4 + r]) { first = p; break; }
    const float c = first < 0 ? 0.f : sqrtf((float)(first + 1));
    for (size_t i = (size_t)blockIdx.x * blockDim.x + threadIdx.x; i < n; i += (size_t)gridDim.x * blockDim.x) out[i] = c;
}
extern "C" void kernel_launch_dbg(void* const* d_in, void* d_out, void* d_ws, hipStream_t stream, int grid) {
    Args a{}; for (int i = 0; i < 27; ++i) a.in[i] = (const float*)d_in[i];
    a.out = (float*)d_out; a.ws = (unsigned char*)d_ws;
    unsigned long long* H = (unsigned long long*)((char*)d_ws + 253 * MiB);
    (void)hipMemsetAsync(H, 0, 2 * NPHASE * 4 * 8, stream);
    struct Reg { size_t off, len; bool out; };
    auto regs_of = [&](int p, Reg (&r)[4]) { for (int i = 0; i < 4; ++i) r[i] = Reg{0, 0, false};
        if (p == 0) { r[0] = Reg{1 * MiB, 1 * MiB, false}; r[1] = Reg{2 * MiB, 1 * MiB + 64 * 1024, false}; r[2] = Reg{4 * MiB, 39 * MiB, false}; r[3] = Reg{43 * MiB, 33 * MiB, false}; return; }
        if (p == 11) { r[0] = Reg{0, (size_t)M * D * 4, true}; return; }
        const int q = (p - 1) % 5;
        if (q == 0) { r[0] = Reg{WS_R1, 128 * MiB, false}; r[1] = Reg{WS_R5, 32 * MiB, false}; }
        if (q == 1) { r[0] = Reg{WS_R1, 32 * MiB, false}; r[1] = Reg{WS_R5, 32 * MiB, false}; }
        if (q == 2) { r[0] = Reg{WS_R3, 64 * MiB, false}; r[1] = Reg{WS_R6, 16 * MiB, false}; r[2] = Reg{WS_R2, 32 * MiB, false}; }
        if (q == 3) { r[0] = Reg{WS_R1, 32 * MiB, false}; }
        if (q == 4) { r[0] = Reg{0, (size_t)M * D * 4, true}; r[1] = Reg{WS_X, 32 * MiB, false}; r[2] = Reg{WS_SSQ, 1 * MiB, false}; } };
    for (int run = 0; run < 2; ++run) {
        if (run == 0) (void)hipMemsetAsync((char*)d_ws + 1 * MiB, 0xAA, 251 * MiB, stream);
        (void)hipMemsetAsync((char*)d_ws + WS_CTL, 0, CTL_ZERO_BYTES, stream);
        for (int p = 0; p < NPHASE; ++p) { a.ph_lo = p; a.ph_hi = p + 1; hipLaunchKernelGGL(mk_fwd, dim3(grid), dim3(NTHREADS), LDS_BYTES, stream, a);
            Reg r[4]; regs_of(p, r);
            for (int i = 0; i < 4; ++i) if (r[i].len) hipLaunchKernelGGL(dbg_hash, dim3(1024), dim3(256), 0, stream, (const unsigned*)((r[i].out ? (char*)d_out : (char*)d_ws) + r[i].off), r[i].len / 4, H + (run * NPHASE + p) * 4 + i); }
    }
    hipLaunchKernelGGL(dbg_report, dim3(1024), dim3(256), 0, stream, H, (float*)d_out, (size_t)M * D);
}
#endif
```
